# Optimizing an MI355X kernel written in HIP

```python
import jax
import jax.numpy as jnp
from jax import lax
import numpy as np


D_MODEL = 1024
BATCH = 8
SEQ = 4096
DEPTH = 1

CHUNK = 64
MEM_LEN = 256
HEAD_DIM = 64
CONV_CH = D_MODEL // 4
CONV_WIDTH = 31
SB_HEADS = D_MODEL // (2 * HEAD_DIM)
MEM_HEADS = 4
SB_WIDTH = SB_HEADS * HEAD_DIM
MEM_WIDTH = MEM_HEADS * HEAD_DIM
MIX_WIDTH = CONV_CH + SB_WIDTH + MEM_WIDTH
IN_WIDTH = 2 * CONV_CH + 3 * SB_WIDTH + MEM_WIDTH
Q_BLOCK = 128
PEER_HEADS = 8
N_KEYS = 128
N_EXPERTS = N_KEYS * N_KEYS
PEER_QUERY_DIM = 256
PEER_HALF = PEER_QUERY_DIM // 2
PEER_TOPK = 16
PEER_TOKEN_BLOCK = 128
EPS = 1e-6

kernel_name = 'hybrid_conv_stickbreak_peer_block'


def rms_norm(x, g):
    x32 = x.astype(jnp.float32)
    y = x32 * lax.rsqrt(jnp.mean(x32 * x32, axis=-1, keepdims=True) + EPS)
    return (y * g.astype(jnp.float32)).astype(x.dtype)


def layer_norm(x, g, b):
    x32 = x.astype(jnp.float32)
    mu = jnp.mean(x32, axis=-1, keepdims=True)
    var = jnp.mean(jnp.square(x32 - mu), axis=-1, keepdims=True)
    y = (x32 - mu) * lax.rsqrt(var + EPS) * g.astype(jnp.float32) + b.astype(jnp.float32)
    return y.astype(x.dtype)


def conformer_conv(a, gate, conv_w, conv_b, ln_g, ln_b):
    u = a * jax.nn.sigmoid(gate)
    rhs = conv_w[:, None, :].astype(u.dtype)
    y = lax.conv_general_dilated(u, rhs, window_strides=(1,), padding=[(CONV_WIDTH - 1, 0)],
                                 dimension_numbers=('NWC', 'WIO', 'NWC'),
                                 feature_group_count=CONV_CH)
    y = y + conv_b.astype(y.dtype)
    return jax.nn.silu(layer_norm(y, ln_g, ln_b))


def stick_breaking_attention(q, k, v):
    seq = q.shape[1]
    scale = HEAD_DIM ** -0.5
    qh = jnp.swapaxes(q, 1, 2).astype(jnp.float32)
    kh = jnp.swapaxes(k, 1, 2).astype(jnp.float32)
    vh = jnp.swapaxes(v, 1, 2).astype(jnp.float32)
    outs = []
    for i in range(seq // Q_BLOCK):
        q0 = i * Q_BLOCK
        kl = q0 + Q_BLOCK
        z = jnp.einsum('bhqd,bhkd->bhqk', qh[:, :, q0:kl], kh[:, :, :kl]) * scale
        t_pos = q0 + jnp.arange(Q_BLOCK)[:, None]
        s_pos = jnp.arange(kl)[None, :]
        mask = s_pos < t_pos
        log_1m = jnp.where(mask, jax.nn.log_sigmoid(-z), 0.0)
        after = lax.cumsum(log_1m, axis=3, reverse=True) - log_1m
        a = jnp.where(mask, jnp.exp(jax.nn.log_sigmoid(z) + after), 0.0)
        outs.append(jnp.einsum('bhqk,bhkd->bhqd', a, vh[:, :, :kl]))
    out = jnp.concatenate(outs, axis=2)
    return jnp.swapaxes(out, 1, 2).astype(q.dtype)


def memory_cross_attention(q, mem_n, w_kv, q_g, k_g):
    b, m, _ = mem_n.shape
    kv = (mem_n @ w_kv).reshape(b, m, 2, MEM_HEADS, HEAD_DIM)
    k = rms_norm(kv[:, :, 0], k_g)
    v = kv[:, :, 1]
    qn = rms_norm(q, q_g)
    scores = jnp.einsum('bshd,bmhd->bhsm', qn.astype(jnp.float32), k.astype(jnp.float32)) * (HEAD_DIM ** -0.5)
    p = jax.nn.softmax(scores, axis=-1)
    o = jnp.einsum('bhsm,bmhd->bshd', p, v.astype(jnp.float32))
    return o.astype(q.dtype)


def peer_ffn(h, w_q, keys1, keys2, u, v):
    b, n, d = h.shape
    blocks = h.reshape(-1, PEER_TOKEN_BLOCK, d)

    def one_block(hb):
        q = (hb @ w_q).reshape(PEER_TOKEN_BLOCK, PEER_HEADS, 2, PEER_HALF)
        s1 = jnp.einsum('thc,hnc->thn', q[:, :, 0], keys1)
        s2 = jnp.einsum('thc,hnc->thn', q[:, :, 1], keys2)
        v1, i1 = lax.top_k(s1, PEER_TOPK)
        v2, i2 = lax.top_k(s2, PEER_TOPK)
        n_cand = PEER_TOPK * PEER_TOPK
        cand_s = (v1[..., :, None] + v2[..., None, :]).reshape(PEER_TOKEN_BLOCK, PEER_HEADS, n_cand)
        cand_i = (i1[..., :, None] * N_KEYS + i2[..., None, :]).reshape(PEER_TOKEN_BLOCK, PEER_HEADS, n_cand)
        top_s, pos = lax.top_k(cand_s, PEER_TOPK)
        eidx = jnp.take_along_axis(cand_i, pos, axis=-1)
        gates = jax.nn.softmax(top_s.astype(jnp.float32), axis=-1).astype(hb.dtype)
        u_sel = u[eidx]
        act = jax.nn.gelu(jnp.einsum('thkd,td->thk', u_sel, hb), approximate=False)
        return jnp.einsum('thk,thkd->td', gates * act, v[eidx])

    out = lax.map(one_block, blocks)
    return out.reshape(b, n, d)


def setup_inputs(seed: int = 0) -> dict:
    key = jax.random.key(seed)
    ks = jax.random.split(key, 24)

    def nrm(k, shape, scale):
        return jax.random.normal(k, shape, jnp.float32) * scale

    def gain(k, shape):
        return 1.0 + 0.01 * jax.random.normal(k, shape, jnp.float32)

    L = DEPTH
    return {
        'x': nrm(ks[0], (BATCH, SEQ, D_MODEL), 1.0),
        'mem': nrm(ks[1], (BATCH, MEM_LEN, D_MODEL), 1.0),
        'attn_norm_g': gain(ks[2], (L, D_MODEL)),
        'w_in': nrm(ks[3], (L, D_MODEL, IN_WIDTH), D_MODEL ** -0.5),
        'conv_w': nrm(ks[4], (L, CONV_WIDTH, CONV_CH), CONV_WIDTH ** -0.5),
        'conv_b': nrm(ks[5], (L, CONV_CH), 0.01),
        'conv_ln_g': gain(ks[6], (L, CONV_CH)),
        'conv_ln_b': nrm(ks[7], (L, CONV_CH), 0.01),
        'sb_out_g': gain(ks[8], (L, SB_WIDTH)),
        'mem_norm_g': gain(ks[9], (L, D_MODEL)),
        'w_mem_kv': nrm(ks[10], (L, D_MODEL, 2 * MEM_WIDTH), D_MODEL ** -0.5),
        'q_norm_g': gain(ks[11], (L, HEAD_DIM)),
        'k_norm_g': gain(ks[12], (L, HEAD_DIM)),
        'mem_out_g': gain(ks[13], (L, MEM_WIDTH)),
        'w_out': nrm(ks[14], (L, MIX_WIDTH, D_MODEL), MIX_WIDTH ** -0.5),
        'ffn_norm_g': gain(ks[15], (L, D_MODEL)),
        'w_peer_q': nrm(ks[16], (L, D_MODEL, PEER_HEADS * PEER_QUERY_DIM), D_MODEL ** -0.5),
        'peer_keys1': nrm(ks[17], (L, PEER_HEADS, N_KEYS, PEER_HALF), PEER_HALF ** -0.5),
        'peer_keys2': nrm(ks[18], (L, PEER_HEADS, N_KEYS, PEER_HALF), PEER_HALF ** -0.5),
        'peer_u': nrm(ks[19], (L, N_EXPERTS, D_MODEL), D_MODEL ** -0.5),
        'peer_v': nrm(ks[20], (L, N_EXPERTS, D_MODEL), 0.5),
    }


def reference(x, mem, attn_norm_g, w_in, conv_w, conv_b, conv_ln_g, conv_ln_b, sb_out_g,
              mem_norm_g, w_mem_kv, q_norm_g, k_norm_g, mem_out_g, w_out, ffn_norm_g,
              w_peer_q, peer_keys1, peer_keys2, peer_u, peer_v):
    b, n, _ = x.shape
    splits = [CONV_CH, 2 * CONV_CH, 2 * CONV_CH + SB_WIDTH, 2 * CONV_CH + 2 * SB_WIDTH,
              2 * CONV_CH + 3 * SB_WIDTH]
    for l in range(DEPTH):
        h = rms_norm(x, attn_norm_g[l])
        proj = h @ w_in[l]
        c_a, c_gate, sb_q, sb_k, sb_v, m_q = jnp.split(proj, splits, axis=-1)
        conv_o = conformer_conv(c_a, c_gate, conv_w[l], conv_b[l], conv_ln_g[l], conv_ln_b[l])
        sb = stick_breaking_attention(sb_q.reshape(b, n, SB_HEADS, HEAD_DIM),
                                      sb_k.reshape(b, n, SB_HEADS, HEAD_DIM),
                                      sb_v.reshape(b, n, SB_HEADS, HEAD_DIM))
        sb_o = rms_norm(sb.reshape(b, n, SB_WIDTH), sb_out_g[l])
        mem_n = rms_norm(mem, mem_norm_g[l])
        mo = memory_cross_attention(m_q.reshape(b, n, MEM_HEADS, HEAD_DIM), mem_n, w_mem_kv[l],
                                    q_norm_g[l], k_norm_g[l])
        mem_o = rms_norm(mo.reshape(b, n, MEM_WIDTH), mem_out_g[l])
        mixed = jnp.concatenate([conv_o, sb_o, mem_o], axis=-1) @ w_out[l]
        x = x + mixed.astype(x.dtype)
        h2 = rms_norm(x, ffn_norm_g[l])
        x = x + peer_ffn(h2, w_peer_q[l], peer_keys1[l], peer_keys2[l], peer_u[l], peer_v[l]).astype(x.dtype)
    return x
```

```cpp
#include <hip/hip_runtime.h>
#include <cstdio>
#include <cstdint>
namespace pg8 {
#define PG8_LAS __attribute__((address_space(3)))
typedef unsigned short bf16_t;
typedef short bf16x8 __attribute__((ext_vector_type(8)));
typedef float f32x4 __attribute__((ext_vector_type(4)));
typedef unsigned u32x4 __attribute__((ext_vector_type(4)));
constexpr int BM = 256, BK = 64, HALF = 128, HTB = HALF * BK * 2  , STAGE_BYTES = 8 * HTB, NXCD = 8, WGM = 8;

__host__ __device__ __forceinline__ int lds_byte(int r, int c) { const int st = (r >> 4) * 2 + (c >> 5), rr = r & 15, cc = c & 31, ob = rr * 64 + cc * 2; return st * 1024 + (ob ^ (((ob >> 9) & 1) << 5)); }
__host__ __device__ __forceinline__ void stage_rc(int b, int& R, int& C) { const int st = b / 1024, sb = b % 1024, swz = sb ^ (((sb >> 9) & 1) << 5); R = (st >> 1) * 16 + swz / 64; C = (st & 1) * 32 + (swz % 64) / 2; }
__host__ __device__ __forceinline__ int perm32(int rho) { const int n = rho >> 4, i = rho & 15; return 8 * (i >> 2) + 4 * n + (i & 3); }

struct Unit { int pm, pn; };
struct Gemm { const bf16_t* A; const bf16_t* Bt; int M, N, K; };

struct StaticOrder {
    int nM, nN, nwg, G, c;
    __host__ __device__ void init(int M, int N, int G_, int c_) { nM = M / BM; nN = N / BM; nwg = nM * nN; G = G_; c = c_; }
    __host__ __device__ bool next(int i, Unit& u) const {
        const long L = (long)i * G + c; if (L >= nwg) return false;
        int wgid = (int)L; { const int q = nwg / NXCD, r = nwg % NXCD, xcd = wgid % NXCD, off = wgid / NXCD; wgid = (xcd < r ? xcd * (q + 1) : r * (q + 1) + (xcd - r) * q) + off; }
        const int nig = WGM * nN, gid = wgid / nig, fm = gid * WGM, gsz = (nM - fm) < WGM ? (nM - fm) : WGM;
        u.pm = fm + ((wgid % nig) % gsz); u.pn = (wgid % nig) / gsz; return true;
    }
    __device__ __forceinline__ void a_ready(const Unit&) const {}
    __device__ __forceinline__ void done(const Unit&) const {}
};

__device__ __forceinline__ unsigned cvt_pk_bf16(float lo, float hi) { unsigned r; asm volatile("v_cvt_pk_bf16_f32 %0, %1, %2" : "=v"(r) : "v"(lo), "v"(hi)); return r; }
typedef unsigned u32x2 __attribute__((ext_vector_type(2)));

struct EpiBf16 {
    static constexpr bool PERM = true, AFTER_DRAIN = false;
    bf16_t* O; int ldc;
    __device__ __forceinline__ void operator()(const f32x4 (&acc)[2][2][4][2], const Unit& u, int wr, int wc, int fr, int fq) const {
        const int row0 = u.pm * BM + wr * 64 + fr; const int col0 = u.pn * BM + wc * 32 + 8 * fq;
#pragma unroll
        for (int ai = 0; ai < 2; ++ai)
#pragma unroll
            for (int m = 0; m < 4; ++m) { bf16_t* rowp = O + (size_t)(row0 + ai * HALF + m * 16) * ldc + col0;
#pragma unroll
                for (int bj = 0; bj < 2; ++bj) { const f32x4 v0 = acc[ai][bj][m][0], v1 = acc[ai][bj][m][1];
                    u32x4 w; w.x = cvt_pk_bf16(v0[0], v0[1]); w.y = cvt_pk_bf16(v0[2], v0[3]); w.z = cvt_pk_bf16(v1[0], v1[1]); w.w = cvt_pk_bf16(v1[2], v1[3]);
                    *(u32x4*)(rowp + bj * HALF) = w; } }
    }
};
struct EpiBf16Row {
    static constexpr bool PERM = true, AFTER_DRAIN = false;
    bf16_t* O; int ldc; const float* ssq;
    __device__ __forceinline__ void operator()(const f32x4 (&acc)[2][2][4][2], const Unit& u, int wr, int wc, int fr, int fq) const {
        const int row0 = u.pm * BM + wr * 64 + fr; const int col0 = u.pn * BM + wc * 32 + 8 * fq;
#pragma unroll
        for (int ai = 0; ai < 2; ++ai)
#pragma unroll
            for (int m = 0; m < 4; ++m) { const int row = row0 + ai * HALF + m * 16; bf16_t* rowp = O + (size_t)row * ldc + col0;
                const float rs = 1.0f / sqrtf(__hip_atomic_load(ssq + row, __ATOMIC_RELAXED, __HIP_MEMORY_SCOPE_AGENT) * (1.0f / 1024.0f) + 1e-6f);
#pragma unroll
                for (int bj = 0; bj < 2; ++bj) { const f32x4 v0 = acc[ai][bj][m][0] * rs, v1 = acc[ai][bj][m][1] * rs;
                    u32x4 w; w.x = cvt_pk_bf16(v0[0], v0[1]); w.y = cvt_pk_bf16(v0[2], v0[3]); w.z = cvt_pk_bf16(v1[0], v1[1]); w.w = cvt_pk_bf16(v1[2], v1[3]);
                    *(u32x4*)(rowp + bj * HALF) = w; } }
    }
};
struct EpiResid {
    static constexpr bool PERM = false, AFTER_DRAIN = false;
    const float* x; float* out; bf16_t* xb; float* ssq; int ldc;
    __device__ __forceinline__ void operator()(const f32x4 (&acc)[2][2][4][2], const Unit& u, int wr, int wc, int fr, int fq) const {
        const int col0 = u.pn * BM + wc * 32 + 4 * fq;
#pragma unroll
        for (int ai = 0; ai < 2; ++ai)
#pragma unroll
            for (int m = 0; m < 4; ++m) { const int row = u.pm * BM + ai * HALF + wr * 64 + m * 16 + fr; const size_t off = (size_t)row * ldc + col0; float s = 0.f;
#pragma unroll
                for (int bj = 0; bj < 2; ++bj)
#pragma unroll
                    for (int n = 0; n < 2; ++n) { const f32x4 xv = *(const f32x4*)(x + off + bj * HALF + n * 16); const f32x4 o = xv + acc[ai][bj][m][n];
                        *(f32x4*)(out + off + bj * HALF + n * 16) = o; s += (o[0] * o[0] + o[1] * o[1]) + (o[2] * o[2] + o[3] * o[3]);
                        u32x2 w; w.x = cvt_pk_bf16(o[0], o[1]); w.y = cvt_pk_bf16(o[2], o[3]); *(u32x2*)(xb + off + bj * HALF + n * 16) = w; }
                s += __shfl_xor(s, 16); s += __shfl_xor(s, 32);
                if (fq == 0) unsafeAtomicAdd(ssq + row, s); }
    }
};

template <class Epi, class Sched, bool ALIGN_EPI = false, bool SP2 = false>
__device__ __forceinline__ void gemm_phase(PG8_LAS unsigned char* lds, const Gemm g, const Sched& S, const Epi& E) {
    const int tid = threadIdx.x, wid = __builtin_amdgcn_readfirstlane(tid >> 6), lane = tid & 63, wr = wid >> 2, wc = wid & 3, fr = lane & 15, fq = lane >> 4;
    const int K = g.K, nt = K / BK;
    unsigned voffA[2], voffB[2];
#pragma unroll
    for (int i = 0; i < 2; ++i) { int R, C; stage_rc(tid * 16 + i * 8192, R, C); const int Rb = Epi::PERM ? ((R & ~31) + perm32(R & 31)) : R;
        voffA[i] = (unsigned)(R * K + C) * 2u; voffB[i] = (unsigned)(Rb * K + C) * 2u; }
    const size_t kstep = (size_t)(BK * 2);
    const size_t hstep = (size_t)HALF * K * 2;
    const size_t tstep = 2 * hstep;
    const unsigned ldsw = (unsigned)wid * 1024u;
    const int aoff = lds_byte(wr * 64 + fr, fq * 8), boff = lds_byte(wc * 32 + fr, fq * 8);
#define PG8_SA(b, h) (((b) * 2 + (h)) * HTB)
#define PG8_SB(b, h) ((4 + (b) * 2 + (h)) * HTB)
#define PG8_STAGE(bufoff, gbase, voff) do { _Pragma("unroll") for (int _i = 0; _i < 2; ++_i) \
        __builtin_amdgcn_global_load_lds((const unsigned*)((const char*)(gbase) + (voff)[_i]), (PG8_LAS unsigned*)(lds + (bufoff) + ldsw + _i * 8192), 16, 0, 0); } while (0)
#define PG8_LDA(dst, b, h) do { _Pragma("unroll") for (int m = 0; m < 4; ++m) _Pragma("unroll") for (int k = 0; k < 2; ++k) dst[m][k] = *(const PG8_LAS bf16x8*)(lds + PG8_SA(b, h) + aoff + m * 2048 + k * 1024); } while (0)
#define PG8_LDB(dst, b, h) do { _Pragma("unroll") for (int n = 0; n < 2; ++n) _Pragma("unroll") for (int k = 0; k < 2; ++k) dst[n][k] = *(const PG8_LAS bf16x8*)(lds + PG8_SB(b, h) + boff + n * 2048 + k * 1024); } while (0)
#define PG8_MMA(ai, bj, At, Bt) do { __builtin_amdgcn_s_setprio(1); _Pragma("unroll") for (int m = 0; m < 4; ++m) _Pragma("unroll") for (int n = 0; n < 2; ++n) _Pragma("unroll") for (int k = 0; k < 2; ++k) \
        acc[ai][bj][m][n] = __builtin_amdgcn_mfma_f32_16x16x32_bf16(Bt[n][k], At[m][k], acc[ai][bj][m][n], 0, 0, 0); __builtin_amdgcn_s_setprio(0); } while (0)
#define PG8_WAIT_V(n) asm volatile("s_waitcnt vmcnt(" #n ")" ::: "memory")
#define PG8_WAIT_L(n) asm volatile("s_waitcnt lgkmcnt(" #n ")" ::: "memory")
#define PG8_BAR __builtin_amdgcn_s_barrier()
#define PG8_SCHED __builtin_amdgcn_sched_barrier(0)
    Unit cur, nxt; int ui = 0;
    if (!S.next(0, cur)) return;
    f32x4 acc[2][2][4][2];
#pragma unroll
    for (int a = 0; a < 2; ++a)
#pragma unroll
        for (int b = 0; b < 2; ++b)
#pragma unroll
            for (int m = 0; m < 4; ++m)
#pragma unroll
                for (int n = 0; n < 2; ++n) acc[a][b][m][n] = (f32x4){0.f, 0.f, 0.f, 0.f};
    bf16x8 At[4][2], B0[2][2], B1[2][2];
    const char* cA = (const char*)g.A + (size_t)cur.pm * tstep; const char* cB = (const char*)g.Bt + (size_t)cur.pn * tstep;
    S.a_ready(cur);
    if constexpr (SP2) {
        PG8_STAGE(PG8_SB(0, 0), cB, voffB); PG8_STAGE(PG8_SB(0, 1), cB + hstep, voffB); PG8_STAGE(PG8_SA(0, 0), cA, voffA); PG8_STAGE(PG8_SA(0, 1), cA + hstep, voffA);
        if (wr == 1) PG8_BAR;
        PG8_WAIT_V(2); PG8_BAR;
        PG8_STAGE(PG8_SB(1, 0), cB + kstep, voffB); PG8_STAGE(PG8_SA(1, 0), cA + kstep, voffA); PG8_STAGE(PG8_SB(1, 1), cB + hstep + kstep, voffB);
        PG8_WAIT_V(6); PG8_BAR;
    } else {
        PG8_STAGE(PG8_SB(0, 0), cB, voffB); PG8_STAGE(PG8_SA(0, 0), cA, voffA); PG8_STAGE(PG8_SB(0, 1), cB + hstep, voffB); PG8_STAGE(PG8_SA(0, 1), cA + hstep, voffA);
        if (wr == 1) PG8_BAR;
        PG8_WAIT_V(4); PG8_BAR;
        PG8_STAGE(PG8_SB(1, 0), cB + kstep, voffB); PG8_STAGE(PG8_SA(1, 0), cA + kstep, voffA); PG8_STAGE(PG8_SB(1, 1), cB + hstep + kstep, voffB);
        PG8_WAIT_V(6); PG8_BAR;
    }
    for (;;) {
        const bool has_next = S.next(ui + 1, nxt);
        const char* nA = has_next ? (const char*)g.A + (size_t)nxt.pm * tstep : cA; const char* nB = has_next ? (const char*)g.Bt + (size_t)nxt.pn * tstep : cB;
        for (int t = 0; t < nt; t += 2) {
            const bool last = (t == nt - 2);
            const char* a1 = cA + (size_t)(t + 1) * kstep;
            const char* a2 = last ? nA : cA + (size_t)(t + 2) * kstep; const char* b2 = last ? nB : cB + (size_t)(t + 2) * kstep;
            const char* a3 = a2 + kstep; const char* b3 = b2 + kstep;
            if (last && has_next) S.a_ready(nxt);
            if constexpr (SP2) {
            PG8_LDB(B0, 0, 0); PG8_LDB(B1, 0, 1); PG8_SCHED; PG8_LDA(At, 0, 0); PG8_STAGE(PG8_SA(1, 1), a1 + hstep, voffA);
            PG8_WAIT_V(8); PG8_WAIT_L(0); PG8_BAR; PG8_MMA(0, 0, At, B0); PG8_MMA(0, 1, At, B1); PG8_BAR; PG8_SCHED;
            PG8_LDA(At, 0, 1); PG8_STAGE(PG8_SB(0, 0), b2, voffB); PG8_STAGE(PG8_SB(0, 1), b2 + hstep, voffB); PG8_STAGE(PG8_SA(0, 0), a2, voffA);
            PG8_WAIT_V(8); PG8_WAIT_L(0); PG8_BAR; PG8_MMA(1, 0, At, B0); PG8_MMA(1, 1, At, B1); PG8_BAR; PG8_SCHED;
            PG8_LDB(B0, 1, 0); PG8_LDB(B1, 1, 1); PG8_SCHED; PG8_LDA(At, 1, 0); PG8_STAGE(PG8_SA(0, 1), a2 + hstep, voffA);
            PG8_WAIT_V(8); PG8_WAIT_L(0); PG8_BAR; PG8_MMA(0, 0, At, B0); PG8_MMA(0, 1, At, B1); PG8_BAR; PG8_SCHED;
            PG8_LDA(At, 1, 1); PG8_STAGE(PG8_SB(1, 0), b3, voffB); PG8_STAGE(PG8_SB(1, 1), b3 + hstep, voffB); PG8_STAGE(PG8_SA(1, 0), a3, voffA);
            PG8_WAIT_V(8); PG8_WAIT_L(0); PG8_BAR; PG8_MMA(1, 0, At, B0); PG8_MMA(1, 1, At, B1); PG8_BAR; PG8_SCHED;
            } else {
            PG8_LDB(B0, 0, 0); PG8_SCHED; PG8_LDA(At, 0, 0); PG8_STAGE(PG8_SA(1, 1), a1 + hstep, voffA);
            PG8_WAIT_L(8); PG8_BAR; PG8_WAIT_L(0); PG8_MMA(0, 0, At, B0); PG8_BAR; PG8_SCHED;
            PG8_LDB(B1, 0, 1); PG8_STAGE(PG8_SB(0, 0), b2, voffB);
            PG8_BAR; PG8_WAIT_L(0); PG8_MMA(0, 1, At, B1); PG8_BAR;
            PG8_LDA(At, 0, 1); PG8_STAGE(PG8_SA(0, 0), a2, voffA);
            PG8_BAR; PG8_WAIT_L(0); PG8_MMA(1, 0, At, B0); PG8_BAR; PG8_SCHED;
            PG8_STAGE(PG8_SB(0, 1), b2 + hstep, voffB);
            PG8_WAIT_V(6); PG8_BAR; PG8_MMA(1, 1, At, B1); PG8_BAR;
            PG8_LDB(B0, 1, 0); PG8_SCHED; PG8_LDA(At, 1, 0); PG8_STAGE(PG8_SA(0, 1), a2 + hstep, voffA);
            PG8_WAIT_L(8); PG8_BAR; PG8_WAIT_L(0); PG8_MMA(0, 0, At, B0); PG8_BAR; PG8_SCHED;
            PG8_LDB(B1, 1, 1); PG8_STAGE(PG8_SB(1, 0), b3, voffB);
            PG8_BAR; PG8_WAIT_L(0); PG8_MMA(0, 1, At, B1); PG8_BAR;
            PG8_LDA(At, 1, 1); PG8_STAGE(PG8_SA(1, 0), a3, voffA);
            PG8_BAR; PG8_WAIT_L(0); PG8_MMA(1, 0, At, B0); PG8_BAR; PG8_SCHED;
            PG8_STAGE(PG8_SB(1, 1), b3 + hstep, voffB);
            PG8_WAIT_V(6); PG8_BAR; PG8_MMA(1, 1, At, B1); PG8_BAR;
            }
        }
        if constexpr (ALIGN_EPI) { if (wr == 0) PG8_BAR; }
        if constexpr (!Epi::AFTER_DRAIN) { E(acc, cur, wr, wc, fr, fq); S.done(cur); }
        if (!has_next) break;
#pragma unroll
        for (int a = 0; a < 2; ++a)
#pragma unroll
            for (int b = 0; b < 2; ++b)
#pragma unroll
                for (int m = 0; m < 4; ++m)
#pragma unroll
                    for (int n = 0; n < 2; ++n) acc[a][b][m][n] = (f32x4){0.f, 0.f, 0.f, 0.f};
        cur = nxt; cA = nA; cB = nB; ++ui;
        if constexpr (ALIGN_EPI) { if (wr == 1) PG8_BAR; }
    }
    PG8_WAIT_V(0);
    if constexpr (!ALIGN_EPI) { if (wr == 0) PG8_BAR; }
    PG8_BAR;
    if constexpr (Epi::AFTER_DRAIN) { E.fused(acc, cur, wr, wc, fr, fq, lds, wid, lane); S.done(cur); }
#undef PG8_SA
#undef PG8_SB
#undef PG8_STAGE
#undef PG8_LDA
#undef PG8_LDB
#undef PG8_MMA
#undef PG8_WAIT_V
#undef PG8_WAIT_L
#undef PG8_BAR
#undef PG8_SCHED
}
}

#ifndef PG8_SP2
#define PG8_SP2 true
#endif
#ifndef PG8_ALIGN
#define PG8_ALIGN true
#endif
#ifndef MK_N_LAUNCHES
#define MK_N_LAUNCHES 7
#endif
constexpr int NWAVES = 8;
constexpr int PER_PHASE = 7;
constexpr int N_LAUNCHES = MK_N_LAUNCHES;

constexpr int BATCH = 8, SEQ = 4096, D = 1024, M = BATCH * SEQ;
constexpr int MEML = 256, MMEM = BATCH * MEML;
constexpr int INW = 2304, KVW = 512, PQW = 2048;
constexpr int C_A = 0, C_G = 256, C_Q = 512, C_K = 1024, C_V = 1536, C_MQ = 2048;
constexpr int NEXP = 16384;
constexpr float EPS = 1e-6f;

constexpr size_t MiB = 1u << 20;
constexpr size_t WS_CTL = 0, CTL_ZERO_BYTES = 1 * MiB;
constexpr size_t WS_WIN = 2 * MiB, WS_WKV = 7 * MiB, WS_WOUT = 8 * MiB, WS_WPQ = 10 * MiB, WS_KEYS = 14 * MiB;
constexpr size_t WS_MEMN = 15 * MiB, WS_MKV = 19 * MiB;
constexpr size_t WS_UT = 24 * MiB, WS_VT = 56 * MiB;
constexpr size_t WS_XN = 88 * MiB;
constexpr size_t WS_CAT = 152 * MiB;
constexpr size_t WS_SELI = 216 * MiB, WS_SELG = 232 * MiB;
constexpr size_t WS_PROJ = 256 * MiB;
constexpr size_t WS_Q = 256 * MiB;
constexpr size_t WS_END = 400 * MiB;
constexpr int CW_BAR = 4096;
constexpr int CW_SSQ2 = 65536;
static_assert((CW_SSQ2 + M) * 4 <= (int)CTL_ZERO_BYTES, "ctl");

constexpr int RING_OFF = 0, RING_BYTES = 131072;
constexpr int LDSCTL_OFF = RING_BYTES, MISC_OFF = LDSCTL_OFF + 320;
constexpr int EXTRA_OFF = RING_BYTES + 1024;
constexpr int LDS_BYTES = 147456;

#define GAS __attribute__((address_space(1)))
#define LAS __attribute__((address_space(3)))
typedef unsigned short bf16;
typedef unsigned v4u __attribute__((ext_vector_type(4)));
typedef unsigned v2u __attribute__((ext_vector_type(2)));
typedef float f32x4 __attribute__((ext_vector_type(4)));
typedef GAS unsigned gu32;
typedef __bf16 bf16x2_t __attribute__((ext_vector_type(2)));
#define RLX_AGENT __ATOMIC_RELAXED, __HIP_MEMORY_SCOPE_AGENT
#define LDS_WAIT() asm volatile("s_waitcnt lgkmcnt(0)" ::: "memory")
__device__ __forceinline__ unsigned f2bf(float f) { unsigned u = __builtin_bit_cast(unsigned, f); return (u + 0x7fffu + ((u >> 16) & 1u)) >> 16; }
__device__ __forceinline__ unsigned pk2(float lo, float hi) { return f2bf(lo) | (f2bf(hi) << 16); }
__device__ __forceinline__ float bflo(unsigned w) { return __uint_as_float(w << 16); }
__device__ __forceinline__ float bfhi(unsigned w) { return __uint_as_float(w & 0xffff0000u); }
__device__ __forceinline__ float dot2(unsigned a, unsigned b, float c) { return __builtin_amdgcn_fdot2_f32_bf16(__builtin_bit_cast(bf16x2_t, a), __builtin_bit_cast(bf16x2_t, b), c, false); }
__device__ __forceinline__ float wave_sum(float v) {
#pragma unroll
    for (int o = 1; o < 64; o <<= 1) v += __shfl_xor(v, o);
    return v;
}
#define XB_TMO      128
#define XB_XCNT(j)  (256  + 64 * (j))
#define XB_XSUB(j)  (1280 + 64 * (j))
#define XB_XGEN(j)  (2304 + 64 * (j))
#define XB_TOP      3328
#define XB_TOPGEN   3392
#define XCD_BAR_WORDS 3456
#define XB_SPIN_CAP (1u << 18)

__device__ __forceinline__ unsigned xb_ld(unsigned* p)              { return __hip_atomic_load(p, __ATOMIC_RELAXED, __HIP_MEMORY_SCOPE_AGENT); }
__device__ __forceinline__ unsigned xb_add(unsigned* p, unsigned v) { return __hip_atomic_fetch_add(p, v, __ATOMIC_RELAXED, __HIP_MEMORY_SCOPE_AGENT); }
__device__ __forceinline__ unsigned xb_xcc_id() { return (unsigned)__builtin_amdgcn_s_getreg((3 << 11) | 20) & 0xFu; }
#define XB_SPIN(cond, bar) do { unsigned _sp = 0; while (cond) { __builtin_amdgcn_s_sleep(1); \
    if ((++_sp & 255u) == 0u) { if (xb_ld(&(bar)[XB_TMO])) break; if (_sp > XB_SPIN_CAP) { atomicAdd(&(bar)[XB_TMO], 1u); break; } } } } while (0)

struct XcdBarrier {
    unsigned* bar; unsigned x;
    volatile LAS unsigned* st;
};

__device__ __forceinline__ XcdBarrier xcd_barrier_post(unsigned* bar, volatile LAS unsigned* st) {
    XcdBarrier b; b.bar = bar; b.x = xb_xcc_id(); b.st = st;
    if (threadIdx.x == 0) (void)xb_add(&bar[XB_XCNT(b.x)], 1u);
    return b;
}
__device__ __forceinline__ void xcd_barrier_complete(unsigned* bar, unsigned x, unsigned& nloc, unsigned& nx) {
    const unsigned G = gridDim.x * gridDim.y * gridDim.z;
    unsigned sum, cnt, mine, sp = 0u;
    for (;;) {
        sum = 0u; cnt = 0u; mine = 0u;
#pragma unroll
        for (unsigned j = 0; j < 16; ++j) { const unsigned c = xb_ld(&bar[XB_XCNT(j)]); sum += c; cnt += (c > 0u) ? 1u : 0u; mine = (j == x) ? c : mine; }
        if (sum == G) break;
        __builtin_amdgcn_s_sleep(1);
        if ((++sp & 255u) == 0u) { if (xb_ld(&bar[XB_TMO])) break; if (sp > XB_SPIN_CAP) { atomicAdd(&bar[XB_TMO], 1u); break; } }
    }
    nloc = mine > 0u ? mine : 1u; nx = cnt > 0u ? cnt : 1u;
}

__device__ __forceinline__ void xcd_barrier(const XcdBarrier& b) {
    asm volatile("s_waitcnt vmcnt(0)" ::: "memory");
    __syncthreads();
    if (threadIdx.x == 0) {
        unsigned* bar = b.bar;
        __builtin_amdgcn_s_waitcnt(0);
        unsigned nloc = b.st[0], nx = b.st[1];
        if (nloc == 0u) { xcd_barrier_complete(bar, b.x, nloc, nx); b.st[0] = nloc; b.st[1] = nx; }
        const unsigned old = xb_add(&bar[XB_XSUB(b.x)], 1u);
        const unsigned gen = old / nloc;
        if (old + 1u == (gen + 1u) * nloc) {
            __builtin_amdgcn_fence(__ATOMIC_RELEASE, "agent");
            asm volatile("s_waitcnt vmcnt(0)" ::: "memory");
            const unsigned og = xb_add(&bar[XB_TOP], 1u);
            const unsigned tg = og / nx;
            if (og + 1u == (tg + 1u) * nx) xb_add(&bar[XB_TOPGEN], 1u);
            else XB_SPIN(xb_ld(&bar[XB_TOPGEN]) == tg, bar);
            __builtin_amdgcn_fence(__ATOMIC_ACQUIRE, "agent");
            xb_add(&bar[XB_XGEN(b.x)], 1u);
            asm volatile("s_waitcnt vmcnt(0)" ::: "memory");
        } else {
            XB_SPIN(xb_ld(&bar[XB_XGEN(b.x)]) == gen, bar);
            __builtin_amdgcn_fence(__ATOMIC_ACQUIRE, "agent");
            asm volatile("s_waitcnt vmcnt(0)" ::: "memory");
        }
    }
    __syncthreads();
}

struct Frame {
    LAS unsigned char* lds;
    volatile LAS unsigned* MISC;
    gu32* ctl;
    int tid, lane, wave;
    int vcu, G;
};
struct Ptrs {
    const float *x, *mem, *attn_g, *w_in, *conv_w, *conv_b, *conv_ln_g, *conv_ln_b, *sb_out_g, *mem_norm_g, *w_mem_kv, *q_norm_g, *k_norm_g, *mem_out_g,
                *w_out, *ffn_g, *w_peer_q, *keys1, *keys2, *peer_u, *peer_v;
    float* out;
    bf16 *WIN, *WKV, *WOUT, *WPQ, *KEYS, *MEMN, *MKV, *UT, *VT, *XN, *CAT, *PROJ, *Q;
    int* SELI; float* SELG; float* SSQ2;
};

__device__ __forceinline__ void p0_transpose_item(const float* W, const float* gk, int K, int N, bf16* WT, LAS float* scr, int item, int lane) {
    const int nblk = N / 32, kb = item / nblk, nb = item % nblk, k0 = 64 * kb, n0 = 32 * nb;
#pragma unroll 8
    for (int i = 0; i < 32; ++i) { const int kk = 2 * i + (lane >> 5); float w = W[(size_t)(k0 + kk) * N + n0 + (lane & 31)]; if (gk) w *= gk[k0 + kk]; scr[kk * 33 + (lane & 31)] = w; }
    LDS_WAIT(); asm volatile("" ::: "memory");
    const int c = lane & 7;
#pragma unroll
    for (int j = 0; j < 4; ++j) { const int n = (lane >> 3) + 8 * j; const LAS float* s = scr + (8 * c) * 33 + n;
        v4u o; o.x = pk2(s[0 * 33], s[1 * 33]); o.y = pk2(s[2 * 33], s[3 * 33]); o.z = pk2(s[4 * 33], s[5 * 33]); o.w = pk2(s[6 * 33], s[7 * 33]);
        *(GAS v4u*)(WT + (size_t)(n0 + n) * K + k0 + 8 * c) = o; }
    LDS_WAIT(); asm volatile("" ::: "memory");
}
__device__ __forceinline__ void rms_row_to_bf16(const float* xrow, const float* g, bf16* orow, int lane) {
    const GAS f32x4* xr = (const GAS f32x4*)xrow + lane; const GAS f32x4* gr = (const GAS f32x4*)g + lane;
    f32x4 v[4]; float s = 0.f;
#pragma unroll
    for (int j = 0; j < 4; ++j) { v[j] = xr[64 * j]; s += (v[j].x * v[j].x + v[j].y * v[j].y) + (v[j].z * v[j].z + v[j].w * v[j].w); }
    const float rinv = 1.f / sqrtf(wave_sum(s) * (1.f / 1024.f) + EPS);
    GAS unsigned long long* o8 = (GAS unsigned long long*)orow + lane;
#pragma unroll
    for (int j = 0; j < 4; ++j) { const f32x4 gg = gr[64 * j]; const f32x4 o = v[j] * rinv * gg;
        o8[64 * j] = (unsigned long long)pk2(o.x, o.y) | ((unsigned long long)pk2(o.z, o.w) << 32); }
}
__device__ __forceinline__ void cvt_f32_to_bf16_stream(const float* src, bf16* dst, size_t n8, size_t gtid, size_t nthr) {
    for (size_t i = gtid; i < n8; i += nthr) { const f32x4 a = ((const GAS f32x4*)src)[2 * i], b = ((const GAS f32x4*)src)[2 * i + 1];
        v4u o; o.x = pk2(a.x, a.y); o.y = pk2(a.z, a.w); o.z = pk2(b.x, b.y); o.w = pk2(b.z, b.w); ((GAS v4u*)dst)[i] = o; }
}
__device__ __forceinline__ void p0_prologue(Frame& F, const Ptrs& P) {
    LAS float* scr = (LAS float*)(F.lds + RING_OFF + F.wave * 16384);
    const int gw = F.vcu * NWAVES + F.wave, NGW = F.G * NWAVES;
    constexpr int I_IN = (D / 64) * (INW / 32), I_KV = (D / 64) * (KVW / 32), I_OUT = (D / 64) * (D / 32), I_PQ = (D / 64) * (PQW / 32);
    constexpr int NITEMS = I_IN + I_KV + I_OUT + I_PQ;
    for (int it = gw; it < NITEMS; it += NGW) {
        int r = it;
        if (r < I_IN) { p0_transpose_item(P.w_in, nullptr, D, INW, P.WIN, scr, r, F.lane); continue; } r -= I_IN;
        if (r < I_KV) { p0_transpose_item(P.w_mem_kv, nullptr, D, KVW, P.WKV, scr, r, F.lane); continue; } r -= I_KV;
        if (r < I_OUT) { p0_transpose_item(P.w_out, nullptr, D, D, P.WOUT, scr, r, F.lane); continue; } r -= I_OUT;
        p0_transpose_item(P.w_peer_q, P.ffn_g, D, PQW, P.WPQ, scr, r, F.lane);
    }
    for (int m = gw; m < M; m += NGW) rms_row_to_bf16(P.x + (size_t)m * D, P.attn_g, P.XN + (size_t)m * D, F.lane);
    for (int m = gw; m < MMEM; m += NGW) rms_row_to_bf16(P.mem + (size_t)m * D, P.mem_norm_g, P.MEMN + (size_t)m * D, F.lane);
    const size_t gtid = (size_t)gw * 64 + F.lane, nthr = (size_t)NGW * 64;
    cvt_f32_to_bf16_stream(P.keys1, P.KEYS, 8 * 128 * 128 / 8, gtid, nthr);
    cvt_f32_to_bf16_stream(P.keys2, P.KEYS + 8 * 128 * 128, 8 * 128 * 128 / 8, gtid, nthr);
    cvt_f32_to_bf16_stream(P.peer_u, P.UT, (size_t)NEXP * D / 8, gtid, nthr);
    cvt_f32_to_bf16_stream(P.peer_v, P.VT, (size_t)NEXP * D / 8, gtid, nthr);
}

__device__ __forceinline__ void conv_item(Frame& F, const Ptrs& P, int b, int ch) {
    LAS float* U = (LAS float*)(F.lds + 0);
    LAS float* Y = (LAS float*)(F.lds + 65536);
    const int t0 = ch * 32, tid = F.tid;
    for (int idx = tid; idx < 62 * 32; idx += 512) {
        const int r = idx >> 5, c8 = idx & 31, t = t0 - 30 + r;
        float u[8];
        if (t >= 0) { const bf16* src = P.PROJ + (size_t)(b * SEQ + t) * INW + c8 * 8;
            const v4u a = *(const GAS v4u*)(src + C_A), g = *(const GAS v4u*)(src + C_G);
            const unsigned aw[4] = {a.x, a.y, a.z, a.w}, gw_[4] = {g.x, g.y, g.z, g.w};
#pragma unroll
            for (int i = 0; i < 4; ++i) { const float a0 = bflo(aw[i]), a1 = bfhi(aw[i]), g0 = bflo(gw_[i]), g1 = bfhi(gw_[i]);
                u[2 * i] = a0 / (1.f + __expf(-g0)); u[2 * i + 1] = a1 / (1.f + __expf(-g1)); }
        } else {
#pragma unroll
            for (int i = 0; i < 8; ++i) u[i] = 0.f;
        }
        LAS f32x4* dst = (LAS f32x4*)(U + r * 256 + c8 * 8);
        dst[0] = (f32x4){u[0], u[1], u[2], u[3]}; dst[1] = (f32x4){u[4], u[5], u[6], u[7]};
    }
    __syncthreads();
    {
        const int c = tid & 255, half = tid >> 8;
        float w[31];
#pragma unroll
        for (int k = 0; k < 31; ++k) w[k] = P.conv_w[k * 256 + c];
        const float bias = P.conv_b[c];
        float win[46];
#pragma unroll
        for (int i = 0; i < 46; ++i) win[i] = U[(half * 16 + i) * 256 + c];
#pragma unroll
        for (int tt = 0; tt < 16; ++tt) { float y = bias;
#pragma unroll
            for (int k = 0; k < 31; ++k) y += w[k] * win[tt + k];
            Y[(half * 16 + tt) * 256 + c] = y; }
    }
    __syncthreads();
    {
        const f32x4 lg = ((const GAS f32x4*)P.conv_ln_g)[F.lane], lb = ((const GAS f32x4*)P.conv_ln_b)[F.lane];
#pragma unroll
        for (int i = 0; i < 4; ++i) { const int tok = F.wave * 4 + i; const f32x4 y = *(const LAS f32x4*)(Y + tok * 256 + F.lane * 4);
            const float mu = wave_sum((y.x + y.y) + (y.z + y.w)) * (1.f / 256.f); const f32x4 d = y - mu;
            const float var = wave_sum((d.x * d.x + d.y * d.y) + (d.z * d.z + d.w * d.w)) * (1.f / 256.f);
            const float rinv = 1.f / sqrtf(var + EPS); const f32x4 yn = d * rinv * lg + lb;
            f32x4 s; s.x = yn.x / (1.f + __expf(-yn.x)); s.y = yn.y / (1.f + __expf(-yn.y)); s.z = yn.z / (1.f + __expf(-yn.z)); s.w = yn.w / (1.f + __expf(-yn.w));
            *(GAS unsigned long long*)(P.CAT + (size_t)(b * SEQ + t0 + tok) * D + F.lane * 4) = (unsigned long long)pk2(s.x, s.y) | ((unsigned long long)pk2(s.z, s.w) << 32); }
    }
}

constexpr int SB_KS = 0, SB_VT = 65536;
__device__ __forceinline__ void sb_item(Frame& F, const Ptrs& P, int b, int qb) {
    LAS unsigned char* lds = F.lds; const int tid = F.tid, lane = F.lane, h = F.wave;
    const int t = qb * 64 + lane; const size_t row = (size_t)b * SEQ + t;
    unsigned q[32];
    { const GAS v4u* qp = (const GAS v4u*)(P.PROJ + row * INW + C_Q + h * 64);
#pragma unroll
      for (int j = 0; j < 8; ++j) { const v4u v = qp[j]; q[4 * j] = v.x; q[4 * j + 1] = v.y; q[4 * j + 2] = v.z; q[4 * j + 3] = v.w; } }
    float o[64];
#pragma unroll
    for (int d = 0; d < 64; ++d) o[d] = 0.f;
    float R = 1.f; bool alive = true;
    LAS float* xs = (LAS float*)(lds + EXTRA_OFF); volatile LAS unsigned* flags = (volatile LAS unsigned*)(lds + EXTRA_OFF + 2048);
    for (int kt = qb; kt >= 0; --kt) {
        __syncthreads();
        if (kt != qb) { unsigned any = 0u;
#pragma unroll
            for (int w = 0; w < 8; ++w) any |= flags[w];
            if (!any) break; }
        { const size_t rb = (size_t)b * SEQ + kt * 64;
#pragma unroll
          for (int i = 0; i < 8; ++i) { const int c = tid + 512 * i; const int key = c >> 6, j = c & 63, hh = j >> 3, d8 = j & 7;
              const bf16* src = P.PROJ + (rb + key) * INW;
              const v4u kv = *(const GAS v4u*)(src + C_K + j * 8); *(LAS v4u*)(lds + SB_KS + ((hh * 64 + key) * 64 + d8 * 8) * 2) = kv;
              const v4u vv = *(const GAS v4u*)(src + C_V + j * 8);
              LAS unsigned short* vd = (LAS unsigned short*)(lds + SB_VT + ((hh * 32 + (key >> 1)) * 64 + d8 * 8) * 4 + (key & 1) * 2);
              vd[0] = (unsigned short)(vv.x & 0xffffu); vd[2] = (unsigned short)(vv.x >> 16); vd[4] = (unsigned short)(vv.y & 0xffffu); vd[6] = (unsigned short)(vv.y >> 16);
              vd[8] = (unsigned short)(vv.z & 0xffffu); vd[10] = (unsigned short)(vv.z >> 16); vd[12] = (unsigned short)(vv.w & 0xffffu); vd[14] = (unsigned short)(vv.w >> 16); } }
        __syncthreads();
        if (alive) {
            const bool diag = (kt == qb);
            const LAS v4u* kbase = (const LAS v4u*)(lds + SB_KS + h * 64 * 128);
            const LAS v4u* vbase = (const LAS v4u*)(lds + SB_VT + h * 32 * 256);
            for (int pp = 31; pp >= 0; --pp) {
                float z1, z0;
                { const LAS v4u* kp = kbase + (2 * pp + 1) * 8; float a0 = 0.f, a1 = 0.f, a2 = 0.f, a3 = 0.f;
#pragma unroll
                  for (int j = 0; j < 8; ++j) { const v4u kk = kp[j]; a0 = dot2(kk.x, q[4 * j], a0); a1 = dot2(kk.y, q[4 * j + 1], a1); a2 = dot2(kk.z, q[4 * j + 2], a2); a3 = dot2(kk.w, q[4 * j + 3], a3); }
                  z1 = ((a0 + a1) + (a2 + a3)) * 0.125f; }
                { const LAS v4u* kp = kbase + (2 * pp) * 8; float a0 = 0.f, a1 = 0.f, a2 = 0.f, a3 = 0.f;
#pragma unroll
                  for (int j = 0; j < 8; ++j) { const v4u kk = kp[j]; a0 = dot2(kk.x, q[4 * j], a0); a1 = dot2(kk.y, q[4 * j + 1], a1); a2 = dot2(kk.z, q[4 * j + 2], a2); a3 = dot2(kk.w, q[4 * j + 3], a3); }
                  z0 = ((a0 + a1) + (a2 + a3)) * 0.125f; }
                float w1, w0;
                { const float e = __expf(-fabsf(z1)), r = __builtin_amdgcn_rcpf(1.f + e), er = e * r; const float beta = z1 >= 0.f ? r : er, om = z1 >= 0.f ? er : r;
                  const bool valid = !diag || (2 * pp + 1 < lane); w1 = valid ? beta * R : 0.f; R = valid ? R * om : R; }
                { const float e = __expf(-fabsf(z0)), r = __builtin_amdgcn_rcpf(1.f + e), er = e * r; const float beta = z0 >= 0.f ? r : er, om = z0 >= 0.f ? er : r;
                  const bool valid = !diag || (2 * pp < lane); w0 = valid ? beta * R : 0.f; R = valid ? R * om : R; }
                const unsigned apk = pk2(w0, w1);
                const LAS v4u* vp = vbase + pp * 16;
#pragma unroll
                for (int j = 0; j < 16; ++j) { const v4u vv = vp[j]; o[4 * j] = dot2(vv.x, apk, o[4 * j]); o[4 * j + 1] = dot2(vv.y, apk, o[4 * j + 1]); o[4 * j + 2] = dot2(vv.z, apk, o[4 * j + 2]); o[4 * j + 3] = dot2(vv.w, apk, o[4 * j + 3]); }
            }
            alive = __builtin_amdgcn_ballot_w64(R > 1.0e-37f) != 0ull;
        }
        if (lane == 0) flags[h] = alive ? 1u : 0u;
    }
    __syncthreads();
    float ss = 0.f;
#pragma unroll
    for (int d = 0; d < 64; ++d) ss += o[d] * o[d];
    xs[h * 64 + lane] = ss;
    __syncthreads();
    float tot = 0.f;
#pragma unroll
    for (int w = 0; w < 8; ++w) tot += xs[w * 64 + lane];
    const float rinv = 1.f / sqrtf(tot * (1.f / 512.f) + EPS);
    GAS v4u* dst = (GAS v4u*)(P.CAT + row * D + 256 + h * 64); const GAS f32x4* gp = (const GAS f32x4*)(P.sb_out_g + h * 64);
#pragma unroll
    for (int j = 0; j < 8; ++j) { const f32x4 g0 = gp[2 * j], g1 = gp[2 * j + 1]; v4u w;
        w.x = pk2(o[8 * j] * rinv * g0.x, o[8 * j + 1] * rinv * g0.y); w.y = pk2(o[8 * j + 2] * rinv * g0.z, o[8 * j + 3] * rinv * g0.w);
        w.z = pk2(o[8 * j + 4] * rinv * g1.x, o[8 * j + 5] * rinv * g1.y); w.w = pk2(o[8 * j + 6] * rinv * g1.z, o[8 * j + 7] * rinv * g1.w); dst[j] = w; }
}

constexpr int MA_KS = 0, MA_VT = 32768;
__device__ __forceinline__ void mem_item(Frame& F, const Ptrs& P, int b, int qblk) {
    LAS unsigned char* lds = F.lds; const int tid = F.tid, lane = F.lane, h = F.wave & 3, sub = F.wave >> 2;
    const int t = qblk * 128 + sub * 64 + lane; const size_t row = (size_t)b * SEQ + t;
    unsigned q[32];
    { const GAS v4u* qp = (const GAS v4u*)(P.PROJ + row * INW + C_MQ + h * 64); float qf[64]; float s = 0.f;
#pragma unroll
      for (int j = 0; j < 8; ++j) { const v4u v = qp[j]; const unsigned w[4] = {v.x, v.y, v.z, v.w};
#pragma unroll
          for (int i = 0; i < 4; ++i) { qf[8 * j + 2 * i] = bflo(w[i]); qf[8 * j + 2 * i + 1] = bfhi(w[i]); s += qf[8 * j + 2 * i] * qf[8 * j + 2 * i] + qf[8 * j + 2 * i + 1] * qf[8 * j + 2 * i + 1]; } }
      const float rinv = 1.f / sqrtf(s * (1.f / 64.f) + EPS);
#pragma unroll
      for (int j = 0; j < 32; ++j) q[j] = pk2(qf[2 * j] * rinv * P.q_norm_g[2 * j], qf[2 * j + 1] * rinv * P.q_norm_g[2 * j + 1]); }
    float o[64];
#pragma unroll
    for (int d = 0; d < 64; ++d) o[d] = 0.f;
    float mx = -1.0e30f, lsum = 0.f;
    LAS float* xs = (LAS float*)(lds + EXTRA_OFF);
    for (int kt = 0; kt < 4; ++kt) {
        __syncthreads();
        { const int key = (tid & 255) >> 2, hh = tid & 3; const bf16* src = P.MKV + (size_t)(b * MEML + kt * 64 + key) * KVW + hh * 64;
          if (tid < 256) {
              const GAS v4u* kp = (const GAS v4u*)src; float s = 0.f;
#pragma unroll
              for (int j = 0; j < 8; ++j) { const v4u kv = kp[j]; const unsigned w[4] = {kv.x, kv.y, kv.z, kv.w};
#pragma unroll
                  for (int i = 0; i < 4; ++i) { const float a = bflo(w[i]), c = bfhi(w[i]); s += a * a + c * c; } }
              const float rinv = 1.f / sqrtf(s * (1.f / 64.f) + EPS);
              asm volatile("" ::: "memory");
              LAS v4u* dst = (LAS v4u*)(lds + MA_KS + (hh * 64 + key) * 128);
#pragma unroll 2
              for (int j = 0; j < 8; ++j) { const v4u kv = kp[j]; const unsigned w[4] = {kv.x, kv.y, kv.z, kv.w}; unsigned ow[4];
#pragma unroll
                  for (int i = 0; i < 4; ++i) ow[i] = pk2(bflo(w[i]) * rinv * P.k_norm_g[8 * j + 2 * i], bfhi(w[i]) * rinv * P.k_norm_g[8 * j + 2 * i + 1]);
                  dst[j] = (v4u){ow[0], ow[1], ow[2], ow[3]}; }
          } else {
              const GAS v4u* vp = (const GAS v4u*)(src + 256);
              LAS unsigned short* vd = (LAS unsigned short*)(lds + MA_VT + ((hh * 32 + (key >> 1)) * 64) * 4 + (key & 1) * 2);
#pragma unroll
              for (int j = 0; j < 8; ++j) { const v4u vv = vp[j]; LAS unsigned short* d8 = vd + j * 16;
                  d8[0] = (unsigned short)(vv.x & 0xffffu); d8[2] = (unsigned short)(vv.x >> 16); d8[4] = (unsigned short)(vv.y & 0xffffu); d8[6] = (unsigned short)(vv.y >> 16);
                  d8[8] = (unsigned short)(vv.z & 0xffffu); d8[10] = (unsigned short)(vv.z >> 16); d8[12] = (unsigned short)(vv.w & 0xffffu); d8[14] = (unsigned short)(vv.w >> 16); }
          } }
        __syncthreads();
        const LAS v4u* kbase = (const LAS v4u*)(lds + MA_KS + h * 64 * 128);
        const LAS v4u* vbase = (const LAS v4u*)(lds + MA_VT + h * 32 * 256);
        for (int blk = 0; blk < 4; ++blk) {
            float s[16];
#pragma unroll
            for (int i = 0; i < 16; ++i) { const LAS v4u* kp = kbase + (blk * 16 + i) * 8; float a0 = 0.f, a1 = 0.f, a2 = 0.f, a3 = 0.f;
#pragma unroll
                for (int j = 0; j < 8; ++j) { const v4u kk = kp[j]; a0 = dot2(kk.x, q[4 * j], a0); a1 = dot2(kk.y, q[4 * j + 1], a1); a2 = dot2(kk.z, q[4 * j + 2], a2); a3 = dot2(kk.w, q[4 * j + 3], a3); }
                s[i] = ((a0 + a1) + (a2 + a3)) * 0.125f; }
            float bm = s[0];
#pragma unroll
            for (int i = 1; i < 16; ++i) bm = fmaxf(bm, s[i]);
            const float mn = fmaxf(mx, bm), sc = __expf(mx - mn); mx = mn; lsum *= sc;
#pragma unroll
            for (int d = 0; d < 64; ++d) o[d] *= sc;
#pragma unroll
            for (int i = 0; i < 16; ++i) { s[i] = __expf(s[i] - mn); lsum += s[i]; }
#pragma unroll
            for (int j2 = 0; j2 < 8; ++j2) { const unsigned apk = pk2(s[2 * j2], s[2 * j2 + 1]); const LAS v4u* vp = vbase + (blk * 8 + j2) * 16;
#pragma unroll
                for (int j = 0; j < 16; ++j) { const v4u vv = vp[j]; o[4 * j] = dot2(vv.x, apk, o[4 * j]); o[4 * j + 1] = dot2(vv.y, apk, o[4 * j + 1]); o[4 * j + 2] = dot2(vv.z, apk, o[4 * j + 2]); o[4 * j + 3] = dot2(vv.w, apk, o[4 * j + 3]); } }
        }
    }
    const float linv = 1.f / lsum; float ss = 0.f;
#pragma unroll
    for (int d = 0; d < 64; ++d) { o[d] *= linv; ss += o[d] * o[d]; }
    __syncthreads();
    xs[F.wave * 64 + lane] = ss;
    __syncthreads();
    float tot = 0.f;
#pragma unroll
    for (int w = 0; w < 4; ++w) tot += xs[(sub * 4 + w) * 64 + lane];
    const float rinv = 1.f / sqrtf(tot * (1.f / 256.f) + EPS);
    GAS v4u* dst = (GAS v4u*)(P.CAT + row * D + 768 + h * 64); const GAS f32x4* gp = (const GAS f32x4*)(P.mem_out_g + h * 64);
#pragma unroll
    for (int j = 0; j < 8; ++j) { const f32x4 g0 = gp[2 * j], g1 = gp[2 * j + 1]; v4u w;
        w.x = pk2(o[8 * j] * rinv * g0.x, o[8 * j + 1] * rinv * g0.y); w.y = pk2(o[8 * j + 2] * rinv * g0.z, o[8 * j + 3] * rinv * g0.w);
        w.z = pk2(o[8 * j + 4] * rinv * g1.x, o[8 * j + 5] * rinv * g1.y); w.w = pk2(o[8 * j + 6] * rinv * g1.z, o[8 * j + 7] * rinv * g1.w); dst[j] = w; }
}

#define INS16(V, I, cv_, ci_) do { float cv = (cv_); int ci = (ci_); \
    _Pragma("unroll") for (int p_ = 0; p_ < 16; ++p_) { const bool gt = cv > V[p_]; const float tv = gt ? V[p_] : cv; const int ti = gt ? I[p_] : ci; V[p_] = gt ? cv : V[p_]; I[p_] = gt ? ci : I[p_]; cv = tv; ci = ti; } } while (0)
__device__ __forceinline__ void topk_half(const LAS unsigned char* keys, const bf16* qrow, float (&V)[16], int (&I)[16]) {
    unsigned q[64];
    { const GAS v4u* qp = (const GAS v4u*)qrow;
#pragma unroll
      for (int j = 0; j < 16; ++j) { const v4u v = qp[j]; q[4 * j] = v.x; q[4 * j + 1] = v.y; q[4 * j + 2] = v.z; q[4 * j + 3] = v.w; } }
#pragma unroll
    for (int p = 0; p < 16; ++p) { V[p] = -3.0e38f; I[p] = 0; }
    for (int n = 0; n < 128; ++n) {
        const LAS v4u* kp = (const LAS v4u*)(keys + n * 256); float a0 = 0.f, a1 = 0.f, a2 = 0.f, a3 = 0.f;
#pragma unroll
        for (int j = 0; j < 16; ++j) { const v4u kk = kp[j]; a0 = dot2(kk.x, q[4 * j], a0); a1 = dot2(kk.y, q[4 * j + 1], a1); a2 = dot2(kk.z, q[4 * j + 2], a2); a3 = dot2(kk.w, q[4 * j + 3], a3); }
        const float s = (a0 + a1) + (a2 + a3);
        INS16(V, I, s, n);
    }
}
__device__ __forceinline__ void peer_select_item(Frame& F, const Ptrs& P, int tb, int h) {
    LAS unsigned char* lds = F.lds; const int tid = F.tid;
    __syncthreads();
#pragma unroll
    for (int i = 0; i < 8; ++i) { const int c = tid + 512 * i;
        const bf16* src = (c < 2048) ? (P.KEYS + (size_t)h * 16384 + c * 8) : (P.KEYS + 131072 + (size_t)h * 16384 + (c - 2048) * 8);
        *(LAS v4u*)(lds + c * 16) = *(const GAS v4u*)src; }
    __syncthreads();
    const int t = tb * 512 + F.wave * 64 + F.lane;
    float v1[16], v2[16]; int i1[16], i2[16];
    topk_half(lds, P.Q + (size_t)t * PQW + h * 256, v1, i1);
    topk_half(lds + 32768, P.Q + (size_t)t * PQW + h * 256 + 128, v2, i2);
    float ts[16]; int te[16];
#pragma unroll
    for (int p = 0; p < 16; ++p) { ts[p] = -3.0e38f; te[p] = 0; }
#pragma unroll
    for (int i = 0; i < 16; ++i)
#pragma unroll
        for (int j = 0; j < 16; ++j) if ((i + 1) * (j + 1) <= 16) { INS16(ts, te, v1[i] + v2[j], i1[i] * 128 + i2[j]); }
    float e[16], sum = 0.f;
#pragma unroll
    for (int p = 0; p < 16; ++p) { e[p] = __expf(ts[p] - ts[0]); sum += e[p]; }
    const float inv = 1.f / sum;
    GAS v4u* di = (GAS v4u*)(P.SELI + ((size_t)t * 8 + h) * 16); GAS f32x4* dg = (GAS f32x4*)(P.SELG + ((size_t)t * 8 + h) * 16);
#pragma unroll
    for (int j = 0; j < 4; ++j) { di[j] = (v4u){(unsigned)te[4 * j], (unsigned)te[4 * j + 1], (unsigned)te[4 * j + 2], (unsigned)te[4 * j + 3]};
        dg[j] = (f32x4){e[4 * j] * inv, e[4 * j + 1] * inv, e[4 * j + 2] * inv, e[4 * j + 3] * inv}; }
}

__device__ __forceinline__ void peer_gather_token(const Ptrs& P, int t, int lane) {
    const float rs = 1.0f / sqrtf(__hip_atomic_load(P.SSQ2 + t, RLX_AGENT) * (1.0f / 1024.0f) + EPS);
    float acc[16]; unsigned hp[8];
    { const GAS f32x4* xr = (const GAS f32x4*)(P.out + (size_t)t * D); const GAS f32x4* gr = (const GAS f32x4*)P.ffn_g;
#pragma unroll
      for (int j = 0; j < 2; ++j)
#pragma unroll
          for (int k = 0; k < 2; ++k) { const f32x4 xv = xr[j * 128 + lane * 2 + k], gv = gr[j * 128 + lane * 2 + k];
              acc[j * 8 + k * 4] = xv.x; acc[j * 8 + k * 4 + 1] = xv.y; acc[j * 8 + k * 4 + 2] = xv.z; acc[j * 8 + k * 4 + 3] = xv.w;
              hp[j * 4 + k * 2] = pk2(xv.x * rs * gv.x, xv.y * rs * gv.y); hp[j * 4 + k * 2 + 1] = pk2(xv.z * rs * gv.z, xv.w * rs * gv.w); } }
    const int e0 = P.SELI[(size_t)t * 128 + lane], e1 = P.SELI[(size_t)t * 128 + 64 + lane];
    const float g0 = P.SELG[(size_t)t * 128 + lane], g1 = P.SELG[(size_t)t * 128 + 64 + lane];
    float d0 = 0.f, d1 = 0.f;
    for (int jb = 0; jb < 128; jb += 8) {
        v4u r0[8], r1[8];
#pragma unroll
        for (int k = 0; k < 8; ++k) { const int j = jb + k; const int e = __builtin_amdgcn_readlane(j < 64 ? e0 : e1, j & 63);
            const GAS v4u* up = (const GAS v4u*)(P.UT + (size_t)e * D); r0[k] = up[lane]; r1[k] = up[64 + lane]; }
#pragma unroll
        for (int k = 0; k < 8; ++k) { const int j = jb + k;
            float a = dot2(r0[k].x, hp[0], 0.f); a = dot2(r0[k].y, hp[1], a); a = dot2(r0[k].z, hp[2], a); a = dot2(r0[k].w, hp[3], a);
            float c = dot2(r1[k].x, hp[4], 0.f); c = dot2(r1[k].y, hp[5], c); c = dot2(r1[k].z, hp[6], c); c = dot2(r1[k].w, hp[7], c);
            const float s = wave_sum(a + c);
            if (j < 64) { if (lane == j) d0 = s; } else { if (lane == j - 64) d1 = s; } }
    }
    const float w0 = 0.5f * d0 * (1.f + erff(d0 * 0.70710678118654752f)) * g0, w1 = 0.5f * d1 * (1.f + erff(d1 * 0.70710678118654752f)) * g1;
    for (int jb = 0; jb < 128; jb += 8) {
        v4u r0[8], r1[8];
#pragma unroll
        for (int k = 0; k < 8; ++k) { const int j = jb + k; const int e = __builtin_amdgcn_readlane(j < 64 ? e0 : e1, j & 63);
            const GAS v4u* vp = (const GAS v4u*)(P.VT + (size_t)e * D); r0[k] = vp[lane]; r1[k] = vp[64 + lane]; }
#pragma unroll
        for (int k = 0; k < 8; ++k) { const int j = jb + k; const float w = __uint_as_float(__builtin_amdgcn_readlane(__float_as_uint(j < 64 ? w0 : w1), j & 63));
            acc[0] += w * bflo(r0[k].x); acc[1] += w * bfhi(r0[k].x); acc[2] += w * bflo(r0[k].y); acc[3] += w * bfhi(r0[k].y);
            acc[4] += w * bflo(r0[k].z); acc[5] += w * bfhi(r0[k].z); acc[6] += w * bflo(r0[k].w); acc[7] += w * bfhi(r0[k].w);
            acc[8] += w * bflo(r1[k].x); acc[9] += w * bfhi(r1[k].x); acc[10] += w * bflo(r1[k].y); acc[11] += w * bfhi(r1[k].y);
            acc[12] += w * bflo(r1[k].z); acc[13] += w * bfhi(r1[k].z); acc[14] += w * bflo(r1[k].w); acc[15] += w * bfhi(r1[k].w); }
    }
    GAS f32x4* orow = (GAS f32x4*)(P.out + (size_t)t * D);
#pragma unroll
    for (int j = 0; j < 2; ++j)
#pragma unroll
        for (int k = 0; k < 2; ++k) orow[j * 128 + lane * 2 + k] = (f32x4){acc[j * 8 + k * 4], acc[j * 8 + k * 4 + 1], acc[j * 8 + k * 4 + 2], acc[j * 8 + k * 4 + 3]};
}

struct Args { const float* in[21]; float* out; unsigned char* ws; int ph_lo, ph_hi, li, pad; };
__device__ __forceinline__ Ptrs make_ptrs(const Args& args) {
    unsigned char* ws = args.ws;
    Ptrs P;
    P.x = args.in[0]; P.mem = args.in[1]; P.attn_g = args.in[2]; P.w_in = args.in[3]; P.conv_w = args.in[4]; P.conv_b = args.in[5]; P.conv_ln_g = args.in[6]; P.conv_ln_b = args.in[7];
    P.sb_out_g = args.in[8]; P.mem_norm_g = args.in[9]; P.w_mem_kv = args.in[10]; P.q_norm_g = args.in[11]; P.k_norm_g = args.in[12]; P.mem_out_g = args.in[13]; P.w_out = args.in[14];
    P.ffn_g = args.in[15]; P.w_peer_q = args.in[16]; P.keys1 = args.in[17]; P.keys2 = args.in[18]; P.peer_u = args.in[19]; P.peer_v = args.in[20];
    P.out = args.out;
    P.WIN = (bf16*)(ws + WS_WIN); P.WKV = (bf16*)(ws + WS_WKV); P.WOUT = (bf16*)(ws + WS_WOUT); P.WPQ = (bf16*)(ws + WS_WPQ); P.KEYS = (bf16*)(ws + WS_KEYS);
    P.MEMN = (bf16*)(ws + WS_MEMN); P.MKV = (bf16*)(ws + WS_MKV); P.UT = (bf16*)(ws + WS_UT); P.VT = (bf16*)(ws + WS_VT); P.XN = (bf16*)(ws + WS_XN); P.CAT = (bf16*)(ws + WS_CAT);
    P.PROJ = (bf16*)(ws + WS_PROJ); P.Q = (bf16*)(ws + WS_Q); P.SELI = (int*)(ws + WS_SELI); P.SELG = (float*)(ws + WS_SELG); P.SSQ2 = (float*)(ws + WS_CTL) + CW_SSQ2;
    return P;
}
__global__ void __launch_bounds__(NWAVES * 64, 2) fwd_kernel(Args args) {
    extern __shared__ __attribute__((aligned(16))) unsigned char lds[];
    Frame F;
    F.lds = (LAS unsigned char*)lds;
    F.MISC = (volatile LAS unsigned*)(F.lds + MISC_OFF);
    F.tid = threadIdx.x; F.lane = F.tid & 63; F.wave = __builtin_amdgcn_readfirstlane(F.tid >> 6);
    F.G = gridDim.x; { const int bx = blockIdx.x; F.vcu = (F.G % 8 == 0) ? (bx % 8) * (F.G / 8) + bx / 8 : bx; }
    unsigned char* ws = args.ws;
    F.ctl = (gu32*)(ws + WS_CTL);
    for (int u = F.tid; u < (LDS_BYTES - LDSCTL_OFF) / 4; u += NWAVES * 64) ((LAS unsigned*)(F.lds + LDSCTL_OFF))[u] = 0u;
    __syncthreads();
    XcdBarrier bar; bar.bar = (unsigned*)(F.ctl + CW_BAR); bar.x = 0; bar.st = nullptr;
    if (N_LAUNCHES != PER_PHASE) bar = xcd_barrier_post((unsigned*)(F.ctl + CW_BAR), F.MISC + 8);
#define GRID_BAR() do { if (N_LAUNCHES != PER_PHASE) xcd_barrier(bar); } while (0)
    const int lo = args.ph_lo, hi = args.ph_hi;
#define IN(k) (lo <= (k) && (k) < hi)
#define BOTH(k) (IN(k) && IN((k) + 1))

    if (IN(0)) { const Ptrs P = make_ptrs(args); p0_prologue(F, P); if (BOTH(0)) GRID_BAR(); }

    if (IN(1)) { const Ptrs P = make_ptrs(args);
        { pg8::Gemm g{P.XN, P.WIN, M, INW, D}; pg8::StaticOrder S; S.init(M, INW, F.G, (int)blockIdx.x);
          pg8::EpiBf16 E{P.PROJ, INW};
          pg8::gemm_phase<pg8::EpiBf16, pg8::StaticOrder, PG8_ALIGN, PG8_SP2>(F.lds + RING_OFF, g, S, E); }
        { pg8::Gemm g{P.MEMN, P.WKV, MMEM, KVW, D}; pg8::StaticOrder S; S.init(MMEM, KVW, F.G, (int)blockIdx.x);
          pg8::EpiBf16 E{P.MKV, KVW};
          pg8::gemm_phase<pg8::EpiBf16, pg8::StaticOrder, PG8_ALIGN, PG8_SP2>(F.lds + RING_OFF, g, S, E); }
        if (BOTH(1)) GRID_BAR();
    }

    if (IN(2)) { const Ptrs P = make_ptrs(args);
        const int c = F.vcu;
        for (int it = c; it < 256; it += F.G) for (int i = 0; i < 2; ++i) { const int b = it >> 5, s = it & 31; sb_item(F, P, b, i == 0 ? s : 63 - s); }
        __syncthreads();
        for (int it = c; it < BATCH * (SEQ / 128); it += F.G) mem_item(F, P, it / (SEQ / 128), it % (SEQ / 128));
        __syncthreads();
        for (int it = c; it < BATCH * (SEQ / 32); it += F.G) { conv_item(F, P, it / (SEQ / 32), it % (SEQ / 32)); }
        __syncthreads();
        if (BOTH(2)) GRID_BAR();
    }

    if (IN(3)) { const Ptrs P = make_ptrs(args);
        pg8::Gemm g{P.CAT, P.WOUT, M, D, D}; pg8::StaticOrder S; S.init(M, D, F.G, (int)blockIdx.x);
        pg8::EpiResid E{P.x, P.out, P.XN, P.SSQ2, D};
        pg8::gemm_phase<pg8::EpiResid, pg8::StaticOrder, PG8_ALIGN, PG8_SP2>(F.lds + RING_OFF, g, S, E);
        if (BOTH(3)) GRID_BAR();
    }

    if (IN(4)) { const Ptrs P = make_ptrs(args);
        pg8::Gemm g{P.XN, P.WPQ, M, PQW, D}; pg8::StaticOrder S; S.init(M, PQW, F.G, (int)blockIdx.x);
        pg8::EpiBf16Row E{P.Q, PQW, P.SSQ2};
        pg8::gemm_phase<pg8::EpiBf16Row, pg8::StaticOrder, PG8_ALIGN, PG8_SP2>(F.lds + RING_OFF, g, S, E);
        if (BOTH(4)) GRID_BAR();
    }

    if (IN(5)) { const Ptrs P = make_ptrs(args);
        for (int it = F.vcu; it < (M / 512) * 8; it += F.G) peer_select_item(F, P, it >> 3, it & 7);
        __syncthreads();
        if (BOTH(5)) GRID_BAR();
    }

    if (IN(6)) { const Ptrs P = make_ptrs(args);
        const int gw = F.vcu * NWAVES + F.wave, NGW = F.G * NWAVES;
        for (int t = gw; t < M; t += NGW) peer_gather_token(P, t, F.lane);
    }
#undef IN
#undef BOTH
}

extern "C" void kernel_launch(void* const* d_in, const int* in_sizes, int n_in, void* d_out, int out_size, void* d_ws, size_t ws_size, hipStream_t stream) {
    static int grid = 0;
    if (grid == 0) {
        if (n_in != 21 || in_sizes[0] != M * D || out_size != M * D || ws_size < WS_END) { fprintf(stderr, "kernel_launch: unexpected shapes/workspace (n_in %d, in0 %d, out %d, ws %zu); nothing launched\n", n_in, n_in > 0 ? in_sizes[0] : -1, out_size, ws_size); grid = -1; return; }
        int dev = 0, cus = 0, per_cu = 0;
        if (hipGetDevice(&dev) != hipSuccess || hipDeviceGetAttribute(&cus, hipDeviceAttributeMultiprocessorCount, dev) != hipSuccess) { grid = -1; return; }
        if (hipFuncSetAttribute((const void*)fwd_kernel, hipFuncAttributeMaxDynamicSharedMemorySize, LDS_BYTES) != hipSuccess) { fprintf(stderr, "kernel_launch: hipFuncSetAttribute failed\n"); grid = -1; return; }
        if (hipOccupancyMaxActiveBlocksPerMultiprocessor(&per_cu, (const void*)fwd_kernel, NWAVES * 64, LDS_BYTES) != hipSuccess || per_cu < 1) { fprintf(stderr, "kernel_launch: occupancy query says %d blocks per CU\n", per_cu); }
        (void)hipGetLastError();
        grid = cus;
    }
    if (grid < 0) return;
    if (hipMemsetAsync((char*)d_ws + WS_CTL, 0, CTL_ZERO_BYTES, stream) != hipSuccess) { fprintf(stderr, "kernel_launch: memset failed\n"); return; }
    Args a{};
    for (int i = 0; i < 21; ++i) a.in[i] = (const float*)d_in[i];
    a.out = (float*)d_out; a.ws = (unsigned char*)d_ws;
    for (int li = 0; li < N_LAUNCHES; ++li) {
        a.ph_lo = (N_LAUNCHES == PER_PHASE) ? li : 0; a.ph_hi = (N_LAUNCHES == PER_PHASE) ? li + 1 : PER_PHASE; a.li = li;
        hipLaunchKernelGGL(fwd_kernel, dim3(grid), dim3(NWAVES * 64), LDS_BYTES, stream, a);
        const hipError_t le = hipPeekAtLastError();
        if (le != hipSuccess) { fprintf(stderr, "kernel_launch: launch %d failed: %s\n", li, hipGetErrorName(le)); break; }
    }
}
```

```cpp
#include <hip/hip_runtime.h>
#include <cstdio>
#include <cstdint>
namespace pg8 {
#define PG8_LAS __attribute__((address_space(3)))
typedef unsigned short bf16_t;
typedef short bf16x8 __attribute__((ext_vector_type(8)));
typedef float f32x4 __attribute__((ext_vector_type(4)));
typedef unsigned u32x4 __attribute__((ext_vector_type(4)));
constexpr int BM = 256, BK = 64, HALF = 128, HTB = HALF * BK * 2  , STAGE_BYTES = 8 * HTB, NXCD = 8, WGM = 8;

__host__ __device__ __forceinline__ int lds_byte(int r, int c) { const int st = (r >> 4) * 2 + (c >> 5), rr = r & 15, cc = c & 31, ob = rr * 64 + cc * 2; return st * 1024 + (ob ^ (((ob >> 9) & 1) << 5)); }
__host__ __device__ __forceinline__ void stage_rc(int b, int& R, int& C) { const int st = b / 1024, sb = b % 1024, swz = sb ^ (((sb >> 9) & 1) << 5); R = (st >> 1) * 16 + swz / 64; C = (st & 1) * 32 + (swz % 64) / 2; }
__host__ __device__ __forceinline__ int perm32(int rho) { const int n = rho >> 4, i = rho & 15; return 8 * (i >> 2) + 4 * n + (i & 3); }

struct Unit { int pm, pn; };
struct Gemm { const bf16_t* A; const bf16_t* Bt; int M, N, K; };

struct StaticOrder {
    int nM, nN, nwg, G, c;
    __host__ __device__ void init(int M, int N, int G_, int c_) { nM = M / BM; nN = N / BM; nwg = nM * nN; G = G_; c = c_; }
    __host__ __device__ bool next(int i, Unit& u) const {
        const long L = (long)i * G + c; if (L >= nwg) return false;
        int wgid = (int)L; { const int q = nwg / NXCD, r = nwg % NXCD, xcd = wgid % NXCD, off = wgid / NXCD; wgid = (xcd < r ? xcd * (q + 1) : r * (q + 1) + (xcd - r) * q) + off; }
        const int nig = WGM * nN, gid = wgid / nig, fm = gid * WGM, gsz = (nM - fm) < WGM ? (nM - fm) : WGM;
        u.pm = fm + ((wgid % nig) % gsz); u.pn = (wgid % nig) / gsz; return true;
    }
    __device__ __forceinline__ void a_ready(const Unit&) const {}
    __device__ __forceinline__ void done(const Unit&) const {}
};

__device__ __forceinline__ unsigned cvt_pk_bf16(float lo, float hi) { unsigned r; asm volatile("v_cvt_pk_bf16_f32 %0, %1, %2" : "=v"(r) : "v"(lo), "v"(hi)); return r; }
typedef unsigned u32x2 __attribute__((ext_vector_type(2)));

struct EpiBf16 {
    static constexpr bool PERM = true, AFTER_DRAIN = false;
    bf16_t* O; int ldc;
    __device__ __forceinline__ void operator()(const f32x4 (&acc)[2][2][4][2], const Unit& u, int wr, int wc, int fr, int fq) const {
        const int row0 = u.pm * BM + wr * 64 + fr; const int col0 = u.pn * BM + wc * 32 + 8 * fq;
#pragma unroll
        for (int ai = 0; ai < 2; ++ai)
#pragma unroll
            for (int m = 0; m < 4; ++m) { bf16_t* rowp = O + (size_t)(row0 + ai * HALF + m * 16) * ldc + col0;
#pragma unroll
                for (int bj = 0; bj < 2; ++bj) { const f32x4 v0 = acc[ai][bj][m][0], v1 = acc[ai][bj][m][1];
                    u32x4 w; w.x = cvt_pk_bf16(v0[0], v0[1]); w.y = cvt_pk_bf16(v0[2], v0[3]); w.z = cvt_pk_bf16(v1[0], v1[1]); w.w = cvt_pk_bf16(v1[2], v1[3]);
                    *(u32x4*)(rowp + bj * HALF) = w; } }
    }
};
struct EpiBf16Row {
    static constexpr bool PERM = true, AFTER_DRAIN = false;
    bf16_t* O; int ldc; const float* ssq;
    __device__ __forceinline__ void operator()(const f32x4 (&acc)[2][2][4][2], const Unit& u, int wr, int wc, int fr, int fq) const {
        const int row0 = u.pm * BM + wr * 64 + fr; const int col0 = u.pn * BM + wc * 32 + 8 * fq;
#pragma unroll
        for (int ai = 0; ai < 2; ++ai)
#pragma unroll
            for (int m = 0; m < 4; ++m) { const int row = row0 + ai * HALF + m * 16; bf16_t* rowp = O + (size_t)row * ldc + col0;
                const float rs = 1.0f / sqrtf(__hip_atomic_load(ssq + row, __ATOMIC_RELAXED, __HIP_MEMORY_SCOPE_AGENT) * (1.0f / 1024.0f) + 1e-6f);
#pragma unroll
                for (int bj = 0; bj < 2; ++bj) { const f32x4 v0 = acc[ai][bj][m][0] * rs, v1 = acc[ai][bj][m][1] * rs;
                    u32x4 w; w.x = cvt_pk_bf16(v0[0], v0[1]); w.y = cvt_pk_bf16(v0[2], v0[3]); w.z = cvt_pk_bf16(v1[0], v1[1]); w.w = cvt_pk_bf16(v1[2], v1[3]);
                    *(u32x4*)(rowp + bj * HALF) = w; } }
    }
};
struct EpiResid {
    static constexpr bool PERM = false, AFTER_DRAIN = false;
    const float* x; float* out; bf16_t* xb; float* ssq; int ldc;
    __device__ __forceinline__ void operator()(const f32x4 (&acc)[2][2][4][2], const Unit& u, int wr, int wc, int fr, int fq) const {
        const int col0 = u.pn * BM + wc * 32 + 4 * fq;
#pragma unroll
        for (int ai = 0; ai < 2; ++ai)
#pragma unroll
            for (int m = 0; m < 4; ++m) { const int row = u.pm * BM + ai * HALF + wr * 64 + m * 16 + fr; const size_t off = (size_t)row * ldc + col0; float s = 0.f;
#pragma unroll
                for (int bj = 0; bj < 2; ++bj)
#pragma unroll
                    for (int n = 0; n < 2; ++n) { const f32x4 xv = *(const f32x4*)(x + off + bj * HALF + n * 16); const f32x4 o = xv + acc[ai][bj][m][n];
                        *(f32x4*)(out + off + bj * HALF + n * 16) = o; s += (o[0] * o[0] + o[1] * o[1]) + (o[2] * o[2] + o[3] * o[3]);
                        u32x2 w; w.x = cvt_pk_bf16(o[0], o[1]); w.y = cvt_pk_bf16(o[2], o[3]); *(u32x2*)(xb + off + bj * HALF + n * 16) = w; }
                s += __shfl_xor(s, 16); s += __shfl_xor(s, 32);
                if (fq == 0) unsafeAtomicAdd(ssq + row, s); }
    }
};

template <class Epi, class Sched, bool ALIGN_EPI = false, bool SP2 = false>
__device__ __forceinline__ void gemm_phase(PG8_LAS unsigned char* lds, const Gemm g, const Sched& S, const Epi& E) {
    const int tid = threadIdx.x, wid = __builtin_amdgcn_readfirstlane(tid >> 6), lane = tid & 63, wr = wid >> 2, wc = wid & 3, fr = lane & 15, fq = lane >> 4;
    const int K = g.K, nt = K / BK;
    unsigned voffA[2], voffB[2];
#pragma unroll
    for (int i = 0; i < 2; ++i) { int R, C; stage_rc(tid * 16 + i * 8192, R, C); const int Rb = Epi::PERM ? ((R & ~31) + perm32(R & 31)) : R;
        voffA[i] = (unsigned)(R * K + C) * 2u; voffB[i] = (unsigned)(Rb * K + C) * 2u; }
    const size_t kstep = (size_t)(BK * 2);
    const size_t hstep = (size_t)HALF * K * 2;
    const size_t tstep = 2 * hstep;
    const unsigned ldsw = (unsigned)wid * 1024u;
    const int aoff = lds_byte(wr * 64 + fr, fq * 8), boff = lds_byte(wc * 32 + fr, fq * 8);
#define PG8_SA(b, h) (((b) * 2 + (h)) * HTB)
#define PG8_SB(b, h) ((4 + (b) * 2 + (h)) * HTB)
#define PG8_STAGE(bufoff, gbase, voff) do { _Pragma("unroll") for (int _i = 0; _i < 2; ++_i) \
        __builtin_amdgcn_global_load_lds((const unsigned*)((const char*)(gbase) + (voff)[_i]), (PG8_LAS unsigned*)(lds + (bufoff) + ldsw + _i * 8192), 16, 0, 0); } while (0)
#define PG8_LDA(dst, b, h) do { _Pragma("unroll") for (int m = 0; m < 4; ++m) _Pragma("unroll") for (int k = 0; k < 2; ++k) dst[m][k] = *(const PG8_LAS bf16x8*)(lds + PG8_SA(b, h) + aoff + m * 2048 + k * 1024); } while (0)
#define PG8_LDB(dst, b, h) do { _Pragma("unroll") for (int n = 0; n < 2; ++n) _Pragma("unroll") for (int k = 0; k < 2; ++k) dst[n][k] = *(const PG8_LAS bf16x8*)(lds + PG8_SB(b, h) + boff + n * 2048 + k * 1024); } while (0)
#define PG8_MMA(ai, bj, At, Bt) do { __builtin_amdgcn_s_setprio(1); _Pragma("unroll") for (int m = 0; m < 4; ++m) _Pragma("unroll") for (int n = 0; n < 2; ++n) _Pragma("unroll") for (int k = 0; k < 2; ++k) \
        acc[ai][bj][m][n] = __builtin_amdgcn_mfma_f32_16x16x32_bf16(Bt[n][k], At[m][k], acc[ai][bj][m][n], 0, 0, 0); __builtin_amdgcn_s_setprio(0); } while (0)
#define PG8_WAIT_V(n) asm volatile("s_waitcnt vmcnt(" #n ")" ::: "memory")
#define PG8_WAIT_L(n) asm volatile("s_waitcnt lgkmcnt(" #n ")" ::: "memory")
#define PG8_BAR __builtin_amdgcn_s_barrier()
#define PG8_SCHED __builtin_amdgcn_sched_barrier(0)
    Unit cur, nxt; int ui = 0;
    if (!S.next(0, cur)) return;
    f32x4 acc[2][2][4][2];
#pragma unroll
    for (int a = 0; a < 2; ++a)
#pragma unroll
        for (int b = 0; b < 2; ++b)
#pragma unroll
            for (int m = 0; m < 4; ++m)
#pragma unroll
                for (int n = 0; n < 2; ++n) acc[a][b][m][n] = (f32x4){0.f, 0.f, 0.f, 0.f};
    bf16x8 At[4][2], B0[2][2], B1[2][2];
    const char* cA = (const char*)g.A + (size_t)cur.pm * tstep; const char* cB = (const char*)g.Bt + (size_t)cur.pn * tstep;
    S.a_ready(cur);
    if constexpr (SP2) {
        PG8_STAGE(PG8_SB(0, 0), cB, voffB); PG8_STAGE(PG8_SB(0, 1), cB + hstep, voffB); PG8_STAGE(PG8_SA(0, 0), cA, voffA); PG8_STAGE(PG8_SA(0, 1), cA + hstep, voffA);
        if (wr == 1) PG8_BAR;
        PG8_WAIT_V(2); PG8_BAR;
        PG8_STAGE(PG8_SB(1, 0), cB + kstep, voffB); PG8_STAGE(PG8_SA(1, 0), cA + kstep, voffA); PG8_STAGE(PG8_SB(1, 1), cB + hstep + kstep, voffB);
        PG8_WAIT_V(6); PG8_BAR;
    } else {
        PG8_STAGE(PG8_SB(0, 0), cB, voffB); PG8_STAGE(PG8_SA(0, 0), cA, voffA); PG8_STAGE(PG8_SB(0, 1), cB + hstep, voffB); PG8_STAGE(PG8_SA(0, 1), cA + hstep, voffA);
        if (wr == 1) PG8_BAR;
        PG8_WAIT_V(4); PG8_BAR;
        PG8_STAGE(PG8_SB(1, 0), cB + kstep, voffB); PG8_STAGE(PG8_SA(1, 0), cA + kstep, voffA); PG8_STAGE(PG8_SB(1, 1), cB + hstep + kstep, voffB);
        PG8_WAIT_V(6); PG8_BAR;
    }
    for (;;) {
        const bool has_next = S.next(ui + 1, nxt);
        const char* nA = has_next ? (const char*)g.A + (size_t)nxt.pm * tstep : cA; const char* nB = has_next ? (const char*)g.Bt + (size_t)nxt.pn * tstep : cB;
        for (int t = 0; t < nt; t += 2) {
            const bool last = (t == nt - 2);
            const char* a1 = cA + (size_t)(t + 1) * kstep;
            const char* a2 = last ? nA : cA + (size_t)(t + 2) * kstep; const char* b2 = last ? nB : cB + (size_t)(t + 2) * kstep;
            const char* a3 = a2 + kstep; const char* b3 = b2 + kstep;
            if (last && has_next) S.a_ready(nxt);
            if constexpr (SP2) {
            PG8_LDB(B0, 0, 0); PG8_LDB(B1, 0, 1); PG8_SCHED; PG8_LDA(At, 0, 0); PG8_STAGE(PG8_SA(1, 1), a1 + hstep, voffA);
            PG8_WAIT_V(8); PG8_WAIT_L(0); PG8_BAR; PG8_MMA(0, 0, At, B0); PG8_MMA(0, 1, At, B1); PG8_BAR; PG8_SCHED;
            PG8_LDA(At, 0, 1); PG8_STAGE(PG8_SB(0, 0), b2, voffB); PG8_STAGE(PG8_SB(0, 1), b2 + hstep, voffB); PG8_STAGE(PG8_SA(0, 0), a2, voffA);
            PG8_WAIT_V(8); PG8_WAIT_L(0); PG8_BAR; PG8_MMA(1, 0, At, B0); PG8_MMA(1, 1, At, B1); PG8_BAR; PG8_SCHED;
            PG8_LDB(B0, 1, 0); PG8_LDB(B1, 1, 1); PG8_SCHED; PG8_LDA(At, 1, 0); PG8_STAGE(PG8_SA(0, 1), a2 + hstep, voffA);
            PG8_WAIT_V(8); PG8_WAIT_L(0); PG8_BAR; PG8_MMA(0, 0, At, B0); PG8_MMA(0, 1, At, B1); PG8_BAR; PG8_SCHED;
            PG8_LDA(At, 1, 1); PG8_STAGE(PG8_SB(1, 0), b3, voffB); PG8_STAGE(PG8_SB(1, 1), b3 + hstep, voffB); PG8_STAGE(PG8_SA(1, 0), a3, voffA);
            PG8_WAIT_V(8); PG8_WAIT_L(0); PG8_BAR; PG8_MMA(1, 0, At, B0); PG8_MMA(1, 1, At, B1); PG8_BAR; PG8_SCHED;
            } else {
            PG8_LDB(B0, 0, 0); PG8_SCHED; PG8_LDA(At, 0, 0); PG8_STAGE(PG8_SA(1, 1), a1 + hstep, voffA);
            PG8_WAIT_L(8); PG8_BAR; PG8_WAIT_L(0); PG8_MMA(0, 0, At, B0); PG8_BAR; PG8_SCHED;
            PG8_LDB(B1, 0, 1); PG8_STAGE(PG8_SB(0, 0), b2, voffB);
            PG8_BAR; PG8_WAIT_L(0); PG8_MMA(0, 1, At, B1); PG8_BAR;
            PG8_LDA(At, 0, 1); PG8_STAGE(PG8_SA(0, 0), a2, voffA);
            PG8_BAR; PG8_WAIT_L(0); PG8_MMA(1, 0, At, B0); PG8_BAR; PG8_SCHED;
            PG8_STAGE(PG8_SB(0, 1), b2 + hstep, voffB);
            PG8_WAIT_V(6); PG8_BAR; PG8_MMA(1, 1, At, B1); PG8_BAR;
            PG8_LDB(B0, 1, 0); PG8_SCHED; PG8_LDA(At, 1, 0); PG8_STAGE(PG8_SA(0, 1), a2 + hstep, voffA);
            PG8_WAIT_L(8); PG8_BAR; PG8_WAIT_L(0); PG8_MMA(0, 0, At, B0); PG8_BAR; PG8_SCHED;
            PG8_LDB(B1, 1, 1); PG8_STAGE(PG8_SB(1, 0), b3, voffB);
            PG8_BAR; PG8_WAIT_L(0); PG8_MMA(0, 1, At, B1); PG8_BAR;
            PG8_LDA(At, 1, 1); PG8_STAGE(PG8_SA(1, 0), a3, voffA);
            PG8_BAR; PG8_WAIT_L(0); PG8_MMA(1, 0, At, B0); PG8_BAR; PG8_SCHED;
            PG8_STAGE(PG8_SB(1, 1), b3 + hstep, voffB);
            PG8_WAIT_V(6); PG8_BAR; PG8_MMA(1, 1, At, B1); PG8_BAR;
            }
        }
        if constexpr (ALIGN_EPI) { if (wr == 0) PG8_BAR; }
        if constexpr (!Epi::AFTER_DRAIN) { E(acc, cur, wr, wc, fr, fq); S.done(cur); }
        if (!has_next) break;
#pragma unroll
        for (int a = 0; a < 2; ++a)
#pragma unroll
            for (int b = 0; b < 2; ++b)
#pragma unroll
                for (int m = 0; m < 4; ++m)
#pragma unroll
                    for (int n = 0; n < 2; ++n) acc[a][b][m][n] = (f32x4){0.f, 0.f, 0.f, 0.f};
        cur = nxt; cA = nA; cB = nB; ++ui;
        if constexpr (ALIGN_EPI) { if (wr == 1) PG8_BAR; }
    }
    PG8_WAIT_V(0);
    if constexpr (!ALIGN_EPI) { if (wr == 0) PG8_BAR; }
    PG8_BAR;
    if constexpr (Epi::AFTER_DRAIN) { E.fused(acc, cur, wr, wc, fr, fq, lds, wid, lane); S.done(cur); }
#undef PG8_SA
#undef PG8_SB
#undef PG8_STAGE
#undef PG8_LDA
#undef PG8_LDB
#undef PG8_MMA
#undef PG8_WAIT_V
#undef PG8_WAIT_L
#undef PG8_BAR
#undef PG8_SCHED
}
}

#ifndef PG8_SP2
#define PG8_SP2 true
#endif
#ifndef PG8_ALIGN
#define PG8_ALIGN true
#endif
#ifndef MK_N_LAUNCHES
#define MK_N_LAUNCHES 1
#endif
constexpr int NWAVES = 8;
constexpr int PER_PHASE = 7;
constexpr int N_LAUNCHES = MK_N_LAUNCHES;

constexpr int BATCH = 8, SEQ = 4096, D = 1024, M = BATCH * SEQ;
constexpr int MEML = 256, MMEM = BATCH * MEML;
constexpr int INW = 2304, KVW = 512, PQW = 2048;
constexpr int C_A = 0, C_G = 256, C_Q = 512, C_K = 1024, C_V = 1536, C_MQ = 2048;
constexpr int NEXP = 16384;
constexpr float EPS = 1e-6f;

constexpr size_t MiB = 1u << 20;
constexpr size_t WS_CTL = 0, CTL_ZERO_BYTES = 1 * MiB;
constexpr size_t WS_WIN = 2 * MiB, WS_WKV = 7 * MiB, WS_WOUT = 8 * MiB, WS_WPQ = 10 * MiB, WS_KEYS = 14 * MiB;
constexpr size_t WS_MEMN = 15 * MiB, WS_MKV = 19 * MiB;
constexpr size_t WS_UT = 24 * MiB, WS_VT = 56 * MiB;
constexpr size_t WS_XN = 88 * MiB;
constexpr size_t WS_CAT = 152 * MiB;
constexpr size_t WS_SELI = 216 * MiB, WS_SELG = 232 * MiB;
constexpr size_t WS_PROJ = 256 * MiB;
constexpr size_t WS_Q = 256 * MiB;
constexpr size_t WS_END = 400 * MiB;
constexpr int CW_BAR = 4096;
constexpr int CW_SSQ2 = 65536;
static_assert((CW_SSQ2 + M) * 4 <= (int)CTL_ZERO_BYTES, "ctl");

constexpr int RING_OFF = 0, RING_BYTES = 131072;
constexpr int LDSCTL_OFF = RING_BYTES, MISC_OFF = LDSCTL_OFF + 320;
constexpr int EXTRA_OFF = RING_BYTES + 1024;
constexpr int LDS_BYTES = 147456;

#define GAS __attribute__((address_space(1)))
#define LAS __attribute__((address_space(3)))
typedef unsigned short bf16;
typedef unsigned v4u __attribute__((ext_vector_type(4)));
typedef unsigned v2u __attribute__((ext_vector_type(2)));
typedef float f32x4 __attribute__((ext_vector_type(4)));
typedef GAS unsigned gu32;
typedef __bf16 bf16x2_t __attribute__((ext_vector_type(2)));
#define RLX_AGENT __ATOMIC_RELAXED, __HIP_MEMORY_SCOPE_AGENT
#define LDS_WAIT() asm volatile("s_waitcnt lgkmcnt(0)" ::: "memory")
__device__ __forceinline__ unsigned f2bf(float f) { unsigned u = __builtin_bit_cast(unsigned, f); return (u + 0x7fffu + ((u >> 16) & 1u)) >> 16; }
__device__ __forceinline__ unsigned pk2(float lo, float hi) { return f2bf(lo) | (f2bf(hi) << 16); }
__device__ __forceinline__ float bflo(unsigned w) { return __uint_as_float(w << 16); }
__device__ __forceinline__ float bfhi(unsigned w) { return __uint_as_float(w & 0xffff0000u); }
__device__ __forceinline__ float dot2(unsigned a, unsigned b, float c) { return __builtin_amdgcn_fdot2_f32_bf16(__builtin_bit_cast(bf16x2_t, a), __builtin_bit_cast(bf16x2_t, b), c, false); }
__device__ __forceinline__ float wave_sum(float v) {
#pragma unroll
    for (int o = 1; o < 64; o <<= 1) v += __shfl_xor(v, o);
    return v;
}
#define XB_TMO      128
#define XB_XCNT(j)  (256  + 64 * (j))
#define XB_XSUB(j)  (1280 + 64 * (j))
#define XB_XGEN(j)  (2304 + 64 * (j))
#define XB_TOP      3328
#define XB_TOPGEN   3392
#define XCD_BAR_WORDS 3456
#define XB_SPIN_CAP (1u << 18)

__device__ __forceinline__ unsigned xb_ld(unsigned* p)              { return __hip_atomic_load(p, __ATOMIC_RELAXED, __HIP_MEMORY_SCOPE_AGENT); }
__device__ __forceinline__ unsigned xb_add(unsigned* p, unsigned v) { return __hip_atomic_fetch_add(p, v, __ATOMIC_RELAXED, __HIP_MEMORY_SCOPE_AGENT); }
__device__ __forceinline__ unsigned xb_xcc_id() { return (unsigned)__builtin_amdgcn_s_getreg((3 << 11) | 20) & 0xFu; }
#define XB_SPIN(cond, bar) do { unsigned _sp = 0; while (cond) { __builtin_amdgcn_s_sleep(1); \
    if ((++_sp & 255u) == 0u) { if (xb_ld(&(bar)[XB_TMO])) break; if (_sp > XB_SPIN_CAP) { atomicAdd(&(bar)[XB_TMO], 1u); break; } } } } while (0)

struct XcdBarrier {
    unsigned* bar; unsigned x;
    volatile LAS unsigned* st;
};

__device__ __forceinline__ XcdBarrier xcd_barrier_post(unsigned* bar, volatile LAS unsigned* st) {
    XcdBarrier b; b.bar = bar; b.x = xb_xcc_id(); b.st = st;
    if (threadIdx.x == 0) (void)xb_add(&bar[XB_XCNT(b.x)], 1u);
    return b;
}
__device__ __forceinline__ void xcd_barrier_complete(unsigned* bar, unsigned x, unsigned& nloc, unsigned& nx) {
    const unsigned G = gridDim.x * gridDim.y * gridDim.z;
    unsigned sum, cnt, mine, sp = 0u;
    for (;;) {
        sum = 0u; cnt = 0u; mine = 0u;
#pragma unroll
        for (unsigned j = 0; j < 16; ++j) { const unsigned c = xb_ld(&bar[XB_XCNT(j)]); sum += c; cnt += (c > 0u) ? 1u : 0u; mine = (j == x) ? c : mine; }
        if (sum == G) break;
        __builtin_amdgcn_s_sleep(1);
        if ((++sp & 255u) == 0u) { if (xb_ld(&bar[XB_TMO])) break; if (sp > XB_SPIN_CAP) { atomicAdd(&bar[XB_TMO], 1u); break; } }
    }
    nloc = mine > 0u ? mine : 1u; nx = cnt > 0u ? cnt : 1u;
}

__device__ __forceinline__ void xcd_barrier(const XcdBarrier& b) {
    asm volatile("s_waitcnt vmcnt(0)" ::: "memory");
    __syncthreads();
    if (threadIdx.x == 0) {
        unsigned* bar = b.bar;
        __builtin_amdgcn_s_waitcnt(0);
        unsigned nloc = b.st[0], nx = b.st[1];
        if (nloc == 0u) { xcd_barrier_complete(bar, b.x, nloc, nx); b.st[0] = nloc; b.st[1] = nx; }
        const unsigned old = xb_add(&bar[XB_XSUB(b.x)], 1u);
        const unsigned gen = old / nloc;
        if (old + 1u == (gen + 1u) * nloc) {
            __builtin_amdgcn_fence(__ATOMIC_RELEASE, "agent");
            asm volatile("s_waitcnt vmcnt(0)" ::: "memory");
            const unsigned og = xb_add(&bar[XB_TOP], 1u);
            const unsigned tg = og / nx;
            if (og + 1u == (tg + 1u) * nx) xb_add(&bar[XB_TOPGEN], 1u);
            else XB_SPIN(xb_ld(&bar[XB_TOPGEN]) == tg, bar);
            __builtin_amdgcn_fence(__ATOMIC_ACQUIRE, "agent");
            xb_add(&bar[XB_XGEN(b.x)], 1u);
            asm volatile("s_waitcnt vmcnt(0)" ::: "memory");
        } else {
            XB_SPIN(xb_ld(&bar[XB_XGEN(b.x)]) == gen, bar);
            __builtin_amdgcn_fence(__ATOMIC_ACQUIRE, "agent");
            asm volatile("s_waitcnt vmcnt(0)" ::: "memory");
        }
    }
    __syncthreads();
}

struct Frame {
    LAS unsigned char* lds;
    volatile LAS unsigned* MISC;
    gu32* ctl;
    int tid, lane, wave;
    int vcu, G;
};
struct Ptrs {
    const float *x, *mem, *attn_g, *w_in, *conv_w, *conv_b, *conv_ln_g, *conv_ln_b, *sb_out_g, *mem_norm_g, *w_mem_kv, *q_norm_g, *k_norm_g, *mem_out_g,
                *w_out, *ffn_g, *w_peer_q, *keys1, *keys2, *peer_u, *peer_v;
    float* out;
    bf16 *WIN, *WKV, *WOUT, *WPQ, *KEYS, *MEMN, *MKV, *UT, *VT, *XN, *CAT, *PROJ, *Q;
    int* SELI; float* SELG; float* SSQ2;
};

__device__ __forceinline__ void p0_transpose_item(const float* W, const float* gk, int K, int N, bf16* WT, LAS float* scr, int item, int lane) {
    const int nblk = N / 32, kb = item / nblk, nb = item % nblk, k0 = 64 * kb, n0 = 32 * nb;
#pragma unroll 8
    for (int i = 0; i < 32; ++i) { const int kk = 2 * i + (lane >> 5); float w = W[(size_t)(k0 + kk) * N + n0 + (lane & 31)]; if (gk) w *= gk[k0 + kk]; scr[kk * 33 + (lane & 31)] = w; }
    LDS_WAIT(); asm volatile("" ::: "memory");
    const int c = lane & 7;
#pragma unroll
    for (int j = 0; j < 4; ++j) { const int n = (lane >> 3) + 8 * j; const LAS float* s = scr + (8 * c) * 33 + n;
        v4u o; o.x = pk2(s[0 * 33], s[1 * 33]); o.y = pk2(s[2 * 33], s[3 * 33]); o.z = pk2(s[4 * 33], s[5 * 33]); o.w = pk2(s[6 * 33], s[7 * 33]);
        *(GAS v4u*)(WT + (size_t)(n0 + n) * K + k0 + 8 * c) = o; }
    LDS_WAIT(); asm volatile("" ::: "memory");
}
__device__ __forceinline__ void rms_row_to_bf16(const float* xrow, const float* g, bf16* orow, int lane) {
    const GAS f32x4* xr = (const GAS f32x4*)xrow + lane; const GAS f32x4* gr = (const GAS f32x4*)g + lane;
    f32x4 v[4]; float s = 0.f;
#pragma unroll
    for (int j = 0; j < 4; ++j) { v[j] = xr[64 * j]; s += (v[j].x * v[j].x + v[j].y * v[j].y) + (v[j].z * v[j].z + v[j].w * v[j].w); }
    const float rinv = 1.f / sqrtf(wave_sum(s) * (1.f / 1024.f) + EPS);
    GAS unsigned long long* o8 = (GAS unsigned long long*)orow + lane;
#pragma unroll
    for (int j = 0; j < 4; ++j) { const f32x4 gg = gr[64 * j]; const f32x4 o = v[j] * rinv * gg;
        o8[64 * j] = (unsigned long long)pk2(o.x, o.y) | ((unsigned long long)pk2(o.z, o.w) << 32); }
}
__device__ __forceinline__ void cvt_f32_to_bf16_stream(const float* src, bf16* dst, size_t n8, size_t gtid, size_t nthr) {
    for (size_t i = gtid; i < n8; i += nthr) { const f32x4 a = ((const GAS f32x4*)src)[2 * i], b = ((const GAS f32x4*)src)[2 * i + 1];
        v4u o; o.x = pk2(a.x, a.y); o.y = pk2(a.z, a.w); o.z = pk2(b.x, b.y); o.w = pk2(b.z, b.w); ((GAS v4u*)dst)[i] = o; }
}
__device__ __forceinline__ void p0_prologue(Frame& F, const Ptrs& P) {
    LAS float* scr = (LAS float*)(F.lds + RING_OFF + F.wave * 16384);
    const int gw = F.vcu * NWAVES + F.wave, NGW = F.G * NWAVES;
    constexpr int I_IN = (D / 64) * (INW / 32), I_KV = (D / 64) * (KVW / 32), I_OUT = (D / 64) * (D / 32), I_PQ = (D / 64) * (PQW / 32);
    constexpr int NITEMS = I_IN + I_KV + I_OUT + I_PQ;
    for (int it = gw; it < NITEMS; it += NGW) {
        int r = it;
        if (r < I_IN) { p0_transpose_item(P.w_in, nullptr, D, INW, P.WIN, scr, r, F.lane); continue; } r -= I_IN;
        if (r < I_KV) { p0_transpose_item(P.w_mem_kv, nullptr, D, KVW, P.WKV, scr, r, F.lane); continue; } r -= I_KV;
        if (r < I_OUT) { p0_transpose_item(P.w_out, nullptr, D, D, P.WOUT, scr, r, F.lane); continue; } r -= I_OUT;
        p0_transpose_item(P.w_peer_q, P.ffn_g, D, PQW, P.WPQ, scr, r, F.lane);
    }
    for (int m = gw; m < M; m += NGW) rms_row_to_bf16(P.x + (size_t)m * D, P.attn_g, P.XN + (size_t)m * D, F.lane);
    for (int m = gw; m < MMEM; m += NGW) rms_row_to_bf16(P.mem + (size_t)m * D, P.mem_norm_g, P.MEMN + (size_t)m * D, F.lane);
    const size_t gtid = (size_t)gw * 64 + F.lane, nthr = (size_t)NGW * 64;
    cvt_f32_to_bf16_stream(P.keys1, P.KEYS, 8 * 128 * 128 / 8, gtid, nthr);
    cvt_f32_to_bf16_stream(P.keys2, P.KEYS + 8 * 128 * 128, 8 * 128 * 128 / 8, gtid, nthr);
    cvt_f32_to_bf16_stream(P.peer_u, P.UT, (size_t)NEXP * D / 8, gtid, nthr);
    cvt_f32_to_bf16_stream(P.peer_v, P.VT, (size_t)NEXP * D / 8, gtid, nthr);
}

__device__ __forceinline__ void conv_item(Frame& F, const Ptrs& P, int b, int ch) {
    LAS float* U = (LAS float*)(F.lds + 0);
    LAS float* Y = (LAS float*)(F.lds + 65536);
    const int t0 = ch * 32, tid = F.tid;
    for (int idx = tid; idx < 62 * 32; idx += 512) {
        const int r = idx >> 5, c8 = idx & 31, t = t0 - 30 + r;
        float u[8];
        if (t >= 0) { const bf16* src = P.PROJ + (size_t)(b * SEQ + t) * INW + c8 * 8;
            const v4u a = *(const GAS v4u*)(src + C_A), g = *(const GAS v4u*)(src + C_G);
            const unsigned aw[4] = {a.x, a.y, a.z, a.w}, gw_[4] = {g.x, g.y, g.z, g.w};
#pragma unroll
            for (int i = 0; i < 4; ++i) { const float a0 = bflo(aw[i]), a1 = bfhi(aw[i]), g0 = bflo(gw_[i]), g1 = bfhi(gw_[i]);
                u[2 * i] = a0 / (1.f + __expf(-g0)); u[2 * i + 1] = a1 / (1.f + __expf(-g1)); }
        } else {
#pragma unroll
            for (int i = 0; i < 8; ++i) u[i] = 0.f;
        }
        LAS f32x4* dst = (LAS f32x4*)(U + r * 256 + c8 * 8);
        dst[0] = (f32x4){u[0], u[1], u[2], u[3]}; dst[1] = (f32x4){u[4], u[5], u[6], u[7]};
    }
    __syncthreads();
    {
        const int c = tid & 255, half = tid >> 8;
        float w[31];
#pragma unroll
        for (int k = 0; k < 31; ++k) w[k] = P.conv_w[k * 256 + c];
        const float bias = P.conv_b[c];
        float win[46];
#pragma unroll
        for (int i = 0; i < 46; ++i) win[i] = U[(half * 16 + i) * 256 + c];
#pragma unroll
        for (int tt = 0; tt < 16; ++tt) { float y = bias;
#pragma unroll
            for (int k = 0; k < 31; ++k) y += w[k] * win[tt + k];
            Y[(half * 16 + tt) * 256 + c] = y; }
    }
    __syncthreads();
    {
        const f32x4 lg = ((const GAS f32x4*)P.conv_ln_g)[F.lane], lb = ((const GAS f32x4*)P.conv_ln_b)[F.lane];
#pragma unroll
        for (int i = 0; i < 4; ++i) { const int tok = F.wave * 4 + i; const f32x4 y = *(const LAS f32x4*)(Y + tok * 256 + F.lane * 4);
            const float mu = wave_sum((y.x + y.y) + (y.z + y.w)) * (1.f / 256.f); const f32x4 d = y - mu;
            const float var = wave_sum((d.x * d.x + d.y * d.y) + (d.z * d.z + d.w * d.w)) * (1.f / 256.f);
            const float rinv = 1.f / sqrtf(var + EPS); const f32x4 yn = d * rinv * lg + lb;
            f32x4 s; s.x = yn.x / (1.f + __expf(-yn.x)); s.y = yn.y / (1.f + __expf(-yn.y)); s.z = yn.z / (1.f + __expf(-yn.z)); s.w = yn.w / (1.f + __expf(-yn.w));
            *(GAS unsigned long long*)(P.CAT + (size_t)(b * SEQ + t0 + tok) * D + F.lane * 4) = (unsigned long long)pk2(s.x, s.y) | ((unsigned long long)pk2(s.z, s.w) << 32); }
    }
}

constexpr int SB_KS = 0, SB_VT = 65536;
__device__ __forceinline__ void sb_item(Frame& F, const Ptrs& P, int b, int qb) {
    LAS unsigned char* lds = F.lds; const int tid = F.tid, lane = F.lane, h = F.wave;
    const int t = qb * 64 + lane; const size_t row = (size_t)b * SEQ + t;
    unsigned q[32];
    { const GAS v4u* qp = (const GAS v4u*)(P.PROJ + row * INW + C_Q + h * 64);
#pragma unroll
      for (int j = 0; j < 8; ++j) { const v4u v = qp[j]; q[4 * j] = v.x; q[4 * j + 1] = v.y; q[4 * j + 2] = v.z; q[4 * j + 3] = v.w; } }
    float o[64];
#pragma unroll
    for (int d = 0; d < 64; ++d) o[d] = 0.f;
    float R = 1.f; bool alive = true;
    LAS float* xs = (LAS float*)(lds + EXTRA_OFF); volatile LAS unsigned* flags = (volatile LAS unsigned*)(lds + EXTRA_OFF + 2048);
    for (int kt = qb; kt >= 0; --kt) {
        __syncthreads();
        if (kt != qb) { unsigned any = 0u;
#pragma unroll
            for (int w = 0; w < 8; ++w) any |= flags[w];
            if (!any) break; }
        { const size_t rb = (size_t)b * SEQ + kt * 64;
#pragma unroll
          for (int i = 0; i < 8; ++i) { const int c = tid + 512 * i; const int key = c >> 6, j = c & 63, hh = j >> 3, d8 = j & 7;
              const bf16* src = P.PROJ + (rb + key) * INW;
              const v4u kv = *(const GAS v4u*)(src + C_K + j * 8); *(LAS v4u*)(lds + SB_KS + ((hh * 64 + key) * 64 + d8 * 8) * 2) = kv;
              const v4u vv = *(const GAS v4u*)(src + C_V + j * 8);
              LAS unsigned short* vd = (LAS unsigned short*)(lds + SB_VT + ((hh * 32 + (key >> 1)) * 64 + d8 * 8) * 4 + (key & 1) * 2);
              vd[0] = (unsigned short)(vv.x & 0xffffu); vd[2] = (unsigned short)(vv.x >> 16); vd[4] = (unsigned short)(vv.y & 0xffffu); vd[6] = (unsigned short)(vv.y >> 16);
              vd[8] = (unsigned short)(vv.z & 0xffffu); vd[10] = (unsigned short)(vv.z >> 16); vd[12] = (unsigned short)(vv.w & 0xffffu); vd[14] = (unsigned short)(vv.w >> 16); } }
        __syncthreads();
        if (alive) {
            const bool diag = (kt == qb);
            const LAS v4u* kbase = (const LAS v4u*)(lds + SB_KS + h * 64 * 128);
            const LAS v4u* vbase = (const LAS v4u*)(lds + SB_VT + h * 32 * 256);
            for (int pp = 31; pp >= 0; --pp) {
                float z1, z0;
                { const LAS v4u* kp = kbase + (2 * pp + 1) * 8; float a0 = 0.f, a1 = 0.f, a2 = 0.f, a3 = 0.f;
#pragma unroll
                  for (int j = 0; j < 8; ++j) { const v4u kk = kp[j]; a0 = dot2(kk.x, q[4 * j], a0); a1 = dot2(kk.y, q[4 * j + 1], a1); a2 = dot2(kk.z, q[4 * j + 2], a2); a3 = dot2(kk.w, q[4 * j + 3], a3); }
                  z1 = ((a0 + a1) + (a2 + a3)) * 0.125f; }
                { const LAS v4u* kp = kbase + (2 * pp) * 8; float a0 = 0.f, a1 = 0.f, a2 = 0.f, a3 = 0.f;
#pragma unroll
                  for (int j = 0; j < 8; ++j) { const v4u kk = kp[j]; a0 = dot2(kk.x, q[4 * j], a0); a1 = dot2(kk.y, q[4 * j + 1], a1); a2 = dot2(kk.z, q[4 * j + 2], a2); a3 = dot2(kk.w, q[4 * j + 3], a3); }
                  z0 = ((a0 + a1) + (a2 + a3)) * 0.125f; }
                float w1, w0;
                { const float e = __expf(-fabsf(z1)), r = __builtin_amdgcn_rcpf(1.f + e), er = e * r; const float beta = z1 >= 0.f ? r : er, om = z1 >= 0.f ? er : r;
                  const bool valid = !diag || (2 * pp + 1 < lane); w1 = valid ? beta * R : 0.f; R = valid ? R * om : R; }
                { const float e = __expf(-fabsf(z0)), r = __builtin_amdgcn_rcpf(1.f + e), er = e * r; const float beta = z0 >= 0.f ? r : er, om = z0 >= 0.f ? er : r;
                  const bool valid = !diag || (2 * pp < lane); w0 = valid ? beta * R : 0.f; R = valid ? R * om : R; }
                const unsigned apk = pk2(w0, w1);
                const LAS v4u* vp = vbase + pp * 16;
#pragma unroll
                for (int j = 0; j < 16; ++j) { const v4u vv = vp[j]; o[4 * j] = dot2(vv.x, apk, o[4 * j]); o[4 * j + 1] = dot2(vv.y, apk, o[4 * j + 1]); o[4 * j + 2] = dot2(vv.z, apk, o[4 * j + 2]); o[4 * j + 3] = dot2(vv.w, apk, o[4 * j + 3]); }
            }
            alive = __builtin_amdgcn_ballot_w64(R > 1.0e-37f) != 0ull;
        }
        if (lane == 0) flags[h] = alive ? 1u : 0u;
    }
    __syncthreads();
    float ss = 0.f;
#pragma unroll
    for (int d = 0; d < 64; ++d) ss += o[d] * o[d];
    xs[h * 64 + lane] = ss;
    __syncthreads();
    float tot = 0.f;
#pragma unroll
    for (int w = 0; w < 8; ++w) tot += xs[w * 64 + lane];
    const float rinv = 1.f / sqrtf(tot * (1.f / 512.f) + EPS);
    GAS v4u* dst = (GAS v4u*)(P.CAT + row * D + 256 + h * 64); const GAS f32x4* gp = (const GAS f32x4*)(P.sb_out_g + h * 64);
#pragma unroll
    for (int j = 0; j < 8; ++j) { const f32x4 g0 = gp[2 * j], g1 = gp[2 * j + 1]; v4u w;
        w.x = pk2(o[8 * j] * rinv * g0.x, o[8 * j + 1] * rinv * g0.y); w.y = pk2(o[8 * j + 2] * rinv * g0.z, o[8 * j + 3] * rinv * g0.w);
        w.z = pk2(o[8 * j + 4] * rinv * g1.x, o[8 * j + 5] * rinv * g1.y); w.w = pk2(o[8 * j + 6] * rinv * g1.z, o[8 * j + 7] * rinv * g1.w); dst[j] = w; }
}

constexpr int MA_KS = 0, MA_VT = 32768;
__device__ __forceinline__ void mem_item(Frame& F, const Ptrs& P, int b, int qblk) {
    LAS unsigned char* lds = F.lds; const int tid = F.tid, lane = F.lane, h = F.wave & 3, sub = F.wave >> 2;
    const int t = qblk * 128 + sub * 64 + lane; const size_t row = (size_t)b * SEQ + t;
    unsigned q[32];
    { const GAS v4u* qp = (const GAS v4u*)(P.PROJ + row * INW + C_MQ + h * 64); float qf[64]; float s = 0.f;
#pragma unroll
      for (int j = 0; j < 8; ++j) { const v4u v = qp[j]; const unsigned w[4] = {v.x, v.y, v.z, v.w};
#pragma unroll
          for (int i = 0; i < 4; ++i) { qf[8 * j + 2 * i] = bflo(w[i]); qf[8 * j + 2 * i + 1] = bfhi(w[i]); s += qf[8 * j + 2 * i] * qf[8 * j + 2 * i] + qf[8 * j + 2 * i + 1] * qf[8 * j + 2 * i + 1]; } }
      const float rinv = 1.f / sqrtf(s * (1.f / 64.f) + EPS);
#pragma unroll
      for (int j = 0; j < 32; ++j) q[j] = pk2(qf[2 * j] * rinv * P.q_norm_g[2 * j], qf[2 * j + 1] * rinv * P.q_norm_g[2 * j + 1]); }
    float o[64];
#pragma unroll
    for (int d = 0; d < 64; ++d) o[d] = 0.f;
    float mx = -1.0e30f, lsum = 0.f;
    LAS float* xs = (LAS float*)(lds + EXTRA_OFF);
    for (int kt = 0; kt < 4; ++kt) {
        __syncthreads();
        { const int key = (tid & 255) >> 2, hh = tid & 3; const bf16* src = P.MKV + (size_t)(b * MEML + kt * 64 + key) * KVW + hh * 64;
          if (tid < 256) {
              const GAS v4u* kp = (const GAS v4u*)src; float s = 0.f;
#pragma unroll
              for (int j = 0; j < 8; ++j) { const v4u kv = kp[j]; const unsigned w[4] = {kv.x, kv.y, kv.z, kv.w};
#pragma unroll
                  for (int i = 0; i < 4; ++i) { const float a = bflo(w[i]), c = bfhi(w[i]); s += a * a + c * c; } }
              const float rinv = 1.f / sqrtf(s * (1.f / 64.f) + EPS);
              asm volatile("" ::: "memory");
              LAS v4u* dst = (LAS v4u*)(lds + MA_KS + (hh * 64 + key) * 128);
#pragma unroll 2
              for (int j = 0; j < 8; ++j) { const v4u kv = kp[j]; const unsigned w[4] = {kv.x, kv.y, kv.z, kv.w}; unsigned ow[4];
#pragma unroll
                  for (int i = 0; i < 4; ++i) ow[i] = pk2(bflo(w[i]) * rinv * P.k_norm_g[8 * j + 2 * i], bfhi(w[i]) * rinv * P.k_norm_g[8 * j + 2 * i + 1]);
                  dst[j] = (v4u){ow[0], ow[1], ow[2], ow[3]}; }
          } else {
              const GAS v4u* vp = (const GAS v4u*)(src + 256);
              LAS unsigned short* vd = (LAS unsigned short*)(lds + MA_VT + ((hh * 32 + (key >> 1)) * 64) * 4 + (key & 1) * 2);
#pragma unroll
              for (int j = 0; j < 8; ++j) { const v4u vv = vp[j]; LAS unsigned short* d8 = vd + j * 16;
                  d8[0] = (unsigned short)(vv.x & 0xffffu); d8[2] = (unsigned short)(vv.x >> 16); d8[4] = (unsigned short)(vv.y & 0xffffu); d8[6] = (unsigned short)(vv.y >> 16);
                  d8[8] = (unsigned short)(vv.z & 0xffffu); d8[10] = (unsigned short)(vv.z >> 16); d8[12] = (unsigned short)(vv.w & 0xffffu); d8[14] = (unsigned short)(vv.w >> 16); }
          } }
        __syncthreads();
        const LAS v4u* kbase = (const LAS v4u*)(lds + MA_KS + h * 64 * 128);
        const LAS v4u* vbase = (const LAS v4u*)(lds + MA_VT + h * 32 * 256);
        for (int blk = 0; blk < 4; ++blk) {
            float s[16];
#pragma unroll
            for (int i = 0; i < 16; ++i) { const LAS v4u* kp = kbase + (blk * 16 + i) * 8; float a0 = 0.f, a1 = 0.f, a2 = 0.f, a3 = 0.f;
#pragma unroll
                for (int j = 0; j < 8; ++j) { const v4u kk = kp[j]; a0 = dot2(kk.x, q[4 * j], a0); a1 = dot2(kk.y, q[4 * j + 1], a1); a2 = dot2(kk.z, q[4 * j + 2], a2); a3 = dot2(kk.w, q[4 * j + 3], a3); }
                s[i] = ((a0 + a1) + (a2 + a3)) * 0.125f; }
            float bm = s[0];
#pragma unroll
            for (int i = 1; i < 16; ++i) bm = fmaxf(bm, s[i]);
            const float mn = fmaxf(mx, bm), sc = __expf(mx - mn); mx = mn; lsum *= sc;
#pragma unroll
            for (int d = 0; d < 64; ++d) o[d] *= sc;
#pragma unroll
            for (int i = 0; i < 16; ++i) { s[i] = __expf(s[i] - mn); lsum += s[i]; }
#pragma unroll
            for (int j2 = 0; j2 < 8; ++j2) { const unsigned apk = pk2(s[2 * j2], s[2 * j2 + 1]); const LAS v4u* vp = vbase + (blk * 8 + j2) * 16;
#pragma unroll
                for (int j = 0; j < 16; ++j) { const v4u vv = vp[j]; o[4 * j] = dot2(vv.x, apk, o[4 * j]); o[4 * j + 1] = dot2(vv.y, apk, o[4 * j + 1]); o[4 * j + 2] = dot2(vv.z, apk, o[4 * j + 2]); o[4 * j + 3] = dot2(vv.w, apk, o[4 * j + 3]); } }
        }
    }
    const float linv = 1.f / lsum; float ss = 0.f;
#pragma unroll
    for (int d = 0; d < 64; ++d) { o[d] *= linv; ss += o[d] * o[d]; }
    __syncthreads();
    xs[F.wave * 64 + lane] = ss;
    __syncthreads();
    float tot = 0.f;
#pragma unroll
    for (int w = 0; w < 4; ++w) tot += xs[(sub * 4 + w) * 64 + lane];
    const float rinv = 1.f / sqrtf(tot * (1.f / 256.f) + EPS);
    GAS v4u* dst = (GAS v4u*)(P.CAT + row * D + 768 + h * 64); const GAS f32x4* gp = (const GAS f32x4*)(P.mem_out_g + h * 64);
#pragma unroll
    for (int j = 0; j < 8; ++j) { const f32x4 g0 = gp[2 * j], g1 = gp[2 * j + 1]; v4u w;
        w.x = pk2(o[8 * j] * rinv * g0.x, o[8 * j + 1] * rinv * g0.y); w.y = pk2(o[8 * j + 2] * rinv * g0.z, o[8 * j + 3] * rinv * g0.w);
        w.z = pk2(o[8 * j + 4] * rinv * g1.x, o[8 * j + 5] * rinv * g1.y); w.w = pk2(o[8 * j + 6] * rinv * g1.z, o[8 * j + 7] * rinv * g1.w); dst[j] = w; }
}

#define INS16(V, I, cv_, ci_) do { float cv = (cv_); int ci = (ci_); \
    _Pragma("unroll") for (int p_ = 0; p_ < 16; ++p_) { const bool gt = cv > V[p_]; const float tv = gt ? V[p_] : cv; const int ti = gt ? I[p_] : ci; V[p_] = gt ? cv : V[p_]; I[p_] = gt ? ci : I[p_]; cv = tv; ci = ti; } } while (0)
__device__ __forceinline__ void topk_half(const LAS unsigned char* keys, const bf16* qrow, float (&V)[16], int (&I)[16]) {
    unsigned q[64];
    { const GAS v4u* qp = (const GAS v4u*)qrow;
#pragma unroll
      for (int j = 0; j < 16; ++j) { const v4u v = qp[j]; q[4 * j] = v.x; q[4 * j + 1] = v.y; q[4 * j + 2] = v.z; q[4 * j + 3] = v.w; } }
#pragma unroll
    for (int p = 0; p < 16; ++p) { V[p] = -3.0e38f; I[p] = 0; }
    for (int n = 0; n < 128; ++n) {
        const LAS v4u* kp = (const LAS v4u*)(keys + n * 256); float a0 = 0.f, a1 = 0.f, a2 = 0.f, a3 = 0.f;
#pragma unroll
        for (int j = 0; j < 16; ++j) { const v4u kk = kp[j]; a0 = dot2(kk.x, q[4 * j], a0); a1 = dot2(kk.y, q[4 * j + 1], a1); a2 = dot2(kk.z, q[4 * j + 2], a2); a3 = dot2(kk.w, q[4 * j + 3], a3); }
        const float s = (a0 + a1) + (a2 + a3);
        INS16(V, I, s, n);
    }
}
__device__ __forceinline__ void peer_select_item(Frame& F, const Ptrs& P, int tb, int h) {
    LAS unsigned char* lds = F.lds; const int tid = F.tid;
    __syncthreads();
#pragma unroll
    for (int i = 0; i < 8; ++i) { const int c = tid + 512 * i;
        const bf16* src = (c < 2048) ? (P.KEYS + (size_t)h * 16384 + c * 8) : (P.KEYS + 131072 + (size_t)h * 16384 + (c - 2048) * 8);
        *(LAS v4u*)(lds + c * 16) = *(const GAS v4u*)src; }
    __syncthreads();
    const int t = tb * 512 + F.wave * 64 + F.lane;
    float v1[16], v2[16]; int i1[16], i2[16];
    topk_half(lds, P.Q + (size_t)t * PQW + h * 256, v1, i1);
    topk_half(lds + 32768, P.Q + (size_t)t * PQW + h * 256 + 128, v2, i2);
    float ts[16]; int te[16];
#pragma unroll
    for (int p = 0; p < 16; ++p) { ts[p] = -3.0e38f; te[p] = 0; }
#pragma unroll
    for (int i = 0; i < 16; ++i)
#pragma unroll
        for (int j = 0; j < 16; ++j) if ((i + 1) * (j + 1) <= 16) { INS16(ts, te, v1[i] + v2[j], i1[i] * 128 + i2[j]); }
    float e[16], sum = 0.f;
#pragma unroll
    for (int p = 0; p < 16; ++p) { e[p] = __expf(ts[p] - ts[0]); sum += e[p]; }
    const float inv = 1.f / sum;
    GAS v4u* di = (GAS v4u*)(P.SELI + ((size_t)t * 8 + h) * 16); GAS f32x4* dg = (GAS f32x4*)(P.SELG + ((size_t)t * 8 + h) * 16);
#pragma unroll
    for (int j = 0; j < 4; ++j) { di[j] = (v4u){(unsigned)te[4 * j], (unsigned)te[4 * j + 1], (unsigned)te[4 * j + 2], (unsigned)te[4 * j + 3]};
        dg[j] = (f32x4){e[4 * j] * inv, e[4 * j + 1] * inv, e[4 * j + 2] * inv, e[4 * j + 3] * inv}; }
}

__device__ __forceinline__ void peer_gather_token(const Ptrs& P, int t, int lane) {
    const float rs = 1.0f / sqrtf(__hip_atomic_load(P.SSQ2 + t, RLX_AGENT) * (1.0f / 1024.0f) + EPS);
    float acc[16]; unsigned hp[8];
    { const GAS f32x4* xr = (const GAS f32x4*)(P.out + (size_t)t * D); const GAS f32x4* gr = (const GAS f32x4*)P.ffn_g;
#pragma unroll
      for (int j = 0; j < 2; ++j)
#pragma unroll
          for (int k = 0; k < 2; ++k) { const f32x4 xv = xr[j * 128 + lane * 2 + k], gv = gr[j * 128 + lane * 2 + k];
              acc[j * 8 + k * 4] = xv.x; acc[j * 8 + k * 4 + 1] = xv.y; acc[j * 8 + k * 4 + 2] = xv.z; acc[j * 8 + k * 4 + 3] = xv.w;
              hp[j * 4 + k * 2] = pk2(xv.x * rs * gv.x, xv.y * rs * gv.y); hp[j * 4 + k * 2 + 1] = pk2(xv.z * rs * gv.z, xv.w * rs * gv.w); } }
    const int e0 = P.SELI[(size_t)t * 128 + lane], e1 = P.SELI[(size_t)t * 128 + 64 + lane];
    const float g0 = P.SELG[(size_t)t * 128 + lane], g1 = P.SELG[(size_t)t * 128 + 64 + lane];
    float d0 = 0.f, d1 = 0.f;
    for (int jb = 0; jb < 128; jb += 8) {
        v4u r0[8], r1[8];
#pragma unroll
        for (int k = 0; k < 8; ++k) { const int j = jb + k; const int e = __builtin_amdgcn_readlane(j < 64 ? e0 : e1, j & 63);
            const GAS v4u* up = (const GAS v4u*)(P.UT + (size_t)e * D); r0[k] = up[lane]; r1[k] = up[64 + lane]; }
#pragma unroll
        for (int k = 0; k < 8; ++k) { const int j = jb + k;
            float a = dot2(r0[k].x, hp[0], 0.f); a = dot2(r0[k].y, hp[1], a); a = dot2(r0[k].z, hp[2], a); a = dot2(r0[k].w, hp[3], a);
            float c = dot2(r1[k].x, hp[4], 0.f); c = dot2(r1[k].y, hp[5], c); c = dot2(r1[k].z, hp[6], c); c = dot2(r1[k].w, hp[7], c);
            const float s = wave_sum(a + c);
            if (j < 64) { if (lane == j) d0 = s; } else { if (lane == j - 64) d1 = s; } }
    }
    const float w0 = 0.5f * d0 * (1.f + erff(d0 * 0.70710678118654752f)) * g0, w1 = 0.5f * d1 * (1.f + erff(d1 * 0.70710678118654752f)) * g1;
    for (int jb = 0; jb < 128; jb += 8) {
        v4u r0[8], r1[8];
#pragma unroll
        for (int k = 0; k < 8; ++k) { const int j = jb + k; const int e = __builtin_amdgcn_readlane(j < 64 ? e0 : e1, j & 63);
            const GAS v4u* vp = (const GAS v4u*)(P.VT + (size_t)e * D); r0[k] = vp[lane]; r1[k] = vp[64 + lane]; }
#pragma unroll
        for (int k = 0; k < 8; ++k) { const int j = jb + k; const float w = __uint_as_float(__builtin_amdgcn_readlane(__float_as_uint(j < 64 ? w0 : w1), j & 63));
            acc[0] += w * bflo(r0[k].x); acc[1] += w * bfhi(r0[k].x); acc[2] += w * bflo(r0[k].y); acc[3] += w * bfhi(r0[k].y);
            acc[4] += w * bflo(r0[k].z); acc[5] += w * bfhi(r0[k].z); acc[6] += w * bflo(r0[k].w); acc[7] += w * bfhi(r0[k].w);
            acc[8] += w * bflo(r1[k].x); acc[9] += w * bfhi(r1[k].x); acc[10] += w * bflo(r1[k].y); acc[11] += w * bfhi(r1[k].y);
            acc[12] += w * bflo(r1[k].z); acc[13] += w * bfhi(r1[k].z); acc[14] += w * bflo(r1[k].w); acc[15] += w * bfhi(r1[k].w); }
    }
    GAS f32x4* orow = (GAS f32x4*)(P.out + (size_t)t * D);
#pragma unroll
    for (int j = 0; j < 2; ++j)
#pragma unroll
        for (int k = 0; k < 2; ++k) orow[j * 128 + lane * 2 + k] = (f32x4){acc[j * 8 + k * 4], acc[j * 8 + k * 4 + 1], acc[j * 8 + k * 4 + 2], acc[j * 8 + k * 4 + 3]};
}

struct Args { const float* in[21]; float* out; unsigned char* ws; int ph_lo, ph_hi, li, pad; };
__device__ __forceinline__ Ptrs make_ptrs(const Args& args) {
    unsigned char* ws = args.ws;
    Ptrs P;
    P.x = args.in[0]; P.mem = args.in[1]; P.attn_g = args.in[2]; P.w_in = args.in[3]; P.conv_w = args.in[4]; P.conv_b = args.in[5]; P.conv_ln_g = args.in[6]; P.conv_ln_b = args.in[7];
    P.sb_out_g = args.in[8]; P.mem_norm_g = args.in[9]; P.w_mem_kv = args.in[10]; P.q_norm_g = args.in[11]; P.k_norm_g = args.in[12]; P.mem_out_g = args.in[13]; P.w_out = args.in[14];
    P.ffn_g = args.in[15]; P.w_peer_q = args.in[16]; P.keys1 = args.in[17]; P.keys2 = args.in[18]; P.peer_u = args.in[19]; P.peer_v = args.in[20];
    P.out = args.out;
    P.WIN = (bf16*)(ws + WS_WIN); P.WKV = (bf16*)(ws + WS_WKV); P.WOUT = (bf16*)(ws + WS_WOUT); P.WPQ = (bf16*)(ws + WS_WPQ); P.KEYS = (bf16*)(ws + WS_KEYS);
    P.MEMN = (bf16*)(ws + WS_MEMN); P.MKV = (bf16*)(ws + WS_MKV); P.UT = (bf16*)(ws + WS_UT); P.VT = (bf16*)(ws + WS_VT); P.XN = (bf16*)(ws + WS_XN); P.CAT = (bf16*)(ws + WS_CAT);
    P.PROJ = (bf16*)(ws + WS_PROJ); P.Q = (bf16*)(ws + WS_Q); P.SELI = (int*)(ws + WS_SELI); P.SELG = (float*)(ws + WS_SELG); P.SSQ2 = (float*)(ws + WS_CTL) + CW_SSQ2;
    return P;
}
__global__ void __launch_bounds__(NWAVES * 64, 2) fwd_kernel(Args args) {
    extern __shared__ __attribute__((aligned(16))) unsigned char lds[];
    Frame F;
    F.lds = (LAS unsigned char*)lds;
    F.MISC = (volatile LAS unsigned*)(F.lds + MISC_OFF);
    F.tid = threadIdx.x; F.lane = F.tid & 63; F.wave = __builtin_amdgcn_readfirstlane(F.tid >> 6);
    F.G = gridDim.x; { const int bx = blockIdx.x; F.vcu = (F.G % 8 == 0) ? (bx % 8) * (F.G / 8) + bx / 8 : bx; }
    unsigned char* ws = args.ws;
    F.ctl = (gu32*)(ws + WS_CTL);
    for (int u = F.tid; u < (LDS_BYTES - LDSCTL_OFF) / 4; u += NWAVES * 64) ((LAS unsigned*)(F.lds + LDSCTL_OFF))[u] = 0u;
    __syncthreads();
    XcdBarrier bar; bar.bar = (unsigned*)(F.ctl + CW_BAR); bar.x = 0; bar.st = nullptr;
    if (N_LAUNCHES != PER_PHASE) bar = xcd_barrier_post((unsigned*)(F.ctl + CW_BAR), F.MISC + 8);
#define GRID_BAR() do { if (N_LAUNCHES != PER_PHASE) xcd_barrier(bar); } while (0)
    const int lo = args.ph_lo, hi = args.ph_hi;
#define IN(k) (lo <= (k) && (k) < hi)
#define BOTH(k) (IN(k) && IN((k) + 1))

    if (IN(0)) { const Ptrs P = make_ptrs(args); p0_prologue(F, P); if (BOTH(0)) GRID_BAR(); }

    if (IN(1)) { const Ptrs P = make_ptrs(args);
        { pg8::Gemm g{P.XN, P.WIN, M, INW, D}; pg8::StaticOrder S; S.init(M, INW, F.G, (int)blockIdx.x);
          pg8::EpiBf16 E{P.PROJ, INW};
          pg8::gemm_phase<pg8::EpiBf16, pg8::StaticOrder, PG8_ALIGN, PG8_SP2>(F.lds + RING_OFF, g, S, E); }
        { pg8::Gemm g{P.MEMN, P.WKV, MMEM, KVW, D}; pg8::StaticOrder S; S.init(MMEM, KVW, F.G, (int)blockIdx.x);
          pg8::EpiBf16 E{P.MKV, KVW};
          pg8::gemm_phase<pg8::EpiBf16, pg8::StaticOrder, PG8_ALIGN, PG8_SP2>(F.lds + RING_OFF, g, S, E); }
        if (BOTH(1)) GRID_BAR();
    }

    if (IN(2)) { const Ptrs P = make_ptrs(args);
        const int c = F.vcu;
        for (int it = c; it < 256; it += F.G) for (int i = 0; i < 2; ++i) { const int b = it >> 5, s = it & 31; sb_item(F, P, b, i == 0 ? s : 63 - s); }
        __syncthreads();
        for (int it = c; it < BATCH * (SEQ / 128); it += F.G) mem_item(F, P, it / (SEQ / 128), it % (SEQ / 128));
        __syncthreads();
        for (int it = c; it < BATCH * (SEQ / 32); it += F.G) { conv_item(F, P, it / (SEQ / 32), it % (SEQ / 32)); }
        __syncthreads();
        if (BOTH(2)) GRID_BAR();
    }

    if (IN(3)) { const Ptrs P = make_ptrs(args);
        pg8::Gemm g{P.CAT, P.WOUT, M, D, D}; pg8::StaticOrder S; S.init(M, D, F.G, (int)blockIdx.x);
        pg8::EpiResid E{P.x, P.out, P.XN, P.SSQ2, D};
        pg8::gemm_phase<pg8::EpiResid, pg8::StaticOrder, PG8_ALIGN, PG8_SP2>(F.lds + RING_OFF, g, S, E);
        if (BOTH(3)) GRID_BAR();
    }

    if (IN(4)) { const Ptrs P = make_ptrs(args);
        pg8::Gemm g{P.XN, P.WPQ, M, PQW, D}; pg8::StaticOrder S; S.init(M, PQW, F.G, (int)blockIdx.x);
        pg8::EpiBf16Row E{P.Q, PQW, P.SSQ2};
        pg8::gemm_phase<pg8::EpiBf16Row, pg8::StaticOrder, PG8_ALIGN, PG8_SP2>(F.lds + RING_OFF, g, S, E);
        if (BOTH(4)) GRID_BAR();
    }

    if (IN(5)) { const Ptrs P = make_ptrs(args);
        for (int it = F.vcu; it < (M / 512) * 8; it += F.G) peer_select_item(F, P, it >> 3, it & 7);
        __syncthreads();
        if (BOTH(5)) GRID_BAR();
    }

    if (IN(6)) { const Ptrs P = make_ptrs(args);
        const int gw = F.vcu * NWAVES + F.wave, NGW = F.G * NWAVES;
        for (int t = gw; t < M; t += NGW) peer_gather_token(P, t, F.lane);
    }
#undef IN
#undef BOTH
}

extern "C" void kernel_launch(void* const* d_in, const int* in_sizes, int n_in, void* d_out, int out_size, void* d_ws, size_t ws_size, hipStream_t stream) {
    static int grid = 0;
    if (grid == 0) {
        if (n_in != 21 || in_sizes[0] != M * D || out_size != M * D || ws_size < WS_END) { fprintf(stderr, "kernel_launch: unexpected shapes/workspace (n_in %d, in0 %d, out %d, ws %zu); nothing launched\n", n_in, n_in > 0 ? in_sizes[0] : -1, out_size, ws_size); grid = -1; return; }
        int dev = 0, cus = 0, per_cu = 0;
        if (hipGetDevice(&dev) != hipSuccess || hipDeviceGetAttribute(&cus, hipDeviceAttributeMultiprocessorCount, dev) != hipSuccess) { grid = -1; return; }
        if (hipFuncSetAttribute((const void*)fwd_kernel, hipFuncAttributeMaxDynamicSharedMemorySize, LDS_BYTES) != hipSuccess) { fprintf(stderr, "kernel_launch: hipFuncSetAttribute failed\n"); grid = -1; return; }
        if (hipOccupancyMaxActiveBlocksPerMultiprocessor(&per_cu, (const void*)fwd_kernel, NWAVES * 64, LDS_BYTES) != hipSuccess || per_cu < 1) { fprintf(stderr, "kernel_launch: occupancy query says %d blocks per CU\n", per_cu); }
        (void)hipGetLastError();
        grid = cus;
    }
    if (grid < 0) return;
    if (hipMemsetAsync((char*)d_ws + WS_CTL, 0, CTL_ZERO_BYTES, stream) != hipSuccess) { fprintf(stderr, "kernel_launch: memset failed\n"); return; }
    Args a{};
    for (int i = 0; i < 21; ++i) a.in[i] = (const float*)d_in[i];
    a.out = (float*)d_out; a.ws = (unsigned char*)d_ws;
    for (int li = 0; li < N_LAUNCHES; ++li) {
        a.ph_lo = (N_LAUNCHES == PER_PHASE) ? li : 0; a.ph_hi = (N_LAUNCHES == PER_PHASE) ? li + 1 : PER_PHASE; a.li = li;
        hipLaunchKernelGGL(fwd_kernel, dim3(grid), dim3(NWAVES * 64), LDS_BYTES, stream, a);
        const hipError_t le = hipPeekAtLastError();
        if (le != hipSuccess) { fprintf(stderr, "kernel_launch: launch %d failed: %s\n", li, hipGetErrorName(le)); break; }
    }
}
```

```cpp
#include <hip/hip_runtime.h>
#include <cstdio>
#include <cstdint>
namespace pg8 {
#define PG8_LAS __attribute__((address_space(3)))
typedef unsigned short bf16_t;
typedef short bf16x8 __attribute__((ext_vector_type(8)));
typedef float f32x4 __attribute__((ext_vector_type(4)));
typedef unsigned u32x4 __attribute__((ext_vector_type(4)));
constexpr int BM = 256, BK = 64, HALF = 128, HTB = HALF * BK * 2  , STAGE_BYTES = 8 * HTB, NXCD = 8, WGM = 8;

__host__ __device__ __forceinline__ int lds_byte(int r, int c) { const int st = (r >> 4) * 2 + (c >> 5), rr = r & 15, cc = c & 31, ob = rr * 64 + cc * 2; return st * 1024 + (ob ^ (((ob >> 9) & 1) << 5)); }
__host__ __device__ __forceinline__ void stage_rc(int b, int& R, int& C) { const int st = b / 1024, sb = b % 1024, swz = sb ^ (((sb >> 9) & 1) << 5); R = (st >> 1) * 16 + swz / 64; C = (st & 1) * 32 + (swz % 64) / 2; }
__host__ __device__ __forceinline__ int perm32(int rho) { const int n = rho >> 4, i = rho & 15; return 8 * (i >> 2) + 4 * n + (i & 3); }

struct Unit { int pm, pn; };
struct Gemm { const bf16_t* A; const bf16_t* Bt; int M, N, K; };

struct StaticOrder {
    int nM, nN, nwg, G, c;
    __host__ __device__ void init(int M, int N, int G_, int c_) { nM = M / BM; nN = N / BM; nwg = nM * nN; G = G_; c = c_; }
    __host__ __device__ bool next(int i, Unit& u) const {
        const long L = (long)i * G + c; if (L >= nwg) return false;
        int wgid = (int)L; { const int q = nwg / NXCD, r = nwg % NXCD, xcd = wgid % NXCD, off = wgid / NXCD; wgid = (xcd < r ? xcd * (q + 1) : r * (q + 1) + (xcd - r) * q) + off; }
        const int nig = WGM * nN, gid = wgid / nig, fm = gid * WGM, gsz = (nM - fm) < WGM ? (nM - fm) : WGM;
        u.pm = fm + ((wgid % nig) % gsz); u.pn = (wgid % nig) / gsz; return true;
    }
    __device__ __forceinline__ void a_ready(const Unit&) const {}
    __device__ __forceinline__ void done(const Unit&) const {}
};

__device__ __forceinline__ unsigned cvt_pk_bf16(float lo, float hi) { unsigned r; asm volatile("v_cvt_pk_bf16_f32 %0, %1, %2" : "=v"(r) : "v"(lo), "v"(hi)); return r; }
typedef unsigned u32x2 __attribute__((ext_vector_type(2)));

struct EpiBf16 {
    static constexpr bool PERM = true, AFTER_DRAIN = false;
    bf16_t* O; int ldc;
    __device__ __forceinline__ void operator()(const f32x4 (&acc)[2][2][4][2], const Unit& u, int wr, int wc, int fr, int fq) const {
        const int row0 = u.pm * BM + wr * 64 + fr; const int col0 = u.pn * BM + wc * 32 + 8 * fq;
#pragma unroll
        for (int ai = 0; ai < 2; ++ai)
#pragma unroll
            for (int m = 0; m < 4; ++m) { bf16_t* rowp = O + (size_t)(row0 + ai * HALF + m * 16) * ldc + col0;
#pragma unroll
                for (int bj = 0; bj < 2; ++bj) { const f32x4 v0 = acc[ai][bj][m][0], v1 = acc[ai][bj][m][1];
                    u32x4 w; w.x = cvt_pk_bf16(v0[0], v0[1]); w.y = cvt_pk_bf16(v0[2], v0[3]); w.z = cvt_pk_bf16(v1[0], v1[1]); w.w = cvt_pk_bf16(v1[2], v1[3]);
                    *(u32x4*)(rowp + bj * HALF) = w; } }
    }
};
struct EpiBf16Row {
    static constexpr bool PERM = true, AFTER_DRAIN = false;
    bf16_t* O; int ldc; const float* ssq;
    __device__ __forceinline__ void operator()(const f32x4 (&acc)[2][2][4][2], const Unit& u, int wr, int wc, int fr, int fq) const {
        const int row0 = u.pm * BM + wr * 64 + fr; const int col0 = u.pn * BM + wc * 32 + 8 * fq;
#pragma unroll
        for (int ai = 0; ai < 2; ++ai)
#pragma unroll
            for (int m = 0; m < 4; ++m) { const int row = row0 + ai * HALF + m * 16; bf16_t* rowp = O + (size_t)row * ldc + col0;
                const float rs = 1.0f / sqrtf(__hip_atomic_load(ssq + row, __ATOMIC_RELAXED, __HIP_MEMORY_SCOPE_AGENT) * (1.0f / 1024.0f) + 1e-6f);
#pragma unroll
                for (int bj = 0; bj < 2; ++bj) { const f32x4 v0 = acc[ai][bj][m][0] * rs, v1 = acc[ai][bj][m][1] * rs;
                    u32x4 w; w.x = cvt_pk_bf16(v0[0], v0[1]); w.y = cvt_pk_bf16(v0[2], v0[3]); w.z = cvt_pk_bf16(v1[0], v1[1]); w.w = cvt_pk_bf16(v1[2], v1[3]);
                    *(u32x4*)(rowp + bj * HALF) = w; } }
    }
};
struct EpiResid {
    static constexpr bool PERM = false, AFTER_DRAIN = false;
    const float* x; float* out; bf16_t* xb; float* ssq; int ldc;
    __device__ __forceinline__ void operator()(const f32x4 (&acc)[2][2][4][2], const Unit& u, int wr, int wc, int fr, int fq) const {
        const int col0 = u.pn * BM + wc * 32 + 4 * fq;
#pragma unroll
        for (int ai = 0; ai < 2; ++ai)
#pragma unroll
            for (int m = 0; m < 4; ++m) { const int row = u.pm * BM + ai * HALF + wr * 64 + m * 16 + fr; const size_t off = (size_t)row * ldc + col0; float s = 0.f;
#pragma unroll
                for (int bj = 0; bj < 2; ++bj)
#pragma unroll
                    for (int n = 0; n < 2; ++n) { const f32x4 xv = *(const f32x4*)(x + off + bj * HALF + n * 16); const f32x4 o = xv + acc[ai][bj][m][n];
                        *(f32x4*)(out + off + bj * HALF + n * 16) = o; s += (o[0] * o[0] + o[1] * o[1]) + (o[2] * o[2] + o[3] * o[3]);
                        u32x2 w; w.x = cvt_pk_bf16(o[0], o[1]); w.y = cvt_pk_bf16(o[2], o[3]); *(u32x2*)(xb + off + bj * HALF + n * 16) = w; }
                s += __shfl_xor(s, 16); s += __shfl_xor(s, 32);
                if (fq == 0) unsafeAtomicAdd(ssq + row, s); }
    }
};

template <class Epi, class Sched, bool ALIGN_EPI = false, bool SP2 = false>
__device__ __forceinline__ void gemm_phase(PG8_LAS unsigned char* lds, const Gemm g, const Sched& S, const Epi& E) {
    const int tid = threadIdx.x, wid = __builtin_amdgcn_readfirstlane(tid >> 6), lane = tid & 63, wr = wid >> 2, wc = wid & 3, fr = lane & 15, fq = lane >> 4;
    const int K = g.K, nt = K / BK;
    unsigned voffA[2], voffB[2];
#pragma unroll
    for (int i = 0; i < 2; ++i) { int R, C; stage_rc(tid * 16 + i * 8192, R, C); const int Rb = Epi::PERM ? ((R & ~31) + perm32(R & 31)) : R;
        voffA[i] = (unsigned)(R * K + C) * 2u; voffB[i] = (unsigned)(Rb * K + C) * 2u; }
    const size_t kstep = (size_t)(BK * 2);
    const size_t hstep = (size_t)HALF * K * 2;
    const size_t tstep = 2 * hstep;
    const unsigned ldsw = (unsigned)wid * 1024u;
    const int aoff = lds_byte(wr * 64 + fr, fq * 8), boff = lds_byte(wc * 32 + fr, fq * 8);
#define PG8_SA(b, h) (((b) * 2 + (h)) * HTB)
#define PG8_SB(b, h) ((4 + (b) * 2 + (h)) * HTB)
#define PG8_STAGE(bufoff, gbase, voff) do { _Pragma("unroll") for (int _i = 0; _i < 2; ++_i) \
        __builtin_amdgcn_global_load_lds((const unsigned*)((const char*)(gbase) + (voff)[_i]), (PG8_LAS unsigned*)(lds + (bufoff) + ldsw + _i * 8192), 16, 0, 0); } while (0)
#define PG8_LDA(dst, b, h) do { _Pragma("unroll") for (int m = 0; m < 4; ++m) _Pragma("unroll") for (int k = 0; k < 2; ++k) dst[m][k] = *(const PG8_LAS bf16x8*)(lds + PG8_SA(b, h) + aoff + m * 2048 + k * 1024); } while (0)
#define PG8_LDB(dst, b, h) do { _Pragma("unroll") for (int n = 0; n < 2; ++n) _Pragma("unroll") for (int k = 0; k < 2; ++k) dst[n][k] = *(const PG8_LAS bf16x8*)(lds + PG8_SB(b, h) + boff + n * 2048 + k * 1024); } while (0)
#define PG8_MMA(ai, bj, At, Bt) do { __builtin_amdgcn_s_setprio(1); _Pragma("unroll") for (int m = 0; m < 4; ++m) _Pragma("unroll") for (int n = 0; n < 2; ++n) _Pragma("unroll") for (int k = 0; k < 2; ++k) \
        acc[ai][bj][m][n] = __builtin_amdgcn_mfma_f32_16x16x32_bf16(Bt[n][k], At[m][k], acc[ai][bj][m][n], 0, 0, 0); __builtin_amdgcn_s_setprio(0); } while (0)
#define PG8_WAIT_V(n) asm volatile("s_waitcnt vmcnt(" #n ")" ::: "memory")
#define PG8_WAIT_L(n) asm volatile("s_waitcnt lgkmcnt(" #n ")" ::: "memory")
#define PG8_BAR __builtin_amdgcn_s_barrier()
#define PG8_SCHED __builtin_amdgcn_sched_barrier(0)
    Unit cur, nxt; int ui = 0;
    if (!S.next(0, cur)) return;
    f32x4 acc[2][2][4][2];
#pragma unroll
    for (int a = 0; a < 2; ++a)
#pragma unroll
        for (int b = 0; b < 2; ++b)
#pragma unroll
            for (int m = 0; m < 4; ++m)
#pragma unroll
                for (int n = 0; n < 2; ++n) acc[a][b][m][n] = (f32x4){0.f, 0.f, 0.f, 0.f};
    bf16x8 At[4][2], B0[2][2], B1[2][2];
    const char* cA = (const char*)g.A + (size_t)cur.pm * tstep; const char* cB = (const char*)g.Bt + (size_t)cur.pn * tstep;
    S.a_ready(cur);
    if constexpr (SP2) {
        PG8_STAGE(PG8_SB(0, 0), cB, voffB); PG8_STAGE(PG8_SB(0, 1), cB + hstep, voffB); PG8_STAGE(PG8_SA(0, 0), cA, voffA); PG8_STAGE(PG8_SA(0, 1), cA + hstep, voffA);
        if (wr == 1) PG8_BAR;
        PG8_WAIT_V(2); PG8_BAR;
        PG8_STAGE(PG8_SB(1, 0), cB + kstep, voffB); PG8_STAGE(PG8_SA(1, 0), cA + kstep, voffA); PG8_STAGE(PG8_SB(1, 1), cB + hstep + kstep, voffB);
        PG8_WAIT_V(6); PG8_BAR;
    } else {
        PG8_STAGE(PG8_SB(0, 0), cB, voffB); PG8_STAGE(PG8_SA(0, 0), cA, voffA); PG8_STAGE(PG8_SB(0, 1), cB + hstep, voffB); PG8_STAGE(PG8_SA(0, 1), cA + hstep, voffA);
        if (wr == 1) PG8_BAR;
        PG8_WAIT_V(4); PG8_BAR;
        PG8_STAGE(PG8_SB(1, 0), cB + kstep, voffB); PG8_STAGE(PG8_SA(1, 0), cA + kstep, voffA); PG8_STAGE(PG8_SB(1, 1), cB + hstep + kstep, voffB);
        PG8_WAIT_V(6); PG8_BAR;
    }
    for (;;) {
        const bool has_next = S.next(ui + 1, nxt);
        const char* nA = has_next ? (const char*)g.A + (size_t)nxt.pm * tstep : cA; const char* nB = has_next ? (const char*)g.Bt + (size_t)nxt.pn * tstep : cB;
        for (int t = 0; t < nt; t += 2) {
            const bool last = (t == nt - 2);
            const char* a1 = cA + (size_t)(t + 1) * kstep;
            const char* a2 = last ? nA : cA + (size_t)(t + 2) * kstep; const char* b2 = last ? nB : cB + (size_t)(t + 2) * kstep;
            const char* a3 = a2 + kstep; const char* b3 = b2 + kstep;
            if (last && has_next) S.a_ready(nxt);
            if constexpr (SP2) {
            PG8_LDB(B0, 0, 0); PG8_LDB(B1, 0, 1); PG8_SCHED; PG8_LDA(At, 0, 0); PG8_STAGE(PG8_SA(1, 1), a1 + hstep, voffA);
            PG8_WAIT_V(8); PG8_WAIT_L(0); PG8_BAR; PG8_MMA(0, 0, At, B0); PG8_MMA(0, 1, At, B1); PG8_BAR; PG8_SCHED;
            PG8_LDA(At, 0, 1); PG8_STAGE(PG8_SB(0, 0), b2, voffB); PG8_STAGE(PG8_SB(0, 1), b2 + hstep, voffB); PG8_STAGE(PG8_SA(0, 0), a2, voffA);
            PG8_WAIT_V(8); PG8_WAIT_L(0); PG8_BAR; PG8_MMA(1, 0, At, B0); PG8_MMA(1, 1, At, B1); PG8_BAR; PG8_SCHED;
            PG8_LDB(B0, 1, 0); PG8_LDB(B1, 1, 1); PG8_SCHED; PG8_LDA(At, 1, 0); PG8_STAGE(PG8_SA(0, 1), a2 + hstep, voffA);
            PG8_WAIT_V(8); PG8_WAIT_L(0); PG8_BAR; PG8_MMA(0, 0, At, B0); PG8_MMA(0, 1, At, B1); PG8_BAR; PG8_SCHED;
            PG8_LDA(At, 1, 1); PG8_STAGE(PG8_SB(1, 0), b3, voffB); PG8_STAGE(PG8_SB(1, 1), b3 + hstep, voffB); PG8_STAGE(PG8_SA(1, 0), a3, voffA);
            PG8_WAIT_V(8); PG8_WAIT_L(0); PG8_BAR; PG8_MMA(1, 0, At, B0); PG8_MMA(1, 1, At, B1); PG8_BAR; PG8_SCHED;
            } else {
            PG8_LDB(B0, 0, 0); PG8_SCHED; PG8_LDA(At, 0, 0); PG8_STAGE(PG8_SA(1, 1), a1 + hstep, voffA);
            PG8_WAIT_L(8); PG8_BAR; PG8_WAIT_L(0); PG8_MMA(0, 0, At, B0); PG8_BAR; PG8_SCHED;
            PG8_LDB(B1, 0, 1); PG8_STAGE(PG8_SB(0, 0), b2, voffB);
            PG8_BAR; PG8_WAIT_L(0); PG8_MMA(0, 1, At, B1); PG8_BAR;
            PG8_LDA(At, 0, 1); PG8_STAGE(PG8_SA(0, 0), a2, voffA);
            PG8_BAR; PG8_WAIT_L(0); PG8_MMA(1, 0, At, B0); PG8_BAR; PG8_SCHED;
            PG8_STAGE(PG8_SB(0, 1), b2 + hstep, voffB);
            PG8_WAIT_V(6); PG8_BAR; PG8_MMA(1, 1, At, B1); PG8_BAR;
            PG8_LDB(B0, 1, 0); PG8_SCHED; PG8_LDA(At, 1, 0); PG8_STAGE(PG8_SA(0, 1), a2 + hstep, voffA);
            PG8_WAIT_L(8); PG8_BAR; PG8_WAIT_L(0); PG8_MMA(0, 0, At, B0); PG8_BAR; PG8_SCHED;
            PG8_LDB(B1, 1, 1); PG8_STAGE(PG8_SB(1, 0), b3, voffB);
            PG8_BAR; PG8_WAIT_L(0); PG8_MMA(0, 1, At, B1); PG8_BAR;
            PG8_LDA(At, 1, 1); PG8_STAGE(PG8_SA(1, 0), a3, voffA);
            PG8_BAR; PG8_WAIT_L(0); PG8_MMA(1, 0, At, B0); PG8_BAR; PG8_SCHED;
            PG8_STAGE(PG8_SB(1, 1), b3 + hstep, voffB);
            PG8_WAIT_V(6); PG8_BAR; PG8_MMA(1, 1, At, B1); PG8_BAR;
            }
        }
        if constexpr (ALIGN_EPI) { if (wr == 0) PG8_BAR; }
        if constexpr (!Epi::AFTER_DRAIN) { E(acc, cur, wr, wc, fr, fq); S.done(cur); }
        if (!has_next) break;
#pragma unroll
        for (int a = 0; a < 2; ++a)
#pragma unroll
            for (int b = 0; b < 2; ++b)
#pragma unroll
                for (int m = 0; m < 4; ++m)
#pragma unroll
                    for (int n = 0; n < 2; ++n) acc[a][b][m][n] = (f32x4){0.f, 0.f, 0.f, 0.f};
        cur = nxt; cA = nA; cB = nB; ++ui;
        if constexpr (ALIGN_EPI) { if (wr == 1) PG8_BAR; }
    }
    PG8_WAIT_V(0);
    if constexpr (!ALIGN_EPI) { if (wr == 0) PG8_BAR; }
    PG8_BAR;
    if constexpr (Epi::AFTER_DRAIN) { E.fused(acc, cur, wr, wc, fr, fq, lds, wid, lane); S.done(cur); }
#undef PG8_SA
#undef PG8_SB
#undef PG8_STAGE
#undef PG8_LDA
#undef PG8_LDB
#undef PG8_MMA
#undef PG8_WAIT_V
#undef PG8_WAIT_L
#undef PG8_BAR
#undef PG8_SCHED
}
}

#ifndef PG8_SP2
#define PG8_SP2 true
#endif
#ifndef PG8_ALIGN
#define PG8_ALIGN true
#endif
#ifndef MK_N_LAUNCHES
#define MK_N_LAUNCHES 1
#endif
constexpr int NWAVES = 8;
constexpr int PER_PHASE = 7;
constexpr int N_LAUNCHES = MK_N_LAUNCHES;

constexpr int BATCH = 8, SEQ = 4096, D = 1024, M = BATCH * SEQ;
constexpr int MEML = 256, MMEM = BATCH * MEML;
constexpr int INW = 2304, KVW = 512, PQW = 2048;
constexpr int C_A = 0, C_G = 256, C_Q = 512, C_K = 1024, C_V = 1536, C_MQ = 2048;
constexpr int NEXP = 16384;
constexpr float EPS = 1e-6f;

constexpr size_t MiB = 1u << 20;
constexpr size_t WS_CTL = 0, CTL_ZERO_BYTES = 1 * MiB;
constexpr size_t WS_WIN = 2 * MiB, WS_WKV = 7 * MiB, WS_WOUT = 8 * MiB, WS_WPQ = 10 * MiB, WS_KEYS = 14 * MiB;
constexpr size_t WS_MEMN = 15 * MiB, WS_MKV = 19 * MiB;
constexpr size_t WS_SC = 22 * MiB;
constexpr size_t WS_UT = 24 * MiB, WS_VT = 56 * MiB;
constexpr size_t WS_XN = 88 * MiB;
constexpr size_t WS_CAT = 152 * MiB;
constexpr size_t WS_SELI = 216 * MiB, WS_SELG = 232 * MiB;
constexpr size_t WS_PROJ = 256 * MiB;
constexpr size_t WS_Q = 256 * MiB;
constexpr size_t WS_END = 400 * MiB;
constexpr int CW_BAR = 4096;
constexpr int CW_SSQ2 = 65536;
static_assert((CW_SSQ2 + M) * 4 <= (int)CTL_ZERO_BYTES, "ctl");

constexpr int RING_OFF = 0, RING_BYTES = 131072;
constexpr int LDSCTL_OFF = RING_BYTES, MISC_OFF = LDSCTL_OFF + 320;
constexpr int EXTRA_OFF = RING_BYTES + 1024;
constexpr int LDS_BYTES = 147456;

#define GAS __attribute__((address_space(1)))
#define LAS __attribute__((address_space(3)))
typedef unsigned short bf16;
typedef unsigned v4u __attribute__((ext_vector_type(4)));
typedef unsigned v2u __attribute__((ext_vector_type(2)));
typedef float f32x4 __attribute__((ext_vector_type(4)));
typedef GAS unsigned gu32;
typedef __bf16 bf16x2_t __attribute__((ext_vector_type(2)));
#define RLX_AGENT __ATOMIC_RELAXED, __HIP_MEMORY_SCOPE_AGENT
#define LDS_WAIT() asm volatile("s_waitcnt lgkmcnt(0)" ::: "memory")
__device__ __forceinline__ unsigned f2bf(float f) { unsigned u = __builtin_bit_cast(unsigned, f); return (u + 0x7fffu + ((u >> 16) & 1u)) >> 16; }
__device__ __forceinline__ unsigned pk2(float lo, float hi) { return f2bf(lo) | (f2bf(hi) << 16); }
__device__ __forceinline__ float bflo(unsigned w) { return __uint_as_float(w << 16); }
__device__ __forceinline__ float bfhi(unsigned w) { return __uint_as_float(w & 0xffff0000u); }
__device__ __forceinline__ float dot2(unsigned a, unsigned b, float c) { return __builtin_amdgcn_fdot2_f32_bf16(__builtin_bit_cast(bf16x2_t, a), __builtin_bit_cast(bf16x2_t, b), c, false); }
__device__ __forceinline__ float wave_sum(float v) {
#pragma unroll
    for (int o = 1; o < 64; o <<= 1) v += __shfl_xor(v, o);
    return v;
}
#define XB_TMO      128
#define XB_XCNT(j)  (256  + 64 * (j))
#define XB_XSUB(j)  (1280 + 64 * (j))
#define XB_XGEN(j)  (2304 + 64 * (j))
#define XB_TOP      3328
#define XB_TOPGEN   3392
#define XCD_BAR_WORDS 3456
#define XB_SPIN_CAP (1u << 18)

__device__ __forceinline__ unsigned xb_ld(unsigned* p)              { return __hip_atomic_load(p, __ATOMIC_RELAXED, __HIP_MEMORY_SCOPE_AGENT); }
__device__ __forceinline__ unsigned xb_add(unsigned* p, unsigned v) { return __hip_atomic_fetch_add(p, v, __ATOMIC_RELAXED, __HIP_MEMORY_SCOPE_AGENT); }
__device__ __forceinline__ unsigned xb_xcc_id() { return (unsigned)__builtin_amdgcn_s_getreg((3 << 11) | 20) & 0xFu; }
#define XB_SPIN(cond, bar) do { unsigned _sp = 0; while (cond) { __builtin_amdgcn_s_sleep(1); \
    if ((++_sp & 255u) == 0u) { if (xb_ld(&(bar)[XB_TMO])) break; if (_sp > XB_SPIN_CAP) { atomicAdd(&(bar)[XB_TMO], 1u); break; } } } } while (0)

struct XcdBarrier {
    unsigned* bar; unsigned x;
    volatile LAS unsigned* st;
};

__device__ __forceinline__ XcdBarrier xcd_barrier_post(unsigned* bar, volatile LAS unsigned* st) {
    XcdBarrier b; b.bar = bar; b.x = xb_xcc_id(); b.st = st;
    if (threadIdx.x == 0) (void)xb_add(&bar[XB_XCNT(b.x)], 1u);
    return b;
}
__device__ __forceinline__ void xcd_barrier_complete(unsigned* bar, unsigned x, unsigned& nloc, unsigned& nx) {
    const unsigned G = gridDim.x * gridDim.y * gridDim.z;
    unsigned sum, cnt, mine, sp = 0u;
    for (;;) {
        sum = 0u; cnt = 0u; mine = 0u;
#pragma unroll
        for (unsigned j = 0; j < 16; ++j) { const unsigned c = xb_ld(&bar[XB_XCNT(j)]); sum += c; cnt += (c > 0u) ? 1u : 0u; mine = (j == x) ? c : mine; }
        if (sum == G) break;
        __builtin_amdgcn_s_sleep(1);
        if ((++sp & 255u) == 0u) { if (xb_ld(&bar[XB_TMO])) break; if (sp > XB_SPIN_CAP) { atomicAdd(&bar[XB_TMO], 1u); break; } }
    }
    nloc = mine > 0u ? mine : 1u; nx = cnt > 0u ? cnt : 1u;
}

__device__ __forceinline__ void xcd_barrier(const XcdBarrier& b) {
    asm volatile("s_waitcnt vmcnt(0)" ::: "memory");
    __syncthreads();
    if (threadIdx.x == 0) {
        unsigned* bar = b.bar;
        __builtin_amdgcn_s_waitcnt(0);
        unsigned nloc = b.st[0], nx = b.st[1];
        if (nloc == 0u) { xcd_barrier_complete(bar, b.x, nloc, nx); b.st[0] = nloc; b.st[1] = nx; }
        const unsigned old = xb_add(&bar[XB_XSUB(b.x)], 1u);
        const unsigned gen = old / nloc;
        if (old + 1u == (gen + 1u) * nloc) {
            __builtin_amdgcn_fence(__ATOMIC_RELEASE, "agent");
            asm volatile("s_waitcnt vmcnt(0)" ::: "memory");
            const unsigned og = xb_add(&bar[XB_TOP], 1u);
            const unsigned tg = og / nx;
            if (og + 1u == (tg + 1u) * nx) xb_add(&bar[XB_TOPGEN], 1u);
            else XB_SPIN(xb_ld(&bar[XB_TOPGEN]) == tg, bar);
            __builtin_amdgcn_fence(__ATOMIC_ACQUIRE, "agent");
            xb_add(&bar[XB_XGEN(b.x)], 1u);
            asm volatile("s_waitcnt vmcnt(0)" ::: "memory");
        } else {
            XB_SPIN(xb_ld(&bar[XB_XGEN(b.x)]) == gen, bar);
            __builtin_amdgcn_fence(__ATOMIC_ACQUIRE, "agent");
            asm volatile("s_waitcnt vmcnt(0)" ::: "memory");
        }
    }
    __syncthreads();
}

struct Frame {
    LAS unsigned char* lds;
    volatile LAS unsigned* MISC;
    gu32* ctl;
    int tid, lane, wave;
    int vcu, G;
};
struct Ptrs {
    const float *x, *mem, *attn_g, *w_in, *conv_w, *conv_b, *conv_ln_g, *conv_ln_b, *sb_out_g, *mem_norm_g, *w_mem_kv, *q_norm_g, *k_norm_g, *mem_out_g,
                *w_out, *ffn_g, *w_peer_q, *keys1, *keys2, *peer_u, *peer_v;
    float* out;
    bf16 *WIN, *WKV, *WOUT, *WPQ, *KEYS, *MEMN, *MKV, *XN, *CAT, *PROJ, *Q;
    unsigned char *UT, *VT; float *USC, *VSC;
    int* SELI; float* SELG; float* SSQ2;
};

__device__ __forceinline__ void p0_transpose_item(const float* W, const float* gk, int K, int N, bf16* WT, LAS float* scr, int item, int lane) {
    const int nblk = N / 32, kb = item / nblk, nb = item % nblk, k0 = 64 * kb, n0 = 32 * nb;
#pragma unroll 8
    for (int i = 0; i < 32; ++i) { const int kk = 2 * i + (lane >> 5); float w = W[(size_t)(k0 + kk) * N + n0 + (lane & 31)]; if (gk) w *= gk[k0 + kk]; scr[kk * 33 + (lane & 31)] = w; }
    LDS_WAIT(); asm volatile("" ::: "memory");
    const int c = lane & 7;
#pragma unroll
    for (int j = 0; j < 4; ++j) { const int n = (lane >> 3) + 8 * j; const LAS float* s = scr + (8 * c) * 33 + n;
        v4u o; o.x = pk2(s[0 * 33], s[1 * 33]); o.y = pk2(s[2 * 33], s[3 * 33]); o.z = pk2(s[4 * 33], s[5 * 33]); o.w = pk2(s[6 * 33], s[7 * 33]);
        *(GAS v4u*)(WT + (size_t)(n0 + n) * K + k0 + 8 * c) = o; }
    LDS_WAIT(); asm volatile("" ::: "memory");
}
__device__ __forceinline__ void rms_row_to_bf16(const float* xrow, const float* g, bf16* orow, int lane) {
    const GAS f32x4* xr = (const GAS f32x4*)xrow + lane; const GAS f32x4* gr = (const GAS f32x4*)g + lane;
    f32x4 v[4]; float s = 0.f;
#pragma unroll
    for (int j = 0; j < 4; ++j) { v[j] = xr[64 * j]; s += (v[j].x * v[j].x + v[j].y * v[j].y) + (v[j].z * v[j].z + v[j].w * v[j].w); }
    const float rinv = 1.f / sqrtf(wave_sum(s) * (1.f / 1024.f) + EPS);
    GAS unsigned long long* o8 = (GAS unsigned long long*)orow + lane;
#pragma unroll
    for (int j = 0; j < 4; ++j) { const f32x4 gg = gr[64 * j]; const f32x4 o = v[j] * rinv * gg;
        o8[64 * j] = (unsigned long long)pk2(o.x, o.y) | ((unsigned long long)pk2(o.z, o.w) << 32); }
}
__device__ __forceinline__ void cvt_f32_to_bf16_stream(const float* src, bf16* dst, size_t n8, size_t gtid, size_t nthr) {
    for (size_t i = gtid; i < n8; i += nthr) { const f32x4 a = ((const GAS f32x4*)src)[2 * i], b = ((const GAS f32x4*)src)[2 * i + 1];
        v4u o; o.x = pk2(a.x, a.y); o.y = pk2(a.z, a.w); o.z = pk2(b.x, b.y); o.w = pk2(b.z, b.w); ((GAS v4u*)dst)[i] = o; }
}
__device__ __forceinline__ void row_to_fp8(const float* src, unsigned char* dst, float* iscale, int e, int lane) {
    const GAS f32x4* p = (const GAS f32x4*)(src + (size_t)e * D) + lane; f32x4 v[4]; float am = 0.f;
#pragma unroll
    for (int k = 0; k < 4; ++k) { v[k] = p[64 * k]; am = fmaxf(fmaxf(am, fmaxf(fabsf(v[k].x), fabsf(v[k].y))), fmaxf(fabsf(v[k].z), fabsf(v[k].w))); }
#pragma unroll
    for (int o = 1; o < 64; o <<= 1) am = fmaxf(am, __shfl_xor(am, o));
    const float sc = am > 0.f ? 256.f / am : 1.f, isc = am > 0.f ? am * (1.f / 256.f) : 1.f;
    GAS unsigned* d = (GAS unsigned*)(dst + (size_t)e * D) + lane;
#pragma unroll
    for (int k = 0; k < 4; ++k) { int w = 0; w = __builtin_amdgcn_cvt_pk_fp8_f32(v[k].x * sc, v[k].y * sc, w, false); w = __builtin_amdgcn_cvt_pk_fp8_f32(v[k].z * sc, v[k].w * sc, w, true); d[64 * k] = (unsigned)w; }
    if (lane == 0) iscale[e] = isc;
}
__device__ __forceinline__ void p0_prologue(Frame& F, const Ptrs& P) {
    LAS float* scr = (LAS float*)(F.lds + RING_OFF + F.wave * 16384);
    const int gw = F.vcu * NWAVES + F.wave, NGW = F.G * NWAVES;
    constexpr int I_IN = (D / 64) * (INW / 32), I_KV = (D / 64) * (KVW / 32), I_OUT = (D / 64) * (D / 32), I_PQ = (D / 64) * (PQW / 32);
    constexpr int NITEMS = I_IN + I_KV + I_OUT + I_PQ;
    for (int it = gw; it < NITEMS; it += NGW) {
        int r = it;
        if (r < I_IN) { p0_transpose_item(P.w_in, nullptr, D, INW, P.WIN, scr, r, F.lane); continue; } r -= I_IN;
        if (r < I_KV) { p0_transpose_item(P.w_mem_kv, nullptr, D, KVW, P.WKV, scr, r, F.lane); continue; } r -= I_KV;
        if (r < I_OUT) { p0_transpose_item(P.w_out, nullptr, D, D, P.WOUT, scr, r, F.lane); continue; } r -= I_OUT;
        p0_transpose_item(P.w_peer_q, P.ffn_g, D, PQW, P.WPQ, scr, r, F.lane);
    }
    for (int m = gw; m < M; m += NGW) rms_row_to_bf16(P.x + (size_t)m * D, P.attn_g, P.XN + (size_t)m * D, F.lane);
    for (int m = gw; m < MMEM; m += NGW) rms_row_to_bf16(P.mem + (size_t)m * D, P.mem_norm_g, P.MEMN + (size_t)m * D, F.lane);
    const size_t gtid = (size_t)gw * 64 + F.lane, nthr = (size_t)NGW * 64;
    cvt_f32_to_bf16_stream(P.keys1, P.KEYS, 8 * 128 * 128 / 8, gtid, nthr);
    cvt_f32_to_bf16_stream(P.keys2, P.KEYS + 8 * 128 * 128, 8 * 128 * 128 / 8, gtid, nthr);
    for (int r = gw; r < 2 * NEXP; r += NGW) { if (r < NEXP) row_to_fp8(P.peer_u, P.UT, P.USC, r, F.lane); else row_to_fp8(P.peer_v, P.VT, P.VSC, r - NEXP, F.lane); }
}

__device__ __forceinline__ void conv_item(Frame& F, const Ptrs& P, int b, int ch) {
    LAS float* U = (LAS float*)(F.lds + 0);
    LAS float* Y = (LAS float*)(F.lds + 65536);
    const int t0 = ch * 32, tid = F.tid;
    for (int idx = tid; idx < 62 * 32; idx += 512) {
        const int r = idx >> 5, c8 = idx & 31, t = t0 - 30 + r;
        float u[8];
        if (t >= 0) { const bf16* src = P.PROJ + (size_t)(b * SEQ + t) * INW + c8 * 8;
            const v4u a = *(const GAS v4u*)(src + C_A), g = *(const GAS v4u*)(src + C_G);
            const unsigned aw[4] = {a.x, a.y, a.z, a.w}, gw_[4] = {g.x, g.y, g.z, g.w};
#pragma unroll
            for (int i = 0; i < 4; ++i) { const float a0 = bflo(aw[i]), a1 = bfhi(aw[i]), g0 = bflo(gw_[i]), g1 = bfhi(gw_[i]);
                u[2 * i] = a0 / (1.f + __expf(-g0)); u[2 * i + 1] = a1 / (1.f + __expf(-g1)); }
        } else {
#pragma unroll
            for (int i = 0; i < 8; ++i) u[i] = 0.f;
        }
        LAS f32x4* dst = (LAS f32x4*)(U + r * 256 + c8 * 8);
        dst[0] = (f32x4){u[0], u[1], u[2], u[3]}; dst[1] = (f32x4){u[4], u[5], u[6], u[7]};
    }
    __syncthreads();
    {
        const int c = tid & 255, half = tid >> 8;
        float w[31];
#pragma unroll
        for (int k = 0; k < 31; ++k) w[k] = P.conv_w[k * 256 + c];
        const float bias = P.conv_b[c];
        float win[46];
#pragma unroll
        for (int i = 0; i < 46; ++i) win[i] = U[(half * 16 + i) * 256 + c];
#pragma unroll
        for (int tt = 0; tt < 16; ++tt) { float y = bias;
#pragma unroll
            for (int k = 0; k < 31; ++k) y += w[k] * win[tt + k];
            Y[(half * 16 + tt) * 256 + c] = y; }
    }
    __syncthreads();
    {
        const f32x4 lg = ((const GAS f32x4*)P.conv_ln_g)[F.lane], lb = ((const GAS f32x4*)P.conv_ln_b)[F.lane];
#pragma unroll
        for (int i = 0; i < 4; ++i) { const int tok = F.wave * 4 + i; const f32x4 y = *(const LAS f32x4*)(Y + tok * 256 + F.lane * 4);
            const float mu = wave_sum((y.x + y.y) + (y.z + y.w)) * (1.f / 256.f); const f32x4 d = y - mu;
            const float var = wave_sum((d.x * d.x + d.y * d.y) + (d.z * d.z + d.w * d.w)) * (1.f / 256.f);
            const float rinv = 1.f / sqrtf(var + EPS); const f32x4 yn = d * rinv * lg + lb;
            f32x4 s; s.x = yn.x / (1.f + __expf(-yn.x)); s.y = yn.y / (1.f + __expf(-yn.y)); s.z = yn.z / (1.f + __expf(-yn.z)); s.w = yn.w / (1.f + __expf(-yn.w));
            *(GAS unsigned long long*)(P.CAT + (size_t)(b * SEQ + t0 + tok) * D + F.lane * 4) = (unsigned long long)pk2(s.x, s.y) | ((unsigned long long)pk2(s.z, s.w) << 32); }
    }
}

constexpr int SB_KS = 0, SB_VT = 65536;
__device__ __forceinline__ void sb_item(Frame& F, const Ptrs& P, int b, int qb) {
    LAS unsigned char* lds = F.lds; const int tid = F.tid, lane = F.lane, h = F.wave;
    const int t = qb * 64 + lane; const size_t row = (size_t)b * SEQ + t;
    unsigned q[32];
    { const GAS v4u* qp = (const GAS v4u*)(P.PROJ + row * INW + C_Q + h * 64);
#pragma unroll
      for (int j = 0; j < 8; ++j) { const v4u v = qp[j]; q[4 * j] = v.x; q[4 * j + 1] = v.y; q[4 * j + 2] = v.z; q[4 * j + 3] = v.w; } }
    float o[64];
#pragma unroll
    for (int d = 0; d < 64; ++d) o[d] = 0.f;
    float R = 1.f; bool alive = true;
    LAS float* xs = (LAS float*)(lds + EXTRA_OFF); volatile LAS unsigned* flags = (volatile LAS unsigned*)(lds + EXTRA_OFF + 2048);
    for (int kt = qb; kt >= 0; --kt) {
        __syncthreads();
        if (kt != qb) { unsigned any = 0u;
#pragma unroll
            for (int w = 0; w < 8; ++w) any |= flags[w];
            if (!any) break; }
        { const size_t rb = (size_t)b * SEQ + kt * 64;
#pragma unroll
          for (int i = 0; i < 8; ++i) { const int c = tid + 512 * i; const int key = c >> 6, j = c & 63, hh = j >> 3, d8 = j & 7;
              const bf16* src = P.PROJ + (rb + key) * INW;
              const v4u kv = *(const GAS v4u*)(src + C_K + j * 8); *(LAS v4u*)(lds + SB_KS + ((hh * 64 + key) * 64 + d8 * 8) * 2) = kv;
              const v4u vv = *(const GAS v4u*)(src + C_V + j * 8);
              LAS unsigned short* vd = (LAS unsigned short*)(lds + SB_VT + ((hh * 32 + (key >> 1)) * 64 + d8 * 8) * 4 + (key & 1) * 2);
              vd[0] = (unsigned short)(vv.x & 0xffffu); vd[2] = (unsigned short)(vv.x >> 16); vd[4] = (unsigned short)(vv.y & 0xffffu); vd[6] = (unsigned short)(vv.y >> 16);
              vd[8] = (unsigned short)(vv.z & 0xffffu); vd[10] = (unsigned short)(vv.z >> 16); vd[12] = (unsigned short)(vv.w & 0xffffu); vd[14] = (unsigned short)(vv.w >> 16); } }
        __syncthreads();
        if (alive) {
            const bool diag = (kt == qb);
            const LAS v4u* kbase = (const LAS v4u*)(lds + SB_KS + h * 64 * 128);
            const LAS v4u* vbase = (const LAS v4u*)(lds + SB_VT + h * 32 * 256);
            for (int pp = 31; pp >= 0; --pp) {
                float z1, z0;
                { const LAS v4u* kp = kbase + (2 * pp + 1) * 8; float a0 = 0.f, a1 = 0.f, a2 = 0.f, a3 = 0.f;
#pragma unroll
                  for (int j = 0; j < 8; ++j) { const v4u kk = kp[j]; a0 = dot2(kk.x, q[4 * j], a0); a1 = dot2(kk.y, q[4 * j + 1], a1); a2 = dot2(kk.z, q[4 * j + 2], a2); a3 = dot2(kk.w, q[4 * j + 3], a3); }
                  z1 = ((a0 + a1) + (a2 + a3)) * 0.125f; }
                { const LAS v4u* kp = kbase + (2 * pp) * 8; float a0 = 0.f, a1 = 0.f, a2 = 0.f, a3 = 0.f;
#pragma unroll
                  for (int j = 0; j < 8; ++j) { const v4u kk = kp[j]; a0 = dot2(kk.x, q[4 * j], a0); a1 = dot2(kk.y, q[4 * j + 1], a1); a2 = dot2(kk.z, q[4 * j + 2], a2); a3 = dot2(kk.w, q[4 * j + 3], a3); }
                  z0 = ((a0 + a1) + (a2 + a3)) * 0.125f; }
                float w1, w0;
                { const float e = __expf(-fabsf(z1)), r = __builtin_amdgcn_rcpf(1.f + e), er = e * r; const float beta = z1 >= 0.f ? r : er, om = z1 >= 0.f ? er : r;
                  const bool valid = !diag || (2 * pp + 1 < lane); w1 = valid ? beta * R : 0.f; R = valid ? R * om : R; }
                { const float e = __expf(-fabsf(z0)), r = __builtin_amdgcn_rcpf(1.f + e), er = e * r; const float beta = z0 >= 0.f ? r : er, om = z0 >= 0.f ? er : r;
                  const bool valid = !diag || (2 * pp < lane); w0 = valid ? beta * R : 0.f; R = valid ? R * om : R; }
                const unsigned apk = pk2(w0, w1);
                const LAS v4u* vp = vbase + pp * 16;
#pragma unroll
                for (int j = 0; j < 16; ++j) { const v4u vv = vp[j]; o[4 * j] = dot2(vv.x, apk, o[4 * j]); o[4 * j + 1] = dot2(vv.y, apk, o[4 * j + 1]); o[4 * j + 2] = dot2(vv.z, apk, o[4 * j + 2]); o[4 * j + 3] = dot2(vv.w, apk, o[4 * j + 3]); }
            }
            alive = __builtin_amdgcn_ballot_w64(R > 1.0e-37f) != 0ull;
        }
        if (lane == 0) flags[h] = alive ? 1u : 0u;
    }
    __syncthreads();
    float ss = 0.f;
#pragma unroll
    for (int d = 0; d < 64; ++d) ss += o[d] * o[d];
    xs[h * 64 + lane] = ss;
    __syncthreads();
    float tot = 0.f;
#pragma unroll
    for (int w = 0; w < 8; ++w) tot += xs[w * 64 + lane];
    const float rinv = 1.f / sqrtf(tot * (1.f / 512.f) + EPS);
    GAS v4u* dst = (GAS v4u*)(P.CAT + row * D + 256 + h * 64); const GAS f32x4* gp = (const GAS f32x4*)(P.sb_out_g + h * 64);
#pragma unroll
    for (int j = 0; j < 8; ++j) { const f32x4 g0 = gp[2 * j], g1 = gp[2 * j + 1]; v4u w;
        w.x = pk2(o[8 * j] * rinv * g0.x, o[8 * j + 1] * rinv * g0.y); w.y = pk2(o[8 * j + 2] * rinv * g0.z, o[8 * j + 3] * rinv * g0.w);
        w.z = pk2(o[8 * j + 4] * rinv * g1.x, o[8 * j + 5] * rinv * g1.y); w.w = pk2(o[8 * j + 6] * rinv * g1.z, o[8 * j + 7] * rinv * g1.w); dst[j] = w; }
}

constexpr int MA_KS = 0, MA_VT = 32768;
__device__ __forceinline__ void mem_item(Frame& F, const Ptrs& P, int b, int qblk) {
    LAS unsigned char* lds = F.lds; const int tid = F.tid, lane = F.lane, h = F.wave & 3, sub = F.wave >> 2;
    const int t = qblk * 128 + sub * 64 + lane; const size_t row = (size_t)b * SEQ + t;
    unsigned q[32];
    { const GAS v4u* qp = (const GAS v4u*)(P.PROJ + row * INW + C_MQ + h * 64); float qf[64]; float s = 0.f;
#pragma unroll
      for (int j = 0; j < 8; ++j) { const v4u v = qp[j]; const unsigned w[4] = {v.x, v.y, v.z, v.w};
#pragma unroll
          for (int i = 0; i < 4; ++i) { qf[8 * j + 2 * i] = bflo(w[i]); qf[8 * j + 2 * i + 1] = bfhi(w[i]); s += qf[8 * j + 2 * i] * qf[8 * j + 2 * i] + qf[8 * j + 2 * i + 1] * qf[8 * j + 2 * i + 1]; } }
      const float rinv = 1.f / sqrtf(s * (1.f / 64.f) + EPS);
#pragma unroll
      for (int j = 0; j < 32; ++j) q[j] = pk2(qf[2 * j] * rinv * P.q_norm_g[2 * j], qf[2 * j + 1] * rinv * P.q_norm_g[2 * j + 1]); }
    float o[64];
#pragma unroll
    for (int d = 0; d < 64; ++d) o[d] = 0.f;
    float mx = -1.0e30f, lsum = 0.f;
    LAS float* xs = (LAS float*)(lds + EXTRA_OFF);
    for (int kt = 0; kt < 4; ++kt) {
        __syncthreads();
        { const int key = (tid & 255) >> 2, hh = tid & 3; const bf16* src = P.MKV + (size_t)(b * MEML + kt * 64 + key) * KVW + hh * 64;
          if (tid < 256) {
              const GAS v4u* kp = (const GAS v4u*)src; float s = 0.f;
#pragma unroll
              for (int j = 0; j < 8; ++j) { const v4u kv = kp[j]; const unsigned w[4] = {kv.x, kv.y, kv.z, kv.w};
#pragma unroll
                  for (int i = 0; i < 4; ++i) { const float a = bflo(w[i]), c = bfhi(w[i]); s += a * a + c * c; } }
              const float rinv = 1.f / sqrtf(s * (1.f / 64.f) + EPS);
              asm volatile("" ::: "memory");
              LAS v4u* dst = (LAS v4u*)(lds + MA_KS + (hh * 64 + key) * 128);
#pragma unroll 2
              for (int j = 0; j < 8; ++j) { const v4u kv = kp[j]; const unsigned w[4] = {kv.x, kv.y, kv.z, kv.w}; unsigned ow[4];
#pragma unroll
                  for (int i = 0; i < 4; ++i) ow[i] = pk2(bflo(w[i]) * rinv * P.k_norm_g[8 * j + 2 * i], bfhi(w[i]) * rinv * P.k_norm_g[8 * j + 2 * i + 1]);
                  dst[j] = (v4u){ow[0], ow[1], ow[2], ow[3]}; }
          } else {
              const GAS v4u* vp = (const GAS v4u*)(src + 256);
              LAS unsigned short* vd = (LAS unsigned short*)(lds + MA_VT + ((hh * 32 + (key >> 1)) * 64) * 4 + (key & 1) * 2);
#pragma unroll
              for (int j = 0; j < 8; ++j) { const v4u vv = vp[j]; LAS unsigned short* d8 = vd + j * 16;
                  d8[0] = (unsigned short)(vv.x & 0xffffu); d8[2] = (unsigned short)(vv.x >> 16); d8[4] = (unsigned short)(vv.y & 0xffffu); d8[6] = (unsigned short)(vv.y >> 16);
                  d8[8] = (unsigned short)(vv.z & 0xffffu); d8[10] = (unsigned short)(vv.z >> 16); d8[12] = (unsigned short)(vv.w & 0xffffu); d8[14] = (unsigned short)(vv.w >> 16); }
          } }
        __syncthreads();
        const LAS v4u* kbase = (const LAS v4u*)(lds + MA_KS + h * 64 * 128);
        const LAS v4u* vbase = (const LAS v4u*)(lds + MA_VT + h * 32 * 256);
        for (int blk = 0; blk < 4; ++blk) {
            float s[16];
#pragma unroll
            for (int i = 0; i < 16; ++i) { const LAS v4u* kp = kbase + (blk * 16 + i) * 8; float a0 = 0.f, a1 = 0.f, a2 = 0.f, a3 = 0.f;
#pragma unroll
                for (int j = 0; j < 8; ++j) { const v4u kk = kp[j]; a0 = dot2(kk.x, q[4 * j], a0); a1 = dot2(kk.y, q[4 * j + 1], a1); a2 = dot2(kk.z, q[4 * j + 2], a2); a3 = dot2(kk.w, q[4 * j + 3], a3); }
                s[i] = ((a0 + a1) + (a2 + a3)) * 0.125f; }
            float bm = s[0];
#pragma unroll
            for (int i = 1; i < 16; ++i) bm = fmaxf(bm, s[i]);
            const float mn = fmaxf(mx, bm), sc = __expf(mx - mn); mx = mn; lsum *= sc;
#pragma unroll
            for (int d = 0; d < 64; ++d) o[d] *= sc;
#pragma unroll
            for (int i = 0; i < 16; ++i) { s[i] = __expf(s[i] - mn); lsum += s[i]; }
#pragma unroll
            for (int j2 = 0; j2 < 8; ++j2) { const unsigned apk = pk2(s[2 * j2], s[2 * j2 + 1]); const LAS v4u* vp = vbase + (blk * 8 + j2) * 16;
#pragma unroll
                for (int j = 0; j < 16; ++j) { const v4u vv = vp[j]; o[4 * j] = dot2(vv.x, apk, o[4 * j]); o[4 * j + 1] = dot2(vv.y, apk, o[4 * j + 1]); o[4 * j + 2] = dot2(vv.z, apk, o[4 * j + 2]); o[4 * j + 3] = dot2(vv.w, apk, o[4 * j + 3]); } }
        }
    }
    const float linv = 1.f / lsum; float ss = 0.f;
#pragma unroll
    for (int d = 0; d < 64; ++d) { o[d] *= linv; ss += o[d] * o[d]; }
    __syncthreads();
    xs[F.wave * 64 + lane] = ss;
    __syncthreads();
    float tot = 0.f;
#pragma unroll
    for (int w = 0; w < 4; ++w) tot += xs[(sub * 4 + w) * 64 + lane];
    const float rinv = 1.f / sqrtf(tot * (1.f / 256.f) + EPS);
    GAS v4u* dst = (GAS v4u*)(P.CAT + row * D + 768 + h * 64); const GAS f32x4* gp = (const GAS f32x4*)(P.mem_out_g + h * 64);
#pragma unroll
    for (int j = 0; j < 8; ++j) { const f32x4 g0 = gp[2 * j], g1 = gp[2 * j + 1]; v4u w;
        w.x = pk2(o[8 * j] * rinv * g0.x, o[8 * j + 1] * rinv * g0.y); w.y = pk2(o[8 * j + 2] * rinv * g0.z, o[8 * j + 3] * rinv * g0.w);
        w.z = pk2(o[8 * j + 4] * rinv * g1.x, o[8 * j + 5] * rinv * g1.y); w.w = pk2(o[8 * j + 6] * rinv * g1.z, o[8 * j + 7] * rinv * g1.w); dst[j] = w; }
}

#define INS16(V, I, cv_, ci_) do { float cv = (cv_); int ci = (ci_); \
    _Pragma("unroll") for (int p_ = 0; p_ < 16; ++p_) { const bool gt = cv > V[p_]; const float tv = gt ? V[p_] : cv; const int ti = gt ? I[p_] : ci; V[p_] = gt ? cv : V[p_]; I[p_] = gt ? ci : I[p_]; cv = tv; ci = ti; } } while (0)
__device__ __forceinline__ void topk_half(const LAS unsigned char* keys, const bf16* qrow, float (&V)[16], int (&I)[16]) {
    unsigned q[64];
    { const GAS v4u* qp = (const GAS v4u*)qrow;
#pragma unroll
      for (int j = 0; j < 16; ++j) { const v4u v = qp[j]; q[4 * j] = v.x; q[4 * j + 1] = v.y; q[4 * j + 2] = v.z; q[4 * j + 3] = v.w; } }
#pragma unroll
    for (int p = 0; p < 16; ++p) { V[p] = -3.0e38f; I[p] = 0; }
    for (int n = 0; n < 128; ++n) {
        const LAS v4u* kp = (const LAS v4u*)(keys + n * 256); float a0 = 0.f, a1 = 0.f, a2 = 0.f, a3 = 0.f;
#pragma unroll
        for (int j = 0; j < 16; ++j) { const v4u kk = kp[j]; a0 = dot2(kk.x, q[4 * j], a0); a1 = dot2(kk.y, q[4 * j + 1], a1); a2 = dot2(kk.z, q[4 * j + 2], a2); a3 = dot2(kk.w, q[4 * j + 3], a3); }
        const float s = (a0 + a1) + (a2 + a3);
        INS16(V, I, s, n);
    }
}
__device__ __forceinline__ void peer_select_item(Frame& F, const Ptrs& P, int tb, int h) {
    LAS unsigned char* lds = F.lds; const int tid = F.tid;
    __syncthreads();
#pragma unroll
    for (int i = 0; i < 8; ++i) { const int c = tid + 512 * i;
        const bf16* src = (c < 2048) ? (P.KEYS + (size_t)h * 16384 + c * 8) : (P.KEYS + 131072 + (size_t)h * 16384 + (c - 2048) * 8);
        *(LAS v4u*)(lds + c * 16) = *(const GAS v4u*)src; }
    __syncthreads();
    const int t = tb * 512 + F.wave * 64 + F.lane;
    float v1[16], v2[16]; int i1[16], i2[16];
    topk_half(lds, P.Q + (size_t)t * PQW + h * 256, v1, i1);
    topk_half(lds + 32768, P.Q + (size_t)t * PQW + h * 256 + 128, v2, i2);
    float ts[16]; int te[16];
#pragma unroll
    for (int p = 0; p < 16; ++p) { ts[p] = -3.0e38f; te[p] = 0; }
#pragma unroll
    for (int i = 0; i < 16; ++i)
#pragma unroll
        for (int j = 0; j < 16; ++j) if ((i + 1) * (j + 1) <= 16) { INS16(ts, te, v1[i] + v2[j], i1[i] * 128 + i2[j]); }
    float e[16], sum = 0.f;
#pragma unroll
    for (int p = 0; p < 16; ++p) { e[p] = __expf(ts[p] - ts[0]); sum += e[p]; }
    const float inv = 1.f / sum;
    GAS v4u* di = (GAS v4u*)(P.SELI + ((size_t)t * 8 + h) * 16); GAS f32x4* dg = (GAS f32x4*)(P.SELG + ((size_t)t * 8 + h) * 16);
#pragma unroll
    for (int j = 0; j < 4; ++j) { di[j] = (v4u){(unsigned)te[4 * j], (unsigned)te[4 * j + 1], (unsigned)te[4 * j + 2], (unsigned)te[4 * j + 3]};
        dg[j] = (f32x4){e[4 * j] * inv, e[4 * j + 1] * inv, e[4 * j + 2] * inv, e[4 * j + 3] * inv}; }
}

typedef float f32x2 __attribute__((ext_vector_type(2)));
__device__ __forceinline__ void peer_gather_token(const Ptrs& P, LAS float* wl, int t, int lane) {
    const float rs = 1.0f / sqrtf(__hip_atomic_load(P.SSQ2 + t, RLX_AGENT) * (1.0f / 1024.0f) + EPS);
    f32x2 acc[8], hh[8];
    { const GAS f32x4* xr = (const GAS f32x4*)(P.out + (size_t)t * D) + lane * 4; const GAS f32x4* gr = (const GAS f32x4*)P.ffn_g + lane * 4;
#pragma unroll
      for (int k = 0; k < 4; ++k) { const f32x4 xv = xr[k], gv = gr[k]; acc[2 * k] = (f32x2){xv.x, xv.y}; acc[2 * k + 1] = (f32x2){xv.z, xv.w};
          hh[2 * k] = (f32x2){xv.x * rs * gv.x, xv.y * rs * gv.y}; hh[2 * k + 1] = (f32x2){xv.z * rs * gv.z, xv.w * rs * gv.w}; } }
    const int e0 = P.SELI[(size_t)t * 128 + lane], e1 = P.SELI[(size_t)t * 128 + 64 + lane];
    const float g0 = P.SELG[(size_t)t * 128 + lane], g1 = P.SELG[(size_t)t * 128 + 64 + lane];
    const bool h5 = (lane & 32) != 0, h4 = (lane & 16) != 0, h3 = (lane & 8) != 0;
    const int kl = 4 * ((lane >> 3) & 1) + 2 * ((lane >> 4) & 1) + ((lane >> 5) & 1);
    for (int jb = 0; jb < 128; jb += 8) {
        v4u r[8];
#pragma unroll
        for (int k = 0; k < 8; ++k) { const int j = jb + k; const int e = __builtin_amdgcn_readlane(jb < 64 ? e0 : e1, j & 63); r[k] = ((const GAS v4u*)(P.UT + (size_t)e * D))[lane]; }
        float p[8];
#pragma unroll
        for (int k = 0; k < 8; ++k) { const unsigned w[4] = {r[k].x, r[k].y, r[k].z, r[k].w}; f32x2 d = {0.f, 0.f};
#pragma unroll
            for (int i = 0; i < 4; ++i) { d += __builtin_amdgcn_cvt_pk_f32_fp8(w[i], false) * hh[2 * i]; d += __builtin_amdgcn_cvt_pk_f32_fp8(w[i], true) * hh[2 * i + 1]; }
            p[k] = d.x + d.y; }
        float v4[4], v2[2];
#pragma unroll
        for (int m = 0; m < 4; ++m) { const float keep = h5 ? p[2 * m + 1] : p[2 * m], send = h5 ? p[2 * m] : p[2 * m + 1]; v4[m] = keep + __shfl_xor(send, 32); }
#pragma unroll
        for (int m = 0; m < 2; ++m) { const float keep = h4 ? v4[2 * m + 1] : v4[2 * m], send = h4 ? v4[2 * m] : v4[2 * m + 1]; v2[m] = keep + __shfl_xor(send, 16); }
        float v1; { const float keep = h3 ? v2[1] : v2[0], send = h3 ? v2[0] : v2[1]; v1 = keep + __shfl_xor(send, 8); }
        v1 += __shfl_xor(v1, 4); v1 += __shfl_xor(v1, 2); v1 += __shfl_xor(v1, 1);
        const int ej = __shfl(jb < 64 ? e0 : e1, (jb & 63) + kl); const float gj = __shfl(jb < 64 ? g0 : g1, (jb & 63) + kl);
        const float dot = v1 * P.USC[ej];
        const float act = 0.5f * dot * (1.f + erff(dot * 0.70710678118654752f)) * gj * P.VSC[ej];
        if ((lane & 7) == 0) wl[jb + kl] = act;
    }
    for (int jb = 0; jb < 128; jb += 8) {
        v4u r[8];
#pragma unroll
        for (int k = 0; k < 8; ++k) { const int j = jb + k; const int e = __builtin_amdgcn_readlane(jb < 64 ? e0 : e1, j & 63); r[k] = ((const GAS v4u*)(P.VT + (size_t)e * D))[lane]; }
#pragma unroll
        for (int k = 0; k < 8; ++k) { const float w = wl[jb + k]; const unsigned ww[4] = {r[k].x, r[k].y, r[k].z, r[k].w};
#pragma unroll
            for (int i = 0; i < 4; ++i) { acc[2 * i] += __builtin_amdgcn_cvt_pk_f32_fp8(ww[i], false) * w; acc[2 * i + 1] += __builtin_amdgcn_cvt_pk_f32_fp8(ww[i], true) * w; } }
    }
    GAS f32x4* orow = (GAS f32x4*)(P.out + (size_t)t * D) + lane * 4;
#pragma unroll
    for (int k = 0; k < 4; ++k) orow[k] = (f32x4){acc[2 * k].x, acc[2 * k].y, acc[2 * k + 1].x, acc[2 * k + 1].y};
}

struct Args { const float* in[21]; float* out; unsigned char* ws; int ph_lo, ph_hi, li, pad; };
__device__ __forceinline__ Ptrs make_ptrs(const Args& args) {
    unsigned char* ws = args.ws;
    Ptrs P;
    P.x = args.in[0]; P.mem = args.in[1]; P.attn_g = args.in[2]; P.w_in = args.in[3]; P.conv_w = args.in[4]; P.conv_b = args.in[5]; P.conv_ln_g = args.in[6]; P.conv_ln_b = args.in[7];
    P.sb_out_g = args.in[8]; P.mem_norm_g = args.in[9]; P.w_mem_kv = args.in[10]; P.q_norm_g = args.in[11]; P.k_norm_g = args.in[12]; P.mem_out_g = args.in[13]; P.w_out = args.in[14];
    P.ffn_g = args.in[15]; P.w_peer_q = args.in[16]; P.keys1 = args.in[17]; P.keys2 = args.in[18]; P.peer_u = args.in[19]; P.peer_v = args.in[20];
    P.out = args.out;
    P.WIN = (bf16*)(ws + WS_WIN); P.WKV = (bf16*)(ws + WS_WKV); P.WOUT = (bf16*)(ws + WS_WOUT); P.WPQ = (bf16*)(ws + WS_WPQ); P.KEYS = (bf16*)(ws + WS_KEYS);
    P.MEMN = (bf16*)(ws + WS_MEMN); P.MKV = (bf16*)(ws + WS_MKV); P.UT = ws + WS_UT; P.VT = ws + WS_VT; P.USC = (float*)(ws + WS_SC); P.VSC = (float*)(ws + WS_SC) + NEXP; P.XN = (bf16*)(ws + WS_XN); P.CAT = (bf16*)(ws + WS_CAT);
    P.PROJ = (bf16*)(ws + WS_PROJ); P.Q = (bf16*)(ws + WS_Q); P.SELI = (int*)(ws + WS_SELI); P.SELG = (float*)(ws + WS_SELG); P.SSQ2 = (float*)(ws + WS_CTL) + CW_SSQ2;
    return P;
}
__global__ void __launch_bounds__(NWAVES * 64, 2) fwd_kernel(Args args) {
    extern __shared__ __attribute__((aligned(16))) unsigned char lds[];
    Frame F;
    F.lds = (LAS unsigned char*)lds;
    F.MISC = (volatile LAS unsigned*)(F.lds + MISC_OFF);
    F.tid = threadIdx.x; F.lane = F.tid & 63; F.wave = __builtin_amdgcn_readfirstlane(F.tid >> 6);
    F.G = gridDim.x; { const int bx = blockIdx.x; F.vcu = (F.G % 8 == 0) ? (bx % 8) * (F.G / 8) + bx / 8 : bx; }
    unsigned char* ws = args.ws;
    F.ctl = (gu32*)(ws + WS_CTL);
    for (int u = F.tid; u < (LDS_BYTES - LDSCTL_OFF) / 4; u += NWAVES * 64) ((LAS unsigned*)(F.lds + LDSCTL_OFF))[u] = 0u;
    __syncthreads();
    XcdBarrier bar; bar.bar = (unsigned*)(F.ctl + CW_BAR); bar.x = 0; bar.st = nullptr;
    if (N_LAUNCHES != PER_PHASE) bar = xcd_barrier_post((unsigned*)(F.ctl + CW_BAR), F.MISC + 8);
#define GRID_BAR() do { if (N_LAUNCHES != PER_PHASE) xcd_barrier(bar); } while (0)
    const int lo = args.ph_lo, hi = args.ph_hi;
#define IN(k) (lo <= (k) && (k) < hi)
#define BOTH(k) (IN(k) && IN((k) + 1))

    if (IN(0)) { const Ptrs P = make_ptrs(args); p0_prologue(F, P); if (BOTH(0)) GRID_BAR(); }

    if (IN(1)) { const Ptrs P = make_ptrs(args);
        { pg8::Gemm g{P.XN, P.WIN, M, INW, D}; pg8::StaticOrder S; S.init(M, INW, F.G, (int)blockIdx.x);
          pg8::EpiBf16 E{P.PROJ, INW};
          pg8::gemm_phase<pg8::EpiBf16, pg8::StaticOrder, PG8_ALIGN, PG8_SP2>(F.lds + RING_OFF, g, S, E); }
        { pg8::Gemm g{P.MEMN, P.WKV, MMEM, KVW, D}; pg8::StaticOrder S; S.init(MMEM, KVW, F.G, (int)blockIdx.x);
          pg8::EpiBf16 E{P.MKV, KVW};
          pg8::gemm_phase<pg8::EpiBf16, pg8::StaticOrder, PG8_ALIGN, PG8_SP2>(F.lds + RING_OFF, g, S, E); }
        if (BOTH(1)) GRID_BAR();
    }

    if (IN(2)) { const Ptrs P = make_ptrs(args);
        const int c = F.vcu;
        for (int it = c; it < 256; it += F.G) for (int i = 0; i < 2; ++i) { const int b = it >> 5, s = it & 31; sb_item(F, P, b, i == 0 ? s : 63 - s); }
        __syncthreads();
        for (int it = c; it < BATCH * (SEQ / 128); it += F.G) mem_item(F, P, it / (SEQ / 128), it % (SEQ / 128));
        __syncthreads();
        for (int it = c; it < BATCH * (SEQ / 32); it += F.G) { conv_item(F, P, it / (SEQ / 32), it % (SEQ / 32)); }
        __syncthreads();
        if (BOTH(2)) GRID_BAR();
    }

    if (IN(3)) { const Ptrs P = make_ptrs(args);
        pg8::Gemm g{P.CAT, P.WOUT, M, D, D}; pg8::StaticOrder S; S.init(M, D, F.G, (int)blockIdx.x);
        pg8::EpiResid E{P.x, P.out, P.XN, P.SSQ2, D};
        pg8::gemm_phase<pg8::EpiResid, pg8::StaticOrder, PG8_ALIGN, PG8_SP2>(F.lds + RING_OFF, g, S, E);
        if (BOTH(3)) GRID_BAR();
    }

    if (IN(4)) { const Ptrs P = make_ptrs(args);
        pg8::Gemm g{P.XN, P.WPQ, M, PQW, D}; pg8::StaticOrder S; S.init(M, PQW, F.G, (int)blockIdx.x);
        pg8::EpiBf16Row E{P.Q, PQW, P.SSQ2};
        pg8::gemm_phase<pg8::EpiBf16Row, pg8::StaticOrder, PG8_ALIGN, PG8_SP2>(F.lds + RING_OFF, g, S, E);
        if (BOTH(4)) GRID_BAR();
    }

    if (IN(5)) { const Ptrs P = make_ptrs(args);
        for (int it = F.vcu; it < (M / 512) * 8; it += F.G) peer_select_item(F, P, it >> 3, it & 7);
        __syncthreads();
        if (BOTH(5)) GRID_BAR();
    }

    if (IN(6)) { const Ptrs P = make_ptrs(args);
        const int gw = F.vcu * NWAVES + F.wave, NGW = F.G * NWAVES;
        LAS float* wl = (LAS float*)(F.lds + F.wave * 512);
        for (int t = gw; t < M; t += NGW) peer_gather_token(P, wl, t, F.lane);
    }
#undef IN
#undef BOTH
}

extern "C" void kernel_launch(void* const* d_in, const int* in_sizes, int n_in, void* d_out, int out_size, void* d_ws, size_t ws_size, hipStream_t stream) {
    static int grid = 0;
    if (grid == 0) {
        if (n_in != 21 || in_sizes[0] != M * D || out_size != M * D || ws_size < WS_END) { fprintf(stderr, "kernel_launch: unexpected shapes/workspace (n_in %d, in0 %d, out %d, ws %zu); nothing launched\n", n_in, n_in > 0 ? in_sizes[0] : -1, out_size, ws_size); grid = -1; return; }
        int dev = 0, cus = 0, per_cu = 0;
        if (hipGetDevice(&dev) != hipSuccess || hipDeviceGetAttribute(&cus, hipDeviceAttributeMultiprocessorCount, dev) != hipSuccess) { grid = -1; return; }
        if (hipFuncSetAttribute((const void*)fwd_kernel, hipFuncAttributeMaxDynamicSharedMemorySize, LDS_BYTES) != hipSuccess) { fprintf(stderr, "kernel_launch: hipFuncSetAttribute failed\n"); grid = -1; return; }
        if (hipOccupancyMaxActiveBlocksPerMultiprocessor(&per_cu, (const void*)fwd_kernel, NWAVES * 64, LDS_BYTES) != hipSuccess || per_cu < 1) { fprintf(stderr, "kernel_launch: occupancy query says %d blocks per CU\n", per_cu); }
        (void)hipGetLastError();
        grid = cus;
    }
    if (grid < 0) return;
    if (hipMemsetAsync((char*)d_ws + WS_CTL, 0, CTL_ZERO_BYTES, stream) != hipSuccess) { fprintf(stderr, "kernel_launch: memset failed\n"); return; }
    Args a{};
    for (int i = 0; i < 21; ++i) a.in[i] = (const float*)d_in[i];
    a.out = (float*)d_out; a.ws = (unsigned char*)d_ws;
    for (int li = 0; li < N_LAUNCHES; ++li) {
        a.ph_lo = (N_LAUNCHES == PER_PHASE) ? li : 0; a.ph_hi = (N_LAUNCHES == PER_PHASE) ? li + 1 : PER_PHASE; a.li = li;
        hipLaunchKernelGGL(fwd_kernel, dim3(grid), dim3(NWAVES * 64), LDS_BYTES, stream, a);
        const hipError_t le = hipPeekAtLastError();
        if (le != hipSuccess) { fprintf(stderr, "kernel_launch: launch %d failed: %s\n", li, hipGetErrorName(le)); break; }
    }
}
```

```cpp
#include <hip/hip_runtime.h>
#include <cstdio>
#include <cstdint>
namespace pg8 {
#define PG8_LAS __attribute__((address_space(3)))
typedef unsigned short bf16_t;
typedef short bf16x8 __attribute__((ext_vector_type(8)));
typedef float f32x4 __attribute__((ext_vector_type(4)));
typedef unsigned u32x4 __attribute__((ext_vector_type(4)));
constexpr int BM = 256, BK = 64, HALF = 128, HTB = HALF * BK * 2  , STAGE_BYTES = 8 * HTB, NXCD = 8, WGM = 8;

__host__ __device__ __forceinline__ int lds_byte(int r, int c) { const int st = (r >> 4) * 2 + (c >> 5), rr = r & 15, cc = c & 31, ob = rr * 64 + cc * 2; return st * 1024 + (ob ^ (((ob >> 9) & 1) << 5)); }
__host__ __device__ __forceinline__ void stage_rc(int b, int& R, int& C) { const int st = b / 1024, sb = b % 1024, swz = sb ^ (((sb >> 9) & 1) << 5); R = (st >> 1) * 16 + swz / 64; C = (st & 1) * 32 + (swz % 64) / 2; }
__host__ __device__ __forceinline__ int perm32(int rho) { const int n = rho >> 4, i = rho & 15; return 8 * (i >> 2) + 4 * n + (i & 3); }

struct Unit { int pm, pn; };
struct Gemm { const bf16_t* A; const bf16_t* Bt; int M, N, K; };

struct StaticOrder {
    int nM, nN, nwg, G, c;
    __host__ __device__ void init(int M, int N, int G_, int c_) { nM = M / BM; nN = N / BM; nwg = nM * nN; G = G_; c = c_; }
    __host__ __device__ bool next(int i, Unit& u) const {
        const long L = (long)i * G + c; if (L >= nwg) return false;
        int wgid = (int)L; { const int q = nwg / NXCD, r = nwg % NXCD, xcd = wgid % NXCD, off = wgid / NXCD; wgid = (xcd < r ? xcd * (q + 1) : r * (q + 1) + (xcd - r) * q) + off; }
        const int nig = WGM * nN, gid = wgid / nig, fm = gid * WGM, gsz = (nM - fm) < WGM ? (nM - fm) : WGM;
        u.pm = fm + ((wgid % nig) % gsz); u.pn = (wgid % nig) / gsz; return true;
    }
    __device__ __forceinline__ void a_ready(const Unit&) const {}
    __device__ __forceinline__ void done(const Unit&) const {}
};

__device__ __forceinline__ unsigned cvt_pk_bf16(float lo, float hi) { unsigned r; asm volatile("v_cvt_pk_bf16_f32 %0, %1, %2" : "=v"(r) : "v"(lo), "v"(hi)); return r; }
typedef unsigned u32x2 __attribute__((ext_vector_type(2)));

struct EpiBf16 {
    static constexpr bool PERM = true, AFTER_DRAIN = false;
    bf16_t* O; int ldc;
    __device__ __forceinline__ void operator()(const f32x4 (&acc)[2][2][4][2], const Unit& u, int wr, int wc, int fr, int fq) const {
        const int row0 = u.pm * BM + wr * 64 + fr; const int col0 = u.pn * BM + wc * 32 + 8 * fq;
#pragma unroll
        for (int ai = 0; ai < 2; ++ai)
#pragma unroll
            for (int m = 0; m < 4; ++m) { bf16_t* rowp = O + (size_t)(row0 + ai * HALF + m * 16) * ldc + col0;
#pragma unroll
                for (int bj = 0; bj < 2; ++bj) { const f32x4 v0 = acc[ai][bj][m][0], v1 = acc[ai][bj][m][1];
                    u32x4 w; w.x = cvt_pk_bf16(v0[0], v0[1]); w.y = cvt_pk_bf16(v0[2], v0[3]); w.z = cvt_pk_bf16(v1[0], v1[1]); w.w = cvt_pk_bf16(v1[2], v1[3]);
                    *(u32x4*)(rowp + bj * HALF) = w; } }
    }
};
struct EpiBf16Row {
    static constexpr bool PERM = true, AFTER_DRAIN = false;
    bf16_t* O; int ldc; const float* ssq;
    __device__ __forceinline__ void operator()(const f32x4 (&acc)[2][2][4][2], const Unit& u, int wr, int wc, int fr, int fq) const {
        const int row0 = u.pm * BM + wr * 64 + fr; const int col0 = u.pn * BM + wc * 32 + 8 * fq;
#pragma unroll
        for (int ai = 0; ai < 2; ++ai)
#pragma unroll
            for (int m = 0; m < 4; ++m) { const int row = row0 + ai * HALF + m * 16; bf16_t* rowp = O + (size_t)row * ldc + col0;
                const float rs = 1.0f / sqrtf(__hip_atomic_load(ssq + row, __ATOMIC_RELAXED, __HIP_MEMORY_SCOPE_AGENT) * (1.0f / 1024.0f) + 1e-6f);
#pragma unroll
                for (int bj = 0; bj < 2; ++bj) { const f32x4 v0 = acc[ai][bj][m][0] * rs, v1 = acc[ai][bj][m][1] * rs;
                    u32x4 w; w.x = cvt_pk_bf16(v0[0], v0[1]); w.y = cvt_pk_bf16(v0[2], v0[3]); w.z = cvt_pk_bf16(v1[0], v1[1]); w.w = cvt_pk_bf16(v1[2], v1[3]);
                    *(u32x4*)(rowp + bj * HALF) = w; } }
    }
};
struct EpiResid {
    static constexpr bool PERM = false, AFTER_DRAIN = false;
    const float* x; float* out; bf16_t* xb; float* ssq; int ldc;
    __device__ __forceinline__ void operator()(const f32x4 (&acc)[2][2][4][2], const Unit& u, int wr, int wc, int fr, int fq) const {
        const int col0 = u.pn * BM + wc * 32 + 4 * fq;
#pragma unroll
        for (int ai = 0; ai < 2; ++ai)
#pragma unroll
            for (int m = 0; m < 4; ++m) { const int row = u.pm * BM + ai * HALF + wr * 64 + m * 16 + fr; const size_t off = (size_t)row * ldc + col0; float s = 0.f;
#pragma unroll
                for (int bj = 0; bj < 2; ++bj)
#pragma unroll
                    for (int n = 0; n < 2; ++n) { const f32x4 xv = *(const f32x4*)(x + off + bj * HALF + n * 16); const f32x4 o = xv + acc[ai][bj][m][n];
                        *(f32x4*)(out + off + bj * HALF + n * 16) = o; s += (o[0] * o[0] + o[1] * o[1]) + (o[2] * o[2] + o[3] * o[3]);
                        u32x2 w; w.x = cvt_pk_bf16(o[0], o[1]); w.y = cvt_pk_bf16(o[2], o[3]); *(u32x2*)(xb + off + bj * HALF + n * 16) = w; }
                s += __shfl_xor(s, 16); s += __shfl_xor(s, 32);
                if (fq == 0) unsafeAtomicAdd(ssq + row, s); }
    }
};

template <class Epi, class Sched, bool ALIGN_EPI = false, bool SP2 = false>
__device__ __forceinline__ void gemm_phase(PG8_LAS unsigned char* lds, const Gemm g, const Sched& S, const Epi& E) {
    const int tid = threadIdx.x, wid = __builtin_amdgcn_readfirstlane(tid >> 6), lane = tid & 63, wr = wid >> 2, wc = wid & 3, fr = lane & 15, fq = lane >> 4;
    const int K = g.K, nt = K / BK;
    unsigned voffA[2], voffB[2];
#pragma unroll
    for (int i = 0; i < 2; ++i) { int R, C; stage_rc(tid * 16 + i * 8192, R, C); const int Rb = Epi::PERM ? ((R & ~31) + perm32(R & 31)) : R;
        voffA[i] = (unsigned)(R * K + C) * 2u; voffB[i] = (unsigned)(Rb * K + C) * 2u; }
    const size_t kstep = (size_t)(BK * 2);
    const size_t hstep = (size_t)HALF * K * 2;
    const size_t tstep = 2 * hstep;
    const unsigned ldsw = (unsigned)wid * 1024u;
    const int aoff = lds_byte(wr * 64 + fr, fq * 8), boff = lds_byte(wc * 32 + fr, fq * 8);
#define PG8_SA(b, h) (((b) * 2 + (h)) * HTB)
#define PG8_SB(b, h) ((4 + (b) * 2 + (h)) * HTB)
#define PG8_STAGE(bufoff, gbase, voff) do { _Pragma("unroll") for (int _i = 0; _i < 2; ++_i) \
        __builtin_amdgcn_global_load_lds((const unsigned*)((const char*)(gbase) + (voff)[_i]), (PG8_LAS unsigned*)(lds + (bufoff) + ldsw + _i * 8192), 16, 0, 0); } while (0)
#define PG8_LDA(dst, b, h) do { _Pragma("unroll") for (int m = 0; m < 4; ++m) _Pragma("unroll") for (int k = 0; k < 2; ++k) dst[m][k] = *(const PG8_LAS bf16x8*)(lds + PG8_SA(b, h) + aoff + m * 2048 + k * 1024); } while (0)
#define PG8_LDB(dst, b, h) do { _Pragma("unroll") for (int n = 0; n < 2; ++n) _Pragma("unroll") for (int k = 0; k < 2; ++k) dst[n][k] = *(const PG8_LAS bf16x8*)(lds + PG8_SB(b, h) + boff + n * 2048 + k * 1024); } while (0)
#define PG8_MMA(ai, bj, At, Bt) do { __builtin_amdgcn_s_setprio(1); _Pragma("unroll") for (int m = 0; m < 4; ++m) _Pragma("unroll") for (int n = 0; n < 2; ++n) _Pragma("unroll") for (int k = 0; k < 2; ++k) \
        acc[ai][bj][m][n] = __builtin_amdgcn_mfma_f32_16x16x32_bf16(Bt[n][k], At[m][k], acc[ai][bj][m][n], 0, 0, 0); __builtin_amdgcn_s_setprio(0); } while (0)
#define PG8_WAIT_V(n) asm volatile("s_waitcnt vmcnt(" #n ")" ::: "memory")
#define PG8_WAIT_L(n) asm volatile("s_waitcnt lgkmcnt(" #n ")" ::: "memory")
#define PG8_BAR __builtin_amdgcn_s_barrier()
#define PG8_SCHED __builtin_amdgcn_sched_barrier(0)
    Unit cur, nxt; int ui = 0;
    if (!S.next(0, cur)) return;
    f32x4 acc[2][2][4][2];
#pragma unroll
    for (int a = 0; a < 2; ++a)
#pragma unroll
        for (int b = 0; b < 2; ++b)
#pragma unroll
            for (int m = 0; m < 4; ++m)
#pragma unroll
                for (int n = 0; n < 2; ++n) acc[a][b][m][n] = (f32x4){0.f, 0.f, 0.f, 0.f};
    bf16x8 At[4][2], B0[2][2], B1[2][2];
    const char* cA = (const char*)g.A + (size_t)cur.pm * tstep; const char* cB = (const char*)g.Bt + (size_t)cur.pn * tstep;
    S.a_ready(cur);
    if constexpr (SP2) {
        PG8_STAGE(PG8_SB(0, 0), cB, voffB); PG8_STAGE(PG8_SB(0, 1), cB + hstep, voffB); PG8_STAGE(PG8_SA(0, 0), cA, voffA); PG8_STAGE(PG8_SA(0, 1), cA + hstep, voffA);
        if (wr == 1) PG8_BAR;
        PG8_WAIT_V(2); PG8_BAR;
        PG8_STAGE(PG8_SB(1, 0), cB + kstep, voffB); PG8_STAGE(PG8_SA(1, 0), cA + kstep, voffA); PG8_STAGE(PG8_SB(1, 1), cB + hstep + kstep, voffB);
        PG8_WAIT_V(6); PG8_BAR;
    } else {
        PG8_STAGE(PG8_SB(0, 0), cB, voffB); PG8_STAGE(PG8_SA(0, 0), cA, voffA); PG8_STAGE(PG8_SB(0, 1), cB + hstep, voffB); PG8_STAGE(PG8_SA(0, 1), cA + hstep, voffA);
        if (wr == 1) PG8_BAR;
        PG8_WAIT_V(4); PG8_BAR;
        PG8_STAGE(PG8_SB(1, 0), cB + kstep, voffB); PG8_STAGE(PG8_SA(1, 0), cA + kstep, voffA); PG8_STAGE(PG8_SB(1, 1), cB + hstep + kstep, voffB);
        PG8_WAIT_V(6); PG8_BAR;
    }
    for (;;) {
        const bool has_next = S.next(ui + 1, nxt);
        const char* nA = has_next ? (const char*)g.A + (size_t)nxt.pm * tstep : cA; const char* nB = has_next ? (const char*)g.Bt + (size_t)nxt.pn * tstep : cB;
        for (int t = 0; t < nt; t += 2) {
            const bool last = (t == nt - 2);
            const char* a1 = cA + (size_t)(t + 1) * kstep;
            const char* a2 = last ? nA : cA + (size_t)(t + 2) * kstep; const char* b2 = last ? nB : cB + (size_t)(t + 2) * kstep;
            const char* a3 = a2 + kstep; const char* b3 = b2 + kstep;
            if (last && has_next) S.a_ready(nxt);
            if constexpr (SP2) {
            PG8_LDB(B0, 0, 0); PG8_LDB(B1, 0, 1); PG8_SCHED; PG8_LDA(At, 0, 0); PG8_STAGE(PG8_SA(1, 1), a1 + hstep, voffA);
            PG8_WAIT_V(8); PG8_WAIT_L(0); PG8_BAR; PG8_MMA(0, 0, At, B0); PG8_MMA(0, 1, At, B1); PG8_BAR; PG8_SCHED;
            PG8_LDA(At, 0, 1); PG8_STAGE(PG8_SB(0, 0), b2, voffB); PG8_STAGE(PG8_SB(0, 1), b2 + hstep, voffB); PG8_STAGE(PG8_SA(0, 0), a2, voffA);
            PG8_WAIT_V(8); PG8_WAIT_L(0); PG8_BAR; PG8_MMA(1, 0, At, B0); PG8_MMA(1, 1, At, B1); PG8_BAR; PG8_SCHED;
            PG8_LDB(B0, 1, 0); PG8_LDB(B1, 1, 1); PG8_SCHED; PG8_LDA(At, 1, 0); PG8_STAGE(PG8_SA(0, 1), a2 + hstep, voffA);
            PG8_WAIT_V(8); PG8_WAIT_L(0); PG8_BAR; PG8_MMA(0, 0, At, B0); PG8_MMA(0, 1, At, B1); PG8_BAR; PG8_SCHED;
            PG8_LDA(At, 1, 1); PG8_STAGE(PG8_SB(1, 0), b3, voffB); PG8_STAGE(PG8_SB(1, 1), b3 + hstep, voffB); PG8_STAGE(PG8_SA(1, 0), a3, voffA);
            PG8_WAIT_V(8); PG8_WAIT_L(0); PG8_BAR; PG8_MMA(1, 0, At, B0); PG8_MMA(1, 1, At, B1); PG8_BAR; PG8_SCHED;
            } else {
            PG8_LDB(B0, 0, 0); PG8_SCHED; PG8_LDA(At, 0, 0); PG8_STAGE(PG8_SA(1, 1), a1 + hstep, voffA);
            PG8_WAIT_L(8); PG8_BAR; PG8_WAIT_L(0); PG8_MMA(0, 0, At, B0); PG8_BAR; PG8_SCHED;
            PG8_LDB(B1, 0, 1); PG8_STAGE(PG8_SB(0, 0), b2, voffB);
            PG8_BAR; PG8_WAIT_L(0); PG8_MMA(0, 1, At, B1); PG8_BAR;
            PG8_LDA(At, 0, 1); PG8_STAGE(PG8_SA(0, 0), a2, voffA);
            PG8_BAR; PG8_WAIT_L(0); PG8_MMA(1, 0, At, B0); PG8_BAR; PG8_SCHED;
            PG8_STAGE(PG8_SB(0, 1), b2 + hstep, voffB);
            PG8_WAIT_V(6); PG8_BAR; PG8_MMA(1, 1, At, B1); PG8_BAR;
            PG8_LDB(B0, 1, 0); PG8_SCHED; PG8_LDA(At, 1, 0); PG8_STAGE(PG8_SA(0, 1), a2 + hstep, voffA);
            PG8_WAIT_L(8); PG8_BAR; PG8_WAIT_L(0); PG8_MMA(0, 0, At, B0); PG8_BAR; PG8_SCHED;
            PG8_LDB(B1, 1, 1); PG8_STAGE(PG8_SB(1, 0), b3, voffB);
            PG8_BAR; PG8_WAIT_L(0); PG8_MMA(0, 1, At, B1); PG8_BAR;
            PG8_LDA(At, 1, 1); PG8_STAGE(PG8_SA(1, 0), a3, voffA);
            PG8_BAR; PG8_WAIT_L(0); PG8_MMA(1, 0, At, B0); PG8_BAR; PG8_SCHED;
            PG8_STAGE(PG8_SB(1, 1), b3 + hstep, voffB);
            PG8_WAIT_V(6); PG8_BAR; PG8_MMA(1, 1, At, B1); PG8_BAR;
            }
        }
        if constexpr (ALIGN_EPI) { if (wr == 0) PG8_BAR; }
        if constexpr (!Epi::AFTER_DRAIN) { E(acc, cur, wr, wc, fr, fq); S.done(cur); }
        if (!has_next) break;
#pragma unroll
        for (int a = 0; a < 2; ++a)
#pragma unroll
            for (int b = 0; b < 2; ++b)
#pragma unroll
                for (int m = 0; m < 4; ++m)
#pragma unroll
                    for (int n = 0; n < 2; ++n) acc[a][b][m][n] = (f32x4){0.f, 0.f, 0.f, 0.f};
        cur = nxt; cA = nA; cB = nB; ++ui;
        if constexpr (ALIGN_EPI) { if (wr == 1) PG8_BAR; }
    }
    PG8_WAIT_V(0);
    if constexpr (!ALIGN_EPI) { if (wr == 0) PG8_BAR; }
    PG8_BAR;
    if constexpr (Epi::AFTER_DRAIN) { E.fused(acc, cur, wr, wc, fr, fq, lds, wid, lane); S.done(cur); }
#undef PG8_SA
#undef PG8_SB
#undef PG8_STAGE
#undef PG8_LDA
#undef PG8_LDB
#undef PG8_MMA
#undef PG8_WAIT_V
#undef PG8_WAIT_L
#undef PG8_BAR
#undef PG8_SCHED
}
}

#ifndef PG8_SP2
#define PG8_SP2 true
#endif
#ifndef PG8_ALIGN
#define PG8_ALIGN true
#endif
#ifndef MK_N_LAUNCHES
#define MK_N_LAUNCHES 1
#endif
#ifndef PROBE_DBL
#define PROBE_DBL -1
#endif
constexpr int NWAVES = 8;
constexpr int PER_PHASE = 7;
constexpr int N_LAUNCHES = MK_N_LAUNCHES;

constexpr int BATCH = 8, SEQ = 4096, D = 1024, M = BATCH * SEQ;
constexpr int MEML = 256, MMEM = BATCH * MEML;
constexpr int INW = 2304, KVW = 512, PQW = 2048;
constexpr int C_A = 0, C_G = 256, C_Q = 512, C_K = 1024, C_V = 1536, C_MQ = 2048;
constexpr int NEXP = 16384;
constexpr float EPS = 1e-6f;

constexpr size_t MiB = 1u << 20;
constexpr size_t WS_CTL = 0, CTL_ZERO_BYTES = 1 * MiB;
constexpr size_t WS_WIN = 2 * MiB, WS_WKV = 7 * MiB, WS_WOUT = 8 * MiB, WS_WPQ = 10 * MiB, WS_KEYS = 14 * MiB;
constexpr size_t WS_MEMN = 15 * MiB, WS_MKV = 19 * MiB;
constexpr size_t WS_SC = 22 * MiB;
constexpr size_t WS_UT = 24 * MiB, WS_VT = 56 * MiB;
constexpr size_t WS_XN = 88 * MiB;
constexpr size_t WS_CAT = 152 * MiB;
constexpr size_t WS_SELI = 216 * MiB, WS_SELG = 232 * MiB;
constexpr size_t WS_PROJ = 256 * MiB;
constexpr size_t WS_Q = 256 * MiB;
constexpr size_t WS_END = 400 * MiB;
constexpr int CW_BAR = 4096;
constexpr int CW_SSQ2 = 65536;
static_assert((CW_SSQ2 + M) * 4 <= (int)CTL_ZERO_BYTES, "ctl");

constexpr int RING_OFF = 0, RING_BYTES = 131072;
constexpr int LDSCTL_OFF = RING_BYTES, MISC_OFF = LDSCTL_OFF + 320;
constexpr int EXTRA_OFF = RING_BYTES + 1024;
constexpr int LDS_BYTES = 147456;

#define GAS __attribute__((address_space(1)))
#define LAS __attribute__((address_space(3)))
typedef unsigned short bf16;
typedef unsigned v4u __attribute__((ext_vector_type(4)));
typedef unsigned v2u __attribute__((ext_vector_type(2)));
typedef float f32x4 __attribute__((ext_vector_type(4)));
typedef GAS unsigned gu32;
typedef __bf16 bf16x2_t __attribute__((ext_vector_type(2)));
#define RLX_AGENT __ATOMIC_RELAXED, __HIP_MEMORY_SCOPE_AGENT
#define LDS_WAIT() asm volatile("s_waitcnt lgkmcnt(0)" ::: "memory")
__device__ __forceinline__ unsigned f2bf(float f) { unsigned u = __builtin_bit_cast(unsigned, f); return (u + 0x7fffu + ((u >> 16) & 1u)) >> 16; }
__device__ __forceinline__ unsigned pk2(float lo, float hi) { return f2bf(lo) | (f2bf(hi) << 16); }
__device__ __forceinline__ float bflo(unsigned w) { return __uint_as_float(w << 16); }
__device__ __forceinline__ float bfhi(unsigned w) { return __uint_as_float(w & 0xffff0000u); }
__device__ __forceinline__ float dot2(unsigned a, unsigned b, float c) { return __builtin_amdgcn_fdot2_f32_bf16(__builtin_bit_cast(bf16x2_t, a), __builtin_bit_cast(bf16x2_t, b), c, false); }
__device__ __forceinline__ float wave_sum(float v) {
#pragma unroll
    for (int o = 1; o < 64; o <<= 1) v += __shfl_xor(v, o);
    return v;
}
#define XB_TMO      128
#define XB_XCNT(j)  (256  + 64 * (j))
#define XB_XSUB(j)  (1280 + 64 * (j))
#define XB_XGEN(j)  (2304 + 64 * (j))
#define XB_TOP      3328
#define XB_TOPGEN   3392
#define XCD_BAR_WORDS 3456
#define XB_SPIN_CAP (1u << 18)

__device__ __forceinline__ unsigned xb_ld(unsigned* p)              { return __hip_atomic_load(p, __ATOMIC_RELAXED, __HIP_MEMORY_SCOPE_AGENT); }
__device__ __forceinline__ unsigned xb_add(unsigned* p, unsigned v) { return __hip_atomic_fetch_add(p, v, __ATOMIC_RELAXED, __HIP_MEMORY_SCOPE_AGENT); }
__device__ __forceinline__ unsigned xb_xcc_id() { return (unsigned)__builtin_amdgcn_s_getreg((3 << 11) | 20) & 0xFu; }
#define XB_SPIN(cond, bar) do { unsigned _sp = 0; while (cond) { __builtin_amdgcn_s_sleep(1); \
    if ((++_sp & 255u) == 0u) { if (xb_ld(&(bar)[XB_TMO])) break; if (_sp > XB_SPIN_CAP) { atomicAdd(&(bar)[XB_TMO], 1u); break; } } } } while (0)

struct XcdBarrier {
    unsigned* bar; unsigned x;
    volatile LAS unsigned* st;
};

__device__ __forceinline__ XcdBarrier xcd_barrier_post(unsigned* bar, volatile LAS unsigned* st) {
    XcdBarrier b; b.bar = bar; b.x = xb_xcc_id(); b.st = st;
    if (threadIdx.x == 0) (void)xb_add(&bar[XB_XCNT(b.x)], 1u);
    return b;
}
__device__ __forceinline__ void xcd_barrier_complete(unsigned* bar, unsigned x, unsigned& nloc, unsigned& nx) {
    const unsigned G = gridDim.x * gridDim.y * gridDim.z;
    unsigned sum, cnt, mine, sp = 0u;
    for (;;) {
        sum = 0u; cnt = 0u; mine = 0u;
#pragma unroll
        for (unsigned j = 0; j < 16; ++j) { const unsigned c = xb_ld(&bar[XB_XCNT(j)]); sum += c; cnt += (c > 0u) ? 1u : 0u; mine = (j == x) ? c : mine; }
        if (sum == G) break;
        __builtin_amdgcn_s_sleep(1);
        if ((++sp & 255u) == 0u) { if (xb_ld(&bar[XB_TMO])) break; if (sp > XB_SPIN_CAP) { atomicAdd(&bar[XB_TMO], 1u); break; } }
    }
    nloc = mine > 0u ? mine : 1u; nx = cnt > 0u ? cnt : 1u;
}

__device__ __forceinline__ void xcd_barrier(const XcdBarrier& b) {
    asm volatile("s_waitcnt vmcnt(0)" ::: "memory");
    __syncthreads();
    if (threadIdx.x == 0) {
        unsigned* bar = b.bar;
        __builtin_amdgcn_s_waitcnt(0);
        unsigned nloc = b.st[0], nx = b.st[1];
        if (nloc == 0u) { xcd_barrier_complete(bar, b.x, nloc, nx); b.st[0] = nloc; b.st[1] = nx; }
        const unsigned old = xb_add(&bar[XB_XSUB(b.x)], 1u);
        const unsigned gen = old / nloc;
        if (old + 1u == (gen + 1u) * nloc) {
            __builtin_amdgcn_fence(__ATOMIC_RELEASE, "agent");
            asm volatile("s_waitcnt vmcnt(0)" ::: "memory");
            const unsigned og = xb_add(&bar[XB_TOP], 1u);
            const unsigned tg = og / nx;
            if (og + 1u == (tg + 1u) * nx) xb_add(&bar[XB_TOPGEN], 1u);
            else XB_SPIN(xb_ld(&bar[XB_TOPGEN]) == tg, bar);
            __builtin_amdgcn_fence(__ATOMIC_ACQUIRE, "agent");
            xb_add(&bar[XB_XGEN(b.x)], 1u);
            asm volatile("s_waitcnt vmcnt(0)" ::: "memory");
        } else {
            XB_SPIN(xb_ld(&bar[XB_XGEN(b.x)]) == gen, bar);
            __builtin_amdgcn_fence(__ATOMIC_ACQUIRE, "agent");
            asm volatile("s_waitcnt vmcnt(0)" ::: "memory");
        }
    }
    __syncthreads();
}

struct Frame {
    LAS unsigned char* lds;
    volatile LAS unsigned* MISC;
    gu32* ctl;
    int tid, lane, wave;
    int vcu, G;
};
struct Ptrs {
    const float *x, *mem, *attn_g, *w_in, *conv_w, *conv_b, *conv_ln_g, *conv_ln_b, *sb_out_g, *mem_norm_g, *w_mem_kv, *q_norm_g, *k_norm_g, *mem_out_g,
                *w_out, *ffn_g, *w_peer_q, *keys1, *keys2, *peer_u, *peer_v;
    float* out;
    bf16 *WIN, *WKV, *WOUT, *WPQ, *KEYS, *MEMN, *MKV, *XN, *CAT, *PROJ, *Q;
    unsigned char *UT, *VT; float *USC, *VSC;
    int* SELI; float* SELG; float* SSQ2;
};

__device__ __forceinline__ void p0_transpose_item(const float* W, const float* gk, int K, int N, bf16* WT, LAS float* scr, int item, int lane) {
    const int nblk = N / 32, kb = item / nblk, nb = item % nblk, k0 = 64 * kb, n0 = 32 * nb;
#pragma unroll 8
    for (int i = 0; i < 32; ++i) { const int kk = 2 * i + (lane >> 5); float w = W[(size_t)(k0 + kk) * N + n0 + (lane & 31)]; if (gk) w *= gk[k0 + kk]; scr[kk * 33 + (lane & 31)] = w; }
    LDS_WAIT(); asm volatile("" ::: "memory");
    const int c = lane & 7;
#pragma unroll
    for (int j = 0; j < 4; ++j) { const int n = (lane >> 3) + 8 * j; const LAS float* s = scr + (8 * c) * 33 + n;
        v4u o; o.x = pk2(s[0 * 33], s[1 * 33]); o.y = pk2(s[2 * 33], s[3 * 33]); o.z = pk2(s[4 * 33], s[5 * 33]); o.w = pk2(s[6 * 33], s[7 * 33]);
        *(GAS v4u*)(WT + (size_t)(n0 + n) * K + k0 + 8 * c) = o; }
    LDS_WAIT(); asm volatile("" ::: "memory");
}
__device__ __forceinline__ void rms_row_to_bf16(const float* xrow, const float* g, bf16* orow, int lane) {
    const GAS f32x4* xr = (const GAS f32x4*)xrow + lane; const GAS f32x4* gr = (const GAS f32x4*)g + lane;
    f32x4 v[4]; float s = 0.f;
#pragma unroll
    for (int j = 0; j < 4; ++j) { v[j] = xr[64 * j]; s += (v[j].x * v[j].x + v[j].y * v[j].y) + (v[j].z * v[j].z + v[j].w * v[j].w); }
    const float rinv = 1.f / sqrtf(wave_sum(s) * (1.f / 1024.f) + EPS);
    GAS unsigned long long* o8 = (GAS unsigned long long*)orow + lane;
#pragma unroll
    for (int j = 0; j < 4; ++j) { const f32x4 gg = gr[64 * j]; const f32x4 o = v[j] * rinv * gg;
        o8[64 * j] = (unsigned long long)pk2(o.x, o.y) | ((unsigned long long)pk2(o.z, o.w) << 32); }
}
__device__ __forceinline__ void cvt_f32_to_bf16_stream(const float* src, bf16* dst, size_t n8, size_t gtid, size_t nthr) {
    for (size_t i = gtid; i < n8; i += nthr) { const f32x4 a = ((const GAS f32x4*)src)[2 * i], b = ((const GAS f32x4*)src)[2 * i + 1];
        v4u o; o.x = pk2(a.x, a.y); o.y = pk2(a.z, a.w); o.z = pk2(b.x, b.y); o.w = pk2(b.z, b.w); ((GAS v4u*)dst)[i] = o; }
}
__device__ __forceinline__ void row_to_fp8(const float* src, unsigned char* dst, float* iscale, int e, int lane) {
    const GAS f32x4* p = (const GAS f32x4*)(src + (size_t)e * D) + lane; f32x4 v[4]; float am = 0.f;
#pragma unroll
    for (int k = 0; k < 4; ++k) { v[k] = p[64 * k]; am = fmaxf(fmaxf(am, fmaxf(fabsf(v[k].x), fabsf(v[k].y))), fmaxf(fabsf(v[k].z), fabsf(v[k].w))); }
#pragma unroll
    for (int o = 1; o < 64; o <<= 1) am = fmaxf(am, __shfl_xor(am, o));
    const float sc = am > 0.f ? 256.f / am : 1.f, isc = am > 0.f ? am * (1.f / 256.f) : 1.f;
    GAS unsigned* d = (GAS unsigned*)(dst + (size_t)e * D) + lane;
#pragma unroll
    for (int k = 0; k < 4; ++k) { int w = 0; w = __builtin_amdgcn_cvt_pk_fp8_f32(v[k].x * sc, v[k].y * sc, w, false); w = __builtin_amdgcn_cvt_pk_fp8_f32(v[k].z * sc, v[k].w * sc, w, true); d[64 * k] = (unsigned)w; }
    if (lane == 0) iscale[e] = isc;
}
__device__ __forceinline__ void p0_prologue(Frame& F, const Ptrs& P) {
    LAS float* scr = (LAS float*)(F.lds + RING_OFF + F.wave * 16384);
    const int gw = F.vcu * NWAVES + F.wave, NGW = F.G * NWAVES;
    constexpr int I_IN = (D / 64) * (INW / 32), I_KV = (D / 64) * (KVW / 32), I_OUT = (D / 64) * (D / 32), I_PQ = (D / 64) * (PQW / 32);
    constexpr int NITEMS = I_IN + I_KV + I_OUT + I_PQ;
    for (int it = gw; it < NITEMS; it += NGW) {
        int r = it;
        if (r < I_IN) { p0_transpose_item(P.w_in, nullptr, D, INW, P.WIN, scr, r, F.lane); continue; } r -= I_IN;
        if (r < I_KV) { p0_transpose_item(P.w_mem_kv, nullptr, D, KVW, P.WKV, scr, r, F.lane); continue; } r -= I_KV;
        if (r < I_OUT) { p0_transpose_item(P.w_out, nullptr, D, D, P.WOUT, scr, r, F.lane); continue; } r -= I_OUT;
        p0_transpose_item(P.w_peer_q, P.ffn_g, D, PQW, P.WPQ, scr, r, F.lane);
    }
    for (int m = gw; m < M; m += NGW) rms_row_to_bf16(P.x + (size_t)m * D, P.attn_g, P.XN + (size_t)m * D, F.lane);
    for (int m = gw; m < MMEM; m += NGW) rms_row_to_bf16(P.mem + (size_t)m * D, P.mem_norm_g, P.MEMN + (size_t)m * D, F.lane);
    const size_t gtid = (size_t)gw * 64 + F.lane, nthr = (size_t)NGW * 64;
    cvt_f32_to_bf16_stream(P.keys1, P.KEYS, 8 * 128 * 128 / 8, gtid, nthr);
    cvt_f32_to_bf16_stream(P.keys2, P.KEYS + 8 * 128 * 128, 8 * 128 * 128 / 8, gtid, nthr);
    for (int r = gw; r < 2 * NEXP; r += NGW) { if (r < NEXP) row_to_fp8(P.peer_u, P.UT, P.USC, r, F.lane); else row_to_fp8(P.peer_v, P.VT, P.VSC, r - NEXP, F.lane); }
}

__device__ __forceinline__ void conv_item(Frame& F, const Ptrs& P, int b, int ch) {
    LAS float* U = (LAS float*)(F.lds + 0);
    LAS float* Y = (LAS float*)(F.lds + 65536);
    const int t0 = ch * 32, tid = F.tid;
    for (int idx = tid; idx < 62 * 32; idx += 512) {
        const int r = idx >> 5, c8 = idx & 31, t = t0 - 30 + r;
        float u[8];
        if (t >= 0) { const bf16* src = P.PROJ + (size_t)(b * SEQ + t) * INW + c8 * 8;
            const v4u a = *(const GAS v4u*)(src + C_A), g = *(const GAS v4u*)(src + C_G);
            const unsigned aw[4] = {a.x, a.y, a.z, a.w}, gw_[4] = {g.x, g.y, g.z, g.w};
#pragma unroll
            for (int i = 0; i < 4; ++i) { const float a0 = bflo(aw[i]), a1 = bfhi(aw[i]), g0 = bflo(gw_[i]), g1 = bfhi(gw_[i]);
                u[2 * i] = a0 / (1.f + __expf(-g0)); u[2 * i + 1] = a1 / (1.f + __expf(-g1)); }
        } else {
#pragma unroll
            for (int i = 0; i < 8; ++i) u[i] = 0.f;
        }
        LAS f32x4* dst = (LAS f32x4*)(U + r * 256 + c8 * 8);
        dst[0] = (f32x4){u[0], u[1], u[2], u[3]}; dst[1] = (f32x4){u[4], u[5], u[6], u[7]};
    }
    __syncthreads();
    {
        const int c = tid & 255, half = tid >> 8;
        float w[31];
#pragma unroll
        for (int k = 0; k < 31; ++k) w[k] = P.conv_w[k * 256 + c];
        const float bias = P.conv_b[c];
        float win[46];
#pragma unroll
        for (int i = 0; i < 46; ++i) win[i] = U[(half * 16 + i) * 256 + c];
#pragma unroll
        for (int tt = 0; tt < 16; ++tt) { float y = bias;
#pragma unroll
            for (int k = 0; k < 31; ++k) y += w[k] * win[tt + k];
            Y[(half * 16 + tt) * 256 + c] = y; }
    }
    __syncthreads();
    {
        const f32x4 lg = ((const GAS f32x4*)P.conv_ln_g)[F.lane], lb = ((const GAS f32x4*)P.conv_ln_b)[F.lane];
#pragma unroll
        for (int i = 0; i < 4; ++i) { const int tok = F.wave * 4 + i; const f32x4 y = *(const LAS f32x4*)(Y + tok * 256 + F.lane * 4);
            const float mu = wave_sum((y.x + y.y) + (y.z + y.w)) * (1.f / 256.f); const f32x4 d = y - mu;
            const float var = wave_sum((d.x * d.x + d.y * d.y) + (d.z * d.z + d.w * d.w)) * (1.f / 256.f);
            const float rinv = 1.f / sqrtf(var + EPS); const f32x4 yn = d * rinv * lg + lb;
            f32x4 s; s.x = yn.x / (1.f + __expf(-yn.x)); s.y = yn.y / (1.f + __expf(-yn.y)); s.z = yn.z / (1.f + __expf(-yn.z)); s.w = yn.w / (1.f + __expf(-yn.w));
            *(GAS unsigned long long*)(P.CAT + (size_t)(b * SEQ + t0 + tok) * D + F.lane * 4) = (unsigned long long)pk2(s.x, s.y) | ((unsigned long long)pk2(s.z, s.w) << 32); }
    }
}

typedef short bf16x8 __attribute__((ext_vector_type(8)));
typedef float f32x16 __attribute__((ext_vector_type(16)));
typedef short s16x4 __attribute__((ext_vector_type(4)));
constexpr int VSTR = 144;
constexpr int VL_BYTES = 32 * VSTR;
__device__ __forceinline__ unsigned cvtpk(float lo, float hi) { typedef float f2 __attribute__((ext_vector_type(2))); typedef __bf16 b2 __attribute__((ext_vector_type(2))); f2 v = {lo, hi}; b2 b = __builtin_convertvector(v, b2); return __builtin_bit_cast(unsigned, b); }
__device__ __forceinline__ s16x4 vtr(LAS unsigned char* p) { return __builtin_bit_cast(s16x4, __builtin_amdgcn_ds_read_tr16_b64_v4i16((LAS s16x4*)p)); }
__device__ __forceinline__ float swap_lo(float x, float& hi_out) { auto rr = __builtin_amdgcn_permlane32_swap(__float_as_uint(x), __float_as_uint(x), false, false); hi_out = __uint_as_float(rr[1]); return __uint_as_float(rr[0]); }
__device__ __forceinline__ void v_frags(LAS unsigned char* vl, int lane, bf16x8 (&vf)[2][2]) {
    const int il = lane & 15, q_ = il >> 2, p_ = il & 3, gg = lane >> 4, hi = lane >> 5;
    LAS unsigned char* base = vl + (4 * hi + q_) * VSTR + (16 * (gg & 1) + 4 * p_) * 2;
#pragma unroll
    for (int mt = 0; mt < 2; ++mt)
#pragma unroll
        for (int c = 0; c < 2; ++c) { const s16x4 lo = vtr(base + c * 16 * VSTR + mt * 64), hh = vtr(base + c * 16 * VSTR + 8 * VSTR + mt * 64);
            vf[mt][c] = (bf16x8){lo[0], lo[1], lo[2], lo[3], hh[0], hh[1], hh[2], hh[3]}; }
}
__device__ __forceinline__ void sb_item_mfma(Frame& F, const Ptrs& P, int b, int g) {
    const int lane = F.lane, h = F.wave, r32 = lane & 31, hi = lane >> 5;
    const int t0 = g * 32; const size_t rowbase = (size_t)b * SEQ;
    LAS unsigned char* vl = F.lds + F.wave * VL_BYTES;
    bf16x8 qf[4];
    { const bf16* qp = P.PROJ + (rowbase + t0 + r32) * INW + C_Q + h * 64 + 8 * hi;
#pragma unroll
      for (int ks = 0; ks < 4; ++ks) qf[ks] = *(const GAS bf16x8*)(qp + 16 * ks); }
    f32x16 o0, o1;
#pragma unroll
    for (int r = 0; r < 16; ++r) { o0[r] = 0.f; o1[r] = 0.f; }
    float R = 1.f;
    const bf16* kbase = P.PROJ + (rowbase + r32) * INW + C_K + h * 64 + 8 * hi;
    const bf16* vbase = P.PROJ + (rowbase + (lane >> 3)) * INW + C_V + h * 64 + (lane & 7) * 8;
    bf16x8 kf[4]; v4u vp[4];
#pragma unroll
    for (int ks = 0; ks < 4; ++ks) kf[ks] = *(const GAS bf16x8*)(kbase + (size_t)t0 * INW + 16 * ks);
#pragma unroll
    for (int k = 0; k < 4; ++k) vp[k] = *(const GAS v4u*)(vbase + (size_t)(t0 + 8 * k) * INW);
    for (int s0 = t0; s0 >= 0; s0 -= 32) {
        f32x16 s;
#pragma unroll
        for (int r = 0; r < 16; ++r) s[r] = 0.f;
#pragma unroll
        for (int ks = 0; ks < 4; ++ks) s = __builtin_amdgcn_mfma_f32_32x32x16_bf16(kf[ks], qf[ks], s, 0, 0, 0);
        asm volatile("" ::: "memory");
#pragma unroll
        for (int k = 0; k < 4; ++k) *(LAS v4u*)(vl + ((lane >> 3) + 8 * k) * VSTR + (lane & 7) * 16) = vp[k];
        asm volatile("" ::: "memory");
        if (s0 > 0) {
#pragma unroll
            for (int ks = 0; ks < 4; ++ks) kf[ks] = *(const GAS bf16x8*)(kbase + (size_t)(s0 - 32) * INW + 16 * ks);
#pragma unroll
            for (int k = 0; k < 4; ++k) vp[k] = *(const GAS v4u*)(vbase + (size_t)(s0 - 32 + 8 * k) * INW);
        }
        const bool diag = (s0 == t0);
        float be[16], om[16];
#pragma unroll
        for (int r = 0; r < 16; ++r) { const float z = s[r] * 0.125f; const float e = __expf(-fabsf(z)), rr = __builtin_amdgcn_rcpf(1.f + e), er = e * rr;
            float b_ = z >= 0.f ? rr : er, o_ = z >= 0.f ? er : rr;
            if (diag) { const bool valid = ((r & 3) + 8 * (r >> 2) + 4 * hi) < r32; b_ = valid ? b_ : 0.f; o_ = valid ? o_ : 1.f; }
            be[r] = b_; om[r] = o_; }
        float sfx[16], G[4], Glo[4], Ghi[4];
#pragma unroll
        for (int j = 0; j < 4; ++j) { sfx[4 * j + 3] = 1.f; sfx[4 * j + 2] = om[4 * j + 3]; sfx[4 * j + 1] = sfx[4 * j + 2] * om[4 * j + 2]; sfx[4 * j] = sfx[4 * j + 1] * om[4 * j + 1]; G[j] = sfx[4 * j] * om[4 * j]; }
#pragma unroll
        for (int j = 0; j < 4; ++j) Glo[j] = swap_lo(G[j], Ghi[j]);
        float run = R, st[4];
#pragma unroll
        for (int j = 3; j >= 0; --j) { const float s_hi = run, s_lo = run * Ghi[j]; st[j] = hi ? s_hi : s_lo; run = s_lo * Glo[j]; }
        R = run;
        bf16x8 pf[2];
#pragma unroll
        for (int c = 0; c < 2; ++c) { unsigned w[4];
#pragma unroll
            for (int u = 0; u < 4; ++u) { const int r = 8 * c + 2 * u; w[u] = cvtpk(be[r] * st[r >> 2] * sfx[r], be[r + 1] * st[(r + 1) >> 2] * sfx[r + 1]); }
            pf[c] = __builtin_bit_cast(bf16x8, (v4u){w[0], w[1], w[2], w[3]}); }
        bf16x8 vf[2][2];
        v_frags(vl, lane, vf);
        o0 = __builtin_amdgcn_mfma_f32_32x32x16_bf16(vf[0][0], pf[0], o0, 0, 0, 0); o0 = __builtin_amdgcn_mfma_f32_32x32x16_bf16(vf[0][1], pf[1], o0, 0, 0, 0);
        o1 = __builtin_amdgcn_mfma_f32_32x32x16_bf16(vf[1][0], pf[0], o1, 0, 0, 0); o1 = __builtin_amdgcn_mfma_f32_32x32x16_bf16(vf[1][1], pf[1], o1, 0, 0, 0);
        asm volatile("" ::: "memory");
        if (__builtin_amdgcn_ballot_w64(R > 1.0e-37f) == 0ull) break;
    }
    float ss = 0.f;
#pragma unroll
    for (int r = 0; r < 16; ++r) ss += o0[r] * o0[r] + o1[r] * o1[r];
    { float sh; const float sl = swap_lo(ss, sh); ss = sl + sh; }
    LAS float* xs = (LAS float*)(F.lds + EXTRA_OFF);
    if (hi == 0) xs[h * 32 + r32] = ss;
    __syncthreads();
    float tot = 0.f;
#pragma unroll
    for (int w = 0; w < 8; ++w) tot += xs[w * 32 + r32];
    const float rinv = 1.f / sqrtf(tot * (1.f / 512.f) + EPS);
    bf16* dst = P.CAT + (rowbase + t0 + r32) * D + 256 + h * 64 + 4 * hi; const float* gp = P.sb_out_g + h * 64 + 4 * hi;
#pragma unroll
    for (int mt = 0; mt < 2; ++mt)
#pragma unroll
        for (int j = 0; j < 4; ++j) { const f32x4 gv = *(const GAS f32x4*)(gp + 32 * mt + 8 * j);
            const float a0 = (mt ? o1[4 * j] : o0[4 * j]) * rinv * gv.x, a1 = (mt ? o1[4 * j + 1] : o0[4 * j + 1]) * rinv * gv.y, a2 = (mt ? o1[4 * j + 2] : o0[4 * j + 2]) * rinv * gv.z, a3 = (mt ? o1[4 * j + 3] : o0[4 * j + 3]) * rinv * gv.w;
            *(GAS v2u*)(dst + 32 * mt + 8 * j) = (v2u){cvtpk(a0, a1), cvtpk(a2, a3)}; }
    __syncthreads();
}
__device__ __forceinline__ void mem_item_mfma(Frame& F, const Ptrs& P, int b, int qb) {
    const int lane = F.lane, h = F.wave & 3, qg = F.wave >> 2, r32 = lane & 31, hi = lane >> 5;
    const size_t row = (size_t)b * SEQ + qb * 64 + qg * 32 + r32;
    LAS unsigned char* vl = F.lds + F.wave * VL_BYTES;
    LAS float* rk = (LAS float*)(F.lds + 8 * VL_BYTES + F.wave * 128);
    bf16x8 qf[4]; float qsc;
    { const bf16* qp = P.PROJ + row * INW + C_MQ + h * 64 + 8 * hi; float ssq = 0.f;
#pragma unroll
      for (int ks = 0; ks < 4; ++ks) { const v4u v = *(const GAS v4u*)(qp + 16 * ks); const unsigned w[4] = {v.x, v.y, v.z, v.w}; unsigned ow[4];
#pragma unroll
          for (int i = 0; i < 4; ++i) { const float a = bflo(w[i]), c = bfhi(w[i]); ssq += a * a + c * c; const int d = 16 * ks + 8 * hi + 2 * i;
              ow[i] = cvtpk(a * (P.q_norm_g[d] * P.k_norm_g[d]), c * (P.q_norm_g[d + 1] * P.k_norm_g[d + 1])); }
          qf[ks] = __builtin_bit_cast(bf16x8, (v4u){ow[0], ow[1], ow[2], ow[3]}); }
      float sh; const float sl = swap_lo(ssq, sh); qsc = 0.125f / sqrtf((sl + sh) * (1.f / 64.f) + EPS); }
    f32x16 o0, o1;
#pragma unroll
    for (int r = 0; r < 16; ++r) { o0[r] = 0.f; o1[r] = 0.f; }
    float mx = -1.0e30f, lsum = 0.f;
    const bf16* kbase = P.MKV + ((size_t)b * MEML + r32) * KVW + h * 64 + 8 * hi;
    const bf16* vbase = P.MKV + ((size_t)b * MEML + (lane >> 3)) * KVW + 256 + h * 64 + (lane & 7) * 8;
    for (int s0 = 0; s0 < MEML; s0 += 32) {
        bf16x8 kf[4]; v4u vp[4]; float kss = 0.f;
#pragma unroll
        for (int ks = 0; ks < 4; ++ks) { const v4u v = *(const GAS v4u*)(kbase + (size_t)s0 * KVW + 16 * ks); kf[ks] = __builtin_bit_cast(bf16x8, v);
            kss = dot2(v.x, v.x, kss); kss = dot2(v.y, v.y, kss); kss = dot2(v.z, v.z, kss); kss = dot2(v.w, v.w, kss); }
#pragma unroll
        for (int k = 0; k < 4; ++k) vp[k] = *(const GAS v4u*)(vbase + (size_t)(s0 + 8 * k) * KVW);
        { float sh; const float sl = swap_lo(kss, sh); kss = 1.f / sqrtf((sl + sh) * (1.f / 64.f) + EPS); }
        asm volatile("" ::: "memory");
        if (hi == 0) rk[r32] = kss;
#pragma unroll
        for (int k = 0; k < 4; ++k) *(LAS v4u*)(vl + ((lane >> 3) + 8 * k) * VSTR + (lane & 7) * 16) = vp[k];
        asm volatile("" ::: "memory");
        f32x16 s;
#pragma unroll
        for (int r = 0; r < 16; ++r) s[r] = 0.f;
#pragma unroll
        for (int ks = 0; ks < 4; ++ks) s = __builtin_amdgcn_mfma_f32_32x32x16_bf16(kf[ks], qf[ks], s, 0, 0, 0);
        float p[16]; float bm = -1.0e30f;
#pragma unroll
        for (int j = 0; j < 4; ++j) { const f32x4 rv = *(const LAS f32x4*)(rk + 8 * j + 4 * hi);
            p[4 * j] = s[4 * j] * qsc * rv.x; p[4 * j + 1] = s[4 * j + 1] * qsc * rv.y; p[4 * j + 2] = s[4 * j + 2] * qsc * rv.z; p[4 * j + 3] = s[4 * j + 3] * qsc * rv.w;
            bm = fmaxf(fmaxf(bm, fmaxf(p[4 * j], p[4 * j + 1])), fmaxf(p[4 * j + 2], p[4 * j + 3])); }
        { float bh; const float bl = swap_lo(bm, bh); bm = fmaxf(bl, bh); }
        const float mn = fmaxf(mx, bm), sc = __expf(mx - mn); mx = mn; lsum *= sc;
#pragma unroll
        for (int r = 0; r < 16; ++r) { o0[r] *= sc; o1[r] *= sc; p[r] = __expf(p[r] - mn); lsum += p[r]; }
        bf16x8 pf[2];
#pragma unroll
        for (int c = 0; c < 2; ++c) pf[c] = __builtin_bit_cast(bf16x8, (v4u){cvtpk(p[8 * c], p[8 * c + 1]), cvtpk(p[8 * c + 2], p[8 * c + 3]), cvtpk(p[8 * c + 4], p[8 * c + 5]), cvtpk(p[8 * c + 6], p[8 * c + 7])});
        bf16x8 vf[2][2];
        v_frags(vl, lane, vf);
        o0 = __builtin_amdgcn_mfma_f32_32x32x16_bf16(vf[0][0], pf[0], o0, 0, 0, 0); o0 = __builtin_amdgcn_mfma_f32_32x32x16_bf16(vf[0][1], pf[1], o0, 0, 0, 0);
        o1 = __builtin_amdgcn_mfma_f32_32x32x16_bf16(vf[1][0], pf[0], o1, 0, 0, 0); o1 = __builtin_amdgcn_mfma_f32_32x32x16_bf16(vf[1][1], pf[1], o1, 0, 0, 0);
        asm volatile("" ::: "memory");
    }
    { float lh; const float ll = swap_lo(lsum, lh); lsum = 1.f / (ll + lh); }
    float ss = 0.f;
#pragma unroll
    for (int r = 0; r < 16; ++r) { o0[r] *= lsum; o1[r] *= lsum; ss += o0[r] * o0[r] + o1[r] * o1[r]; }
    { float sh; const float sl = swap_lo(ss, sh); ss = sl + sh; }
    LAS float* xs = (LAS float*)(F.lds + EXTRA_OFF);
    if (hi == 0) xs[F.wave * 32 + r32] = ss;
    __syncthreads();
    float tot = 0.f;
#pragma unroll
    for (int w = 0; w < 4; ++w) tot += xs[(qg * 4 + w) * 32 + r32];
    const float rinv = 1.f / sqrtf(tot * (1.f / 256.f) + EPS);
    bf16* dst = P.CAT + row * D + 768 + h * 64 + 4 * hi; const float* gp = P.mem_out_g + h * 64 + 4 * hi;
#pragma unroll
    for (int mt = 0; mt < 2; ++mt)
#pragma unroll
        for (int j = 0; j < 4; ++j) { const f32x4 gv = *(const GAS f32x4*)(gp + 32 * mt + 8 * j);
            const float a0 = (mt ? o1[4 * j] : o0[4 * j]) * rinv * gv.x, a1 = (mt ? o1[4 * j + 1] : o0[4 * j + 1]) * rinv * gv.y, a2 = (mt ? o1[4 * j + 2] : o0[4 * j + 2]) * rinv * gv.z, a3 = (mt ? o1[4 * j + 3] : o0[4 * j + 3]) * rinv * gv.w;
            *(GAS v2u*)(dst + 32 * mt + 8 * j) = (v2u){cvtpk(a0, a1), cvtpk(a2, a3)}; }
    __syncthreads();
}

#define INS16(V, I, cv_, ci_) do { float cv = (cv_); int ci = (ci_); \
    _Pragma("unroll") for (int p_ = 0; p_ < 16; ++p_) { const bool gt = cv > V[p_]; const float tv = gt ? V[p_] : cv; const int ti = gt ? I[p_] : ci; V[p_] = gt ? cv : V[p_]; I[p_] = gt ? ci : I[p_]; cv = tv; ci = ti; } } while (0)
__device__ __forceinline__ void topk_half(const LAS unsigned char* keys, const bf16* qrow, float (&V)[16], int (&I)[16]) {
    unsigned q[64];
    { const GAS v4u* qp = (const GAS v4u*)qrow;
#pragma unroll
      for (int j = 0; j < 16; ++j) { const v4u v = qp[j]; q[4 * j] = v.x; q[4 * j + 1] = v.y; q[4 * j + 2] = v.z; q[4 * j + 3] = v.w; } }
#pragma unroll
    for (int p = 0; p < 16; ++p) { V[p] = -3.0e38f; I[p] = 0; }
    for (int n = 0; n < 128; ++n) {
        const LAS v4u* kp = (const LAS v4u*)(keys + n * 256); float a0 = 0.f, a1 = 0.f, a2 = 0.f, a3 = 0.f;
#pragma unroll
        for (int j = 0; j < 16; ++j) { const v4u kk = kp[j]; a0 = dot2(kk.x, q[4 * j], a0); a1 = dot2(kk.y, q[4 * j + 1], a1); a2 = dot2(kk.z, q[4 * j + 2], a2); a3 = dot2(kk.w, q[4 * j + 3], a3); }
        const float s = (a0 + a1) + (a2 + a3);
        INS16(V, I, s, n);
    }
}
__device__ __forceinline__ void peer_select_item(Frame& F, const Ptrs& P, int tb, int h) {
    LAS unsigned char* lds = F.lds; const int tid = F.tid;
    __syncthreads();
#pragma unroll
    for (int i = 0; i < 8; ++i) { const int c = tid + 512 * i;
        const bf16* src = (c < 2048) ? (P.KEYS + (size_t)h * 16384 + c * 8) : (P.KEYS + 131072 + (size_t)h * 16384 + (c - 2048) * 8);
        *(LAS v4u*)(lds + c * 16) = *(const GAS v4u*)src; }
    __syncthreads();
    const int t = tb * 512 + F.wave * 64 + F.lane;
    float v1[16], v2[16]; int i1[16], i2[16];
    topk_half(lds, P.Q + (size_t)t * PQW + h * 256, v1, i1);
    topk_half(lds + 32768, P.Q + (size_t)t * PQW + h * 256 + 128, v2, i2);
    float ts[16]; int te[16];
#pragma unroll
    for (int p = 0; p < 16; ++p) { ts[p] = -3.0e38f; te[p] = 0; }
#pragma unroll
    for (int i = 0; i < 16; ++i)
#pragma unroll
        for (int j = 0; j < 16; ++j) if ((i + 1) * (j + 1) <= 16) { INS16(ts, te, v1[i] + v2[j], i1[i] * 128 + i2[j]); }
    float e[16], sum = 0.f;
#pragma unroll
    for (int p = 0; p < 16; ++p) { e[p] = __expf(ts[p] - ts[0]); sum += e[p]; }
    const float inv = 1.f / sum;
    GAS v4u* di = (GAS v4u*)(P.SELI + ((size_t)t * 8 + h) * 16); GAS f32x4* dg = (GAS f32x4*)(P.SELG + ((size_t)t * 8 + h) * 16);
#pragma unroll
    for (int j = 0; j < 4; ++j) { di[j] = (v4u){(unsigned)te[4 * j], (unsigned)te[4 * j + 1], (unsigned)te[4 * j + 2], (unsigned)te[4 * j + 3]};
        dg[j] = (f32x4){e[4 * j] * inv, e[4 * j + 1] * inv, e[4 * j + 2] * inv, e[4 * j + 3] * inv}; }
}

typedef float f32x2 __attribute__((ext_vector_type(2)));
__device__ __forceinline__ void peer_gather_token(const Ptrs& P, LAS float* wl, int t, int lane) {
    const float rs = 1.0f / sqrtf(__hip_atomic_load(P.SSQ2 + t, RLX_AGENT) * (1.0f / 1024.0f) + EPS);
    f32x2 acc[8], hh[8];
    { const GAS f32x4* xr = (const GAS f32x4*)(P.out + (size_t)t * D) + lane * 4; const GAS f32x4* gr = (const GAS f32x4*)P.ffn_g + lane * 4;
#pragma unroll
      for (int k = 0; k < 4; ++k) { const f32x4 xv = xr[k], gv = gr[k]; acc[2 * k] = (f32x2){xv.x, xv.y}; acc[2 * k + 1] = (f32x2){xv.z, xv.w};
          hh[2 * k] = (f32x2){xv.x * rs * gv.x, xv.y * rs * gv.y}; hh[2 * k + 1] = (f32x2){xv.z * rs * gv.z, xv.w * rs * gv.w}; } }
    const int e0 = P.SELI[(size_t)t * 128 + lane], e1 = P.SELI[(size_t)t * 128 + 64 + lane];
    const float g0 = P.SELG[(size_t)t * 128 + lane], g1 = P.SELG[(size_t)t * 128 + 64 + lane];
    const bool h5 = (lane & 32) != 0, h4 = (lane & 16) != 0, h3 = (lane & 8) != 0;
    const int kl = 4 * ((lane >> 3) & 1) + 2 * ((lane >> 4) & 1) + ((lane >> 5) & 1);
    for (int jb = 0; jb < 128; jb += 8) {
        v4u r[8];
#pragma unroll
        for (int k = 0; k < 8; ++k) { const int j = jb + k; const int e = __builtin_amdgcn_readlane(jb < 64 ? e0 : e1, j & 63); r[k] = ((const GAS v4u*)(P.UT + (size_t)e * D))[lane]; }
        float p[8];
#pragma unroll
        for (int k = 0; k < 8; ++k) { const unsigned w[4] = {r[k].x, r[k].y, r[k].z, r[k].w}; f32x2 d = {0.f, 0.f};
#pragma unroll
            for (int i = 0; i < 4; ++i) { d += __builtin_amdgcn_cvt_pk_f32_fp8(w[i], false) * hh[2 * i]; d += __builtin_amdgcn_cvt_pk_f32_fp8(w[i], true) * hh[2 * i + 1]; }
            p[k] = d.x + d.y; }
        float v4[4], v2[2];
#pragma unroll
        for (int m = 0; m < 4; ++m) { const float keep = h5 ? p[2 * m + 1] : p[2 * m], send = h5 ? p[2 * m] : p[2 * m + 1]; v4[m] = keep + __shfl_xor(send, 32); }
#pragma unroll
        for (int m = 0; m < 2; ++m) { const float keep = h4 ? v4[2 * m + 1] : v4[2 * m], send = h4 ? v4[2 * m] : v4[2 * m + 1]; v2[m] = keep + __shfl_xor(send, 16); }
        float v1; { const float keep = h3 ? v2[1] : v2[0], send = h3 ? v2[0] : v2[1]; v1 = keep + __shfl_xor(send, 8); }
        v1 += __shfl_xor(v1, 4); v1 += __shfl_xor(v1, 2); v1 += __shfl_xor(v1, 1);
        const int ej = __shfl(jb < 64 ? e0 : e1, (jb & 63) + kl); const float gj = __shfl(jb < 64 ? g0 : g1, (jb & 63) + kl);
        const float dot = v1 * P.USC[ej];
        const float act = 0.5f * dot * (1.f + erff(dot * 0.70710678118654752f)) * gj * P.VSC[ej];
        if ((lane & 7) == 0) wl[jb + kl] = act;
    }
    for (int jb = 0; jb < 128; jb += 8) {
        v4u r[8];
#pragma unroll
        for (int k = 0; k < 8; ++k) { const int j = jb + k; const int e = __builtin_amdgcn_readlane(jb < 64 ? e0 : e1, j & 63); r[k] = ((const GAS v4u*)(P.VT + (size_t)e * D))[lane]; }
#pragma unroll
        for (int k = 0; k < 8; ++k) { const float w = wl[jb + k]; const unsigned ww[4] = {r[k].x, r[k].y, r[k].z, r[k].w};
#pragma unroll
            for (int i = 0; i < 4; ++i) { acc[2 * i] += __builtin_amdgcn_cvt_pk_f32_fp8(ww[i], false) * w; acc[2 * i + 1] += __builtin_amdgcn_cvt_pk_f32_fp8(ww[i], true) * w; } }
    }
    GAS f32x4* orow = (GAS f32x4*)(P.out + (size_t)t * D) + lane * 4;
#pragma unroll
    for (int k = 0; k < 4; ++k) orow[k] = (f32x4){acc[2 * k].x, acc[2 * k].y, acc[2 * k + 1].x, acc[2 * k + 1].y};
}

struct Args { const float* in[21]; float* out; unsigned char* ws; int ph_lo, ph_hi, li, pad; };
__device__ __forceinline__ Ptrs make_ptrs(const Args& args) {
    unsigned char* ws = args.ws;
    Ptrs P;
    P.x = args.in[0]; P.mem = args.in[1]; P.attn_g = args.in[2]; P.w_in = args.in[3]; P.conv_w = args.in[4]; P.conv_b = args.in[5]; P.conv_ln_g = args.in[6]; P.conv_ln_b = args.in[7];
    P.sb_out_g = args.in[8]; P.mem_norm_g = args.in[9]; P.w_mem_kv = args.in[10]; P.q_norm_g = args.in[11]; P.k_norm_g = args.in[12]; P.mem_out_g = args.in[13]; P.w_out = args.in[14];
    P.ffn_g = args.in[15]; P.w_peer_q = args.in[16]; P.keys1 = args.in[17]; P.keys2 = args.in[18]; P.peer_u = args.in[19]; P.peer_v = args.in[20];
    P.out = args.out;
    P.WIN = (bf16*)(ws + WS_WIN); P.WKV = (bf16*)(ws + WS_WKV); P.WOUT = (bf16*)(ws + WS_WOUT); P.WPQ = (bf16*)(ws + WS_WPQ); P.KEYS = (bf16*)(ws + WS_KEYS);
    P.MEMN = (bf16*)(ws + WS_MEMN); P.MKV = (bf16*)(ws + WS_MKV); P.UT = ws + WS_UT; P.VT = ws + WS_VT; P.USC = (float*)(ws + WS_SC); P.VSC = (float*)(ws + WS_SC) + NEXP; P.XN = (bf16*)(ws + WS_XN); P.CAT = (bf16*)(ws + WS_CAT);
    P.PROJ = (bf16*)(ws + WS_PROJ); P.Q = (bf16*)(ws + WS_Q); P.SELI = (int*)(ws + WS_SELI); P.SELG = (float*)(ws + WS_SELG); P.SSQ2 = (float*)(ws + WS_CTL) + CW_SSQ2;
    return P;
}
__global__ void __launch_bounds__(NWAVES * 64, 2) fwd_kernel(Args args) {
    extern __shared__ __attribute__((aligned(16))) unsigned char lds[];
    Frame F;
    F.lds = (LAS unsigned char*)lds;
    F.MISC = (volatile LAS unsigned*)(F.lds + MISC_OFF);
    F.tid = threadIdx.x; F.lane = F.tid & 63; F.wave = __builtin_amdgcn_readfirstlane(F.tid >> 6);
    F.G = gridDim.x; { const int bx = blockIdx.x; F.vcu = (F.G % 8 == 0) ? (bx % 8) * (F.G / 8) + bx / 8 : bx; }
    unsigned char* ws = args.ws;
    F.ctl = (gu32*)(ws + WS_CTL);
    for (int u = F.tid; u < (LDS_BYTES - LDSCTL_OFF) / 4; u += NWAVES * 64) ((LAS unsigned*)(F.lds + LDSCTL_OFF))[u] = 0u;
    __syncthreads();
    XcdBarrier bar; bar.bar = (unsigned*)(F.ctl + CW_BAR); bar.x = 0; bar.st = nullptr;
    if (N_LAUNCHES != PER_PHASE) bar = xcd_barrier_post((unsigned*)(F.ctl + CW_BAR), F.MISC + 8);
#define GRID_BAR() do { if (N_LAUNCHES != PER_PHASE) xcd_barrier(bar); } while (0)
    const int lo = args.ph_lo, hi = args.ph_hi;
#define IN(k) (lo <= (k) && (k) < hi)
#define BOTH(k) (IN(k) && IN((k) + 1))

    if (IN(0)) { const Ptrs P = make_ptrs(args); for (int rep = 0; rep < (PROBE_DBL == 0 ? 2 : 1); ++rep) p0_prologue(F, P); if (BOTH(0)) GRID_BAR(); }

    if (IN(1)) { const Ptrs P = make_ptrs(args);
        { pg8::Gemm g{P.XN, P.WIN, M, INW, D}; pg8::StaticOrder S; S.init(M, INW, F.G, (int)blockIdx.x);
          pg8::EpiBf16 E{P.PROJ, INW};
          pg8::gemm_phase<pg8::EpiBf16, pg8::StaticOrder, PG8_ALIGN, PG8_SP2>(F.lds + RING_OFF, g, S, E); }
        { pg8::Gemm g{P.MEMN, P.WKV, MMEM, KVW, D}; pg8::StaticOrder S; S.init(MMEM, KVW, F.G, (int)blockIdx.x);
          pg8::EpiBf16 E{P.MKV, KVW};
          pg8::gemm_phase<pg8::EpiBf16, pg8::StaticOrder, PG8_ALIGN, PG8_SP2>(F.lds + RING_OFF, g, S, E); }
        if (BOTH(1)) GRID_BAR();
    }

    if (IN(2)) { const Ptrs P = make_ptrs(args);
        const int c = F.vcu;
        for (int rep = 0; rep < (PROBE_DBL == 2 ? 2 : 1); ++rep) {
        for (int it = c; it < BATCH * (SEQ / 32); it += F.G) sb_item_mfma(F, P, it >> 7, it & 127);
        for (int it = c; it < BATCH * (SEQ / 64); it += F.G) mem_item_mfma(F, P, it >> 6, it & 63);
        __syncthreads();
        for (int it = c; it < BATCH * (SEQ / 32); it += F.G) { conv_item(F, P, it / (SEQ / 32), it % (SEQ / 32)); }
        __syncthreads();
        }
        if (BOTH(2)) GRID_BAR();
    }

    if (IN(3)) { const Ptrs P = make_ptrs(args);
        pg8::Gemm g{P.CAT, P.WOUT, M, D, D}; pg8::StaticOrder S; S.init(M, D, F.G, (int)blockIdx.x);
        pg8::EpiResid E{P.x, P.out, P.XN, P.SSQ2, D};
        pg8::gemm_phase<pg8::EpiResid, pg8::StaticOrder, PG8_ALIGN, PG8_SP2>(F.lds + RING_OFF, g, S, E);
        if (BOTH(3)) GRID_BAR();
    }

    if (IN(4)) { const Ptrs P = make_ptrs(args);
        pg8::Gemm g{P.XN, P.WPQ, M, PQW, D}; pg8::StaticOrder S; S.init(M, PQW, F.G, (int)blockIdx.x);
        pg8::EpiBf16Row E{P.Q, PQW, P.SSQ2};
        pg8::gemm_phase<pg8::EpiBf16Row, pg8::StaticOrder, PG8_ALIGN, PG8_SP2>(F.lds + RING_OFF, g, S, E);
        if (BOTH(4)) GRID_BAR();
    }

    if (IN(5)) { const Ptrs P = make_ptrs(args);
        for (int rep = 0; rep < (PROBE_DBL == 5 ? 2 : 1); ++rep)
        for (int it = F.vcu; it < (M / 512) * 8; it += F.G) peer_select_item(F, P, it >> 3, it & 7);
        __syncthreads();
        if (BOTH(5)) GRID_BAR();
    }

    if (IN(6)) { const Ptrs P = make_ptrs(args);
        const int gw = F.vcu * NWAVES + F.wave, NGW = F.G * NWAVES;
        LAS float* wl = (LAS float*)(F.lds + F.wave * 512);
        for (int t = gw; t < M; t += NGW) peer_gather_token(P, wl, t, F.lane);
    }
#undef IN
#undef BOTH
}

extern "C" void kernel_launch(void* const* d_in, const int* in_sizes, int n_in, void* d_out, int out_size, void* d_ws, size_t ws_size, hipStream_t stream) {
    static int grid = 0;
    if (grid == 0) {
        if (n_in != 21 || in_sizes[0] != M * D || out_size != M * D || ws_size < WS_END) { fprintf(stderr, "kernel_launch: unexpected shapes/workspace (n_in %d, in0 %d, out %d, ws %zu); nothing launched\n", n_in, n_in > 0 ? in_sizes[0] : -1, out_size, ws_size); grid = -1; return; }
        int dev = 0, cus = 0, per_cu = 0;
        if (hipGetDevice(&dev) != hipSuccess || hipDeviceGetAttribute(&cus, hipDeviceAttributeMultiprocessorCount, dev) != hipSuccess) { grid = -1; return; }
        if (hipFuncSetAttribute((const void*)fwd_kernel, hipFuncAttributeMaxDynamicSharedMemorySize, LDS_BYTES) != hipSuccess) { fprintf(stderr, "kernel_launch: hipFuncSetAttribute failed\n"); grid = -1; return; }
        if (hipOccupancyMaxActiveBlocksPerMultiprocessor(&per_cu, (const void*)fwd_kernel, NWAVES * 64, LDS_BYTES) != hipSuccess || per_cu < 1) { fprintf(stderr, "kernel_launch: occupancy query says %d blocks per CU\n", per_cu); }
        (void)hipGetLastError();
        grid = cus;
    }
    if (grid < 0) return;
    if (hipMemsetAsync((char*)d_ws + WS_CTL, 0, CTL_ZERO_BYTES, stream) != hipSuccess) { fprintf(stderr, "kernel_launch: memset failed\n"); return; }
    Args a{};
    for (int i = 0; i < 21; ++i) a.in[i] = (const float*)d_in[i];
    a.out = (float*)d_out; a.ws = (unsigned char*)d_ws;
    for (int li = 0; li < N_LAUNCHES; ++li) {
        a.ph_lo = (N_LAUNCHES == PER_PHASE) ? li : 0; a.ph_hi = (N_LAUNCHES == PER_PHASE) ? li + 1 : PER_PHASE; a.li = li;
        hipLaunchKernelGGL(fwd_kernel, dim3(grid), dim3(NWAVES * 64), LDS_BYTES, stream, a);
        const hipError_t le = hipPeekAtLastError();
        if (le != hipSuccess) { fprintf(stderr, "kernel_launch: launch %d failed: %s\n", li, hipGetErrorName(le)); break; }
    }
}
```

```cpp
#include <hip/hip_runtime.h>
#include <cstdio>
#include <cstdint>
namespace pg8 {
#define PG8_LAS __attribute__((address_space(3)))
typedef unsigned short bf16_t;
typedef short bf16x8 __attribute__((ext_vector_type(8)));
typedef float f32x4 __attribute__((ext_vector_type(4)));
typedef unsigned u32x4 __attribute__((ext_vector_type(4)));
constexpr int BM = 256, BK = 64, HALF = 128, HTB = HALF * BK * 2  , STAGE_BYTES = 8 * HTB, NXCD = 8, WGM = 8;

__host__ __device__ __forceinline__ int lds_byte(int r, int c) { const int st = (r >> 4) * 2 + (c >> 5), rr = r & 15, cc = c & 31, ob = rr * 64 + cc * 2; return st * 1024 + (ob ^ (((ob >> 9) & 1) << 5)); }
__host__ __device__ __forceinline__ void stage_rc(int b, int& R, int& C) { const int st = b / 1024, sb = b % 1024, swz = sb ^ (((sb >> 9) & 1) << 5); R = (st >> 1) * 16 + swz / 64; C = (st & 1) * 32 + (swz % 64) / 2; }
__host__ __device__ __forceinline__ int perm32(int rho) { const int n = rho >> 4, i = rho & 15; return 8 * (i >> 2) + 4 * n + (i & 3); }

struct Unit { int pm, pn; };
struct Gemm { const bf16_t* A; const bf16_t* Bt; int M, N, K; };

struct StaticOrder {
    int nM, nN, nwg, G, c;
    __host__ __device__ void init(int M, int N, int G_, int c_) { nM = M / BM; nN = N / BM; nwg = nM * nN; G = G_; c = c_; }
    __host__ __device__ bool next(int i, Unit& u) const {
        const long L = (long)i * G + c; if (L >= nwg) return false;
        int wgid = (int)L; { const int q = nwg / NXCD, r = nwg % NXCD, xcd = wgid % NXCD, off = wgid / NXCD; wgid = (xcd < r ? xcd * (q + 1) : r * (q + 1) + (xcd - r) * q) + off; }
        const int nig = WGM * nN, gid = wgid / nig, fm = gid * WGM, gsz = (nM - fm) < WGM ? (nM - fm) : WGM;
        u.pm = fm + ((wgid % nig) % gsz); u.pn = (wgid % nig) / gsz; return true;
    }
    __device__ __forceinline__ void a_ready(const Unit&) const {}
    __device__ __forceinline__ void done(const Unit&) const {}
};

__device__ __forceinline__ unsigned cvt_pk_bf16(float lo, float hi) { unsigned r; asm volatile("v_cvt_pk_bf16_f32 %0, %1, %2" : "=v"(r) : "v"(lo), "v"(hi)); return r; }
typedef unsigned u32x2 __attribute__((ext_vector_type(2)));

struct EpiBf16 {
    static constexpr bool PERM = true, AFTER_DRAIN = false;
    bf16_t* O; int ldc;
    __device__ __forceinline__ void operator()(const f32x4 (&acc)[2][2][4][2], const Unit& u, int wr, int wc, int fr, int fq) const {
        const int row0 = u.pm * BM + wr * 64 + fr; const int col0 = u.pn * BM + wc * 32 + 8 * fq;
#pragma unroll
        for (int ai = 0; ai < 2; ++ai)
#pragma unroll
            for (int m = 0; m < 4; ++m) { bf16_t* rowp = O + (size_t)(row0 + ai * HALF + m * 16) * ldc + col0;
#pragma unroll
                for (int bj = 0; bj < 2; ++bj) { const f32x4 v0 = acc[ai][bj][m][0], v1 = acc[ai][bj][m][1];
                    u32x4 w; w.x = cvt_pk_bf16(v0[0], v0[1]); w.y = cvt_pk_bf16(v0[2], v0[3]); w.z = cvt_pk_bf16(v1[0], v1[1]); w.w = cvt_pk_bf16(v1[2], v1[3]);
                    *(u32x4*)(rowp + bj * HALF) = w; } }
    }
};
struct EpiBf16Row {
    static constexpr bool PERM = true, AFTER_DRAIN = false;
    bf16_t* O; int ldc; const float* ssq;
    __device__ __forceinline__ void operator()(const f32x4 (&acc)[2][2][4][2], const Unit& u, int wr, int wc, int fr, int fq) const {
        const int row0 = u.pm * BM + wr * 64 + fr; const int col0 = u.pn * BM + wc * 32 + 8 * fq;
#pragma unroll
        for (int ai = 0; ai < 2; ++ai)
#pragma unroll
            for (int m = 0; m < 4; ++m) { const int row = row0 + ai * HALF + m * 16; bf16_t* rowp = O + (size_t)row * ldc + col0;
                const float rs = 1.0f / sqrtf(__hip_atomic_load(ssq + row, __ATOMIC_RELAXED, __HIP_MEMORY_SCOPE_AGENT) * (1.0f / 1024.0f) + 1e-6f);
#pragma unroll
                for (int bj = 0; bj < 2; ++bj) { const f32x4 v0 = acc[ai][bj][m][0] * rs, v1 = acc[ai][bj][m][1] * rs;
                    u32x4 w; w.x = cvt_pk_bf16(v0[0], v0[1]); w.y = cvt_pk_bf16(v0[2], v0[3]); w.z = cvt_pk_bf16(v1[0], v1[1]); w.w = cvt_pk_bf16(v1[2], v1[3]);
                    *(u32x4*)(rowp + bj * HALF) = w; } }
    }
};
struct EpiResid {
    static constexpr bool PERM = false, AFTER_DRAIN = false;
    const float* x; float* out; bf16_t* xb; float* ssq; int ldc;
    __device__ __forceinline__ void operator()(const f32x4 (&acc)[2][2][4][2], const Unit& u, int wr, int wc, int fr, int fq) const {
        const int col0 = u.pn * BM + wc * 32 + 4 * fq;
#pragma unroll
        for (int ai = 0; ai < 2; ++ai)
#pragma unroll
            for (int m = 0; m < 4; ++m) { const int row = u.pm * BM + ai * HALF + wr * 64 + m * 16 + fr; const size_t off = (size_t)row * ldc + col0; float s = 0.f;
#pragma unroll
                for (int bj = 0; bj < 2; ++bj)
#pragma unroll
                    for (int n = 0; n < 2; ++n) { const f32x4 xv = *(const f32x4*)(x + off + bj * HALF + n * 16); const f32x4 o = xv + acc[ai][bj][m][n];
                        *(f32x4*)(out + off + bj * HALF + n * 16) = o; s += (o[0] * o[0] + o[1] * o[1]) + (o[2] * o[2] + o[3] * o[3]);
                        u32x2 w; w.x = cvt_pk_bf16(o[0], o[1]); w.y = cvt_pk_bf16(o[2], o[3]); *(u32x2*)(xb + off + bj * HALF + n * 16) = w; }
                s += __shfl_xor(s, 16); s += __shfl_xor(s, 32);
                if (fq == 0) unsafeAtomicAdd(ssq + row, s); }
    }
};

template <class Epi, class Sched, bool ALIGN_EPI = false, bool SP2 = false>
__device__ __forceinline__ void gemm_phase(PG8_LAS unsigned char* lds, const Gemm g, const Sched& S, const Epi& E) {
    const int tid = threadIdx.x, wid = __builtin_amdgcn_readfirstlane(tid >> 6), lane = tid & 63, wr = wid >> 2, wc = wid & 3, fr = lane & 15, fq = lane >> 4;
    const int K = g.K, nt = K / BK;
    unsigned voffA[2], voffB[2];
#pragma unroll
    for (int i = 0; i < 2; ++i) { int R, C; stage_rc(tid * 16 + i * 8192, R, C); const int Rb = Epi::PERM ? ((R & ~31) + perm32(R & 31)) : R;
        voffA[i] = (unsigned)(R * K + C) * 2u; voffB[i] = (unsigned)(Rb * K + C) * 2u; }
    const size_t kstep = (size_t)(BK * 2);
    const size_t hstep = (size_t)HALF * K * 2;
    const size_t tstep = 2 * hstep;
    const unsigned ldsw = (unsigned)wid * 1024u;
    const int aoff = lds_byte(wr * 64 + fr, fq * 8), boff = lds_byte(wc * 32 + fr, fq * 8);
#define PG8_SA(b, h) (((b) * 2 + (h)) * HTB)
#define PG8_SB(b, h) ((4 + (b) * 2 + (h)) * HTB)
#define PG8_STAGE(bufoff, gbase, voff) do { _Pragma("unroll") for (int _i = 0; _i < 2; ++_i) \
        __builtin_amdgcn_global_load_lds((const unsigned*)((const char*)(gbase) + (voff)[_i]), (PG8_LAS unsigned*)(lds + (bufoff) + ldsw + _i * 8192), 16, 0, 0); } while (0)
#define PG8_LDA(dst, b, h) do { _Pragma("unroll") for (int m = 0; m < 4; ++m) _Pragma("unroll") for (int k = 0; k < 2; ++k) dst[m][k] = *(const PG8_LAS bf16x8*)(lds + PG8_SA(b, h) + aoff + m * 2048 + k * 1024); } while (0)
#define PG8_LDB(dst, b, h) do { _Pragma("unroll") for (int n = 0; n < 2; ++n) _Pragma("unroll") for (int k = 0; k < 2; ++k) dst[n][k] = *(const PG8_LAS bf16x8*)(lds + PG8_SB(b, h) + boff + n * 2048 + k * 1024); } while (0)
#define PG8_MMA(ai, bj, At, Bt) do { __builtin_amdgcn_s_setprio(1); _Pragma("unroll") for (int m = 0; m < 4; ++m) _Pragma("unroll") for (int n = 0; n < 2; ++n) _Pragma("unroll") for (int k = 0; k < 2; ++k) \
        acc[ai][bj][m][n] = __builtin_amdgcn_mfma_f32_16x16x32_bf16(Bt[n][k], At[m][k], acc[ai][bj][m][n], 0, 0, 0); __builtin_amdgcn_s_setprio(0); } while (0)
#define PG8_WAIT_V(n) asm volatile("s_waitcnt vmcnt(" #n ")" ::: "memory")
#define PG8_WAIT_L(n) asm volatile("s_waitcnt lgkmcnt(" #n ")" ::: "memory")
#define PG8_BAR __builtin_amdgcn_s_barrier()
#define PG8_SCHED __builtin_amdgcn_sched_barrier(0)
    Unit cur, nxt; int ui = 0;
    if (!S.next(0, cur)) return;
    f32x4 acc[2][2][4][2];
#pragma unroll
    for (int a = 0; a < 2; ++a)
#pragma unroll
        for (int b = 0; b < 2; ++b)
#pragma unroll
            for (int m = 0; m < 4; ++m)
#pragma unroll
                for (int n = 0; n < 2; ++n) acc[a][b][m][n] = (f32x4){0.f, 0.f, 0.f, 0.f};
    bf16x8 At[4][2], B0[2][2], B1[2][2];
    const char* cA = (const char*)g.A + (size_t)cur.pm * tstep; const char* cB = (const char*)g.Bt + (size_t)cur.pn * tstep;
    S.a_ready(cur);
    if constexpr (SP2) {
        PG8_STAGE(PG8_SB(0, 0), cB, voffB); PG8_STAGE(PG8_SB(0, 1), cB + hstep, voffB); PG8_STAGE(PG8_SA(0, 0), cA, voffA); PG8_STAGE(PG8_SA(0, 1), cA + hstep, voffA);
        if (wr == 1) PG8_BAR;
        PG8_WAIT_V(2); PG8_BAR;
        PG8_STAGE(PG8_SB(1, 0), cB + kstep, voffB); PG8_STAGE(PG8_SA(1, 0), cA + kstep, voffA); PG8_STAGE(PG8_SB(1, 1), cB + hstep + kstep, voffB);
        PG8_WAIT_V(6); PG8_BAR;
    } else {
        PG8_STAGE(PG8_SB(0, 0), cB, voffB); PG8_STAGE(PG8_SA(0, 0), cA, voffA); PG8_STAGE(PG8_SB(0, 1), cB + hstep, voffB); PG8_STAGE(PG8_SA(0, 1), cA + hstep, voffA);
        if (wr == 1) PG8_BAR;
        PG8_WAIT_V(4); PG8_BAR;
        PG8_STAGE(PG8_SB(1, 0), cB + kstep, voffB); PG8_STAGE(PG8_SA(1, 0), cA + kstep, voffA); PG8_STAGE(PG8_SB(1, 1), cB + hstep + kstep, voffB);
        PG8_WAIT_V(6); PG8_BAR;
    }
    for (;;) {
        const bool has_next = S.next(ui + 1, nxt);
        const char* nA = has_next ? (const char*)g.A + (size_t)nxt.pm * tstep : cA; const char* nB = has_next ? (const char*)g.Bt + (size_t)nxt.pn * tstep : cB;
        for (int t = 0; t < nt; t += 2) {
            const bool last = (t == nt - 2);
            const char* a1 = cA + (size_t)(t + 1) * kstep;
            const char* a2 = last ? nA : cA + (size_t)(t + 2) * kstep; const char* b2 = last ? nB : cB + (size_t)(t + 2) * kstep;
            const char* a3 = a2 + kstep; const char* b3 = b2 + kstep;
            if (last && has_next) S.a_ready(nxt);
            if constexpr (SP2) {
            PG8_LDB(B0, 0, 0); PG8_LDB(B1, 0, 1); PG8_SCHED; PG8_LDA(At, 0, 0); PG8_STAGE(PG8_SA(1, 1), a1 + hstep, voffA);
            PG8_WAIT_V(8); PG8_WAIT_L(0); PG8_BAR; PG8_MMA(0, 0, At, B0); PG8_MMA(0, 1, At, B1); PG8_BAR; PG8_SCHED;
            PG8_LDA(At, 0, 1); PG8_STAGE(PG8_SB(0, 0), b2, voffB); PG8_STAGE(PG8_SB(0, 1), b2 + hstep, voffB); PG8_STAGE(PG8_SA(0, 0), a2, voffA);
            PG8_WAIT_V(8); PG8_WAIT_L(0); PG8_BAR; PG8_MMA(1, 0, At, B0); PG8_MMA(1, 1, At, B1); PG8_BAR; PG8_SCHED;
            PG8_LDB(B0, 1, 0); PG8_LDB(B1, 1, 1); PG8_SCHED; PG8_LDA(At, 1, 0); PG8_STAGE(PG8_SA(0, 1), a2 + hstep, voffA);
            PG8_WAIT_V(8); PG8_WAIT_L(0); PG8_BAR; PG8_MMA(0, 0, At, B0); PG8_MMA(0, 1, At, B1); PG8_BAR; PG8_SCHED;
            PG8_LDA(At, 1, 1); PG8_STAGE(PG8_SB(1, 0), b3, voffB); PG8_STAGE(PG8_SB(1, 1), b3 + hstep, voffB); PG8_STAGE(PG8_SA(1, 0), a3, voffA);
            PG8_WAIT_V(8); PG8_WAIT_L(0); PG8_BAR; PG8_MMA(1, 0, At, B0); PG8_MMA(1, 1, At, B1); PG8_BAR; PG8_SCHED;
            } else {
            PG8_LDB(B0, 0, 0); PG8_SCHED; PG8_LDA(At, 0, 0); PG8_STAGE(PG8_SA(1, 1), a1 + hstep, voffA);
            PG8_WAIT_L(8); PG8_BAR; PG8_WAIT_L(0); PG8_MMA(0, 0, At, B0); PG8_BAR; PG8_SCHED;
            PG8_LDB(B1, 0, 1); PG8_STAGE(PG8_SB(0, 0), b2, voffB);
            PG8_BAR; PG8_WAIT_L(0); PG8_MMA(0, 1, At, B1); PG8_BAR;
            PG8_LDA(At, 0, 1); PG8_STAGE(PG8_SA(0, 0), a2, voffA);
            PG8_BAR; PG8_WAIT_L(0); PG8_MMA(1, 0, At, B0); PG8_BAR; PG8_SCHED;
            PG8_STAGE(PG8_SB(0, 1), b2 + hstep, voffB);
            PG8_WAIT_V(6); PG8_BAR; PG8_MMA(1, 1, At, B1); PG8_BAR;
            PG8_LDB(B0, 1, 0); PG8_SCHED; PG8_LDA(At, 1, 0); PG8_STAGE(PG8_SA(0, 1), a2 + hstep, voffA);
            PG8_WAIT_L(8); PG8_BAR; PG8_WAIT_L(0); PG8_MMA(0, 0, At, B0); PG8_BAR; PG8_SCHED;
            PG8_LDB(B1, 1, 1); PG8_STAGE(PG8_SB(1, 0), b3, voffB);
            PG8_BAR; PG8_WAIT_L(0); PG8_MMA(0, 1, At, B1); PG8_BAR;
            PG8_LDA(At, 1, 1); PG8_STAGE(PG8_SA(1, 0), a3, voffA);
            PG8_BAR; PG8_WAIT_L(0); PG8_MMA(1, 0, At, B0); PG8_BAR; PG8_SCHED;
            PG8_STAGE(PG8_SB(1, 1), b3 + hstep, voffB);
            PG8_WAIT_V(6); PG8_BAR; PG8_MMA(1, 1, At, B1); PG8_BAR;
            }
        }
        if constexpr (ALIGN_EPI) { if (wr == 0) PG8_BAR; }
        if constexpr (!Epi::AFTER_DRAIN) { E(acc, cur, wr, wc, fr, fq); S.done(cur); }
        if (!has_next) break;
#pragma unroll
        for (int a = 0; a < 2; ++a)
#pragma unroll
            for (int b = 0; b < 2; ++b)
#pragma unroll
                for (int m = 0; m < 4; ++m)
#pragma unroll
                    for (int n = 0; n < 2; ++n) acc[a][b][m][n] = (f32x4){0.f, 0.f, 0.f, 0.f};
        cur = nxt; cA = nA; cB = nB; ++ui;
        if constexpr (ALIGN_EPI) { if (wr == 1) PG8_BAR; }
    }
    PG8_WAIT_V(0);
    if constexpr (!ALIGN_EPI) { if (wr == 0) PG8_BAR; }
    PG8_BAR;
    if constexpr (Epi::AFTER_DRAIN) { E.fused(acc, cur, wr, wc, fr, fq, lds, wid, lane); S.done(cur); }
#undef PG8_SA
#undef PG8_SB
#undef PG8_STAGE
#undef PG8_LDA
#undef PG8_LDB
#undef PG8_MMA
#undef PG8_WAIT_V
#undef PG8_WAIT_L
#undef PG8_BAR
#undef PG8_SCHED
}
}

#ifndef PG8_SP2
#define PG8_SP2 true
#endif
#ifndef PG8_ALIGN
#define PG8_ALIGN true
#endif
#ifndef MK_N_LAUNCHES
#define MK_N_LAUNCHES 1
#endif
#ifndef PROBE_DBL
#define PROBE_DBL -1
#endif
constexpr int NWAVES = 8;
constexpr int PER_PHASE = 7;
constexpr int N_LAUNCHES = MK_N_LAUNCHES;

constexpr int BATCH = 8, SEQ = 4096, D = 1024, M = BATCH * SEQ;
constexpr int MEML = 256, MMEM = BATCH * MEML;
constexpr int INW = 2304, KVW = 512, PQW = 2048;
constexpr int C_A = 0, C_G = 256, C_Q = 512, C_K = 1024, C_V = 1536, C_MQ = 2048;
constexpr int NEXP = 16384;
constexpr float EPS = 1e-6f;

constexpr size_t MiB = 1u << 20;
constexpr size_t WS_CTL = 0, CTL_ZERO_BYTES = 1 * MiB;
constexpr size_t WS_WIN = 2 * MiB, WS_WKV = 7 * MiB, WS_WOUT = 8 * MiB, WS_WPQ = 10 * MiB, WS_KEYS = 14 * MiB;
constexpr size_t WS_MEMN = 15 * MiB, WS_MKV = 19 * MiB;
constexpr size_t WS_SC = 22 * MiB;
constexpr size_t WS_UT = 24 * MiB, WS_VT = 56 * MiB;
constexpr size_t WS_XN = 88 * MiB;
constexpr size_t WS_CAT = 152 * MiB;
constexpr size_t WS_SELI = 216 * MiB, WS_SELG = 232 * MiB;
constexpr size_t WS_PROJ = 256 * MiB;
constexpr size_t WS_Q = 256 * MiB;
constexpr size_t WS_END = 400 * MiB;
constexpr int CW_BAR = 4096;
constexpr int CW_SSQ2 = 65536;
static_assert((CW_SSQ2 + M) * 4 <= (int)CTL_ZERO_BYTES, "ctl");

constexpr int RING_OFF = 0, RING_BYTES = 131072;
constexpr int LDSCTL_OFF = RING_BYTES, MISC_OFF = LDSCTL_OFF + 320;
constexpr int EXTRA_OFF = RING_BYTES + 1024;
constexpr int LDS_BYTES = 147456;

#define GAS __attribute__((address_space(1)))
#define LAS __attribute__((address_space(3)))
typedef unsigned short bf16;
typedef unsigned v4u __attribute__((ext_vector_type(4)));
typedef unsigned v2u __attribute__((ext_vector_type(2)));
typedef float f32x4 __attribute__((ext_vector_type(4)));
typedef GAS unsigned gu32;
typedef __bf16 bf16x2_t __attribute__((ext_vector_type(2)));
#define RLX_AGENT __ATOMIC_RELAXED, __HIP_MEMORY_SCOPE_AGENT
#define LDS_WAIT() asm volatile("s_waitcnt lgkmcnt(0)" ::: "memory")
__device__ __forceinline__ unsigned f2bf(float f) { unsigned u = __builtin_bit_cast(unsigned, f); return (u + 0x7fffu + ((u >> 16) & 1u)) >> 16; }
__device__ __forceinline__ unsigned pk2(float lo, float hi) { return f2bf(lo) | (f2bf(hi) << 16); }
__device__ __forceinline__ float bflo(unsigned w) { return __uint_as_float(w << 16); }
__device__ __forceinline__ float bfhi(unsigned w) { return __uint_as_float(w & 0xffff0000u); }
__device__ __forceinline__ float dot2(unsigned a, unsigned b, float c) { return __builtin_amdgcn_fdot2_f32_bf16(__builtin_bit_cast(bf16x2_t, a), __builtin_bit_cast(bf16x2_t, b), c, false); }
__device__ __forceinline__ float wave_sum(float v) {
#pragma unroll
    for (int o = 1; o < 64; o <<= 1) v += __shfl_xor(v, o);
    return v;
}
#define XB_TMO      128
#define XB_XCNT(j)  (256  + 64 * (j))
#define XB_XSUB(j)  (1280 + 64 * (j))
#define XB_XGEN(j)  (2304 + 64 * (j))
#define XB_TOP      3328
#define XB_TOPGEN   3392
#define XCD_BAR_WORDS 3456
#define XB_SPIN_CAP (1u << 18)

__device__ __forceinline__ unsigned xb_ld(unsigned* p)              { return __hip_atomic_load(p, __ATOMIC_RELAXED, __HIP_MEMORY_SCOPE_AGENT); }
__device__ __forceinline__ unsigned xb_add(unsigned* p, unsigned v) { return __hip_atomic_fetch_add(p, v, __ATOMIC_RELAXED, __HIP_MEMORY_SCOPE_AGENT); }
__device__ __forceinline__ unsigned xb_xcc_id() { return (unsigned)__builtin_amdgcn_s_getreg((3 << 11) | 20) & 0xFu; }
#define XB_SPIN(cond, bar) do { unsigned _sp = 0; while (cond) { __builtin_amdgcn_s_sleep(1); \
    if ((++_sp & 255u) == 0u) { if (xb_ld(&(bar)[XB_TMO])) break; if (_sp > XB_SPIN_CAP) { atomicAdd(&(bar)[XB_TMO], 1u); break; } } } } while (0)

struct XcdBarrier {
    unsigned* bar; unsigned x;
    volatile LAS unsigned* st;
};

__device__ __forceinline__ XcdBarrier xcd_barrier_post(unsigned* bar, volatile LAS unsigned* st) {
    XcdBarrier b; b.bar = bar; b.x = xb_xcc_id(); b.st = st;
    if (threadIdx.x == 0) (void)xb_add(&bar[XB_XCNT(b.x)], 1u);
    return b;
}
__device__ __forceinline__ void xcd_barrier_complete(unsigned* bar, unsigned x, unsigned& nloc, unsigned& nx) {
    const unsigned G = gridDim.x * gridDim.y * gridDim.z;
    unsigned sum, cnt, mine, sp = 0u;
    for (;;) {
        sum = 0u; cnt = 0u; mine = 0u;
#pragma unroll
        for (unsigned j = 0; j < 16; ++j) { const unsigned c = xb_ld(&bar[XB_XCNT(j)]); sum += c; cnt += (c > 0u) ? 1u : 0u; mine = (j == x) ? c : mine; }
        if (sum == G) break;
        __builtin_amdgcn_s_sleep(1);
        if ((++sp & 255u) == 0u) { if (xb_ld(&bar[XB_TMO])) break; if (sp > XB_SPIN_CAP) { atomicAdd(&bar[XB_TMO], 1u); break; } }
    }
    nloc = mine > 0u ? mine : 1u; nx = cnt > 0u ? cnt : 1u;
}

__device__ __forceinline__ void xcd_barrier(const XcdBarrier& b) {
    asm volatile("s_waitcnt vmcnt(0)" ::: "memory");
    __syncthreads();
    if (threadIdx.x == 0) {
        unsigned* bar = b.bar;
        __builtin_amdgcn_s_waitcnt(0);
        unsigned nloc = b.st[0], nx = b.st[1];
        if (nloc == 0u) { xcd_barrier_complete(bar, b.x, nloc, nx); b.st[0] = nloc; b.st[1] = nx; }
        const unsigned old = xb_add(&bar[XB_XSUB(b.x)], 1u);
        const unsigned gen = old / nloc;
        if (old + 1u == (gen + 1u) * nloc) {
            __builtin_amdgcn_fence(__ATOMIC_RELEASE, "agent");
            asm volatile("s_waitcnt vmcnt(0)" ::: "memory");
            const unsigned og = xb_add(&bar[XB_TOP], 1u);
            const unsigned tg = og / nx;
            if (og + 1u == (tg + 1u) * nx) xb_add(&bar[XB_TOPGEN], 1u);
            else XB_SPIN(xb_ld(&bar[XB_TOPGEN]) == tg, bar);
            __builtin_amdgcn_fence(__ATOMIC_ACQUIRE, "agent");
            xb_add(&bar[XB_XGEN(b.x)], 1u);
            asm volatile("s_waitcnt vmcnt(0)" ::: "memory");
        } else {
            XB_SPIN(xb_ld(&bar[XB_XGEN(b.x)]) == gen, bar);
            __builtin_amdgcn_fence(__ATOMIC_ACQUIRE, "agent");
            asm volatile("s_waitcnt vmcnt(0)" ::: "memory");
        }
    }
    __syncthreads();
}

struct Frame {
    LAS unsigned char* lds;
    volatile LAS unsigned* MISC;
    gu32* ctl;
    int tid, lane, wave;
    int vcu, G;
};
struct Ptrs {
    const float *x, *mem, *attn_g, *w_in, *conv_w, *conv_b, *conv_ln_g, *conv_ln_b, *sb_out_g, *mem_norm_g, *w_mem_kv, *q_norm_g, *k_norm_g, *mem_out_g,
                *w_out, *ffn_g, *w_peer_q, *keys1, *keys2, *peer_u, *peer_v;
    float* out;
    bf16 *WIN, *WKV, *WOUT, *WPQ, *KEYS, *MEMN, *MKV, *XN, *CAT, *PROJ, *Q;
    unsigned char *UT, *VT; float *USC, *VSC;
    int* SELI; float* SELG; float* SSQ2;
};

__device__ __forceinline__ void p0_transpose_item(const float* W, const float* gk, int K, int N, bf16* WT, LAS float* scr, int item, int lane) {
    const int nblk = N / 32, kb = item / nblk, nb = item % nblk, k0 = 64 * kb, n0 = 32 * nb;
#pragma unroll 8
    for (int i = 0; i < 32; ++i) { const int kk = 2 * i + (lane >> 5); float w = W[(size_t)(k0 + kk) * N + n0 + (lane & 31)]; if (gk) w *= gk[k0 + kk]; scr[kk * 33 + (lane & 31)] = w; }
    LDS_WAIT(); asm volatile("" ::: "memory");
    const int c = lane & 7;
#pragma unroll
    for (int j = 0; j < 4; ++j) { const int n = (lane >> 3) + 8 * j; const LAS float* s = scr + (8 * c) * 33 + n;
        v4u o; o.x = pk2(s[0 * 33], s[1 * 33]); o.y = pk2(s[2 * 33], s[3 * 33]); o.z = pk2(s[4 * 33], s[5 * 33]); o.w = pk2(s[6 * 33], s[7 * 33]);
        *(GAS v4u*)(WT + (size_t)(n0 + n) * K + k0 + 8 * c) = o; }
    LDS_WAIT(); asm volatile("" ::: "memory");
}
__device__ __forceinline__ void rms_row_to_bf16(const float* xrow, const float* g, bf16* orow, int lane) {
    const GAS f32x4* xr = (const GAS f32x4*)xrow + lane; const GAS f32x4* gr = (const GAS f32x4*)g + lane;
    f32x4 v[4]; float s = 0.f;
#pragma unroll
    for (int j = 0; j < 4; ++j) { v[j] = xr[64 * j]; s += (v[j].x * v[j].x + v[j].y * v[j].y) + (v[j].z * v[j].z + v[j].w * v[j].w); }
    const float rinv = 1.f / sqrtf(wave_sum(s) * (1.f / 1024.f) + EPS);
    GAS unsigned long long* o8 = (GAS unsigned long long*)orow + lane;
#pragma unroll
    for (int j = 0; j < 4; ++j) { const f32x4 gg = gr[64 * j]; const f32x4 o = v[j] * rinv * gg;
        o8[64 * j] = (unsigned long long)pk2(o.x, o.y) | ((unsigned long long)pk2(o.z, o.w) << 32); }
}
__device__ __forceinline__ void cvt_f32_to_bf16_stream(const float* src, bf16* dst, size_t n8, size_t gtid, size_t nthr) {
    for (size_t i = gtid; i < n8; i += nthr) { const f32x4 a = ((const GAS f32x4*)src)[2 * i], b = ((const GAS f32x4*)src)[2 * i + 1];
        v4u o; o.x = pk2(a.x, a.y); o.y = pk2(a.z, a.w); o.z = pk2(b.x, b.y); o.w = pk2(b.z, b.w); ((GAS v4u*)dst)[i] = o; }
}
__device__ __forceinline__ void row_to_fp8(const float* src, unsigned char* dst, float* iscale, int e, int lane) {
    const GAS f32x4* p = (const GAS f32x4*)(src + (size_t)e * D) + lane; f32x4 v[4]; float am = 0.f;
#pragma unroll
    for (int k = 0; k < 4; ++k) { v[k] = p[64 * k]; am = fmaxf(fmaxf(am, fmaxf(fabsf(v[k].x), fabsf(v[k].y))), fmaxf(fabsf(v[k].z), fabsf(v[k].w))); }
#pragma unroll
    for (int o = 1; o < 64; o <<= 1) am = fmaxf(am, __shfl_xor(am, o));
    const float sc = am > 0.f ? 256.f / am : 1.f, isc = am > 0.f ? am * (1.f / 256.f) : 1.f;
    GAS unsigned* d = (GAS unsigned*)(dst + (size_t)e * D) + lane;
#pragma unroll
    for (int k = 0; k < 4; ++k) { int w = 0; w = __builtin_amdgcn_cvt_pk_fp8_f32(v[k].x * sc, v[k].y * sc, w, false); w = __builtin_amdgcn_cvt_pk_fp8_f32(v[k].z * sc, v[k].w * sc, w, true); d[64 * k] = (unsigned)w; }
    if (lane == 0) iscale[e] = isc;
}
__device__ __forceinline__ void p0_prologue(Frame& F, const Ptrs& P) {
    LAS float* scr = (LAS float*)(F.lds + RING_OFF + F.wave * 16384);
    const int gw = F.vcu * NWAVES + F.wave, NGW = F.G * NWAVES;
    constexpr int I_IN = (D / 64) * (INW / 32), I_KV = (D / 64) * (KVW / 32), I_OUT = (D / 64) * (D / 32), I_PQ = (D / 64) * (PQW / 32);
    constexpr int NITEMS = I_IN + I_KV + I_OUT + I_PQ;
    for (int it = gw; it < NITEMS; it += NGW) {
        int r = it;
        if (r < I_IN) { p0_transpose_item(P.w_in, nullptr, D, INW, P.WIN, scr, r, F.lane); continue; } r -= I_IN;
        if (r < I_KV) { p0_transpose_item(P.w_mem_kv, nullptr, D, KVW, P.WKV, scr, r, F.lane); continue; } r -= I_KV;
        if (r < I_OUT) { p0_transpose_item(P.w_out, nullptr, D, D, P.WOUT, scr, r, F.lane); continue; } r -= I_OUT;
        p0_transpose_item(P.w_peer_q, P.ffn_g, D, PQW, P.WPQ, scr, r, F.lane);
    }
    for (int m = gw; m < M; m += NGW) rms_row_to_bf16(P.x + (size_t)m * D, P.attn_g, P.XN + (size_t)m * D, F.lane);
    for (int m = gw; m < MMEM; m += NGW) rms_row_to_bf16(P.mem + (size_t)m * D, P.mem_norm_g, P.MEMN + (size_t)m * D, F.lane);
    const size_t gtid = (size_t)gw * 64 + F.lane, nthr = (size_t)NGW * 64;
    cvt_f32_to_bf16_stream(P.keys1, P.KEYS, 8 * 128 * 128 / 8, gtid, nthr);
    cvt_f32_to_bf16_stream(P.keys2, P.KEYS + 8 * 128 * 128, 8 * 128 * 128 / 8, gtid, nthr);
    for (int r = gw; r < 2 * NEXP; r += NGW) { if (r < NEXP) row_to_fp8(P.peer_u, P.UT, P.USC, r, F.lane); else row_to_fp8(P.peer_v, P.VT, P.VSC, r - NEXP, F.lane); }
}

__device__ __forceinline__ void conv_item(Frame& F, const Ptrs& P, int b, int ch) {
    LAS float* U = (LAS float*)(F.lds + 0);
    LAS float* Y = (LAS float*)(F.lds + 65536);
    const int t0 = ch * 32, tid = F.tid;
    for (int idx = tid; idx < 62 * 32; idx += 512) {
        const int r = idx >> 5, c8 = idx & 31, t = t0 - 30 + r;
        float u[8];
        if (t >= 0) { const bf16* src = P.PROJ + (size_t)(b * SEQ + t) * INW + c8 * 8;
            const v4u a = *(const GAS v4u*)(src + C_A), g = *(const GAS v4u*)(src + C_G);
            const unsigned aw[4] = {a.x, a.y, a.z, a.w}, gw_[4] = {g.x, g.y, g.z, g.w};
#pragma unroll
            for (int i = 0; i < 4; ++i) { const float a0 = bflo(aw[i]), a1 = bfhi(aw[i]), g0 = bflo(gw_[i]), g1 = bfhi(gw_[i]);
                u[2 * i] = a0 / (1.f + __expf(-g0)); u[2 * i + 1] = a1 / (1.f + __expf(-g1)); }
        } else {
#pragma unroll
            for (int i = 0; i < 8; ++i) u[i] = 0.f;
        }
        LAS f32x4* dst = (LAS f32x4*)(U + r * 256 + c8 * 8);
        dst[0] = (f32x4){u[0], u[1], u[2], u[3]}; dst[1] = (f32x4){u[4], u[5], u[6], u[7]};
    }
    __syncthreads();
    {
        const int c = tid & 255, half = tid >> 8;
        float w[31];
#pragma unroll
        for (int k = 0; k < 31; ++k) w[k] = P.conv_w[k * 256 + c];
        const float bias = P.conv_b[c];
        float win[46];
#pragma unroll
        for (int i = 0; i < 46; ++i) win[i] = U[(half * 16 + i) * 256 + c];
#pragma unroll
        for (int tt = 0; tt < 16; ++tt) { float y = bias;
#pragma unroll
            for (int k = 0; k < 31; ++k) y += w[k] * win[tt + k];
            Y[(half * 16 + tt) * 256 + c] = y; }
    }
    __syncthreads();
    {
        const f32x4 lg = ((const GAS f32x4*)P.conv_ln_g)[F.lane], lb = ((const GAS f32x4*)P.conv_ln_b)[F.lane];
#pragma unroll
        for (int i = 0; i < 4; ++i) { const int tok = F.wave * 4 + i; const f32x4 y = *(const LAS f32x4*)(Y + tok * 256 + F.lane * 4);
            const float mu = wave_sum((y.x + y.y) + (y.z + y.w)) * (1.f / 256.f); const f32x4 d = y - mu;
            const float var = wave_sum((d.x * d.x + d.y * d.y) + (d.z * d.z + d.w * d.w)) * (1.f / 256.f);
            const float rinv = 1.f / sqrtf(var + EPS); const f32x4 yn = d * rinv * lg + lb;
            f32x4 s; s.x = yn.x / (1.f + __expf(-yn.x)); s.y = yn.y / (1.f + __expf(-yn.y)); s.z = yn.z / (1.f + __expf(-yn.z)); s.w = yn.w / (1.f + __expf(-yn.w));
            *(GAS unsigned long long*)(P.CAT + (size_t)(b * SEQ + t0 + tok) * D + F.lane * 4) = (unsigned long long)pk2(s.x, s.y) | ((unsigned long long)pk2(s.z, s.w) << 32); }
    }
}

typedef short bf16x8 __attribute__((ext_vector_type(8)));
typedef float f32x16 __attribute__((ext_vector_type(16)));
typedef short s16x4 __attribute__((ext_vector_type(4)));
constexpr int VSTR = 144;
constexpr int VL_BYTES = 32 * VSTR;
__device__ __forceinline__ unsigned cvtpk(float lo, float hi) { typedef float f2 __attribute__((ext_vector_type(2))); typedef __bf16 b2 __attribute__((ext_vector_type(2))); f2 v = {lo, hi}; b2 b = __builtin_convertvector(v, b2); return __builtin_bit_cast(unsigned, b); }
__device__ __forceinline__ s16x4 vtr(LAS unsigned char* p) { return __builtin_bit_cast(s16x4, __builtin_amdgcn_ds_read_tr16_b64_v4i16((LAS s16x4*)p)); }
__device__ __forceinline__ float swap_lo(float x, float& hi_out) { auto rr = __builtin_amdgcn_permlane32_swap(__float_as_uint(x), __float_as_uint(x), false, false); hi_out = __uint_as_float(rr[1]); return __uint_as_float(rr[0]); }
__device__ __forceinline__ void v_frags(LAS unsigned char* vl, int lane, bf16x8 (&vf)[2][2]) {
    const int il = lane & 15, q_ = il >> 2, p_ = il & 3, gg = lane >> 4, hi = lane >> 5;
    LAS unsigned char* base = vl + (4 * hi + q_) * VSTR + (16 * (gg & 1) + 4 * p_) * 2;
#pragma unroll
    for (int mt = 0; mt < 2; ++mt)
#pragma unroll
        for (int c = 0; c < 2; ++c) { const s16x4 lo = vtr(base + c * 16 * VSTR + mt * 64), hh = vtr(base + c * 16 * VSTR + 8 * VSTR + mt * 64);
            vf[mt][c] = (bf16x8){lo[0], lo[1], lo[2], lo[3], hh[0], hh[1], hh[2], hh[3]}; }
}
__device__ __forceinline__ void sb_item_mfma(Frame& F, const Ptrs& P, int b, int g) {
    const int lane = F.lane, h = F.wave, r32 = lane & 31, hi = lane >> 5;
    const int t0 = g * 32; const size_t rowbase = (size_t)b * SEQ;
    LAS unsigned char* vl = F.lds + F.wave * VL_BYTES;
    bf16x8 qf[4];
    { const bf16* qp = P.PROJ + (rowbase + t0 + r32) * INW + C_Q + h * 64 + 8 * hi;
#pragma unroll
      for (int ks = 0; ks < 4; ++ks) qf[ks] = *(const GAS bf16x8*)(qp + 16 * ks); }
    f32x16 o0, o1;
#pragma unroll
    for (int r = 0; r < 16; ++r) { o0[r] = 0.f; o1[r] = 0.f; }
    float R = 1.f;
    const bf16* kbase = P.PROJ + (rowbase + r32) * INW + C_K + h * 64 + 8 * hi;
    const bf16* vbase = P.PROJ + (rowbase + (lane >> 3)) * INW + C_V + h * 64 + (lane & 7) * 8;
    bf16x8 kf[4]; v4u vp[4];
#pragma unroll
    for (int ks = 0; ks < 4; ++ks) kf[ks] = *(const GAS bf16x8*)(kbase + (size_t)t0 * INW + 16 * ks);
#pragma unroll
    for (int k = 0; k < 4; ++k) vp[k] = *(const GAS v4u*)(vbase + (size_t)(t0 + 8 * k) * INW);
    for (int s0 = t0; s0 >= 0; s0 -= 32) {
        f32x16 s;
#pragma unroll
        for (int r = 0; r < 16; ++r) s[r] = 0.f;
#pragma unroll
        for (int ks = 0; ks < 4; ++ks) s = __builtin_amdgcn_mfma_f32_32x32x16_bf16(kf[ks], qf[ks], s, 0, 0, 0);
        asm volatile("" ::: "memory");
#pragma unroll
        for (int k = 0; k < 4; ++k) *(LAS v4u*)(vl + ((lane >> 3) + 8 * k) * VSTR + (lane & 7) * 16) = vp[k];
        asm volatile("" ::: "memory");
        if (s0 > 0) {
#pragma unroll
            for (int ks = 0; ks < 4; ++ks) kf[ks] = *(const GAS bf16x8*)(kbase + (size_t)(s0 - 32) * INW + 16 * ks);
#pragma unroll
            for (int k = 0; k < 4; ++k) vp[k] = *(const GAS v4u*)(vbase + (size_t)(s0 - 32 + 8 * k) * INW);
        }
        const bool diag = (s0 == t0);
        float be[16], om[16];
#pragma unroll
        for (int r = 0; r < 16; ++r) { const float z = s[r] * 0.125f; const float e = __expf(-fabsf(z)), rr = __builtin_amdgcn_rcpf(1.f + e), er = e * rr;
            float b_ = z >= 0.f ? rr : er, o_ = z >= 0.f ? er : rr;
            if (diag) { const bool valid = ((r & 3) + 8 * (r >> 2) + 4 * hi) < r32; b_ = valid ? b_ : 0.f; o_ = valid ? o_ : 1.f; }
            be[r] = b_; om[r] = o_; }
        float sfx[16], G[4], Glo[4], Ghi[4];
#pragma unroll
        for (int j = 0; j < 4; ++j) { sfx[4 * j + 3] = 1.f; sfx[4 * j + 2] = om[4 * j + 3]; sfx[4 * j + 1] = sfx[4 * j + 2] * om[4 * j + 2]; sfx[4 * j] = sfx[4 * j + 1] * om[4 * j + 1]; G[j] = sfx[4 * j] * om[4 * j]; }
#pragma unroll
        for (int j = 0; j < 4; ++j) Glo[j] = swap_lo(G[j], Ghi[j]);
        float run = R, st[4];
#pragma unroll
        for (int j = 3; j >= 0; --j) { const float s_hi = run, s_lo = run * Ghi[j]; st[j] = hi ? s_hi : s_lo; run = s_lo * Glo[j]; }
        R = run;
        bf16x8 pf[2];
#pragma unroll
        for (int c = 0; c < 2; ++c) { unsigned w[4];
#pragma unroll
            for (int u = 0; u < 4; ++u) { const int r = 8 * c + 2 * u; w[u] = cvtpk(be[r] * st[r >> 2] * sfx[r], be[r + 1] * st[(r + 1) >> 2] * sfx[r + 1]); }
            pf[c] = __builtin_bit_cast(bf16x8, (v4u){w[0], w[1], w[2], w[3]}); }
        bf16x8 vf[2][2];
        v_frags(vl, lane, vf);
        o0 = __builtin_amdgcn_mfma_f32_32x32x16_bf16(vf[0][0], pf[0], o0, 0, 0, 0); o0 = __builtin_amdgcn_mfma_f32_32x32x16_bf16(vf[0][1], pf[1], o0, 0, 0, 0);
        o1 = __builtin_amdgcn_mfma_f32_32x32x16_bf16(vf[1][0], pf[0], o1, 0, 0, 0); o1 = __builtin_amdgcn_mfma_f32_32x32x16_bf16(vf[1][1], pf[1], o1, 0, 0, 0);
        asm volatile("" ::: "memory");
        if (__builtin_amdgcn_ballot_w64(R > 1.0e-37f) == 0ull) break;
    }
    float ss = 0.f;
#pragma unroll
    for (int r = 0; r < 16; ++r) ss += o0[r] * o0[r] + o1[r] * o1[r];
    { float sh; const float sl = swap_lo(ss, sh); ss = sl + sh; }
    LAS float* xs = (LAS float*)(F.lds + EXTRA_OFF);
    if (hi == 0) xs[h * 32 + r32] = ss;
    __syncthreads();
    float tot = 0.f;
#pragma unroll
    for (int w = 0; w < 8; ++w) tot += xs[w * 32 + r32];
    const float rinv = 1.f / sqrtf(tot * (1.f / 512.f) + EPS);
    bf16* dst = P.CAT + (rowbase + t0 + r32) * D + 256 + h * 64 + 4 * hi; const float* gp = P.sb_out_g + h * 64 + 4 * hi;
#pragma unroll
    for (int mt = 0; mt < 2; ++mt)
#pragma unroll
        for (int j = 0; j < 4; ++j) { const f32x4 gv = *(const GAS f32x4*)(gp + 32 * mt + 8 * j);
            const float a0 = (mt ? o1[4 * j] : o0[4 * j]) * rinv * gv.x, a1 = (mt ? o1[4 * j + 1] : o0[4 * j + 1]) * rinv * gv.y, a2 = (mt ? o1[4 * j + 2] : o0[4 * j + 2]) * rinv * gv.z, a3 = (mt ? o1[4 * j + 3] : o0[4 * j + 3]) * rinv * gv.w;
            *(GAS v2u*)(dst + 32 * mt + 8 * j) = (v2u){cvtpk(a0, a1), cvtpk(a2, a3)}; }
    __syncthreads();
}
__device__ __forceinline__ void mem_item_mfma(Frame& F, const Ptrs& P, int b, int qb) {
    const int lane = F.lane, h = F.wave & 3, qg = F.wave >> 2, r32 = lane & 31, hi = lane >> 5;
    const size_t row = (size_t)b * SEQ + qb * 64 + qg * 32 + r32;
    LAS unsigned char* vl = F.lds + F.wave * VL_BYTES;
    LAS float* rk = (LAS float*)(F.lds + 8 * VL_BYTES + F.wave * 128);
    bf16x8 qf[4]; float qsc;
    { const bf16* qp = P.PROJ + row * INW + C_MQ + h * 64 + 8 * hi; float ssq = 0.f;
#pragma unroll
      for (int ks = 0; ks < 4; ++ks) { const v4u v = *(const GAS v4u*)(qp + 16 * ks); const unsigned w[4] = {v.x, v.y, v.z, v.w}; unsigned ow[4];
#pragma unroll
          for (int i = 0; i < 4; ++i) { const float a = bflo(w[i]), c = bfhi(w[i]); ssq += a * a + c * c; const int d = 16 * ks + 8 * hi + 2 * i;
              ow[i] = cvtpk(a * (P.q_norm_g[d] * P.k_norm_g[d]), c * (P.q_norm_g[d + 1] * P.k_norm_g[d + 1])); }
          qf[ks] = __builtin_bit_cast(bf16x8, (v4u){ow[0], ow[1], ow[2], ow[3]}); }
      float sh; const float sl = swap_lo(ssq, sh); qsc = 0.125f / sqrtf((sl + sh) * (1.f / 64.f) + EPS); }
    f32x16 o0, o1;
#pragma unroll
    for (int r = 0; r < 16; ++r) { o0[r] = 0.f; o1[r] = 0.f; }
    float mx = -1.0e30f, lsum = 0.f;
    const bf16* kbase = P.MKV + ((size_t)b * MEML + r32) * KVW + h * 64 + 8 * hi;
    const bf16* vbase = P.MKV + ((size_t)b * MEML + (lane >> 3)) * KVW + 256 + h * 64 + (lane & 7) * 8;
    for (int s0 = 0; s0 < MEML; s0 += 32) {
        bf16x8 kf[4]; v4u vp[4]; float kss = 0.f;
#pragma unroll
        for (int ks = 0; ks < 4; ++ks) { const v4u v = *(const GAS v4u*)(kbase + (size_t)s0 * KVW + 16 * ks); kf[ks] = __builtin_bit_cast(bf16x8, v);
            kss = dot2(v.x, v.x, kss); kss = dot2(v.y, v.y, kss); kss = dot2(v.z, v.z, kss); kss = dot2(v.w, v.w, kss); }
#pragma unroll
        for (int k = 0; k < 4; ++k) vp[k] = *(const GAS v4u*)(vbase + (size_t)(s0 + 8 * k) * KVW);
        { float sh; const float sl = swap_lo(kss, sh); kss = 1.f / sqrtf((sl + sh) * (1.f / 64.f) + EPS); }
        asm volatile("" ::: "memory");
        if (hi == 0) rk[r32] = kss;
#pragma unroll
        for (int k = 0; k < 4; ++k) *(LAS v4u*)(vl + ((lane >> 3) + 8 * k) * VSTR + (lane & 7) * 16) = vp[k];
        asm volatile("" ::: "memory");
        f32x16 s;
#pragma unroll
        for (int r = 0; r < 16; ++r) s[r] = 0.f;
#pragma unroll
        for (int ks = 0; ks < 4; ++ks) s = __builtin_amdgcn_mfma_f32_32x32x16_bf16(kf[ks], qf[ks], s, 0, 0, 0);
        float p[16]; float bm = -1.0e30f;
#pragma unroll
        for (int j = 0; j < 4; ++j) { const f32x4 rv = *(const LAS f32x4*)(rk + 8 * j + 4 * hi);
            p[4 * j] = s[4 * j] * qsc * rv.x; p[4 * j + 1] = s[4 * j + 1] * qsc * rv.y; p[4 * j + 2] = s[4 * j + 2] * qsc * rv.z; p[4 * j + 3] = s[4 * j + 3] * qsc * rv.w;
            bm = fmaxf(fmaxf(bm, fmaxf(p[4 * j], p[4 * j + 1])), fmaxf(p[4 * j + 2], p[4 * j + 3])); }
        { float bh; const float bl = swap_lo(bm, bh); bm = fmaxf(bl, bh); }
        const float mn = fmaxf(mx, bm), sc = __expf(mx - mn); mx = mn; lsum *= sc;
#pragma unroll
        for (int r = 0; r < 16; ++r) { o0[r] *= sc; o1[r] *= sc; p[r] = __expf(p[r] - mn); lsum += p[r]; }
        bf16x8 pf[2];
#pragma unroll
        for (int c = 0; c < 2; ++c) pf[c] = __builtin_bit_cast(bf16x8, (v4u){cvtpk(p[8 * c], p[8 * c + 1]), cvtpk(p[8 * c + 2], p[8 * c + 3]), cvtpk(p[8 * c + 4], p[8 * c + 5]), cvtpk(p[8 * c + 6], p[8 * c + 7])});
        bf16x8 vf[2][2];
        v_frags(vl, lane, vf);
        o0 = __builtin_amdgcn_mfma_f32_32x32x16_bf16(vf[0][0], pf[0], o0, 0, 0, 0); o0 = __builtin_amdgcn_mfma_f32_32x32x16_bf16(vf[0][1], pf[1], o0, 0, 0, 0);
        o1 = __builtin_amdgcn_mfma_f32_32x32x16_bf16(vf[1][0], pf[0], o1, 0, 0, 0); o1 = __builtin_amdgcn_mfma_f32_32x32x16_bf16(vf[1][1], pf[1], o1, 0, 0, 0);
        asm volatile("" ::: "memory");
    }
    { float lh; const float ll = swap_lo(lsum, lh); lsum = 1.f / (ll + lh); }
    float ss = 0.f;
#pragma unroll
    for (int r = 0; r < 16; ++r) { o0[r] *= lsum; o1[r] *= lsum; ss += o0[r] * o0[r] + o1[r] * o1[r]; }
    { float sh; const float sl = swap_lo(ss, sh); ss = sl + sh; }
    LAS float* xs = (LAS float*)(F.lds + EXTRA_OFF);
    if (hi == 0) xs[F.wave * 32 + r32] = ss;
    __syncthreads();
    float tot = 0.f;
#pragma unroll
    for (int w = 0; w < 4; ++w) tot += xs[(qg * 4 + w) * 32 + r32];
    const float rinv = 1.f / sqrtf(tot * (1.f / 256.f) + EPS);
    bf16* dst = P.CAT + row * D + 768 + h * 64 + 4 * hi; const float* gp = P.mem_out_g + h * 64 + 4 * hi;
#pragma unroll
    for (int mt = 0; mt < 2; ++mt)
#pragma unroll
        for (int j = 0; j < 4; ++j) { const f32x4 gv = *(const GAS f32x4*)(gp + 32 * mt + 8 * j);
            const float a0 = (mt ? o1[4 * j] : o0[4 * j]) * rinv * gv.x, a1 = (mt ? o1[4 * j + 1] : o0[4 * j + 1]) * rinv * gv.y, a2 = (mt ? o1[4 * j + 2] : o0[4 * j + 2]) * rinv * gv.z, a3 = (mt ? o1[4 * j + 3] : o0[4 * j + 3]) * rinv * gv.w;
            *(GAS v2u*)(dst + 32 * mt + 8 * j) = (v2u){cvtpk(a0, a1), cvtpk(a2, a3)}; }
    __syncthreads();
}

#define CE(a, b) { const float hi_ = fmaxf(a, b), lo_ = fminf(a, b); a = hi_; b = lo_; }
#define SORT16(V) do { CE(V[0], V[1]); CE(V[2], V[3]); CE(V[0], V[2]); CE(V[1], V[3]); CE(V[1], V[2]); CE(V[4], V[5]); CE(V[6], V[7]); CE(V[4], V[6]); CE(V[5], V[7]); CE(V[5], V[6]); CE(V[0], V[4]); CE(V[2], V[6]); CE(V[2], V[4]); CE(V[1], V[5]); CE(V[3], V[7]); CE(V[3], V[5]); CE(V[1], V[2]); CE(V[3], V[4]); CE(V[5], V[6]); CE(V[8], V[9]); CE(V[10], V[11]); CE(V[8], V[10]); CE(V[9], V[11]); CE(V[9], V[10]); CE(V[12], V[13]); CE(V[14], V[15]); CE(V[12], V[14]); CE(V[13], V[15]); CE(V[13], V[14]); CE(V[8], V[12]); CE(V[10], V[14]); CE(V[10], V[12]); CE(V[9], V[13]); CE(V[11], V[15]); CE(V[11], V[13]); CE(V[9], V[10]); CE(V[11], V[12]); CE(V[13], V[14]); CE(V[0], V[8]); CE(V[4], V[12]); CE(V[4], V[8]); CE(V[2], V[10]); CE(V[6], V[14]); CE(V[6], V[10]); CE(V[2], V[4]); CE(V[6], V[8]); CE(V[10], V[12]); CE(V[1], V[9]); CE(V[5], V[13]); CE(V[5], V[9]); CE(V[3], V[11]); CE(V[7], V[15]); CE(V[7], V[11]); CE(V[3], V[5]); CE(V[7], V[9]); CE(V[11], V[13]); CE(V[1], V[2]); CE(V[3], V[4]); CE(V[5], V[6]); CE(V[7], V[8]); CE(V[9], V[10]); CE(V[11], V[12]); CE(V[13], V[14]); } while (0)
#define BITONIC16(V) do { CE(V[0], V[8]); CE(V[1], V[9]); CE(V[2], V[10]); CE(V[3], V[11]); CE(V[4], V[12]); CE(V[5], V[13]); CE(V[6], V[14]); CE(V[7], V[15]); CE(V[0], V[4]); CE(V[1], V[5]); CE(V[2], V[6]); CE(V[3], V[7]); CE(V[8], V[12]); CE(V[9], V[13]); CE(V[10], V[14]); CE(V[11], V[15]); CE(V[0], V[2]); CE(V[1], V[3]); CE(V[4], V[6]); CE(V[5], V[7]); CE(V[8], V[10]); CE(V[9], V[11]); CE(V[12], V[14]); CE(V[13], V[15]); CE(V[0], V[1]); CE(V[2], V[3]); CE(V[4], V[5]); CE(V[6], V[7]); CE(V[8], V[9]); CE(V[10], V[11]); CE(V[12], V[13]); CE(V[14], V[15]); } while (0)
#define MERGE16(A, B) do { _Pragma("unroll") for (int i_ = 0; i_ < 16; ++i_) A[i_] = fmaxf(A[i_], B[15 - i_]); BITONIC16(A); } while (0)
constexpr int KSTR = 272;
constexpr int P5_KEYS2 = 128 * KSTR, P5_TAB = 2 * 128 * KSTR;
__device__ __forceinline__ void peer_top16(const LAS unsigned char* keysL, const bf16* qptr, int r32, int hi, float (&T)[16]) {
    bf16x8 qf[8];
#pragma unroll
    for (int ks = 0; ks < 8; ++ks) qf[ks] = *(const GAS bf16x8*)(qptr + 16 * ks);
    f32x16 acc[4];
#pragma unroll
    for (int mt = 0; mt < 4; ++mt)
#pragma unroll
        for (int r = 0; r < 16; ++r) acc[mt][r] = 0.f;
#pragma unroll
    for (int ks = 0; ks < 8; ++ks)
#pragma unroll
        for (int mt = 0; mt < 4; ++mt) { const bf16x8 a = *(const LAS bf16x8*)(keysL + (32 * mt + r32) * KSTR + (16 * ks + 8 * hi) * 2); acc[mt] = __builtin_amdgcn_mfma_f32_32x32x16_bf16(a, qf[ks], acc[mt], 0, 0, 0); }
    float v[4][16]; const unsigned hi4 = (unsigned)hi << 2;
#pragma unroll
    for (int mt = 0; mt < 4; ++mt)
#pragma unroll
        for (int r = 0; r < 16; ++r) v[mt][r] = __uint_as_float((__float_as_uint(acc[mt][r]) & 0xFFFFFF80u) | ((unsigned)(32 * mt + (r & 3) + 8 * (r >> 2)) | hi4));
    SORT16(v[0]); SORT16(v[1]); SORT16(v[2]); SORT16(v[3]);
    MERGE16(v[0], v[1]); MERGE16(v[2], v[3]); MERGE16(v[0], v[2]);
    float plo[16], phi[16];
#pragma unroll
    for (int i = 0; i < 16; ++i) plo[i] = swap_lo(v[0][i], phi[i]);
#pragma unroll
    for (int i = 0; i < 16; ++i) T[i] = fmaxf(plo[i], phi[15 - i]);
    BITONIC16(T);
}
__device__ __forceinline__ float pack8(float s, unsigned code) { return __uint_as_float((__float_as_uint(s) & 0xFFFFFF00u) | code); }
__device__ __forceinline__ void peer_select_mfma(Frame& F, const Ptrs& P, int tb, int h, bool load_keys) {
    LAS unsigned char* lds = F.lds; const int tid = F.tid, lane = F.lane, r32 = lane & 31, hi = lane >> 5;
    if (load_keys) {
        __syncthreads();
#pragma unroll
        for (int i = 0; i < 8; ++i) { const int c = tid + 512 * i; const int which = c >> 11, rem = c & 2047, n = rem >> 4, ch = rem & 15;
            *(LAS v4u*)(lds + which * P5_KEYS2 + n * KSTR + ch * 16) = *(const GAS v4u*)(P.KEYS + (size_t)which * 131072 + (size_t)h * 16384 + n * 128 + ch * 8); }
        __syncthreads();
    }
    const int tok = tb * 256 + F.wave * 32 + r32;
    const bf16* qrow = P.Q + (size_t)tok * PQW + h * 256 + 8 * hi;
    float T1[16], T2[16];
    peer_top16(lds, qrow, r32, hi, T1);
    peer_top16(lds + P5_KEYS2, qrow + 128, r32, hi, T2);
    LAS unsigned char* tabA = lds + P5_TAB + F.wave * 2048 + lane; LAS unsigned char* tabB = tabA + 1024;
#pragma unroll
    for (int i = 0; i < 16; ++i) { tabA[i * 64] = (unsigned char)(__float_as_uint(T1[i]) & 127u); tabB[i * 64] = (unsigned char)(__float_as_uint(T2[i]) & 127u); }
    float C0[16], X0[16], X1[16];
#pragma unroll
    for (int j = 0; j < 16; ++j) C0[j] = pack8(T1[0] + T2[j], (unsigned)j);
    {
        int n = 0;
#pragma unroll
        for (int i = 1; i < 14; ++i)
#pragma unroll
            for (int j = 0; j < 16; ++j) if ((i + 1) * (j + 1) <= 16) { const float c = pack8(T1[i] + T2[j], (unsigned)(i * 16 + j)); if (n < 16) X0[n] = c; else X1[n - 16] = c; ++n; }
    }
    SORT16(X0); SORT16(X1);
    MERGE16(X0, X1); MERGE16(C0, X0);
#pragma unroll
    for (int i = 14; i < 16; ++i) { float cv = pack8(T1[i] + T2[0], (unsigned)(i * 16));
#pragma unroll
        for (int p = 0; p < 16; ++p) { const float hi_ = fmaxf(C0[p], cv), lo_ = fminf(C0[p], cv); C0[p] = hi_; cv = lo_; } }
    float e[16], sum = 0.f;
#pragma unroll
    for (int p = 0; p < 16; ++p) { e[p] = __expf(C0[p] - C0[0]); sum += e[p]; }
    const float inv = 1.f / sum;
    if (hi == 0) {
        unsigned id[16];
#pragma unroll
        for (int p = 0; p < 16; ++p) { const unsigned code = __float_as_uint(C0[p]) & 255u; id[p] = (unsigned)tabA[(code >> 4) * 64] * 128u + (unsigned)tabB[(code & 15u) * 64]; }
        GAS v4u* di = (GAS v4u*)(P.SELI + ((size_t)tok * 8 + h) * 16);
#pragma unroll
        for (int j = 0; j < 4; ++j) di[j] = (v4u){id[4 * j], id[4 * j + 1], id[4 * j + 2], id[4 * j + 3]};
    } else {
        GAS f32x4* dg = (GAS f32x4*)(P.SELG + ((size_t)tok * 8 + h) * 16);
#pragma unroll
        for (int j = 0; j < 4; ++j) dg[j] = (f32x4){e[4 * j] * inv, e[4 * j + 1] * inv, e[4 * j + 2] * inv, e[4 * j + 3] * inv};
    }
}

typedef float f32x2 __attribute__((ext_vector_type(2)));
__device__ __forceinline__ void peer_gather_token(const Ptrs& P, LAS float* wl, int t, int lane) {
    const float rs = 1.0f / sqrtf(__hip_atomic_load(P.SSQ2 + t, RLX_AGENT) * (1.0f / 1024.0f) + EPS);
    f32x2 acc[8], hh[8];
    { const GAS f32x4* xr = (const GAS f32x4*)(P.out + (size_t)t * D) + lane * 4; const GAS f32x4* gr = (const GAS f32x4*)P.ffn_g + lane * 4;
#pragma unroll
      for (int k = 0; k < 4; ++k) { const f32x4 xv = xr[k], gv = gr[k]; acc[2 * k] = (f32x2){xv.x, xv.y}; acc[2 * k + 1] = (f32x2){xv.z, xv.w};
          hh[2 * k] = (f32x2){xv.x * rs * gv.x, xv.y * rs * gv.y}; hh[2 * k + 1] = (f32x2){xv.z * rs * gv.z, xv.w * rs * gv.w}; } }
    const int e0 = P.SELI[(size_t)t * 128 + lane], e1 = P.SELI[(size_t)t * 128 + 64 + lane];
    const float g0 = P.SELG[(size_t)t * 128 + lane], g1 = P.SELG[(size_t)t * 128 + 64 + lane];
    const bool h5 = (lane & 32) != 0, h4 = (lane & 16) != 0, h3 = (lane & 8) != 0;
    const int kl = 4 * ((lane >> 3) & 1) + 2 * ((lane >> 4) & 1) + ((lane >> 5) & 1);
    for (int jb = 0; jb < 128; jb += 8) {
        v4u r[8];
#pragma unroll
        for (int k = 0; k < 8; ++k) { const int j = jb + k; const int e = __builtin_amdgcn_readlane(jb < 64 ? e0 : e1, j & 63); r[k] = ((const GAS v4u*)(P.UT + (size_t)e * D))[lane]; }
        float p[8];
#pragma unroll
        for (int k = 0; k < 8; ++k) { const unsigned w[4] = {r[k].x, r[k].y, r[k].z, r[k].w}; f32x2 d = {0.f, 0.f};
#pragma unroll
            for (int i = 0; i < 4; ++i) { d += __builtin_amdgcn_cvt_pk_f32_fp8(w[i], false) * hh[2 * i]; d += __builtin_amdgcn_cvt_pk_f32_fp8(w[i], true) * hh[2 * i + 1]; }
            p[k] = d.x + d.y; }
        float v4[4], v2[2];
#pragma unroll
        for (int m = 0; m < 4; ++m) { const float keep = h5 ? p[2 * m + 1] : p[2 * m], send = h5 ? p[2 * m] : p[2 * m + 1]; v4[m] = keep + __shfl_xor(send, 32); }
#pragma unroll
        for (int m = 0; m < 2; ++m) { const float keep = h4 ? v4[2 * m + 1] : v4[2 * m], send = h4 ? v4[2 * m] : v4[2 * m + 1]; v2[m] = keep + __shfl_xor(send, 16); }
        float v1; { const float keep = h3 ? v2[1] : v2[0], send = h3 ? v2[0] : v2[1]; v1 = keep + __shfl_xor(send, 8); }
        v1 += __shfl_xor(v1, 4); v1 += __shfl_xor(v1, 2); v1 += __shfl_xor(v1, 1);
        const int ej = __shfl(jb < 64 ? e0 : e1, (jb & 63) + kl); const float gj = __shfl(jb < 64 ? g0 : g1, (jb & 63) + kl);
        const float dot = v1 * P.USC[ej];
        const float act = 0.5f * dot * (1.f + erff(dot * 0.70710678118654752f)) * gj * P.VSC[ej];
        if ((lane & 7) == 0) wl[jb + kl] = act;
    }
    for (int jb = 0; jb < 128; jb += 8) {
        v4u r[8];
#pragma unroll
        for (int k = 0; k < 8; ++k) { const int j = jb + k; const int e = __builtin_amdgcn_readlane(jb < 64 ? e0 : e1, j & 63); r[k] = ((const GAS v4u*)(P.VT + (size_t)e * D))[lane]; }
#pragma unroll
        for (int k = 0; k < 8; ++k) { const float w = wl[jb + k]; const unsigned ww[4] = {r[k].x, r[k].y, r[k].z, r[k].w};
#pragma unroll
            for (int i = 0; i < 4; ++i) { acc[2 * i] += __builtin_amdgcn_cvt_pk_f32_fp8(ww[i], false) * w; acc[2 * i + 1] += __builtin_amdgcn_cvt_pk_f32_fp8(ww[i], true) * w; } }
    }
    GAS f32x4* orow = (GAS f32x4*)(P.out + (size_t)t * D) + lane * 4;
#pragma unroll
    for (int k = 0; k < 4; ++k) orow[k] = (f32x4){acc[2 * k].x, acc[2 * k].y, acc[2 * k + 1].x, acc[2 * k + 1].y};
}

struct Args { const float* in[21]; float* out; unsigned char* ws; int ph_lo, ph_hi, li, pad; };
__device__ __forceinline__ Ptrs make_ptrs(const Args& args) {
    unsigned char* ws = args.ws;
    Ptrs P;
    P.x = args.in[0]; P.mem = args.in[1]; P.attn_g = args.in[2]; P.w_in = args.in[3]; P.conv_w = args.in[4]; P.conv_b = args.in[5]; P.conv_ln_g = args.in[6]; P.conv_ln_b = args.in[7];
    P.sb_out_g = args.in[8]; P.mem_norm_g = args.in[9]; P.w_mem_kv = args.in[10]; P.q_norm_g = args.in[11]; P.k_norm_g = args.in[12]; P.mem_out_g = args.in[13]; P.w_out = args.in[14];
    P.ffn_g = args.in[15]; P.w_peer_q = args.in[16]; P.keys1 = args.in[17]; P.keys2 = args.in[18]; P.peer_u = args.in[19]; P.peer_v = args.in[20];
    P.out = args.out;
    P.WIN = (bf16*)(ws + WS_WIN); P.WKV = (bf16*)(ws + WS_WKV); P.WOUT = (bf16*)(ws + WS_WOUT); P.WPQ = (bf16*)(ws + WS_WPQ); P.KEYS = (bf16*)(ws + WS_KEYS);
    P.MEMN = (bf16*)(ws + WS_MEMN); P.MKV = (bf16*)(ws + WS_MKV); P.UT = ws + WS_UT; P.VT = ws + WS_VT; P.USC = (float*)(ws + WS_SC); P.VSC = (float*)(ws + WS_SC) + NEXP; P.XN = (bf16*)(ws + WS_XN); P.CAT = (bf16*)(ws + WS_CAT);
    P.PROJ = (bf16*)(ws + WS_PROJ); P.Q = (bf16*)(ws + WS_Q); P.SELI = (int*)(ws + WS_SELI); P.SELG = (float*)(ws + WS_SELG); P.SSQ2 = (float*)(ws + WS_CTL) + CW_SSQ2;
    return P;
}
__global__ void __launch_bounds__(NWAVES * 64, 2) fwd_kernel(Args args) {
    extern __shared__ __attribute__((aligned(16))) unsigned char lds[];
    Frame F;
    F.lds = (LAS unsigned char*)lds;
    F.MISC = (volatile LAS unsigned*)(F.lds + MISC_OFF);
    F.tid = threadIdx.x; F.lane = F.tid & 63; F.wave = __builtin_amdgcn_readfirstlane(F.tid >> 6);
    F.G = gridDim.x; { const int bx = blockIdx.x; F.vcu = (F.G % 8 == 0) ? (bx % 8) * (F.G / 8) + bx / 8 : bx; }
    unsigned char* ws = args.ws;
    F.ctl = (gu32*)(ws + WS_CTL);
    for (int u = F.tid; u < (LDS_BYTES - LDSCTL_OFF) / 4; u += NWAVES * 64) ((LAS unsigned*)(F.lds + LDSCTL_OFF))[u] = 0u;
    __syncthreads();
    XcdBarrier bar; bar.bar = (unsigned*)(F.ctl + CW_BAR); bar.x = 0; bar.st = nullptr;
    if (N_LAUNCHES != PER_PHASE) bar = xcd_barrier_post((unsigned*)(F.ctl + CW_BAR), F.MISC + 8);
#define GRID_BAR() do { if (N_LAUNCHES != PER_PHASE) xcd_barrier(bar); } while (0)
    const int lo = args.ph_lo, hi = args.ph_hi;
#define IN(k) (lo <= (k) && (k) < hi)
#define BOTH(k) (IN(k) && IN((k) + 1))

    if (IN(0)) { const Ptrs P = make_ptrs(args); for (int rep = 0; rep < (PROBE_DBL == 0 ? 2 : 1); ++rep) p0_prologue(F, P); if (BOTH(0)) GRID_BAR(); }

    if (IN(1)) { const Ptrs P = make_ptrs(args);
        { pg8::Gemm g{P.XN, P.WIN, M, INW, D}; pg8::StaticOrder S; S.init(M, INW, F.G, (int)blockIdx.x);
          pg8::EpiBf16 E{P.PROJ, INW};
          pg8::gemm_phase<pg8::EpiBf16, pg8::StaticOrder, PG8_ALIGN, PG8_SP2>(F.lds + RING_OFF, g, S, E); }
        { pg8::Gemm g{P.MEMN, P.WKV, MMEM, KVW, D}; pg8::StaticOrder S; S.init(MMEM, KVW, F.G, (int)blockIdx.x);
          pg8::EpiBf16 E{P.MKV, KVW};
          pg8::gemm_phase<pg8::EpiBf16, pg8::StaticOrder, PG8_ALIGN, PG8_SP2>(F.lds + RING_OFF, g, S, E); }
        if (BOTH(1)) GRID_BAR();
    }

    if (IN(2)) { const Ptrs P = make_ptrs(args);
        const int c = F.vcu;
        for (int rep = 0; rep < (PROBE_DBL == 2 ? 2 : 1); ++rep) {
        for (int it = c; it < BATCH * (SEQ / 32); it += F.G) sb_item_mfma(F, P, it >> 7, it & 127);
        for (int it = c; it < BATCH * (SEQ / 64); it += F.G) mem_item_mfma(F, P, it >> 6, it & 63);
        __syncthreads();
        for (int it = c; it < BATCH * (SEQ / 32); it += F.G) { conv_item(F, P, it / (SEQ / 32), it % (SEQ / 32)); }
        __syncthreads();
        }
        if (BOTH(2)) GRID_BAR();
    }

    if (IN(3)) { const Ptrs P = make_ptrs(args);
        pg8::Gemm g{P.CAT, P.WOUT, M, D, D}; pg8::StaticOrder S; S.init(M, D, F.G, (int)blockIdx.x);
        pg8::EpiResid E{P.x, P.out, P.XN, P.SSQ2, D};
        pg8::gemm_phase<pg8::EpiResid, pg8::StaticOrder, PG8_ALIGN, PG8_SP2>(F.lds + RING_OFF, g, S, E);
        if (BOTH(3)) GRID_BAR();
    }

    if (IN(4)) { const Ptrs P = make_ptrs(args);
        pg8::Gemm g{P.XN, P.WPQ, M, PQW, D}; pg8::StaticOrder S; S.init(M, PQW, F.G, (int)blockIdx.x);
        pg8::EpiBf16Row E{P.Q, PQW, P.SSQ2};
        pg8::gemm_phase<pg8::EpiBf16Row, pg8::StaticOrder, PG8_ALIGN, PG8_SP2>(F.lds + RING_OFF, g, S, E);
        if (BOTH(4)) GRID_BAR();
    }

    if (IN(5)) { const Ptrs P = make_ptrs(args);
        for (int rep = 0; rep < (PROBE_DBL == 5 ? 2 : 1); ++rep)
        { int prev_h = -1; for (int it = (int)blockIdx.x; it < (M / 256) * 8; it += F.G) { const int h = it & 7; peer_select_mfma(F, P, it >> 3, h, h != prev_h); prev_h = h; } }
        __syncthreads();
        if (BOTH(5)) GRID_BAR();
    }

    if (IN(6)) { const Ptrs P = make_ptrs(args);
        const int gw = F.vcu * NWAVES + F.wave, NGW = F.G * NWAVES;
        LAS float* wl = (LAS float*)(F.lds + F.wave * 512);
        for (int t = gw; t < M; t += NGW) peer_gather_token(P, wl, t, F.lane);
    }
#undef IN
#undef BOTH
}

extern "C" void kernel_launch(void* const* d_in, const int* in_sizes, int n_in, void* d_out, int out_size, void* d_ws, size_t ws_size, hipStream_t stream) {
    static int grid = 0;
    if (grid == 0) {
        if (n_in != 21 || in_sizes[0] != M * D || out_size != M * D || ws_size < WS_END) { fprintf(stderr, "kernel_launch: unexpected shapes/workspace (n_in %d, in0 %d, out %d, ws %zu); nothing launched\n", n_in, n_in > 0 ? in_sizes[0] : -1, out_size, ws_size); grid = -1; return; }
        int dev = 0, cus = 0, per_cu = 0;
        if (hipGetDevice(&dev) != hipSuccess || hipDeviceGetAttribute(&cus, hipDeviceAttributeMultiprocessorCount, dev) != hipSuccess) { grid = -1; return; }
        if (hipFuncSetAttribute((const void*)fwd_kernel, hipFuncAttributeMaxDynamicSharedMemorySize, LDS_BYTES) != hipSuccess) { fprintf(stderr, "kernel_launch: hipFuncSetAttribute failed\n"); grid = -1; return; }
        if (hipOccupancyMaxActiveBlocksPerMultiprocessor(&per_cu, (const void*)fwd_kernel, NWAVES * 64, LDS_BYTES) != hipSuccess || per_cu < 1) { fprintf(stderr, "kernel_launch: occupancy query says %d blocks per CU\n", per_cu); }
        (void)hipGetLastError();
        grid = cus;
    }
    if (grid < 0) return;
    if (hipMemsetAsync((char*)d_ws + WS_CTL, 0, CTL_ZERO_BYTES, stream) != hipSuccess) { fprintf(stderr, "kernel_launch: memset failed\n"); return; }
    Args a{};
    for (int i = 0; i < 21; ++i) a.in[i] = (const float*)d_in[i];
    a.out = (float*)d_out; a.ws = (unsigned char*)d_ws;
    for (int li = 0; li < N_LAUNCHES; ++li) {
        a.ph_lo = (N_LAUNCHES == PER_PHASE) ? li : 0; a.ph_hi = (N_LAUNCHES == PER_PHASE) ? li + 1 : PER_PHASE; a.li = li;
        hipLaunchKernelGGL(fwd_kernel, dim3(grid), dim3(NWAVES * 64), LDS_BYTES, stream, a);
        const hipError_t le = hipPeekAtLastError();
        if (le != hipSuccess) { fprintf(stderr, "kernel_launch: launch %d failed: %s\n", li, hipGetErrorName(le)); break; }
    }
}
```

```cpp
#include <hip/hip_runtime.h>
#include <cstdio>
#include <cstdint>
namespace pg8 {
#define PG8_LAS __attribute__((address_space(3)))
typedef unsigned short bf16_t;
typedef short bf16x8 __attribute__((ext_vector_type(8)));
typedef float f32x4 __attribute__((ext_vector_type(4)));
typedef unsigned u32x4 __attribute__((ext_vector_type(4)));
constexpr int BM = 256, BK = 64, HALF = 128, HTB = HALF * BK * 2  , STAGE_BYTES = 8 * HTB, NXCD = 8, WGM = 8;

__host__ __device__ __forceinline__ int lds_byte(int r, int c) { const int st = (r >> 4) * 2 + (c >> 5), rr = r & 15, cc = c & 31, ob = rr * 64 + cc * 2; return st * 1024 + (ob ^ (((ob >> 9) & 1) << 5)); }
__host__ __device__ __forceinline__ void stage_rc(int b, int& R, int& C) { const int st = b / 1024, sb = b % 1024, swz = sb ^ (((sb >> 9) & 1) << 5); R = (st >> 1) * 16 + swz / 64; C = (st & 1) * 32 + (swz % 64) / 2; }
__host__ __device__ __forceinline__ int perm32(int rho) { const int n = rho >> 4, i = rho & 15; return 8 * (i >> 2) + 4 * n + (i & 3); }

struct Unit { int pm, pn; };
struct Gemm { const bf16_t* A; const bf16_t* Bt; int M, N, K; };

struct StaticOrder {
    int nM, nN, nwg, G, c;
    __host__ __device__ void init(int M, int N, int G_, int c_) { nM = M / BM; nN = N / BM; nwg = nM * nN; G = G_; c = c_; }
    __host__ __device__ bool next(int i, Unit& u) const {
        const long L = (long)i * G + c; if (L >= nwg) return false;
        int wgid = (int)L; { const int q = nwg / NXCD, r = nwg % NXCD, xcd = wgid % NXCD, off = wgid / NXCD; wgid = (xcd < r ? xcd * (q + 1) : r * (q + 1) + (xcd - r) * q) + off; }
        const int nig = WGM * nN, gid = wgid / nig, fm = gid * WGM, gsz = (nM - fm) < WGM ? (nM - fm) : WGM;
        u.pm = fm + ((wgid % nig) % gsz); u.pn = (wgid % nig) / gsz; return true;
    }
    __device__ __forceinline__ void a_ready(const Unit&) const {}
    __device__ __forceinline__ void done(const Unit&) const {}
};

__device__ __forceinline__ unsigned cvt_pk_bf16(float lo, float hi) { unsigned r; asm volatile("v_cvt_pk_bf16_f32 %0, %1, %2" : "=v"(r) : "v"(lo), "v"(hi)); return r; }
typedef unsigned u32x2 __attribute__((ext_vector_type(2)));

struct EpiBf16 {
    static constexpr bool PERM = true, AFTER_DRAIN = false;
    bf16_t* O; int ldc;
    __device__ __forceinline__ void operator()(const f32x4 (&acc)[2][2][4][2], const Unit& u, int wr, int wc, int fr, int fq) const {
        const int row0 = u.pm * BM + wr * 64 + fr; const int col0 = u.pn * BM + wc * 32 + 8 * fq;
#pragma unroll
        for (int ai = 0; ai < 2; ++ai)
#pragma unroll
            for (int m = 0; m < 4; ++m) { bf16_t* rowp = O + (size_t)(row0 + ai * HALF + m * 16) * ldc + col0;
#pragma unroll
                for (int bj = 0; bj < 2; ++bj) { const f32x4 v0 = acc[ai][bj][m][0], v1 = acc[ai][bj][m][1];
                    u32x4 w; w.x = cvt_pk_bf16(v0[0], v0[1]); w.y = cvt_pk_bf16(v0[2], v0[3]); w.z = cvt_pk_bf16(v1[0], v1[1]); w.w = cvt_pk_bf16(v1[2], v1[3]);
                    *(u32x4*)(rowp + bj * HALF) = w; } }
    }
};
struct EpiBf16Row {
    static constexpr bool PERM = true, AFTER_DRAIN = false;
    bf16_t* O; int ldc; const float* ssq;
    __device__ __forceinline__ void operator()(const f32x4 (&acc)[2][2][4][2], const Unit& u, int wr, int wc, int fr, int fq) const {
        const int row0 = u.pm * BM + wr * 64 + fr; const int col0 = u.pn * BM + wc * 32 + 8 * fq;
#pragma unroll
        for (int ai = 0; ai < 2; ++ai)
#pragma unroll
            for (int m = 0; m < 4; ++m) { const int row = row0 + ai * HALF + m * 16; bf16_t* rowp = O + (size_t)row * ldc + col0;
                const float rs = 1.0f / sqrtf(__hip_atomic_load(ssq + row, __ATOMIC_RELAXED, __HIP_MEMORY_SCOPE_AGENT) * (1.0f / 1024.0f) + 1e-6f);
#pragma unroll
                for (int bj = 0; bj < 2; ++bj) { const f32x4 v0 = acc[ai][bj][m][0] * rs, v1 = acc[ai][bj][m][1] * rs;
                    u32x4 w; w.x = cvt_pk_bf16(v0[0], v0[1]); w.y = cvt_pk_bf16(v0[2], v0[3]); w.z = cvt_pk_bf16(v1[0], v1[1]); w.w = cvt_pk_bf16(v1[2], v1[3]);
                    *(u32x4*)(rowp + bj * HALF) = w; } }
    }
};
struct EpiResid {
    static constexpr bool PERM = false, AFTER_DRAIN = false;
    const float* x; float* out; bf16_t* xb; float* ssq; int ldc;
    __device__ __forceinline__ void operator()(const f32x4 (&acc)[2][2][4][2], const Unit& u, int wr, int wc, int fr, int fq) const {
        const int col0 = u.pn * BM + wc * 32 + 4 * fq;
#pragma unroll
        for (int ai = 0; ai < 2; ++ai)
#pragma unroll
            for (int m = 0; m < 4; ++m) { const int row = u.pm * BM + ai * HALF + wr * 64 + m * 16 + fr; const size_t off = (size_t)row * ldc + col0; float s = 0.f;
#pragma unroll
                for (int bj = 0; bj < 2; ++bj)
#pragma unroll
                    for (int n = 0; n < 2; ++n) { const f32x4 xv = *(const f32x4*)(x + off + bj * HALF + n * 16); const f32x4 o = xv + acc[ai][bj][m][n];
                        *(f32x4*)(out + off + bj * HALF + n * 16) = o; s += (o[0] * o[0] + o[1] * o[1]) + (o[2] * o[2] + o[3] * o[3]);
                        u32x2 w; w.x = cvt_pk_bf16(o[0], o[1]); w.y = cvt_pk_bf16(o[2], o[3]); *(u32x2*)(xb + off + bj * HALF + n * 16) = w; }
                s += __shfl_xor(s, 16); s += __shfl_xor(s, 32);
                if (fq == 0) unsafeAtomicAdd(ssq + row, s); }
    }
};

template <class Epi, class Sched, bool ALIGN_EPI = false, bool SP2 = false>
__device__ __forceinline__ void gemm_phase(PG8_LAS unsigned char* lds, const Gemm g, const Sched& S, const Epi& E) {
    const int tid = threadIdx.x, wid = __builtin_amdgcn_readfirstlane(tid >> 6), lane = tid & 63, wr = wid >> 2, wc = wid & 3, fr = lane & 15, fq = lane >> 4;
    const int K = g.K, nt = K / BK;
    unsigned voffA[2], voffB[2];
#pragma unroll
    for (int i = 0; i < 2; ++i) { int R, C; stage_rc(tid * 16 + i * 8192, R, C); const int Rb = Epi::PERM ? ((R & ~31) + perm32(R & 31)) : R;
        voffA[i] = (unsigned)(R * K + C) * 2u; voffB[i] = (unsigned)(Rb * K + C) * 2u; }
    const size_t kstep = (size_t)(BK * 2);
    const size_t hstep = (size_t)HALF * K * 2;
    const size_t tstep = 2 * hstep;
    const unsigned ldsw = (unsigned)wid * 1024u;
    const int aoff = lds_byte(wr * 64 + fr, fq * 8), boff = lds_byte(wc * 32 + fr, fq * 8);
#define PG8_SA(b, h) (((b) * 2 + (h)) * HTB)
#define PG8_SB(b, h) ((4 + (b) * 2 + (h)) * HTB)
#define PG8_STAGE(bufoff, gbase, voff) do { _Pragma("unroll") for (int _i = 0; _i < 2; ++_i) \
        __builtin_amdgcn_global_load_lds((const unsigned*)((const char*)(gbase) + (voff)[_i]), (PG8_LAS unsigned*)(lds + (bufoff) + ldsw + _i * 8192), 16, 0, 0); } while (0)
#define PG8_LDA(dst, b, h) do { _Pragma("unroll") for (int m = 0; m < 4; ++m) _Pragma("unroll") for (int k = 0; k < 2; ++k) dst[m][k] = *(const PG8_LAS bf16x8*)(lds + PG8_SA(b, h) + aoff + m * 2048 + k * 1024); } while (0)
#define PG8_LDB(dst, b, h) do { _Pragma("unroll") for (int n = 0; n < 2; ++n) _Pragma("unroll") for (int k = 0; k < 2; ++k) dst[n][k] = *(const PG8_LAS bf16x8*)(lds + PG8_SB(b, h) + boff + n * 2048 + k * 1024); } while (0)
#define PG8_MMA(ai, bj, At, Bt) do { __builtin_amdgcn_s_setprio(1); _Pragma("unroll") for (int m = 0; m < 4; ++m) _Pragma("unroll") for (int n = 0; n < 2; ++n) _Pragma("unroll") for (int k = 0; k < 2; ++k) \
        acc[ai][bj][m][n] = __builtin_amdgcn_mfma_f32_16x16x32_bf16(Bt[n][k], At[m][k], acc[ai][bj][m][n], 0, 0, 0); __builtin_amdgcn_s_setprio(0); } while (0)
#define PG8_WAIT_V(n) asm volatile("s_waitcnt vmcnt(" #n ")" ::: "memory")
#define PG8_WAIT_L(n) asm volatile("s_waitcnt lgkmcnt(" #n ")" ::: "memory")
#define PG8_BAR __builtin_amdgcn_s_barrier()
#define PG8_SCHED __builtin_amdgcn_sched_barrier(0)
    Unit cur, nxt; int ui = 0;
    if (!S.next(0, cur)) return;
    f32x4 acc[2][2][4][2];
#pragma unroll
    for (int a = 0; a < 2; ++a)
#pragma unroll
        for (int b = 0; b < 2; ++b)
#pragma unroll
            for (int m = 0; m < 4; ++m)
#pragma unroll
                for (int n = 0; n < 2; ++n) acc[a][b][m][n] = (f32x4){0.f, 0.f, 0.f, 0.f};
    bf16x8 At[4][2], B0[2][2], B1[2][2];
    const char* cA = (const char*)g.A + (size_t)cur.pm * tstep; const char* cB = (const char*)g.Bt + (size_t)cur.pn * tstep;
    S.a_ready(cur);
    if constexpr (SP2) {
        PG8_STAGE(PG8_SB(0, 0), cB, voffB); PG8_STAGE(PG8_SB(0, 1), cB + hstep, voffB); PG8_STAGE(PG8_SA(0, 0), cA, voffA); PG8_STAGE(PG8_SA(0, 1), cA + hstep, voffA);
        if (wr == 1) PG8_BAR;
        PG8_WAIT_V(2); PG8_BAR;
        PG8_STAGE(PG8_SB(1, 0), cB + kstep, voffB); PG8_STAGE(PG8_SA(1, 0), cA + kstep, voffA); PG8_STAGE(PG8_SB(1, 1), cB + hstep + kstep, voffB);
        PG8_WAIT_V(6); PG8_BAR;
    } else {
        PG8_STAGE(PG8_SB(0, 0), cB, voffB); PG8_STAGE(PG8_SA(0, 0), cA, voffA); PG8_STAGE(PG8_SB(0, 1), cB + hstep, voffB); PG8_STAGE(PG8_SA(0, 1), cA + hstep, voffA);
        if (wr == 1) PG8_BAR;
        PG8_WAIT_V(4); PG8_BAR;
        PG8_STAGE(PG8_SB(1, 0), cB + kstep, voffB); PG8_STAGE(PG8_SA(1, 0), cA + kstep, voffA); PG8_STAGE(PG8_SB(1, 1), cB + hstep + kstep, voffB);
        PG8_WAIT_V(6); PG8_BAR;
    }
    for (;;) {
        const bool has_next = S.next(ui + 1, nxt);
        const char* nA = has_next ? (const char*)g.A + (size_t)nxt.pm * tstep : cA; const char* nB = has_next ? (const char*)g.Bt + (size_t)nxt.pn * tstep : cB;
        for (int t = 0; t < nt; t += 2) {
            const bool last = (t == nt - 2);
            const char* a1 = cA + (size_t)(t + 1) * kstep;
            const char* a2 = last ? nA : cA + (size_t)(t + 2) * kstep; const char* b2 = last ? nB : cB + (size_t)(t + 2) * kstep;
            const char* a3 = a2 + kstep; const char* b3 = b2 + kstep;
            if (last && has_next) S.a_ready(nxt);
            if constexpr (SP2) {
            PG8_LDB(B0, 0, 0); PG8_LDB(B1, 0, 1); PG8_SCHED; PG8_LDA(At, 0, 0); PG8_STAGE(PG8_SA(1, 1), a1 + hstep, voffA);
            PG8_WAIT_V(8); PG8_WAIT_L(0); PG8_BAR; PG8_MMA(0, 0, At, B0); PG8_MMA(0, 1, At, B1); PG8_BAR; PG8_SCHED;
            PG8_LDA(At, 0, 1); PG8_STAGE(PG8_SB(0, 0), b2, voffB); PG8_STAGE(PG8_SB(0, 1), b2 + hstep, voffB); PG8_STAGE(PG8_SA(0, 0), a2, voffA);
            PG8_WAIT_V(8); PG8_WAIT_L(0); PG8_BAR; PG8_MMA(1, 0, At, B0); PG8_MMA(1, 1, At, B1); PG8_BAR; PG8_SCHED;
            PG8_LDB(B0, 1, 0); PG8_LDB(B1, 1, 1); PG8_SCHED; PG8_LDA(At, 1, 0); PG8_STAGE(PG8_SA(0, 1), a2 + hstep, voffA);
            PG8_WAIT_V(8); PG8_WAIT_L(0); PG8_BAR; PG8_MMA(0, 0, At, B0); PG8_MMA(0, 1, At, B1); PG8_BAR; PG8_SCHED;
            PG8_LDA(At, 1, 1); PG8_STAGE(PG8_SB(1, 0), b3, voffB); PG8_STAGE(PG8_SB(1, 1), b3 + hstep, voffB); PG8_STAGE(PG8_SA(1, 0), a3, voffA);
            PG8_WAIT_V(8); PG8_WAIT_L(0); PG8_BAR; PG8_MMA(1, 0, At, B0); PG8_MMA(1, 1, At, B1); PG8_BAR; PG8_SCHED;
            } else {
            PG8_LDB(B0, 0, 0); PG8_SCHED; PG8_LDA(At, 0, 0); PG8_STAGE(PG8_SA(1, 1), a1 + hstep, voffA);
            PG8_WAIT_L(8); PG8_BAR; PG8_WAIT_L(0); PG8_MMA(0, 0, At, B0); PG8_BAR; PG8_SCHED;
            PG8_LDB(B1, 0, 1); PG8_STAGE(PG8_SB(0, 0), b2, voffB);
            PG8_BAR; PG8_WAIT_L(0); PG8_MMA(0, 1, At, B1); PG8_BAR;
            PG8_LDA(At, 0, 1); PG8_STAGE(PG8_SA(0, 0), a2, voffA);
            PG8_BAR; PG8_WAIT_L(0); PG8_MMA(1, 0, At, B0); PG8_BAR; PG8_SCHED;
            PG8_STAGE(PG8_SB(0, 1), b2 + hstep, voffB);
            PG8_WAIT_V(6); PG8_BAR; PG8_MMA(1, 1, At, B1); PG8_BAR;
            PG8_LDB(B0, 1, 0); PG8_SCHED; PG8_LDA(At, 1, 0); PG8_STAGE(PG8_SA(0, 1), a2 + hstep, voffA);
            PG8_WAIT_L(8); PG8_BAR; PG8_WAIT_L(0); PG8_MMA(0, 0, At, B0); PG8_BAR; PG8_SCHED;
            PG8_LDB(B1, 1, 1); PG8_STAGE(PG8_SB(1, 0), b3, voffB);
            PG8_BAR; PG8_WAIT_L(0); PG8_MMA(0, 1, At, B1); PG8_BAR;
            PG8_LDA(At, 1, 1); PG8_STAGE(PG8_SA(1, 0), a3, voffA);
            PG8_BAR; PG8_WAIT_L(0); PG8_MMA(1, 0, At, B0); PG8_BAR; PG8_SCHED;
            PG8_STAGE(PG8_SB(1, 1), b3 + hstep, voffB);
            PG8_WAIT_V(6); PG8_BAR; PG8_MMA(1, 1, At, B1); PG8_BAR;
            }
        }
        if constexpr (ALIGN_EPI) { if (wr == 0) PG8_BAR; }
        if constexpr (!Epi::AFTER_DRAIN) { E(acc, cur, wr, wc, fr, fq); S.done(cur); }
        if (!has_next) break;
#pragma unroll
        for (int a = 0; a < 2; ++a)
#pragma unroll
            for (int b = 0; b < 2; ++b)
#pragma unroll
                for (int m = 0; m < 4; ++m)
#pragma unroll
                    for (int n = 0; n < 2; ++n) acc[a][b][m][n] = (f32x4){0.f, 0.f, 0.f, 0.f};
        cur = nxt; cA = nA; cB = nB; ++ui;
        if constexpr (ALIGN_EPI) { if (wr == 1) PG8_BAR; }
    }
    PG8_WAIT_V(0);
    if constexpr (!ALIGN_EPI) { if (wr == 0) PG8_BAR; }
    PG8_BAR;
    if constexpr (Epi::AFTER_DRAIN) { E.fused(acc, cur, wr, wc, fr, fq, lds, wid, lane); S.done(cur); }
#undef PG8_SA
#undef PG8_SB
#undef PG8_STAGE
#undef PG8_LDA
#undef PG8_LDB
#undef PG8_MMA
#undef PG8_WAIT_V
#undef PG8_WAIT_L
#undef PG8_BAR
#undef PG8_SCHED
}
}

#ifndef PG8_SP2
#define PG8_SP2 true
#endif
#ifndef PG8_ALIGN
#define PG8_ALIGN true
#endif
#ifndef MK_N_LAUNCHES
#define MK_N_LAUNCHES 1
#endif
#ifndef PROBE_DBL
#define PROBE_DBL -1
#endif
constexpr int NWAVES = 8;
constexpr int PER_PHASE = 9;
constexpr int N_LAUNCHES = MK_N_LAUNCHES;

constexpr int BATCH = 8, SEQ = 4096, D = 1024, M = BATCH * SEQ;
constexpr int MEML = 256, MMEM = BATCH * MEML;
constexpr int INW = 2304, KVW = 512, PQW = 2048;
constexpr int C_A = 0, C_G = 256, C_Q = 512, C_K = 1024, C_V = 1536, C_MQ = 2048;
constexpr int NEXP = 16384;
constexpr float EPS = 1e-6f;

constexpr size_t MiB = 1u << 20;
constexpr size_t WS_CTL = 0, CTL_ZERO_BYTES = 1 * MiB;
constexpr size_t WS_WIN = 2 * MiB, WS_WKV = 7 * MiB, WS_WOUT = 8 * MiB, WS_WPQ = 10 * MiB, WS_KEYS = 14 * MiB;
constexpr size_t WS_MEMN = 15 * MiB, WS_MKV = 19 * MiB;
constexpr size_t WS_SC = 22 * MiB;
constexpr size_t WS_UT = 24 * MiB, WS_VT = 56 * MiB;
constexpr size_t WS_XN = 88 * MiB;
constexpr size_t WS_CAT = 152 * MiB;
constexpr size_t WS_SELI = 216 * MiB, WS_SELG = 232 * MiB;
constexpr size_t WS_PROJ = 256 * MiB;
constexpr size_t WS_Q = 256 * MiB;
constexpr size_t WS_END = 400 * MiB;
constexpr int CW_BAR = 4096;
constexpr int CW_SSQ2 = 65536;
static_assert((CW_SSQ2 + M) * 4 <= (int)CTL_ZERO_BYTES, "ctl");

constexpr int RING_OFF = 0, RING_BYTES = 131072;
constexpr int LDSCTL_OFF = RING_BYTES, MISC_OFF = LDSCTL_OFF + 320;
constexpr int EXTRA_OFF = RING_BYTES + 1024;
constexpr int LDS_BYTES = 147456;

#define GAS __attribute__((address_space(1)))
#define LAS __attribute__((address_space(3)))
typedef unsigned short bf16;
typedef unsigned v4u __attribute__((ext_vector_type(4)));
typedef unsigned v2u __attribute__((ext_vector_type(2)));
typedef float f32x4 __attribute__((ext_vector_type(4)));
typedef GAS unsigned gu32;
typedef __bf16 bf16x2_t __attribute__((ext_vector_type(2)));
#define RLX_AGENT __ATOMIC_RELAXED, __HIP_MEMORY_SCOPE_AGENT
#define LDS_WAIT() asm volatile("s_waitcnt lgkmcnt(0)" ::: "memory")
__device__ __forceinline__ unsigned f2bf(float f) { unsigned u = __builtin_bit_cast(unsigned, f); return (u + 0x7fffu + ((u >> 16) & 1u)) >> 16; }
__device__ __forceinline__ unsigned pk2(float lo, float hi) { return f2bf(lo) | (f2bf(hi) << 16); }
__device__ __forceinline__ float bflo(unsigned w) { return __uint_as_float(w << 16); }
__device__ __forceinline__ float bfhi(unsigned w) { return __uint_as_float(w & 0xffff0000u); }
__device__ __forceinline__ float dot2(unsigned a, unsigned b, float c) { return __builtin_amdgcn_fdot2_f32_bf16(__builtin_bit_cast(bf16x2_t, a), __builtin_bit_cast(bf16x2_t, b), c, false); }
__device__ __forceinline__ float wave_sum(float v) {
#pragma unroll
    for (int o = 1; o < 64; o <<= 1) v += __shfl_xor(v, o);
    return v;
}
#define XB_TMO      128
#define XB_XCNT(j)  (256  + 64 * (j))
#define XB_XSUB(j)  (1280 + 64 * (j))
#define XB_XGEN(j)  (2304 + 64 * (j))
#define XB_TOP      3328
#define XB_TOPGEN   3392
#define XCD_BAR_WORDS 3456
#define XB_SPIN_CAP (1u << 18)

__device__ __forceinline__ unsigned xb_ld(unsigned* p)              { return __hip_atomic_load(p, __ATOMIC_RELAXED, __HIP_MEMORY_SCOPE_AGENT); }
__device__ __forceinline__ unsigned xb_add(unsigned* p, unsigned v) { return __hip_atomic_fetch_add(p, v, __ATOMIC_RELAXED, __HIP_MEMORY_SCOPE_AGENT); }
__device__ __forceinline__ unsigned xb_xcc_id() { return (unsigned)__builtin_amdgcn_s_getreg((3 << 11) | 20) & 0xFu; }
#define XB_SPIN(cond, bar) do { unsigned _sp = 0; while (cond) { __builtin_amdgcn_s_sleep(1); \
    if ((++_sp & 255u) == 0u) { if (xb_ld(&(bar)[XB_TMO])) break; if (_sp > XB_SPIN_CAP) { atomicAdd(&(bar)[XB_TMO], 1u); break; } } } } while (0)

struct XcdBarrier {
    unsigned* bar; unsigned x;
    volatile LAS unsigned* st;
};

__device__ __forceinline__ XcdBarrier xcd_barrier_post(unsigned* bar, volatile LAS unsigned* st) {
    XcdBarrier b; b.bar = bar; b.x = xb_xcc_id(); b.st = st;
    if (threadIdx.x == 0) (void)xb_add(&bar[XB_XCNT(b.x)], 1u);
    return b;
}
__device__ __forceinline__ void xcd_barrier_complete(unsigned* bar, unsigned x, unsigned& nloc, unsigned& nx) {
    const unsigned G = gridDim.x * gridDim.y * gridDim.z;
    unsigned sum, cnt, mine, sp = 0u;
    for (;;) {
        sum = 0u; cnt = 0u; mine = 0u;
#pragma unroll
        for (unsigned j = 0; j < 16; ++j) { const unsigned c = xb_ld(&bar[XB_XCNT(j)]); sum += c; cnt += (c > 0u) ? 1u : 0u; mine = (j == x) ? c : mine; }
        if (sum == G) break;
        __builtin_amdgcn_s_sleep(1);
        if ((++sp & 255u) == 0u) { if (xb_ld(&bar[XB_TMO])) break; if (sp > XB_SPIN_CAP) { atomicAdd(&bar[XB_TMO], 1u); break; } }
    }
    nloc = mine > 0u ? mine : 1u; nx = cnt > 0u ? cnt : 1u;
}

__device__ __forceinline__ void xcd_barrier(const XcdBarrier& b) {
    asm volatile("s_waitcnt vmcnt(0)" ::: "memory");
    __syncthreads();
    if (threadIdx.x == 0) {
        unsigned* bar = b.bar;
        __builtin_amdgcn_s_waitcnt(0);
        unsigned nloc = b.st[0], nx = b.st[1];
        if (nloc == 0u) { xcd_barrier_complete(bar, b.x, nloc, nx); b.st[0] = nloc; b.st[1] = nx; }
        const unsigned old = xb_add(&bar[XB_XSUB(b.x)], 1u);
        const unsigned gen = old / nloc;
        if (old + 1u == (gen + 1u) * nloc) {
            __builtin_amdgcn_fence(__ATOMIC_RELEASE, "agent");
            asm volatile("s_waitcnt vmcnt(0)" ::: "memory");
            const unsigned og = xb_add(&bar[XB_TOP], 1u);
            const unsigned tg = og / nx;
            if (og + 1u == (tg + 1u) * nx) xb_add(&bar[XB_TOPGEN], 1u);
            else XB_SPIN(xb_ld(&bar[XB_TOPGEN]) == tg, bar);
            __builtin_amdgcn_fence(__ATOMIC_ACQUIRE, "agent");
            xb_add(&bar[XB_XGEN(b.x)], 1u);
            asm volatile("s_waitcnt vmcnt(0)" ::: "memory");
        } else {
            XB_SPIN(xb_ld(&bar[XB_XGEN(b.x)]) == gen, bar);
            __builtin_amdgcn_fence(__ATOMIC_ACQUIRE, "agent");
            asm volatile("s_waitcnt vmcnt(0)" ::: "memory");
        }
    }
    __syncthreads();
}

struct Frame {
    LAS unsigned char* lds;
    volatile LAS unsigned* MISC;
    gu32* ctl;
    int tid, lane, wave;
    int vcu, G;
};
struct Ptrs {
    const float *x, *mem, *attn_g, *w_in, *conv_w, *conv_b, *conv_ln_g, *conv_ln_b, *sb_out_g, *mem_norm_g, *w_mem_kv, *q_norm_g, *k_norm_g, *mem_out_g,
                *w_out, *ffn_g, *w_peer_q, *keys1, *keys2, *peer_u, *peer_v;
    float* out;
    bf16 *WIN, *WKV, *WOUT, *WPQ, *KEYS, *MEMN, *MKV, *XN, *CAT, *PROJ, *Q;
    unsigned char *UT, *VT; float *USC, *VSC, *PART, *W;
    int* SELI; float* SELG; float* SSQ2;
};

__device__ __forceinline__ void p0_transpose_item(const float* W, const float* gk, int K, int N, bf16* WT, LAS float* scr, int item, int lane) {
    const int nblk = N / 32, kb = item / nblk, nb = item % nblk, k0 = 64 * kb, n0 = 32 * nb;
#pragma unroll 8
    for (int i = 0; i < 32; ++i) { const int kk = 2 * i + (lane >> 5); float w = W[(size_t)(k0 + kk) * N + n0 + (lane & 31)]; if (gk) w *= gk[k0 + kk]; scr[kk * 33 + (lane & 31)] = w; }
    LDS_WAIT(); asm volatile("" ::: "memory");
    const int c = lane & 7;
#pragma unroll
    for (int j = 0; j < 4; ++j) { const int n = (lane >> 3) + 8 * j; const LAS float* s = scr + (8 * c) * 33 + n;
        v4u o; o.x = pk2(s[0 * 33], s[1 * 33]); o.y = pk2(s[2 * 33], s[3 * 33]); o.z = pk2(s[4 * 33], s[5 * 33]); o.w = pk2(s[6 * 33], s[7 * 33]);
        *(GAS v4u*)(WT + (size_t)(n0 + n) * K + k0 + 8 * c) = o; }
    LDS_WAIT(); asm volatile("" ::: "memory");
}
template <int NR> __device__ __forceinline__ void rms_rows_to_bf16(const float* xrow, const float* g, bf16* orow, int lane) {
    const GAS f32x4* gr = (const GAS f32x4*)g + lane;
    f32x4 v[NR][4]; float s[NR];
#pragma unroll
    for (int r = 0; r < NR; ++r) { const GAS f32x4* xr = (const GAS f32x4*)(xrow + (size_t)r * D) + lane;
#pragma unroll
        for (int j = 0; j < 4; ++j) v[r][j] = __builtin_nontemporal_load(xr + 64 * j); }
    f32x4 gg[4];
#pragma unroll
    for (int j = 0; j < 4; ++j) gg[j] = gr[64 * j];
#pragma unroll
    for (int r = 0; r < NR; ++r) { s[r] = 0.f;
#pragma unroll
        for (int j = 0; j < 4; ++j) s[r] += (v[r][j].x * v[r][j].x + v[r][j].y * v[r][j].y) + (v[r][j].z * v[r][j].z + v[r][j].w * v[r][j].w); }
#pragma unroll
    for (int o = 1; o < 64; o <<= 1)
#pragma unroll
        for (int r = 0; r < NR; ++r) s[r] += __shfl_xor(s[r], o);
#pragma unroll
    for (int r = 0; r < NR; ++r) { const float rinv = 1.f / sqrtf(s[r] * (1.f / 1024.f) + EPS);
        GAS unsigned long long* o8 = (GAS unsigned long long*)(orow + (size_t)r * D) + lane;
#pragma unroll
        for (int j = 0; j < 4; ++j) { const f32x4 o = v[r][j] * rinv * gg[j];
            o8[64 * j] = (unsigned long long)pk2(o.x, o.y) | ((unsigned long long)pk2(o.z, o.w) << 32); } }
}
__device__ __forceinline__ void cvt_f32_to_bf16_stream(const float* src, bf16* dst, size_t n8, size_t gtid, size_t nthr) {
    for (size_t i = gtid; i < n8; i += nthr) { const f32x4 a = ((const GAS f32x4*)src)[2 * i], b = ((const GAS f32x4*)src)[2 * i + 1];
        v4u o; o.x = pk2(a.x, a.y); o.y = pk2(a.z, a.w); o.z = pk2(b.x, b.y); o.w = pk2(b.z, b.w); ((GAS v4u*)dst)[i] = o; }
}
template <int NR> __device__ __forceinline__ void rows_to_fp8(const float* src, unsigned char* dst, float* iscale, int e, int lane) {
    f32x4 v[NR][4]; float am[NR];
#pragma unroll
    for (int r = 0; r < NR; ++r) { const GAS f32x4* p = (const GAS f32x4*)(src + (size_t)(e + r) * D) + lane;
#pragma unroll
        for (int k = 0; k < 4; ++k) v[r][k] = __builtin_nontemporal_load(p + 64 * k); }
#pragma unroll
    for (int r = 0; r < NR; ++r) { am[r] = 0.f;
#pragma unroll
        for (int k = 0; k < 4; ++k) am[r] = fmaxf(fmaxf(am[r], fmaxf(fabsf(v[r][k].x), fabsf(v[r][k].y))), fmaxf(fabsf(v[r][k].z), fabsf(v[r][k].w))); }
#pragma unroll
    for (int o = 1; o < 64; o <<= 1)
#pragma unroll
        for (int r = 0; r < NR; ++r) am[r] = fmaxf(am[r], __shfl_xor(am[r], o));
#pragma unroll
    for (int r = 0; r < NR; ++r) { const float sc = am[r] > 0.f ? 256.f / am[r] : 1.f, isc = am[r] > 0.f ? am[r] * (1.f / 256.f) : 1.f;
#pragma unroll
        for (int k = 0; k < 4; ++k) { int w = 0; w = __builtin_amdgcn_cvt_pk_fp8_f32(v[r][k].x * sc, v[r][k].y * sc, w, false); w = __builtin_amdgcn_cvt_pk_fp8_f32(v[r][k].z * sc, v[r][k].w * sc, w, true);
            *(GAS unsigned*)(dst + ((size_t)(2 * k + (lane >> 5)) * NEXP + e + r) * 128 + 4 * (lane & 31)) = (unsigned)w; }
        if (lane == 0) iscale[e + r] = isc; }
}
__device__ __forceinline__ void p0_prologue(Frame& F, const Ptrs& P) {
    LAS float* scr = (LAS float*)(F.lds + RING_OFF + F.wave * 16384);
    const int gw = F.vcu * NWAVES + F.wave, NGW = F.G * NWAVES;
    constexpr int I_IN = (D / 64) * (INW / 32), I_KV = (D / 64) * (KVW / 32), I_OUT = (D / 64) * (D / 32), I_PQ = (D / 64) * (PQW / 32);
    constexpr int NITEMS = I_IN + I_KV + I_OUT + I_PQ;
    for (int it = gw; it < NITEMS; it += NGW) {
        int r = it;
        if (r < I_IN) { p0_transpose_item(P.w_in, nullptr, D, INW, P.WIN, scr, r, F.lane); continue; } r -= I_IN;
        if (r < I_KV) { p0_transpose_item(P.w_mem_kv, nullptr, D, KVW, P.WKV, scr, r, F.lane); continue; } r -= I_KV;
        if (r < I_OUT) { p0_transpose_item(P.w_out, nullptr, D, D, P.WOUT, scr, r, F.lane); continue; } r -= I_OUT;
        p0_transpose_item(P.w_peer_q, P.ffn_g, D, PQW, P.WPQ, scr, r, F.lane);
    }
    for (int m = gw * 4; m < M; m += NGW * 4) rms_rows_to_bf16<4>(P.x + (size_t)m * D, P.attn_g, P.XN + (size_t)m * D, F.lane);
    for (int m = gw; m < MMEM; m += NGW) rms_rows_to_bf16<1>(P.mem + (size_t)m * D, P.mem_norm_g, P.MEMN + (size_t)m * D, F.lane);
    const size_t gtid = (size_t)gw * 64 + F.lane, nthr = (size_t)NGW * 64;
    cvt_f32_to_bf16_stream(P.keys1, P.KEYS, 8 * 128 * 128 / 8, gtid, nthr);
    cvt_f32_to_bf16_stream(P.keys2, P.KEYS + 8 * 128 * 128, 8 * 128 * 128 / 8, gtid, nthr);
    for (int r = gw * 4; r < 2 * NEXP; r += NGW * 4) { if (r < NEXP) rows_to_fp8<4>(P.peer_u, P.UT, P.USC, r, F.lane); else rows_to_fp8<4>(P.peer_v, P.VT, P.VSC, r - NEXP, F.lane); }
}

__device__ __forceinline__ void conv_item(Frame& F, const Ptrs& P, int b, int ch) {
    LAS float* U = (LAS float*)(F.lds + 0);
    LAS float* Y = (LAS float*)(F.lds + 65536);
    const int t0 = ch * 32, tid = F.tid;
    for (int idx = tid; idx < 62 * 32; idx += 512) {
        const int r = idx >> 5, c8 = idx & 31, t = t0 - 30 + r;
        float u[8];
        if (t >= 0) { const bf16* src = P.PROJ + (size_t)(b * SEQ + t) * INW + c8 * 8;
            const v4u a = *(const GAS v4u*)(src + C_A), g = *(const GAS v4u*)(src + C_G);
            const unsigned aw[4] = {a.x, a.y, a.z, a.w}, gw_[4] = {g.x, g.y, g.z, g.w};
#pragma unroll
            for (int i = 0; i < 4; ++i) { const float a0 = bflo(aw[i]), a1 = bfhi(aw[i]), g0 = bflo(gw_[i]), g1 = bfhi(gw_[i]);
                u[2 * i] = a0 / (1.f + __expf(-g0)); u[2 * i + 1] = a1 / (1.f + __expf(-g1)); }
        } else {
#pragma unroll
            for (int i = 0; i < 8; ++i) u[i] = 0.f;
        }
        LAS f32x4* dst = (LAS f32x4*)(U + r * 256 + c8 * 8);
        dst[0] = (f32x4){u[0], u[1], u[2], u[3]}; dst[1] = (f32x4){u[4], u[5], u[6], u[7]};
    }
    __syncthreads();
    {
        const int c = tid & 255, half = tid >> 8;
        float w[31];
#pragma unroll
        for (int k = 0; k < 31; ++k) w[k] = P.conv_w[k * 256 + c];
        const float bias = P.conv_b[c];
        float win[46];
#pragma unroll
        for (int i = 0; i < 46; ++i) win[i] = U[(half * 16 + i) * 256 + c];
#pragma unroll
        for (int tt = 0; tt < 16; ++tt) { float y = bias;
#pragma unroll
            for (int k = 0; k < 31; ++k) y += w[k] * win[tt + k];
            Y[(half * 16 + tt) * 256 + c] = y; }
    }
    __syncthreads();
    {
        const f32x4 lg = ((const GAS f32x4*)P.conv_ln_g)[F.lane], lb = ((const GAS f32x4*)P.conv_ln_b)[F.lane];
#pragma unroll
        for (int i = 0; i < 4; ++i) { const int tok = F.wave * 4 + i; const f32x4 y = *(const LAS f32x4*)(Y + tok * 256 + F.lane * 4);
            const float mu = wave_sum((y.x + y.y) + (y.z + y.w)) * (1.f / 256.f); const f32x4 d = y - mu;
            const float var = wave_sum((d.x * d.x + d.y * d.y) + (d.z * d.z + d.w * d.w)) * (1.f / 256.f);
            const float rinv = 1.f / sqrtf(var + EPS); const f32x4 yn = d * rinv * lg + lb;
            f32x4 s; s.x = yn.x / (1.f + __expf(-yn.x)); s.y = yn.y / (1.f + __expf(-yn.y)); s.z = yn.z / (1.f + __expf(-yn.z)); s.w = yn.w / (1.f + __expf(-yn.w));
            *(GAS unsigned long long*)(P.CAT + (size_t)(b * SEQ + t0 + tok) * D + F.lane * 4) = (unsigned long long)pk2(s.x, s.y) | ((unsigned long long)pk2(s.z, s.w) << 32); }
    }
}

typedef short bf16x8 __attribute__((ext_vector_type(8)));
typedef float f32x16 __attribute__((ext_vector_type(16)));
typedef short s16x4 __attribute__((ext_vector_type(4)));
constexpr int VSTR = 144;
constexpr int VL_BYTES = 32 * VSTR;
__device__ __forceinline__ unsigned cvtpk(float lo, float hi) { typedef float f2 __attribute__((ext_vector_type(2))); typedef __bf16 b2 __attribute__((ext_vector_type(2))); f2 v = {lo, hi}; b2 b = __builtin_convertvector(v, b2); return __builtin_bit_cast(unsigned, b); }
__device__ __forceinline__ s16x4 vtr(LAS unsigned char* p) { return __builtin_bit_cast(s16x4, __builtin_amdgcn_ds_read_tr16_b64_v4i16((LAS s16x4*)p)); }
__device__ __forceinline__ float swap_lo(float x, float& hi_out) { auto rr = __builtin_amdgcn_permlane32_swap(__float_as_uint(x), __float_as_uint(x), false, false); hi_out = __uint_as_float(rr[1]); return __uint_as_float(rr[0]); }
__device__ __forceinline__ void v_frags(LAS unsigned char* vl, int lane, bf16x8 (&vf)[2][2]) {
    const int il = lane & 15, q_ = il >> 2, p_ = il & 3, gg = lane >> 4, hi = lane >> 5;
    LAS unsigned char* base = vl + (4 * hi + q_) * VSTR + (16 * (gg & 1) + 4 * p_) * 2;
#pragma unroll
    for (int mt = 0; mt < 2; ++mt)
#pragma unroll
        for (int c = 0; c < 2; ++c) { const s16x4 lo = vtr(base + c * 16 * VSTR + mt * 64), hh = vtr(base + c * 16 * VSTR + 8 * VSTR + mt * 64);
            vf[mt][c] = (bf16x8){lo[0], lo[1], lo[2], lo[3], hh[0], hh[1], hh[2], hh[3]}; }
}
__device__ __forceinline__ void sb_item_mfma(Frame& F, const Ptrs& P, int b, int g) {
    const int lane = F.lane, h = F.wave, r32 = lane & 31, hi = lane >> 5;
    const int t0 = g * 32; const size_t rowbase = (size_t)b * SEQ;
    LAS unsigned char* vl = F.lds + F.wave * VL_BYTES;
    bf16x8 qf[4];
    { const bf16* qp = P.PROJ + (rowbase + t0 + r32) * INW + C_Q + h * 64 + 8 * hi;
#pragma unroll
      for (int ks = 0; ks < 4; ++ks) qf[ks] = *(const GAS bf16x8*)(qp + 16 * ks); }
    f32x16 o0, o1;
#pragma unroll
    for (int r = 0; r < 16; ++r) { o0[r] = 0.f; o1[r] = 0.f; }
    float R = 1.f;
    const bf16* kbase = P.PROJ + (rowbase + r32) * INW + C_K + h * 64 + 8 * hi;
    const bf16* vbase = P.PROJ + (rowbase + (lane >> 3)) * INW + C_V + h * 64 + (lane & 7) * 8;
    bf16x8 kf[4]; v4u vp[4];
#pragma unroll
    for (int ks = 0; ks < 4; ++ks) kf[ks] = *(const GAS bf16x8*)(kbase + (size_t)t0 * INW + 16 * ks);
#pragma unroll
    for (int k = 0; k < 4; ++k) vp[k] = *(const GAS v4u*)(vbase + (size_t)(t0 + 8 * k) * INW);
    for (int s0 = t0; s0 >= 0; s0 -= 32) {
        f32x16 s;
#pragma unroll
        for (int r = 0; r < 16; ++r) s[r] = 0.f;
#pragma unroll
        for (int ks = 0; ks < 4; ++ks) s = __builtin_amdgcn_mfma_f32_32x32x16_bf16(kf[ks], qf[ks], s, 0, 0, 0);
        asm volatile("" ::: "memory");
#pragma unroll
        for (int k = 0; k < 4; ++k) *(LAS v4u*)(vl + ((lane >> 3) + 8 * k) * VSTR + (lane & 7) * 16) = vp[k];
        asm volatile("" ::: "memory");
        if (s0 > 0) {
#pragma unroll
            for (int ks = 0; ks < 4; ++ks) kf[ks] = *(const GAS bf16x8*)(kbase + (size_t)(s0 - 32) * INW + 16 * ks);
#pragma unroll
            for (int k = 0; k < 4; ++k) vp[k] = *(const GAS v4u*)(vbase + (size_t)(s0 - 32 + 8 * k) * INW);
        }
        const bool diag = (s0 == t0);
        float be[16], om[16];
#pragma unroll
        for (int r = 0; r < 16; ++r) { const float z = s[r] * 0.125f; const float e = __expf(-fabsf(z)), rr = __builtin_amdgcn_rcpf(1.f + e), er = e * rr;
            float b_ = z >= 0.f ? rr : er, o_ = z >= 0.f ? er : rr;
            if (diag) { const bool valid = ((r & 3) + 8 * (r >> 2) + 4 * hi) < r32; b_ = valid ? b_ : 0.f; o_ = valid ? o_ : 1.f; }
            be[r] = b_; om[r] = o_; }
        float sfx[16], G[4], Glo[4], Ghi[4];
#pragma unroll
        for (int j = 0; j < 4; ++j) { sfx[4 * j + 3] = 1.f; sfx[4 * j + 2] = om[4 * j + 3]; sfx[4 * j + 1] = sfx[4 * j + 2] * om[4 * j + 2]; sfx[4 * j] = sfx[4 * j + 1] * om[4 * j + 1]; G[j] = sfx[4 * j] * om[4 * j]; }
#pragma unroll
        for (int j = 0; j < 4; ++j) Glo[j] = swap_lo(G[j], Ghi[j]);
        float run = R, st[4];
#pragma unroll
        for (int j = 3; j >= 0; --j) { const float s_hi = run, s_lo = run * Ghi[j]; st[j] = hi ? s_hi : s_lo; run = s_lo * Glo[j]; }
        R = run;
        bf16x8 pf[2];
#pragma unroll
        for (int c = 0; c < 2; ++c) { unsigned w[4];
#pragma unroll
            for (int u = 0; u < 4; ++u) { const int r = 8 * c + 2 * u; w[u] = cvtpk(be[r] * st[r >> 2] * sfx[r], be[r + 1] * st[(r + 1) >> 2] * sfx[r + 1]); }
            pf[c] = __builtin_bit_cast(bf16x8, (v4u){w[0], w[1], w[2], w[3]}); }
        bf16x8 vf[2][2];
        v_frags(vl, lane, vf);
        o0 = __builtin_amdgcn_mfma_f32_32x32x16_bf16(vf[0][0], pf[0], o0, 0, 0, 0); o0 = __builtin_amdgcn_mfma_f32_32x32x16_bf16(vf[0][1], pf[1], o0, 0, 0, 0);
        o1 = __builtin_amdgcn_mfma_f32_32x32x16_bf16(vf[1][0], pf[0], o1, 0, 0, 0); o1 = __builtin_amdgcn_mfma_f32_32x32x16_bf16(vf[1][1], pf[1], o1, 0, 0, 0);
        asm volatile("" ::: "memory");
        if (__builtin_amdgcn_ballot_w64(R > 1.0e-37f) == 0ull) break;
    }
    float ss = 0.f;
#pragma unroll
    for (int r = 0; r < 16; ++r) ss += o0[r] * o0[r] + o1[r] * o1[r];
    { float sh; const float sl = swap_lo(ss, sh); ss = sl + sh; }
    LAS float* xs = (LAS float*)(F.lds + EXTRA_OFF);
    if (hi == 0) xs[h * 32 + r32] = ss;
    __syncthreads();
    float tot = 0.f;
#pragma unroll
    for (int w = 0; w < 8; ++w) tot += xs[w * 32 + r32];
    const float rinv = 1.f / sqrtf(tot * (1.f / 512.f) + EPS);
    bf16* dst = P.CAT + (rowbase + t0 + r32) * D + 256 + h * 64 + 4 * hi; const float* gp = P.sb_out_g + h * 64 + 4 * hi;
#pragma unroll
    for (int mt = 0; mt < 2; ++mt)
#pragma unroll
        for (int j = 0; j < 4; ++j) { const f32x4 gv = *(const GAS f32x4*)(gp + 32 * mt + 8 * j);
            const float a0 = (mt ? o1[4 * j] : o0[4 * j]) * rinv * gv.x, a1 = (mt ? o1[4 * j + 1] : o0[4 * j + 1]) * rinv * gv.y, a2 = (mt ? o1[4 * j + 2] : o0[4 * j + 2]) * rinv * gv.z, a3 = (mt ? o1[4 * j + 3] : o0[4 * j + 3]) * rinv * gv.w;
            *(GAS v2u*)(dst + 32 * mt + 8 * j) = (v2u){cvtpk(a0, a1), cvtpk(a2, a3)}; }
    __syncthreads();
}
__device__ __forceinline__ void mem_item_mfma(Frame& F, const Ptrs& P, int b, int qb) {
    const int lane = F.lane, h = F.wave & 3, qg = F.wave >> 2, r32 = lane & 31, hi = lane >> 5;
    const size_t row = (size_t)b * SEQ + qb * 64 + qg * 32 + r32;
    LAS unsigned char* vl = F.lds + F.wave * VL_BYTES;
    LAS float* rk = (LAS float*)(F.lds + 8 * VL_BYTES + F.wave * 128);
    bf16x8 qf[4]; float qsc;
    { const bf16* qp = P.PROJ + row * INW + C_MQ + h * 64 + 8 * hi; float ssq = 0.f;
#pragma unroll
      for (int ks = 0; ks < 4; ++ks) { const v4u v = *(const GAS v4u*)(qp + 16 * ks); const unsigned w[4] = {v.x, v.y, v.z, v.w}; unsigned ow[4];
#pragma unroll
          for (int i = 0; i < 4; ++i) { const float a = bflo(w[i]), c = bfhi(w[i]); ssq += a * a + c * c; const int d = 16 * ks + 8 * hi + 2 * i;
              ow[i] = cvtpk(a * (P.q_norm_g[d] * P.k_norm_g[d]), c * (P.q_norm_g[d + 1] * P.k_norm_g[d + 1])); }
          qf[ks] = __builtin_bit_cast(bf16x8, (v4u){ow[0], ow[1], ow[2], ow[3]}); }
      float sh; const float sl = swap_lo(ssq, sh); qsc = 0.125f / sqrtf((sl + sh) * (1.f / 64.f) + EPS); }
    f32x16 o0, o1;
#pragma unroll
    for (int r = 0; r < 16; ++r) { o0[r] = 0.f; o1[r] = 0.f; }
    float mx = -1.0e30f, lsum = 0.f;
    const bf16* kbase = P.MKV + ((size_t)b * MEML + r32) * KVW + h * 64 + 8 * hi;
    const bf16* vbase = P.MKV + ((size_t)b * MEML + (lane >> 3)) * KVW + 256 + h * 64 + (lane & 7) * 8;
    for (int s0 = 0; s0 < MEML; s0 += 32) {
        bf16x8 kf[4]; v4u vp[4]; float kss = 0.f;
#pragma unroll
        for (int ks = 0; ks < 4; ++ks) { const v4u v = *(const GAS v4u*)(kbase + (size_t)s0 * KVW + 16 * ks); kf[ks] = __builtin_bit_cast(bf16x8, v);
            kss = dot2(v.x, v.x, kss); kss = dot2(v.y, v.y, kss); kss = dot2(v.z, v.z, kss); kss = dot2(v.w, v.w, kss); }
#pragma unroll
        for (int k = 0; k < 4; ++k) vp[k] = *(const GAS v4u*)(vbase + (size_t)(s0 + 8 * k) * KVW);
        { float sh; const float sl = swap_lo(kss, sh); kss = 1.f / sqrtf((sl + sh) * (1.f / 64.f) + EPS); }
        asm volatile("" ::: "memory");
        if (hi == 0) rk[r32] = kss;
#pragma unroll
        for (int k = 0; k < 4; ++k) *(LAS v4u*)(vl + ((lane >> 3) + 8 * k) * VSTR + (lane & 7) * 16) = vp[k];
        asm volatile("" ::: "memory");
        f32x16 s;
#pragma unroll
        for (int r = 0; r < 16; ++r) s[r] = 0.f;
#pragma unroll
        for (int ks = 0; ks < 4; ++ks) s = __builtin_amdgcn_mfma_f32_32x32x16_bf16(kf[ks], qf[ks], s, 0, 0, 0);
        float p[16]; float bm = -1.0e30f;
#pragma unroll
        for (int j = 0; j < 4; ++j) { const f32x4 rv = *(const LAS f32x4*)(rk + 8 * j + 4 * hi);
            p[4 * j] = s[4 * j] * qsc * rv.x; p[4 * j + 1] = s[4 * j + 1] * qsc * rv.y; p[4 * j + 2] = s[4 * j + 2] * qsc * rv.z; p[4 * j + 3] = s[4 * j + 3] * qsc * rv.w;
            bm = fmaxf(fmaxf(bm, fmaxf(p[4 * j], p[4 * j + 1])), fmaxf(p[4 * j + 2], p[4 * j + 3])); }
        { float bh; const float bl = swap_lo(bm, bh); bm = fmaxf(bl, bh); }
        const float mn = fmaxf(mx, bm), sc = __expf(mx - mn); mx = mn; lsum *= sc;
#pragma unroll
        for (int r = 0; r < 16; ++r) { o0[r] *= sc; o1[r] *= sc; p[r] = __expf(p[r] - mn); lsum += p[r]; }
        bf16x8 pf[2];
#pragma unroll
        for (int c = 0; c < 2; ++c) pf[c] = __builtin_bit_cast(bf16x8, (v4u){cvtpk(p[8 * c], p[8 * c + 1]), cvtpk(p[8 * c + 2], p[8 * c + 3]), cvtpk(p[8 * c + 4], p[8 * c + 5]), cvtpk(p[8 * c + 6], p[8 * c + 7])});
        bf16x8 vf[2][2];
        v_frags(vl, lane, vf);
        o0 = __builtin_amdgcn_mfma_f32_32x32x16_bf16(vf[0][0], pf[0], o0, 0, 0, 0); o0 = __builtin_amdgcn_mfma_f32_32x32x16_bf16(vf[0][1], pf[1], o0, 0, 0, 0);
        o1 = __builtin_amdgcn_mfma_f32_32x32x16_bf16(vf[1][0], pf[0], o1, 0, 0, 0); o1 = __builtin_amdgcn_mfma_f32_32x32x16_bf16(vf[1][1], pf[1], o1, 0, 0, 0);
        asm volatile("" ::: "memory");
    }
    { float lh; const float ll = swap_lo(lsum, lh); lsum = 1.f / (ll + lh); }
    float ss = 0.f;
#pragma unroll
    for (int r = 0; r < 16; ++r) { o0[r] *= lsum; o1[r] *= lsum; ss += o0[r] * o0[r] + o1[r] * o1[r]; }
    { float sh; const float sl = swap_lo(ss, sh); ss = sl + sh; }
    LAS float* xs = (LAS float*)(F.lds + EXTRA_OFF);
    if (hi == 0) xs[F.wave * 32 + r32] = ss;
    __syncthreads();
    float tot = 0.f;
#pragma unroll
    for (int w = 0; w < 4; ++w) tot += xs[(qg * 4 + w) * 32 + r32];
    const float rinv = 1.f / sqrtf(tot * (1.f / 256.f) + EPS);
    bf16* dst = P.CAT + row * D + 768 + h * 64 + 4 * hi; const float* gp = P.mem_out_g + h * 64 + 4 * hi;
#pragma unroll
    for (int mt = 0; mt < 2; ++mt)
#pragma unroll
        for (int j = 0; j < 4; ++j) { const f32x4 gv = *(const GAS f32x4*)(gp + 32 * mt + 8 * j);
            const float a0 = (mt ? o1[4 * j] : o0[4 * j]) * rinv * gv.x, a1 = (mt ? o1[4 * j + 1] : o0[4 * j + 1]) * rinv * gv.y, a2 = (mt ? o1[4 * j + 2] : o0[4 * j + 2]) * rinv * gv.z, a3 = (mt ? o1[4 * j + 3] : o0[4 * j + 3]) * rinv * gv.w;
            *(GAS v2u*)(dst + 32 * mt + 8 * j) = (v2u){cvtpk(a0, a1), cvtpk(a2, a3)}; }
    __syncthreads();
}

#define CE(a, b) { const float hi_ = fmaxf(a, b), lo_ = fminf(a, b); a = hi_; b = lo_; }
#define SORT16(V) do { CE(V[0], V[1]); CE(V[2], V[3]); CE(V[0], V[2]); CE(V[1], V[3]); CE(V[1], V[2]); CE(V[4], V[5]); CE(V[6], V[7]); CE(V[4], V[6]); CE(V[5], V[7]); CE(V[5], V[6]); CE(V[0], V[4]); CE(V[2], V[6]); CE(V[2], V[4]); CE(V[1], V[5]); CE(V[3], V[7]); CE(V[3], V[5]); CE(V[1], V[2]); CE(V[3], V[4]); CE(V[5], V[6]); CE(V[8], V[9]); CE(V[10], V[11]); CE(V[8], V[10]); CE(V[9], V[11]); CE(V[9], V[10]); CE(V[12], V[13]); CE(V[14], V[15]); CE(V[12], V[14]); CE(V[13], V[15]); CE(V[13], V[14]); CE(V[8], V[12]); CE(V[10], V[14]); CE(V[10], V[12]); CE(V[9], V[13]); CE(V[11], V[15]); CE(V[11], V[13]); CE(V[9], V[10]); CE(V[11], V[12]); CE(V[13], V[14]); CE(V[0], V[8]); CE(V[4], V[12]); CE(V[4], V[8]); CE(V[2], V[10]); CE(V[6], V[14]); CE(V[6], V[10]); CE(V[2], V[4]); CE(V[6], V[8]); CE(V[10], V[12]); CE(V[1], V[9]); CE(V[5], V[13]); CE(V[5], V[9]); CE(V[3], V[11]); CE(V[7], V[15]); CE(V[7], V[11]); CE(V[3], V[5]); CE(V[7], V[9]); CE(V[11], V[13]); CE(V[1], V[2]); CE(V[3], V[4]); CE(V[5], V[6]); CE(V[7], V[8]); CE(V[9], V[10]); CE(V[11], V[12]); CE(V[13], V[14]); } while (0)
#define BITONIC16(V) do { CE(V[0], V[8]); CE(V[1], V[9]); CE(V[2], V[10]); CE(V[3], V[11]); CE(V[4], V[12]); CE(V[5], V[13]); CE(V[6], V[14]); CE(V[7], V[15]); CE(V[0], V[4]); CE(V[1], V[5]); CE(V[2], V[6]); CE(V[3], V[7]); CE(V[8], V[12]); CE(V[9], V[13]); CE(V[10], V[14]); CE(V[11], V[15]); CE(V[0], V[2]); CE(V[1], V[3]); CE(V[4], V[6]); CE(V[5], V[7]); CE(V[8], V[10]); CE(V[9], V[11]); CE(V[12], V[14]); CE(V[13], V[15]); CE(V[0], V[1]); CE(V[2], V[3]); CE(V[4], V[5]); CE(V[6], V[7]); CE(V[8], V[9]); CE(V[10], V[11]); CE(V[12], V[13]); CE(V[14], V[15]); } while (0)
#define MERGE16(A, B) do { _Pragma("unroll") for (int i_ = 0; i_ < 16; ++i_) A[i_] = fmaxf(A[i_], B[15 - i_]); BITONIC16(A); } while (0)
constexpr int KSTR = 272;
constexpr int P5_KEYS2 = 128 * KSTR, P5_TAB = 2 * 128 * KSTR;
__device__ __forceinline__ void peer_top16(const LAS unsigned char* keysL, const bf16* qptr, int r32, int hi, float (&T)[16]) {
    bf16x8 qf[8];
#pragma unroll
    for (int ks = 0; ks < 8; ++ks) qf[ks] = *(const GAS bf16x8*)(qptr + 16 * ks);
    f32x16 acc[4];
#pragma unroll
    for (int mt = 0; mt < 4; ++mt)
#pragma unroll
        for (int r = 0; r < 16; ++r) acc[mt][r] = 0.f;
#pragma unroll
    for (int ks = 0; ks < 8; ++ks)
#pragma unroll
        for (int mt = 0; mt < 4; ++mt) { const bf16x8 a = *(const LAS bf16x8*)(keysL + (32 * mt + r32) * KSTR + (16 * ks + 8 * hi) * 2); acc[mt] = __builtin_amdgcn_mfma_f32_32x32x16_bf16(a, qf[ks], acc[mt], 0, 0, 0); }
    float v[4][16]; const unsigned hi4 = (unsigned)hi << 2;
#pragma unroll
    for (int mt = 0; mt < 4; ++mt)
#pragma unroll
        for (int r = 0; r < 16; ++r) v[mt][r] = __uint_as_float((__float_as_uint(acc[mt][r]) & 0xFFFFFF80u) | ((unsigned)(32 * mt + (r & 3) + 8 * (r >> 2)) | hi4));
    SORT16(v[0]); SORT16(v[1]); SORT16(v[2]); SORT16(v[3]);
    MERGE16(v[0], v[1]); MERGE16(v[2], v[3]); MERGE16(v[0], v[2]);
    float plo[16], phi[16];
#pragma unroll
    for (int i = 0; i < 16; ++i) plo[i] = swap_lo(v[0][i], phi[i]);
#pragma unroll
    for (int i = 0; i < 16; ++i) T[i] = fmaxf(plo[i], phi[15 - i]);
    BITONIC16(T);
}
__device__ __forceinline__ float pack8(float s, unsigned code) { return __uint_as_float((__float_as_uint(s) & 0xFFFFFF00u) | code); }
__device__ __forceinline__ void peer_select_mfma(Frame& F, const Ptrs& P, int tb, int h, bool load_keys) {
    LAS unsigned char* lds = F.lds; const int tid = F.tid, lane = F.lane, r32 = lane & 31, hi = lane >> 5;
    if (load_keys) {
        __syncthreads();
#pragma unroll
        for (int i = 0; i < 8; ++i) { const int c = tid + 512 * i; const int which = c >> 11, rem = c & 2047, n = rem >> 4, ch = rem & 15;
            *(LAS v4u*)(lds + which * P5_KEYS2 + n * KSTR + ch * 16) = *(const GAS v4u*)(P.KEYS + (size_t)which * 131072 + (size_t)h * 16384 + n * 128 + ch * 8); }
        __syncthreads();
    }
    const int tok = tb * 256 + F.wave * 32 + r32;
    const bf16* qrow = P.Q + (size_t)tok * PQW + h * 256 + 8 * hi;
    float T1[16], T2[16];
    peer_top16(lds, qrow, r32, hi, T1);
    peer_top16(lds + P5_KEYS2, qrow + 128, r32, hi, T2);
    LAS unsigned char* tabA = lds + P5_TAB + F.wave * 2048 + lane; LAS unsigned char* tabB = tabA + 1024;
#pragma unroll
    for (int i = 0; i < 16; ++i) { tabA[i * 64] = (unsigned char)(__float_as_uint(T1[i]) & 127u); tabB[i * 64] = (unsigned char)(__float_as_uint(T2[i]) & 127u); }
    float C0[16], X0[16], X1[16];
#pragma unroll
    for (int j = 0; j < 16; ++j) C0[j] = pack8(T1[0] + T2[j], (unsigned)j);
    {
        int n = 0;
#pragma unroll
        for (int i = 1; i < 14; ++i)
#pragma unroll
            for (int j = 0; j < 16; ++j) if ((i + 1) * (j + 1) <= 16) { const float c = pack8(T1[i] + T2[j], (unsigned)(i * 16 + j)); if (n < 16) X0[n] = c; else X1[n - 16] = c; ++n; }
    }
    SORT16(X0); SORT16(X1);
    MERGE16(X0, X1); MERGE16(C0, X0);
#pragma unroll
    for (int i = 14; i < 16; ++i) { float cv = pack8(T1[i] + T2[0], (unsigned)(i * 16));
#pragma unroll
        for (int p = 0; p < 16; ++p) { const float hi_ = fmaxf(C0[p], cv), lo_ = fminf(C0[p], cv); C0[p] = hi_; cv = lo_; } }
    float e[16], sum = 0.f;
#pragma unroll
    for (int p = 0; p < 16; ++p) { e[p] = __expf(C0[p] - C0[0]); sum += e[p]; }
    const float inv = 1.f / sum;
    if (hi == 0) {
        unsigned id[16];
#pragma unroll
        for (int p = 0; p < 16; ++p) { const unsigned code = __float_as_uint(C0[p]) & 255u; id[p] = (unsigned)tabA[(code >> 4) * 64] * 128u + (unsigned)tabB[(code & 15u) * 64]; }
        GAS v4u* di = (GAS v4u*)(P.SELI + ((size_t)tok * 8 + h) * 16);
#pragma unroll
        for (int j = 0; j < 4; ++j) di[j] = (v4u){id[4 * j], id[4 * j + 1], id[4 * j + 2], id[4 * j + 3]};
    } else {
        GAS f32x4* dg = (GAS f32x4*)(P.SELG + ((size_t)tok * 8 + h) * 16);
#pragma unroll
        for (int j = 0; j < 4; ++j) dg[j] = (f32x4){e[4 * j] * inv, e[4 * j + 1] * inv, e[4 * j + 2] * inv, e[4 * j + 3] * inv};
    }
}

typedef float f32x2 __attribute__((ext_vector_type(2)));
__device__ __forceinline__ float dpp_xor1(float x) { return __uint_as_float(__builtin_amdgcn_update_dpp(0u, __float_as_uint(x), 0xB1, 0xF, 0xF, true)); }
__device__ __forceinline__ float dpp_xor2(float x) { return __uint_as_float(__builtin_amdgcn_update_dpp(0u, __float_as_uint(x), 0x4E, 0xF, 0xF, true)); }
__device__ __forceinline__ float dpp_hmir(float x) { return __uint_as_float(__builtin_amdgcn_update_dpp(0u, __float_as_uint(x), 0x141, 0xF, 0xF, true)); }
__device__ __forceinline__ void asm_store_b64_nt(float* p, f32x2 v) { asm volatile("global_store_dwordx2 %0, %1, off nt" :: "v"(p), "v"(v) : "memory"); }
__device__ __forceinline__ void asm_store_b64(float* p, f32x2 v) { asm volatile("global_store_dwordx2 %0, %1, off" :: "v"(p), "v"(v) : "memory"); }
__device__ __forceinline__ float fp8_dot16(const v4u r, const f32x2 (&hh)[8]) {
    const unsigned w[4] = {r.x, r.y, r.z, r.w}; f32x2 d = {0.f, 0.f};
#pragma unroll
    for (int i = 0; i < 4; ++i) { d += __builtin_amdgcn_cvt_pk_f32_fp8(w[i], false) * hh[2 * i]; d += __builtin_amdgcn_cvt_pk_f32_fp8(w[i], true) * hh[2 * i + 1]; }
    return d.x + d.y;
}
__device__ __forceinline__ void peer_dots_phase(Frame& F, const Ptrs& P) {
    const int nsl = F.G >> 3; if ((int)blockIdx.x >= nsl * 8) return;
    const int sx = blockIdx.x & 7, rank = blockIdx.x >> 3, lane = F.lane, k = lane >> 3, c = lane & 7;
    const int tstride = nsl * NWAVES;
    const unsigned char* tab = P.UT + (size_t)sx * NEXP * 128 + 16 * c;
    LAS float* tl = (LAS float*)(F.lds + F.wave * 512);
    const GAS f32x4* gr = (const GAS f32x4*)(P.ffn_g + 128 * sx + 16 * c);
    f32x4 gv[4];
#pragma unroll
    for (int i = 0; i < 4; ++i) gv[i] = gr[i];
    int t = rank * NWAVES + F.wave;
    if (t >= M) return;
    int e0 = P.SELI[(size_t)t * 128 + lane], e1 = P.SELI[(size_t)t * 128 + 64 + lane];
    f32x4 xv[4]; float sq = __hip_atomic_load(P.SSQ2 + t, RLX_AGENT);
    { const GAS f32x4* xr = (const GAS f32x4*)(P.out + (size_t)t * D + 128 * sx + 16 * c);
#pragma unroll
      for (int i = 0; i < 4; ++i) xv[i] = xr[i]; }
    v4u ra[8], rb[8];
    asm volatile("" ::: "memory"); __builtin_amdgcn_sched_barrier(0);
#pragma unroll
    for (int i = 0; i < 8; ++i) { const int ej = __shfl(e0, 8 * i + k); ra[i] = *(const GAS v4u*)(tab + (size_t)ej * 128); }
    asm volatile("" ::: "memory"); __builtin_amdgcn_sched_barrier(0);
    for (; t < M; t += tstride) {
        const int tn = (t + tstride < M) ? t + tstride : t;
        f32x2 hh[8];
        { const float rs = 1.0f / sqrtf(sq * (1.0f / 1024.0f) + EPS);
#pragma unroll
          for (int i = 0; i < 4; ++i) { hh[2 * i] = (f32x2){xv[i].x * rs * gv[i].x, xv[i].y * rs * gv[i].y}; hh[2 * i + 1] = (f32x2){xv[i].z * rs * gv[i].z, xv[i].w * rs * gv[i].w}; } }
        __builtin_amdgcn_sched_barrier(0);
        const int ne0 = __builtin_nontemporal_load(P.SELI + (size_t)tn * 128 + lane), ne1 = __builtin_nontemporal_load(P.SELI + (size_t)tn * 128 + 64 + lane);
        sq = __hip_atomic_load(P.SSQ2 + tn, RLX_AGENT);
        { const GAS f32x4* xr = (const GAS f32x4*)(P.out + (size_t)tn * D + 128 * sx + 16 * c);
#pragma unroll
          for (int i = 0; i < 4; ++i) xv[i] = xr[i]; }
#pragma unroll
        for (int i = 0; i < 8; ++i) { const int ej = __shfl(e1, 8 * i + k); rb[i] = *(const GAS v4u*)(tab + (size_t)ej * 128); }
        asm volatile("" ::: "memory"); __builtin_amdgcn_sched_barrier(0);
        float res[16];
#pragma unroll
        for (int i = 0; i < 8; ++i) { float p = fp8_dot16(ra[i], hh); p += dpp_xor1(p); p += dpp_xor2(p); p += dpp_hmir(p); res[i] = p; }
        asm volatile("" ::: "memory"); __builtin_amdgcn_sched_barrier(0);
#pragma unroll
        for (int i = 0; i < 8; ++i) { const int ej = __shfl(ne0, 8 * i + k); ra[i] = *(const GAS v4u*)(tab + (size_t)ej * 128); }
        asm volatile("" ::: "memory"); __builtin_amdgcn_sched_barrier(0);
#pragma unroll
        for (int i = 0; i < 8; ++i) { float p = fp8_dot16(rb[i], hh); p += dpp_xor1(p); p += dpp_xor2(p); p += dpp_hmir(p); res[8 + i] = p; }
        __builtin_amdgcn_sched_barrier(0);
        if (c == 0) {
#pragma unroll
            for (int i = 0; i < 16; ++i) tl[8 * i + k] = res[i];
        }
        const f32x2 pv = *(const LAS f32x2*)(tl + 2 * lane);
        asm_store_b64_nt(P.PART + ((size_t)sx * M + t) * 128 + 2 * lane, pv);
        e0 = ne0; e1 = ne1;
    }
}
__device__ __forceinline__ void peer_act_phase(Frame& F, const Ptrs& P) {
    const size_t n4 = (size_t)M * 128 / 4, nthr = (size_t)F.G * NWAVES * 64;
    for (size_t i = (size_t)blockIdx.x * (NWAVES * 64) + F.tid; i < n4; i += nthr) {
        f32x4 d = ((const GAS f32x4*)P.PART)[i];
#pragma unroll
        for (int sx = 1; sx < 8; ++sx) d += ((const GAS f32x4*)(P.PART + (size_t)sx * M * 128))[i];
        const v4u e = ((const GAS v4u*)P.SELI)[i]; const f32x4 g = ((const GAS f32x4*)P.SELG)[i];
        const unsigned ee[4] = {e.x, e.y, e.z, e.w}; const float dd[4] = {d.x, d.y, d.z, d.w}, gg[4] = {g.x, g.y, g.z, g.w}; float w[4];
#pragma unroll
        for (int q = 0; q < 4; ++q) { const float dot = dd[q] * P.USC[ee[q]]; w[q] = 0.5f * dot * (1.f + erff(dot * 0.70710678118654752f)) * gg[q] * P.VSC[ee[q]]; }
        ((GAS f32x4*)P.W)[i] = (f32x4){w[0], w[1], w[2], w[3]};
    }
}
__device__ __forceinline__ void fp8_axpy16(const v4u r, const float w, f32x2 (&acc)[8]) {
    const unsigned ww[4] = {r.x, r.y, r.z, r.w};
#pragma unroll
    for (int i = 0; i < 4; ++i) { acc[2 * i] += __builtin_amdgcn_cvt_pk_f32_fp8(ww[i], false) * w; acc[2 * i + 1] += __builtin_amdgcn_cvt_pk_f32_fp8(ww[i], true) * w; }
}
__device__ __forceinline__ void peer_accum_phase(Frame& F, const Ptrs& P) {
    const int nsl = F.G >> 3; if ((int)blockIdx.x >= nsl * 8) return;
    const int sx = blockIdx.x & 7, rank = blockIdx.x >> 3, lane = F.lane, k = lane >> 3, c = lane & 7;
    const int tstride = nsl * NWAVES;
    const unsigned char* tab = P.VT + (size_t)sx * NEXP * 128 + 16 * c;
    const bool h5 = (lane & 32) != 0, h4 = (lane & 16) != 0, h3 = (lane & 8) != 0;
    const int chan = 128 * sx + 16 * c + 8 * (h5 ? 1 : 0) + 4 * (h4 ? 1 : 0) + 2 * (h3 ? 1 : 0);
    int t = rank * NWAVES + F.wave;
    if (t >= M) return;
    int e0 = P.SELI[(size_t)t * 128 + lane], e1 = P.SELI[(size_t)t * 128 + 64 + lane];
    float w0 = P.W[(size_t)t * 128 + lane], w1 = P.W[(size_t)t * 128 + 64 + lane];
    f32x2 xres = *(const GAS f32x2*)(P.out + (size_t)t * D + chan);
    v4u ra[8], rb[8];
    asm volatile("" ::: "memory"); __builtin_amdgcn_sched_barrier(0);
#pragma unroll
    for (int i = 0; i < 8; ++i) { const int ej = __shfl(e0, 8 * i + k); ra[i] = *(const GAS v4u*)(tab + (size_t)ej * 128); }
    asm volatile("" ::: "memory"); __builtin_amdgcn_sched_barrier(0);
    for (; t < M; t += tstride) {
        const int tn = (t + tstride < M) ? t + tstride : t;
        const int ne0 = __builtin_nontemporal_load(P.SELI + (size_t)tn * 128 + lane), ne1 = __builtin_nontemporal_load(P.SELI + (size_t)tn * 128 + 64 + lane);
        const float nw0 = __builtin_nontemporal_load(P.W + (size_t)tn * 128 + lane), nw1 = __builtin_nontemporal_load(P.W + (size_t)tn * 128 + 64 + lane);
        const f32x2 nx = __builtin_nontemporal_load((const f32x2*)(P.out + (size_t)tn * D + chan));
#pragma unroll
        for (int i = 0; i < 8; ++i) { const int ej = __shfl(e1, 8 * i + k); rb[i] = *(const GAS v4u*)(tab + (size_t)ej * 128); }
        asm volatile("" ::: "memory"); __builtin_amdgcn_sched_barrier(0);
        f32x2 acc[8];
#pragma unroll
        for (int i = 0; i < 8; ++i) acc[i] = (f32x2){0.f, 0.f};
#pragma unroll
        for (int i = 0; i < 8; ++i) fp8_axpy16(ra[i], __shfl(w0, 8 * i + k), acc);
        asm volatile("" ::: "memory"); __builtin_amdgcn_sched_barrier(0);
#pragma unroll
        for (int i = 0; i < 8; ++i) { const int ej = __shfl(ne0, 8 * i + k); ra[i] = *(const GAS v4u*)(tab + (size_t)ej * 128); }
        asm volatile("" ::: "memory"); __builtin_amdgcn_sched_barrier(0);
#pragma unroll
        for (int i = 0; i < 8; ++i) fp8_axpy16(rb[i], __shfl(w1, 8 * i + k), acc);
        __builtin_amdgcn_sched_barrier(0);
        f32x2 b4[4], b2[2], b1;
#pragma unroll
        for (int i = 0; i < 4; ++i) { const f32x2 keep = h5 ? acc[4 + i] : acc[i], send = h5 ? acc[i] : acc[4 + i]; b4[i] = (f32x2){keep.x + __shfl_xor(send.x, 32), keep.y + __shfl_xor(send.y, 32)}; }
#pragma unroll
        for (int i = 0; i < 2; ++i) { const f32x2 keep = h4 ? b4[2 + i] : b4[i], send = h4 ? b4[i] : b4[2 + i]; b2[i] = (f32x2){keep.x + __shfl_xor(send.x, 16), keep.y + __shfl_xor(send.y, 16)}; }
        { const f32x2 keep = h3 ? b2[1] : b2[0], send = h3 ? b2[0] : b2[1]; b1 = (f32x2){keep.x + __shfl_xor(send.x, 8), keep.y + __shfl_xor(send.y, 8)}; }
        asm_store_b64_nt(P.out + (size_t)t * D + chan, xres + b1);
        e0 = ne0; e1 = ne1; w0 = nw0; w1 = nw1; xres = nx;
    }
}

struct Args { const float* in[21]; float* out; unsigned char* ws; int ph_lo, ph_hi, li, pad; };
__device__ __forceinline__ Ptrs make_ptrs(const Args& args) {
    unsigned char* ws = args.ws;
    Ptrs P;
    P.x = args.in[0]; P.mem = args.in[1]; P.attn_g = args.in[2]; P.w_in = args.in[3]; P.conv_w = args.in[4]; P.conv_b = args.in[5]; P.conv_ln_g = args.in[6]; P.conv_ln_b = args.in[7];
    P.sb_out_g = args.in[8]; P.mem_norm_g = args.in[9]; P.w_mem_kv = args.in[10]; P.q_norm_g = args.in[11]; P.k_norm_g = args.in[12]; P.mem_out_g = args.in[13]; P.w_out = args.in[14];
    P.ffn_g = args.in[15]; P.w_peer_q = args.in[16]; P.keys1 = args.in[17]; P.keys2 = args.in[18]; P.peer_u = args.in[19]; P.peer_v = args.in[20];
    P.out = args.out;
    P.WIN = (bf16*)(ws + WS_WIN); P.WKV = (bf16*)(ws + WS_WKV); P.WOUT = (bf16*)(ws + WS_WOUT); P.WPQ = (bf16*)(ws + WS_WPQ); P.KEYS = (bf16*)(ws + WS_KEYS);
    P.MEMN = (bf16*)(ws + WS_MEMN); P.MKV = (bf16*)(ws + WS_MKV); P.UT = ws + WS_UT; P.VT = ws + WS_VT; P.PART = (float*)(ws + WS_PROJ); P.W = (float*)(ws + WS_CAT); P.USC = (float*)(ws + WS_SC); P.VSC = (float*)(ws + WS_SC) + NEXP; P.XN = (bf16*)(ws + WS_XN); P.CAT = (bf16*)(ws + WS_CAT);
    P.PROJ = (bf16*)(ws + WS_PROJ); P.Q = (bf16*)(ws + WS_Q); P.SELI = (int*)(ws + WS_SELI); P.SELG = (float*)(ws + WS_SELG); P.SSQ2 = (float*)(ws + WS_CTL) + CW_SSQ2;
    return P;
}
__global__ void __launch_bounds__(NWAVES * 64, 2) fwd_kernel(Args args) {
    extern __shared__ __attribute__((aligned(16))) unsigned char lds[];
    Frame F;
    F.lds = (LAS unsigned char*)lds;
    F.MISC = (volatile LAS unsigned*)(F.lds + MISC_OFF);
    F.tid = threadIdx.x; F.lane = F.tid & 63; F.wave = __builtin_amdgcn_readfirstlane(F.tid >> 6);
    F.G = gridDim.x; { const int bx = blockIdx.x; F.vcu = (F.G % 8 == 0) ? (bx % 8) * (F.G / 8) + bx / 8 : bx; }
    unsigned char* ws = args.ws;
    F.ctl = (gu32*)(ws + WS_CTL);
    for (int u = F.tid; u < (LDS_BYTES - LDSCTL_OFF) / 4; u += NWAVES * 64) ((LAS unsigned*)(F.lds + LDSCTL_OFF))[u] = 0u;
    __syncthreads();
    XcdBarrier bar; bar.bar = (unsigned*)(F.ctl + CW_BAR); bar.x = 0; bar.st = nullptr;
    if (N_LAUNCHES != PER_PHASE) bar = xcd_barrier_post((unsigned*)(F.ctl + CW_BAR), F.MISC + 8);
#define GRID_BAR() do { if (N_LAUNCHES != PER_PHASE) xcd_barrier(bar); } while (0)
    const int lo = args.ph_lo, hi = args.ph_hi;
#define IN(k) (lo <= (k) && (k) < hi)
#define BOTH(k) (IN(k) && IN((k) + 1))

    if (IN(0)) { const Ptrs P = make_ptrs(args); for (int rep = 0; rep < (PROBE_DBL == 0 ? 2 : 1); ++rep) p0_prologue(F, P); if (BOTH(0)) GRID_BAR(); }

    if (IN(1)) { const Ptrs P = make_ptrs(args);
        { pg8::Gemm g{P.XN, P.WIN, M, INW, D}; pg8::StaticOrder S; S.init(M, INW, F.G, (int)blockIdx.x);
          pg8::EpiBf16 E{P.PROJ, INW};
          for (int rep = 0; rep < (PROBE_DBL == 1 ? 2 : 1); ++rep)
          pg8::gemm_phase<pg8::EpiBf16, pg8::StaticOrder, PG8_ALIGN, PG8_SP2>(F.lds + RING_OFF, g, S, E); }
        { pg8::Gemm g{P.MEMN, P.WKV, MMEM, KVW, D}; pg8::StaticOrder S; S.init(MMEM, KVW, F.G, (int)((blockIdx.x + (unsigned)(F.G / 2)) % (unsigned)F.G));
          pg8::EpiBf16 E{P.MKV, KVW};
          pg8::gemm_phase<pg8::EpiBf16, pg8::StaticOrder, PG8_ALIGN, PG8_SP2>(F.lds + RING_OFF, g, S, E); }
        if (BOTH(1)) GRID_BAR();
    }

    if (IN(2)) { const Ptrs P = make_ptrs(args);
        const int c = F.vcu;
        for (int rep = 0; rep < (PROBE_DBL == 2 ? 2 : 1); ++rep) {
        for (int it = c; it < BATCH * (SEQ / 32); it += F.G) sb_item_mfma(F, P, it >> 7, it & 127);
        for (int it = c; it < BATCH * (SEQ / 64); it += F.G) mem_item_mfma(F, P, it >> 6, it & 63);
        __syncthreads();
        for (int it = c; it < BATCH * (SEQ / 32); it += F.G) { conv_item(F, P, it / (SEQ / 32), it % (SEQ / 32)); }
        __syncthreads();
        }
        if (BOTH(2)) GRID_BAR();
    }

    if (IN(3)) { const Ptrs P = make_ptrs(args);
        pg8::Gemm g{P.CAT, P.WOUT, M, D, D}; pg8::StaticOrder S; S.init(M, D, F.G, (int)blockIdx.x);
        pg8::EpiResid E{P.x, P.out, P.XN, P.SSQ2, D};
        pg8::gemm_phase<pg8::EpiResid, pg8::StaticOrder, PG8_ALIGN, PG8_SP2>(F.lds + RING_OFF, g, S, E);
        if (BOTH(3)) GRID_BAR();
    }

    if (IN(4)) { const Ptrs P = make_ptrs(args);
        pg8::Gemm g{P.XN, P.WPQ, M, PQW, D}; pg8::StaticOrder S; S.init(M, PQW, F.G, (int)blockIdx.x);
        pg8::EpiBf16Row E{P.Q, PQW, P.SSQ2};
        for (int rep = 0; rep < (PROBE_DBL == 4 ? 2 : 1); ++rep)
        pg8::gemm_phase<pg8::EpiBf16Row, pg8::StaticOrder, PG8_ALIGN, PG8_SP2>(F.lds + RING_OFF, g, S, E);
        asm volatile("s_waitcnt vmcnt(0)" ::: "memory");
        __builtin_amdgcn_fence(__ATOMIC_ACQUIRE, "agent");
        asm volatile("s_waitcnt vmcnt(0)" ::: "memory");
        __syncthreads();
        for (int rep = 0; rep < (PROBE_DBL == 5 ? 2 : 1); ++rep) { pg8::Unit u; for (int i = 0; S.next(i, u); ++i) peer_select_mfma(F, P, u.pm, u.pn, true); }
        __syncthreads();
        if (BOTH(4)) GRID_BAR();
    }
    if (IN(6)) { const Ptrs P = make_ptrs(args); for (int rep = 0; rep < (PROBE_DBL == 6 ? 2 : 1); ++rep) peer_dots_phase(F, P); if (BOTH(6)) GRID_BAR(); }
    if (IN(7)) { const Ptrs P = make_ptrs(args); for (int rep = 0; rep < (PROBE_DBL == 7 ? 2 : 1); ++rep) peer_act_phase(F, P); if (BOTH(7)) GRID_BAR(); }
    if (IN(8)) { const Ptrs P = make_ptrs(args); peer_accum_phase(F, P);
        if (PROBE_DBL == 8) { GRID_BAR(); for (size_t i = (size_t)blockIdx.x * 512 + F.tid; i < (size_t)M * 32; i += (size_t)F.G * 512) ((GAS f32x4*)P.W)[i] = (f32x4){0.f, 0.f, 0.f, 0.f}; GRID_BAR(); peer_accum_phase(F, P); } }
#undef IN
#undef BOTH
}

extern "C" void kernel_launch(void* const* d_in, const int* in_sizes, int n_in, void* d_out, int out_size, void* d_ws, size_t ws_size, hipStream_t stream) {
    static int grid = 0;
    if (grid == 0) {
        if (n_in != 21 || in_sizes[0] != M * D || out_size != M * D || ws_size < WS_END) { fprintf(stderr, "kernel_launch: unexpected shapes/workspace (n_in %d, in0 %d, out %d, ws %zu); nothing launched\n", n_in, n_in > 0 ? in_sizes[0] : -1, out_size, ws_size); grid = -1; return; }
        int dev = 0, cus = 0, per_cu = 0;
        if (hipGetDevice(&dev) != hipSuccess || hipDeviceGetAttribute(&cus, hipDeviceAttributeMultiprocessorCount, dev) != hipSuccess) { grid = -1; return; }
        if (hipFuncSetAttribute((const void*)fwd_kernel, hipFuncAttributeMaxDynamicSharedMemorySize, LDS_BYTES) != hipSuccess) { fprintf(stderr, "kernel_launch: hipFuncSetAttribute failed\n"); grid = -1; return; }
        if (hipOccupancyMaxActiveBlocksPerMultiprocessor(&per_cu, (const void*)fwd_kernel, NWAVES * 64, LDS_BYTES) != hipSuccess || per_cu < 1) { fprintf(stderr, "kernel_launch: occupancy query says %d blocks per CU\n", per_cu); }
        (void)hipGetLastError();
        grid = cus;
    }
    if (grid < 0) return;
    if (hipMemsetAsync((char*)d_ws + WS_CTL, 0, CTL_ZERO_BYTES, stream) != hipSuccess) { fprintf(stderr, "kernel_launch: memset failed\n"); return; }
    Args a{};
    for (int i = 0; i < 21; ++i) a.in[i] = (const float*)d_in[i];
    a.out = (float*)d_out; a.ws = (unsigned char*)d_ws;
    for (int li = 0; li < N_LAUNCHES; ++li) {
        a.ph_lo = (N_LAUNCHES == PER_PHASE) ? li : 0; a.ph_hi = (N_LAUNCHES == PER_PHASE) ? li + 1 : PER_PHASE; a.li = li;
        hipLaunchKernelGGL(fwd_kernel, dim3(grid), dim3(NWAVES * 64), LDS_BYTES, stream, a);
        const hipError_t le = hipPeekAtLastError();
        if (le != hipSuccess) { fprintf(stderr, "kernel_launch: launch %d failed: %s\n", li, hipGetErrorName(le)); break; }
    }
}
```

```cpp
#include <hip/hip_runtime.h>
#include <cstdio>
#include <cstdint>
namespace pg8 {
#define PG8_LAS __attribute__((address_space(3)))
typedef unsigned short bf16_t;
typedef short bf16x8 __attribute__((ext_vector_type(8)));
typedef float f32x4 __attribute__((ext_vector_type(4)));
typedef unsigned u32x4 __attribute__((ext_vector_type(4)));
constexpr int BM = 256, BK = 64, HALF = 128, HTB = HALF * BK * 2  , STAGE_BYTES = 8 * HTB, NXCD = 8, WGM = 8;

__host__ __device__ __forceinline__ int lds_byte(int r, int c) { const int st = (r >> 4) * 2 + (c >> 5), rr = r & 15, cc = c & 31, ob = rr * 64 + cc * 2; return st * 1024 + (ob ^ (((ob >> 9) & 1) << 5)); }
__host__ __device__ __forceinline__ void stage_rc(int b, int& R, int& C) { const int st = b / 1024, sb = b % 1024, swz = sb ^ (((sb >> 9) & 1) << 5); R = (st >> 1) * 16 + swz / 64; C = (st & 1) * 32 + (swz % 64) / 2; }
__host__ __device__ __forceinline__ int perm32(int rho) { const int n = rho >> 4, i = rho & 15; return 8 * (i >> 2) + 4 * n + (i & 3); }

struct Unit { int pm, pn; };
struct Gemm { const bf16_t* A; const bf16_t* Bt; int M, N, K; };

struct StaticOrder {
    int nM, nN, nwg, G, c;
    __host__ __device__ void init(int M, int N, int G_, int c_) { nM = M / BM; nN = N / BM; nwg = nM * nN; G = G_; c = c_; }
    __host__ __device__ bool next(int i, Unit& u) const {
        const long L = (long)i * G + c; if (L >= nwg) return false;
        int wgid = (int)L; { const int q = nwg / NXCD, r = nwg % NXCD, xcd = wgid % NXCD, off = wgid / NXCD; wgid = (xcd < r ? xcd * (q + 1) : r * (q + 1) + (xcd - r) * q) + off; }
        const int nig = WGM * nN, gid = wgid / nig, fm = gid * WGM, gsz = (nM - fm) < WGM ? (nM - fm) : WGM;
        u.pm = fm + ((wgid % nig) % gsz); u.pn = (wgid % nig) / gsz; return true;
    }
    __device__ __forceinline__ void a_ready(const Unit&) const {}
    __device__ __forceinline__ void done(const Unit&) const {}
};

__device__ __forceinline__ unsigned cvt_pk_bf16(float lo, float hi) { unsigned r; asm volatile("v_cvt_pk_bf16_f32 %0, %1, %2" : "=v"(r) : "v"(lo), "v"(hi)); return r; }
typedef unsigned u32x2 __attribute__((ext_vector_type(2)));

struct EpiBf16 {
    static constexpr bool PERM = true, AFTER_DRAIN = false;
    bf16_t* O; int ldc;
    __device__ __forceinline__ void operator()(const f32x4 (&acc)[2][2][4][2], const Unit& u, int wr, int wc, int fr, int fq) const {
        const int row0 = u.pm * BM + wr * 64 + fr; const int col0 = u.pn * BM + wc * 32 + 8 * fq;
#pragma unroll
        for (int ai = 0; ai < 2; ++ai)
#pragma unroll
            for (int m = 0; m < 4; ++m) { bf16_t* rowp = O + (size_t)(row0 + ai * HALF + m * 16) * ldc + col0;
#pragma unroll
                for (int bj = 0; bj < 2; ++bj) { const f32x4 v0 = acc[ai][bj][m][0], v1 = acc[ai][bj][m][1];
                    u32x4 w; w.x = cvt_pk_bf16(v0[0], v0[1]); w.y = cvt_pk_bf16(v0[2], v0[3]); w.z = cvt_pk_bf16(v1[0], v1[1]); w.w = cvt_pk_bf16(v1[2], v1[3]);
                    *(u32x4*)(rowp + bj * HALF) = w; } }
    }
};
struct EpiBf16Row {
    static constexpr bool PERM = true, AFTER_DRAIN = false;
    bf16_t* O; int ldc; const unsigned long long* ssq;
    __device__ __forceinline__ void operator()(const f32x4 (&acc)[2][2][4][2], const Unit& u, int wr, int wc, int fr, int fq) const {
        const int row0 = u.pm * BM + wr * 64 + fr; const int col0 = u.pn * BM + wc * 32 + 8 * fq;
#pragma unroll
        for (int ai = 0; ai < 2; ++ai)
#pragma unroll
            for (int m = 0; m < 4; ++m) { const int row = row0 + ai * HALF + m * 16; bf16_t* rowp = O + (size_t)row * ldc + col0;
                const float rs = 1.0f / sqrtf((float)((double)__hip_atomic_load(ssq + row, __ATOMIC_RELAXED, __HIP_MEMORY_SCOPE_AGENT) * 2.3283064365386963e-10) * (1.0f / 1024.0f) + 1e-6f);
#pragma unroll
                for (int bj = 0; bj < 2; ++bj) { const f32x4 v0 = acc[ai][bj][m][0] * rs, v1 = acc[ai][bj][m][1] * rs;
                    u32x4 w; w.x = cvt_pk_bf16(v0[0], v0[1]); w.y = cvt_pk_bf16(v0[2], v0[3]); w.z = cvt_pk_bf16(v1[0], v1[1]); w.w = cvt_pk_bf16(v1[2], v1[3]);
                    *(u32x4*)(rowp + bj * HALF) = w; } }
    }
};
struct EpiBf16RowQ {
    static constexpr bool PERM = true, AFTER_DRAIN = false;
    bf16_t* O; int ldc; const unsigned long long* ssq;
    __device__ __forceinline__ void operator()(const f32x4 (&acc)[2][2][4][2], const Unit& u, int wr, int wc, int fr, int fq) const {
        const int row0 = u.pm * BM + wr * 64 + fr;
        u32x4* blk = (u32x4*)O + ((size_t)u.pm * (ldc / BM) + u.pn) * 8192;
        unsigned long long sq[2][4];
#pragma unroll
        for (int ai = 0; ai < 2; ++ai)
#pragma unroll
            for (int m = 0; m < 4; ++m) sq[ai][m] = __builtin_nontemporal_load(ssq + row0 + ai * HALF + m * 16);
#pragma unroll
        for (int ai = 0; ai < 2; ++ai)
#pragma unroll
            for (int m = 0; m < 4; ++m) {
                const float rs = 1.0f / sqrtf((float)((double)sq[ai][m] * 2.3283064365386963e-10) * (1.0f / 1024.0f) + 1e-6f);
#pragma unroll
                for (int bj = 0; bj < 2; ++bj) { const f32x4 v0 = acc[ai][bj][m][0] * rs, v1 = acc[ai][bj][m][1] * rs;
                    u32x4 w; w.x = cvt_pk_bf16(v0[0], v0[1]); w.y = cvt_pk_bf16(v0[2], v0[3]); w.z = cvt_pk_bf16(v1[0], v1[1]); w.w = cvt_pk_bf16(v1[2], v1[3]);
                    blk[((((bj * 8 + (ai * 4 + wr * 2 + (m >> 1))) * 8 + (2 * wc + (fq >> 1))) * 2 + (fq & 1)) * 32) + ((m & 1) * 16 + fr)] = w; } }
    }
};
struct EpiBf16K {
    static constexpr bool PERM = true, AFTER_DRAIN = false;
    bf16_t* O; int ldc; bf16_t* KF; int pn_lo, pn_hi, NH;
    __device__ __forceinline__ void operator()(const f32x4 (&acc)[2][2][4][2], const Unit& u, int wr, int wc, int fr, int fq) const {
        const int row0 = u.pm * BM + wr * 64 + fr; const int col0 = u.pn * BM + wc * 32 + 8 * fq;
        const bool isk = u.pn >= pn_lo && u.pn <= pn_hi;
#pragma unroll
        for (int ai = 0; ai < 2; ++ai)
#pragma unroll
            for (int m = 0; m < 4; ++m) { bf16_t* rowp = O + (size_t)(row0 + ai * HALF + m * 16) * ldc + col0;
#pragma unroll
                for (int bj = 0; bj < 2; ++bj) { const f32x4 v0 = acc[ai][bj][m][0], v1 = acc[ai][bj][m][1];
                    u32x4 w; w.x = cvt_pk_bf16(v0[0], v0[1]); w.y = cvt_pk_bf16(v0[2], v0[3]); w.z = cvt_pk_bf16(v1[0], v1[1]); w.w = cvt_pk_bf16(v1[2], v1[3]);
                    if (isk) { const size_t kt = (size_t)u.pm * 8 + ai * 4 + wr * 2 + (m >> 1); const int h = (u.pn - pn_lo) * 4 + 2 * bj + (wc >> 1), ks = 2 * (wc & 1) + (fq >> 1);
                        ((u32x4*)KF)[(((kt * NH + h) * 4 + ks) * 2 + (fq & 1)) * 32 + ((m & 1) * 16 + fr)] = w; }
                    else *(u32x4*)(rowp + bj * HALF) = w; } }
    }
};
struct EpiResid {
    static constexpr bool PERM = true, AFTER_DRAIN = false;
    const float* x; bf16_t* xb; unsigned long long* ssq; int ldc;
    __device__ __forceinline__ void operator()(const f32x4 (&acc)[2][2][4][2], const Unit& u, int wr, int wc, int fr, int fq) const {
        const int col0 = u.pn * BM + wc * 32 + 8 * fq;
#pragma unroll
        for (int ai = 0; ai < 2; ++ai)
#pragma unroll
            for (int m = 0; m < 4; ++m) { const int row = u.pm * BM + ai * HALF + wr * 64 + m * 16 + fr; const size_t off = (size_t)row * ldc + col0; float s = 0.f;
#pragma unroll
                for (int bj = 0; bj < 2; ++bj) { const f32x4 x0 = *(const f32x4*)(x + off + bj * HALF), x1 = *(const f32x4*)(x + off + bj * HALF + 4);
                    const f32x4 o0 = x0 + acc[ai][bj][m][0], o1 = x1 + acc[ai][bj][m][1];
                    s += ((o0[0] * o0[0] + o0[1] * o0[1]) + (o0[2] * o0[2] + o0[3] * o0[3])) + ((o1[0] * o1[0] + o1[1] * o1[1]) + (o1[2] * o1[2] + o1[3] * o1[3]));
                    u32x4 w; w.x = cvt_pk_bf16(o0[0], o0[1]); w.y = cvt_pk_bf16(o0[2], o0[3]); w.z = cvt_pk_bf16(o1[0], o1[1]); w.w = cvt_pk_bf16(o1[2], o1[3]);
                    *(u32x4*)(xb + off + bj * HALF) = w; }
                s += __shfl_xor(s, 16); s += __shfl_xor(s, 32);
                if (fq == 0) atomicAdd(ssq + row, (unsigned long long)((double)s * 4294967296.0)); }
    }
};

template <class Epi, class Sched, bool ALIGN_EPI = false, bool SP2 = false>
__device__ __forceinline__ void gemm_phase(PG8_LAS unsigned char* lds, const Gemm g, const Sched& S, const Epi& E) {
    const int tid = threadIdx.x, wid = __builtin_amdgcn_readfirstlane(tid >> 6), lane = tid & 63, wr = wid >> 2, wc = wid & 3, fr = lane & 15, fq = lane >> 4;
    const int K = g.K, nt = K / BK;
    unsigned voffA[2], voffB[2];
#pragma unroll
    for (int i = 0; i < 2; ++i) { int R, C; stage_rc(tid * 16 + i * 8192, R, C); const int Rb = Epi::PERM ? ((R & ~31) + perm32(R & 31)) : R;
        voffA[i] = (unsigned)(R * K + C) * 2u; voffB[i] = (unsigned)(Rb * K + C) * 2u; }
    const size_t kstep = (size_t)(BK * 2);
    const size_t hstep = (size_t)HALF * K * 2;
    const size_t tstep = 2 * hstep;
    const unsigned ldsw = (unsigned)wid * 1024u;
    const int aoff = lds_byte(wr * 64 + fr, fq * 8), boff = lds_byte(wc * 32 + fr, fq * 8);
#define PG8_SA(b, h) (((b) * 2 + (h)) * HTB)
#define PG8_SB(b, h) ((4 + (b) * 2 + (h)) * HTB)
#define PG8_STAGE(bufoff, gbase, voff) do { _Pragma("unroll") for (int _i = 0; _i < 2; ++_i) \
        __builtin_amdgcn_global_load_lds((const unsigned*)((const char*)(gbase) + (voff)[_i]), (PG8_LAS unsigned*)(lds + (bufoff) + ldsw + _i * 8192), 16, 0, 0); } while (0)
#define PG8_LDA(dst, b, h) do { _Pragma("unroll") for (int m = 0; m < 4; ++m) _Pragma("unroll") for (int k = 0; k < 2; ++k) dst[m][k] = *(const PG8_LAS bf16x8*)(lds + PG8_SA(b, h) + aoff + m * 2048 + k * 1024); } while (0)
#define PG8_LDB(dst, b, h) do { _Pragma("unroll") for (int n = 0; n < 2; ++n) _Pragma("unroll") for (int k = 0; k < 2; ++k) dst[n][k] = *(const PG8_LAS bf16x8*)(lds + PG8_SB(b, h) + boff + n * 2048 + k * 1024); } while (0)
#define PG8_MMA(ai, bj, At, Bt) do { __builtin_amdgcn_s_setprio(1); _Pragma("unroll") for (int m = 0; m < 4; ++m) _Pragma("unroll") for (int n = 0; n < 2; ++n) _Pragma("unroll") for (int k = 0; k < 2; ++k) \
        acc[ai][bj][m][n] = __builtin_amdgcn_mfma_f32_16x16x32_bf16(Bt[n][k], At[m][k], acc[ai][bj][m][n], 0, 0, 0); __builtin_amdgcn_s_setprio(0); } while (0)
#define PG8_WAIT_V(n) asm volatile("s_waitcnt vmcnt(" #n ")" ::: "memory")
#define PG8_WAIT_L(n) asm volatile("s_waitcnt lgkmcnt(" #n ")" ::: "memory")
#define PG8_BAR __builtin_amdgcn_s_barrier()
#define PG8_SCHED __builtin_amdgcn_sched_barrier(0)
    Unit cur, nxt; int ui = 0;
    if (!S.next(0, cur)) return;
    f32x4 acc[2][2][4][2];
#pragma unroll
    for (int a = 0; a < 2; ++a)
#pragma unroll
        for (int b = 0; b < 2; ++b)
#pragma unroll
            for (int m = 0; m < 4; ++m)
#pragma unroll
                for (int n = 0; n < 2; ++n) acc[a][b][m][n] = (f32x4){0.f, 0.f, 0.f, 0.f};
    bf16x8 At[4][2], B0[2][2], B1[2][2];
    const char* cA = (const char*)g.A + (size_t)cur.pm * tstep; const char* cB = (const char*)g.Bt + (size_t)cur.pn * tstep;
    S.a_ready(cur);
    if constexpr (SP2) {
        PG8_STAGE(PG8_SB(0, 0), cB, voffB); PG8_STAGE(PG8_SB(0, 1), cB + hstep, voffB); PG8_STAGE(PG8_SA(0, 0), cA, voffA); PG8_STAGE(PG8_SA(0, 1), cA + hstep, voffA);
        if (wr == 1) PG8_BAR;
        PG8_WAIT_V(2); PG8_BAR;
        PG8_STAGE(PG8_SB(1, 0), cB + kstep, voffB); PG8_STAGE(PG8_SA(1, 0), cA + kstep, voffA); PG8_STAGE(PG8_SB(1, 1), cB + hstep + kstep, voffB);
        PG8_WAIT_V(6); PG8_BAR;
    } else {
        PG8_STAGE(PG8_SB(0, 0), cB, voffB); PG8_STAGE(PG8_SA(0, 0), cA, voffA); PG8_STAGE(PG8_SB(0, 1), cB + hstep, voffB); PG8_STAGE(PG8_SA(0, 1), cA + hstep, voffA);
        if (wr == 1) PG8_BAR;
        PG8_WAIT_V(4); PG8_BAR;
        PG8_STAGE(PG8_SB(1, 0), cB + kstep, voffB); PG8_STAGE(PG8_SA(1, 0), cA + kstep, voffA); PG8_STAGE(PG8_SB(1, 1), cB + hstep + kstep, voffB);
        PG8_WAIT_V(6); PG8_BAR;
    }
    for (;;) {
        const bool has_next = S.next(ui + 1, nxt);
        const char* nA = has_next ? (const char*)g.A + (size_t)nxt.pm * tstep : cA; const char* nB = has_next ? (const char*)g.Bt + (size_t)nxt.pn * tstep : cB;
        for (int t = 0; t < nt; t += 2) {
            const bool last = (t == nt - 2);
            const char* a1 = cA + (size_t)(t + 1) * kstep;
            const char* a2 = last ? nA : cA + (size_t)(t + 2) * kstep; const char* b2 = last ? nB : cB + (size_t)(t + 2) * kstep;
            const char* a3 = a2 + kstep; const char* b3 = b2 + kstep;
            if (last && has_next) S.a_ready(nxt);
            if constexpr (SP2) {
            PG8_LDB(B0, 0, 0); PG8_LDB(B1, 0, 1); PG8_SCHED; PG8_LDA(At, 0, 0); PG8_STAGE(PG8_SA(1, 1), a1 + hstep, voffA);
            PG8_WAIT_V(8); PG8_WAIT_L(0); PG8_BAR; PG8_MMA(0, 0, At, B0); PG8_MMA(0, 1, At, B1); PG8_BAR; PG8_SCHED;
            PG8_LDA(At, 0, 1); PG8_STAGE(PG8_SB(0, 0), b2, voffB); PG8_STAGE(PG8_SB(0, 1), b2 + hstep, voffB); PG8_STAGE(PG8_SA(0, 0), a2, voffA);
            PG8_WAIT_V(8); PG8_WAIT_L(0); PG8_BAR; PG8_MMA(1, 0, At, B0); PG8_MMA(1, 1, At, B1); PG8_BAR; PG8_SCHED;
            PG8_LDB(B0, 1, 0); PG8_LDB(B1, 1, 1); PG8_SCHED; PG8_LDA(At, 1, 0); PG8_STAGE(PG8_SA(0, 1), a2 + hstep, voffA);
            PG8_WAIT_V(8); PG8_WAIT_L(0); PG8_BAR; PG8_MMA(0, 0, At, B0); PG8_MMA(0, 1, At, B1); PG8_BAR; PG8_SCHED;
            PG8_LDA(At, 1, 1); PG8_STAGE(PG8_SB(1, 0), b3, voffB); PG8_STAGE(PG8_SB(1, 1), b3 + hstep, voffB); PG8_STAGE(PG8_SA(1, 0), a3, voffA);
            PG8_WAIT_V(8); PG8_WAIT_L(0); PG8_BAR; PG8_MMA(1, 0, At, B0); PG8_MMA(1, 1, At, B1); PG8_BAR; PG8_SCHED;
            } else {
            PG8_LDB(B0, 0, 0); PG8_SCHED; PG8_LDA(At, 0, 0); PG8_STAGE(PG8_SA(1, 1), a1 + hstep, voffA);
            PG8_WAIT_L(8); PG8_BAR; PG8_WAIT_L(0); PG8_MMA(0, 0, At, B0); PG8_BAR; PG8_SCHED;
            PG8_LDB(B1, 0, 1); PG8_STAGE(PG8_SB(0, 0), b2, voffB);
            PG8_BAR; PG8_WAIT_L(0); PG8_MMA(0, 1, At, B1); PG8_BAR;
            PG8_LDA(At, 0, 1); PG8_STAGE(PG8_SA(0, 0), a2, voffA);
            PG8_BAR; PG8_WAIT_L(0); PG8_MMA(1, 0, At, B0); PG8_BAR; PG8_SCHED;
            PG8_STAGE(PG8_SB(0, 1), b2 + hstep, voffB);
            PG8_WAIT_V(6); PG8_BAR; PG8_MMA(1, 1, At, B1); PG8_BAR;
            PG8_LDB(B0, 1, 0); PG8_SCHED; PG8_LDA(At, 1, 0); PG8_STAGE(PG8_SA(0, 1), a2 + hstep, voffA);
            PG8_WAIT_L(8); PG8_BAR; PG8_WAIT_L(0); PG8_MMA(0, 0, At, B0); PG8_BAR; PG8_SCHED;
            PG8_LDB(B1, 1, 1); PG8_STAGE(PG8_SB(1, 0), b3, voffB);
            PG8_BAR; PG8_WAIT_L(0); PG8_MMA(0, 1, At, B1); PG8_BAR;
            PG8_LDA(At, 1, 1); PG8_STAGE(PG8_SA(1, 0), a3, voffA);
            PG8_BAR; PG8_WAIT_L(0); PG8_MMA(1, 0, At, B0); PG8_BAR; PG8_SCHED;
            PG8_STAGE(PG8_SB(1, 1), b3 + hstep, voffB);
            PG8_WAIT_V(6); PG8_BAR; PG8_MMA(1, 1, At, B1); PG8_BAR;
            }
        }
        if constexpr (ALIGN_EPI) { if (wr == 0) PG8_BAR; }
        if constexpr (!Epi::AFTER_DRAIN) { E(acc, cur, wr, wc, fr, fq); S.done(cur); }
        if (!has_next) break;
#pragma unroll
        for (int a = 0; a < 2; ++a)
#pragma unroll
            for (int b = 0; b < 2; ++b)
#pragma unroll
                for (int m = 0; m < 4; ++m)
#pragma unroll
                    for (int n = 0; n < 2; ++n) acc[a][b][m][n] = (f32x4){0.f, 0.f, 0.f, 0.f};
        cur = nxt; cA = nA; cB = nB; ++ui;
        if constexpr (ALIGN_EPI) { if (wr == 1) PG8_BAR; }
    }
    PG8_WAIT_V(0);
    if constexpr (!ALIGN_EPI) { if (wr == 0) PG8_BAR; }
    PG8_BAR;
    if constexpr (Epi::AFTER_DRAIN) { E.fused(acc, cur, wr, wc, fr, fq, lds, wid, lane); S.done(cur); }
#undef PG8_SA
#undef PG8_SB
#undef PG8_STAGE
#undef PG8_LDA
#undef PG8_LDB
#undef PG8_MMA
#undef PG8_WAIT_V
#undef PG8_WAIT_L
#undef PG8_BAR
#undef PG8_SCHED
}
}

#ifndef PG8_SP2
#define PG8_SP2 true
#endif
#ifndef PG8_ALIGN
#define PG8_ALIGN true
#endif
#ifndef MK_N_LAUNCHES
#define MK_N_LAUNCHES 1
#endif
#ifndef SB_EARLY_EXIT
#define SB_EARLY_EXIT 1
#endif
#ifndef PROBE_DBL
#define PROBE_DBL -1
#endif
constexpr int NWAVES = 8;
constexpr int PER_PHASE = 9;
constexpr int N_LAUNCHES = MK_N_LAUNCHES;

constexpr int BATCH = 8, SEQ = 4096, D = 1024, M = BATCH * SEQ;
constexpr int MEML = 256, MMEM = BATCH * MEML;
constexpr int INW = 2304, KVW = 512, PQW = 2048;
constexpr int C_A = 0, C_G = 256, C_Q = 512, C_K = 1024, C_V = 1536, C_MQ = 2048;
constexpr int NEXP = 16384;
constexpr float EPS = 1e-6f;

constexpr size_t MiB = 1u << 20;
constexpr size_t WS_CTL = 0, CTL_ZERO_BYTES = 1 * MiB;
constexpr size_t WS_WIN = 2 * MiB, WS_WKV = 7 * MiB, WS_WOUT = 8 * MiB, WS_WPQ = 10 * MiB, WS_KEYS = 14 * MiB;
constexpr size_t WS_MEMN = 15 * MiB, WS_MKV = 19 * MiB;
constexpr size_t WS_SC = 22 * MiB;
constexpr size_t WS_UT = 24 * MiB, WS_VT = 56 * MiB;
constexpr size_t WS_XN = 88 * MiB;
constexpr size_t WS_CAT = 152 * MiB;
constexpr size_t WS_SELI = 216 * MiB, WS_SELG = 232 * MiB;
constexpr size_t WS_PROJ = 256 * MiB;
constexpr size_t WS_Q = 256 * MiB;
constexpr size_t WS_KF = 400 * MiB;
constexpr size_t WS_MKF = 432 * MiB;
constexpr size_t WS_END = 434 * MiB;
constexpr int CW_BAR = 4096;
constexpr int CW_SSQ2 = 65536;
static_assert((CW_SSQ2 + 2 * M) * 4 <= (int)CTL_ZERO_BYTES, "ctl");

constexpr int RING_OFF = 0, RING_BYTES = 131072;
constexpr int LDSCTL_OFF = RING_BYTES, MISC_OFF = LDSCTL_OFF + 320;
constexpr int EXTRA_OFF = RING_BYTES + 1024;
constexpr int LDS_BYTES = 147456;

#define GAS __attribute__((address_space(1)))
#define LAS __attribute__((address_space(3)))
typedef unsigned short bf16;
typedef unsigned v4u __attribute__((ext_vector_type(4)));
typedef unsigned v2u __attribute__((ext_vector_type(2)));
typedef float f32x4 __attribute__((ext_vector_type(4)));
typedef GAS unsigned gu32;
typedef __bf16 bf16x2_t __attribute__((ext_vector_type(2)));
#define RLX_AGENT __ATOMIC_RELAXED, __HIP_MEMORY_SCOPE_AGENT
#define LDS_WAIT() asm volatile("s_waitcnt lgkmcnt(0)" ::: "memory")
__device__ __forceinline__ unsigned f2bf(float f) { unsigned u = __builtin_bit_cast(unsigned, f); return (u + 0x7fffu + ((u >> 16) & 1u)) >> 16; }
__device__ __forceinline__ unsigned pk2(float lo, float hi) { return f2bf(lo) | (f2bf(hi) << 16); }
__device__ __forceinline__ float bflo(unsigned w) { return __uint_as_float(w << 16); }
__device__ __forceinline__ float bfhi(unsigned w) { return __uint_as_float(w & 0xffff0000u); }
__device__ __forceinline__ float dot2(unsigned a, unsigned b, float c) { return __builtin_amdgcn_fdot2_f32_bf16(__builtin_bit_cast(bf16x2_t, a), __builtin_bit_cast(bf16x2_t, b), c, false); }
__device__ __forceinline__ float wave_sum(float v) {
#pragma unroll
    for (int o = 1; o < 64; o <<= 1) v += __shfl_xor(v, o);
    return v;
}
#define XB_TMO      128
#define XB_XCNT(j)  (256  + 64 * (j))
#define XB_XSUB(j)  (1280 + 64 * (j))
#define XB_XGEN(j)  (2304 + 64 * (j))
#define XB_TOP      3328
#define XB_TOPGEN   3392
#define XCD_BAR_WORDS 3456
#define XB_SPIN_CAP (1u << 18)

__device__ __forceinline__ unsigned xb_ld(unsigned* p)              { return __hip_atomic_load(p, __ATOMIC_RELAXED, __HIP_MEMORY_SCOPE_AGENT); }
__device__ __forceinline__ unsigned xb_add(unsigned* p, unsigned v) { return __hip_atomic_fetch_add(p, v, __ATOMIC_RELAXED, __HIP_MEMORY_SCOPE_AGENT); }
__device__ __forceinline__ unsigned xb_xcc_id() { return (unsigned)__builtin_amdgcn_s_getreg((3 << 11) | 20) & 0xFu; }
#define XB_SPIN(cond, bar) do { unsigned _sp = 0; while (cond) { __builtin_amdgcn_s_sleep(1); \
    if ((++_sp & 255u) == 0u) { if (xb_ld(&(bar)[XB_TMO])) break; if (_sp > XB_SPIN_CAP) { atomicAdd(&(bar)[XB_TMO], 1u); break; } } } } while (0)

struct XcdBarrier {
    unsigned* bar; unsigned x;
    volatile LAS unsigned* st;
};

__device__ __forceinline__ XcdBarrier xcd_barrier_post(unsigned* bar, volatile LAS unsigned* st) {
    XcdBarrier b; b.bar = bar; b.x = xb_xcc_id(); b.st = st;
    if (threadIdx.x == 0) (void)xb_add(&bar[XB_XCNT(b.x)], 1u);
    return b;
}
__device__ __forceinline__ void xcd_barrier_complete(unsigned* bar, unsigned x, unsigned& nloc, unsigned& nx) {
    const unsigned G = gridDim.x * gridDim.y * gridDim.z;
    unsigned sum, cnt, mine, sp = 0u;
    for (;;) {
        sum = 0u; cnt = 0u; mine = 0u;
#pragma unroll
        for (unsigned j = 0; j < 16; ++j) { const unsigned c = xb_ld(&bar[XB_XCNT(j)]); sum += c; cnt += (c > 0u) ? 1u : 0u; mine = (j == x) ? c : mine; }
        if (sum == G) break;
        __builtin_amdgcn_s_sleep(1);
        if ((++sp & 255u) == 0u) { if (xb_ld(&bar[XB_TMO])) break; if (sp > XB_SPIN_CAP) { atomicAdd(&bar[XB_TMO], 1u); break; } }
    }
    nloc = mine > 0u ? mine : 1u; nx = cnt > 0u ? cnt : 1u;
}

__device__ __forceinline__ void xcd_barrier(const XcdBarrier& b) {
    asm volatile("s_waitcnt vmcnt(0)" ::: "memory");
    __syncthreads();
    if (threadIdx.x == 0) {
        unsigned* bar = b.bar;
        __builtin_amdgcn_s_waitcnt(0);
        unsigned nloc = b.st[0], nx = b.st[1];
        if (nloc == 0u) { xcd_barrier_complete(bar, b.x, nloc, nx); b.st[0] = nloc; b.st[1] = nx; }
        const unsigned old = xb_add(&bar[XB_XSUB(b.x)], 1u);
        const unsigned gen = old / nloc;
        if (old + 1u == (gen + 1u) * nloc) {
            __builtin_amdgcn_fence(__ATOMIC_RELEASE, "agent");
            asm volatile("s_waitcnt vmcnt(0)" ::: "memory");
            const unsigned og = xb_add(&bar[XB_TOP], 1u);
            const unsigned tg = og / nx;
            if (og + 1u == (tg + 1u) * nx) xb_add(&bar[XB_TOPGEN], 1u);
            else XB_SPIN(xb_ld(&bar[XB_TOPGEN]) == tg, bar);
            __builtin_amdgcn_fence(__ATOMIC_ACQUIRE, "agent");
            xb_add(&bar[XB_XGEN(b.x)], 1u);
            asm volatile("s_waitcnt vmcnt(0)" ::: "memory");
        } else {
            XB_SPIN(xb_ld(&bar[XB_XGEN(b.x)]) == gen, bar);
            __builtin_amdgcn_fence(__ATOMIC_ACQUIRE, "agent");
            asm volatile("s_waitcnt vmcnt(0)" ::: "memory");
        }
    }
    __syncthreads();
}

struct Frame {
    LAS unsigned char* lds;
    volatile LAS unsigned* MISC;
    gu32* ctl;
    int tid, lane, wave;
    int vcu, G;
};
struct Ptrs {
    const float *x, *mem, *attn_g, *w_in, *conv_w, *conv_b, *conv_ln_g, *conv_ln_b, *sb_out_g, *mem_norm_g, *w_mem_kv, *q_norm_g, *k_norm_g, *mem_out_g,
                *w_out, *ffn_g, *w_peer_q, *keys1, *keys2, *peer_u, *peer_v;
    float* out;
    bf16 *WIN, *WKV, *WOUT, *WPQ, *KEYS, *MEMN, *MKV, *XN, *CAT, *PROJ, *Q;
    unsigned char *UT, *VT; float *USC, *VSC, *PART;
    unsigned short* SELH; float* SELG; unsigned long long* SSQ2; unsigned short* WB; bf16 *KF, *MKF; unsigned char* H2Q; float* HS;
};

__device__ __forceinline__ void p0_transpose_item(const float* W, const float* gk, int K, int N, bf16* WT, LAS float* scr, int item, int lane) {
    const int nblk = N / 32, kb = item / nblk, nb = item % nblk, k0 = 64 * kb, n0 = 32 * nb;
    float wv[32];
#pragma unroll
    for (int i = 0; i < 32; ++i) { const int kk = 2 * i + (lane >> 5); wv[i] = W[(size_t)(k0 + kk) * N + n0 + (lane & 31)]; }
#pragma unroll
    for (int i = 0; i < 32; ++i) { const int kk = 2 * i + (lane >> 5); float w = wv[i]; if (gk) w *= gk[k0 + kk]; scr[kk * 33 + (lane & 31)] = w; }
    LDS_WAIT(); asm volatile("" ::: "memory");
    const int c = lane & 7;
#pragma unroll
    for (int j = 0; j < 4; ++j) { const int n = (lane >> 3) + 8 * j; const LAS float* s = scr + (8 * c) * 33 + n;
        v4u o; o.x = pk2(s[0 * 33], s[1 * 33]); o.y = pk2(s[2 * 33], s[3 * 33]); o.z = pk2(s[4 * 33], s[5 * 33]); o.w = pk2(s[6 * 33], s[7 * 33]);
        *(GAS v4u*)(WT + (size_t)(n0 + n) * K + k0 + 8 * c) = o; }
    LDS_WAIT(); asm volatile("" ::: "memory");
}
template <int NR> __device__ __forceinline__ void rms_rows_to_bf16(const float* xrow, const float* g, bf16* orow, int lane) {
    const GAS f32x4* gr = (const GAS f32x4*)g + lane;
    f32x4 v[NR][4]; float s[NR];
#pragma unroll
    for (int r = 0; r < NR; ++r) { const GAS f32x4* xr = (const GAS f32x4*)(xrow + (size_t)r * D) + lane;
#pragma unroll
        for (int j = 0; j < 4; ++j) v[r][j] = __builtin_nontemporal_load(xr + 64 * j); }
    f32x4 gg[4];
#pragma unroll
    for (int j = 0; j < 4; ++j) gg[j] = gr[64 * j];
#pragma unroll
    for (int r = 0; r < NR; ++r) { s[r] = 0.f;
#pragma unroll
        for (int j = 0; j < 4; ++j) s[r] += (v[r][j].x * v[r][j].x + v[r][j].y * v[r][j].y) + (v[r][j].z * v[r][j].z + v[r][j].w * v[r][j].w); }
#pragma unroll
    for (int o = 1; o < 64; o <<= 1)
#pragma unroll
        for (int r = 0; r < NR; ++r) s[r] += __shfl_xor(s[r], o);
#pragma unroll
    for (int r = 0; r < NR; ++r) { const float rinv = 1.f / sqrtf(s[r] * (1.f / 1024.f) + EPS);
        GAS unsigned long long* o8 = (GAS unsigned long long*)(orow + (size_t)r * D) + lane;
#pragma unroll
        for (int j = 0; j < 4; ++j) { const f32x4 o = v[r][j] * rinv * gg[j];
            o8[64 * j] = (unsigned long long)pk2(o.x, o.y) | ((unsigned long long)pk2(o.z, o.w) << 32); } }
}
__device__ __forceinline__ void cvt_f32_to_bf16_stream(const float* src, bf16* dst, size_t n8, size_t gtid, size_t nthr) {
    for (size_t i = gtid; i < n8; i += nthr) { const f32x4 a = ((const GAS f32x4*)src)[2 * i], b = ((const GAS f32x4*)src)[2 * i + 1];
        v4u o; o.x = pk2(a.x, a.y); o.y = pk2(a.z, a.w); o.z = pk2(b.x, b.y); o.w = pk2(b.z, b.w); ((GAS v4u*)dst)[i] = o; }
}
__device__ __forceinline__ unsigned pack_i8x4(int a, int b, int c, int d) { return (unsigned)(a & 255) | ((unsigned)(b & 255) << 8) | ((unsigned)(c & 255) << 16) | ((unsigned)(d & 255) << 24); }
template <int NR> __device__ __forceinline__ void rows_to_fp8(const float* src, unsigned char* dst, float* iscale, int e, int lane) {
    f32x4 v[NR][4]; float am[NR];
#pragma unroll
    for (int r = 0; r < NR; ++r) { const GAS f32x4* p = (const GAS f32x4*)(src + (size_t)(e + r) * D) + lane;
#pragma unroll
        for (int k = 0; k < 4; ++k) v[r][k] = __builtin_nontemporal_load(p + 64 * k); }
#pragma unroll
    for (int r = 0; r < NR; ++r) { am[r] = 0.f;
#pragma unroll
        for (int k = 0; k < 4; ++k) am[r] = fmaxf(fmaxf(am[r], fmaxf(fabsf(v[r][k].x), fabsf(v[r][k].y))), fmaxf(fabsf(v[r][k].z), fabsf(v[r][k].w))); }
#pragma unroll
    for (int o = 1; o < 64; o <<= 1)
#pragma unroll
        for (int r = 0; r < NR; ++r) am[r] = fmaxf(am[r], __shfl_xor(am[r], o));
#pragma unroll
    for (int r = 0; r < NR; ++r) { const float sc = am[r] > 0.f ? 256.f / am[r] : 1.f, isc = am[r] > 0.f ? am[r] * (1.f / 256.f) : 1.f;
#pragma unroll
        for (int k = 0; k < 4; ++k) { int w = 0; w = __builtin_amdgcn_cvt_pk_fp8_f32(v[r][k].x * sc, v[r][k].y * sc, w, false); w = __builtin_amdgcn_cvt_pk_fp8_f32(v[r][k].z * sc, v[r][k].w * sc, w, true);
            *(GAS unsigned*)(dst + ((size_t)(2 * k + (lane >> 5)) * NEXP + e + r) * 128 + 4 * (lane & 31)) = (unsigned)w; }
        if (lane == 0) iscale[e + r] = isc; }
}
template <int NR> __device__ __forceinline__ void rows_to_i8(const float* src, unsigned char* dst, float* iscale, int e, int lane) {
    f32x4 v[NR][4]; float am[NR];
#pragma unroll
    for (int r = 0; r < NR; ++r) { const GAS f32x4* p = (const GAS f32x4*)(src + (size_t)(e + r) * D) + lane;
#pragma unroll
        for (int k = 0; k < 4; ++k) v[r][k] = __builtin_nontemporal_load(p + 64 * k); }
#pragma unroll
    for (int r = 0; r < NR; ++r) { am[r] = 0.f;
#pragma unroll
        for (int k = 0; k < 4; ++k) am[r] = fmaxf(fmaxf(am[r], fmaxf(fabsf(v[r][k].x), fabsf(v[r][k].y))), fmaxf(fabsf(v[r][k].z), fabsf(v[r][k].w))); }
#pragma unroll
    for (int o = 1; o < 64; o <<= 1)
#pragma unroll
        for (int r = 0; r < NR; ++r) am[r] = fmaxf(am[r], __shfl_xor(am[r], o));
#pragma unroll
    for (int r = 0; r < NR; ++r) { const float sc = am[r] > 0.f ? 127.f / am[r] : 1.f, isc = am[r] > 0.f ? am[r] * (1.f / 127.f) : 1.f;
#pragma unroll
        for (int k = 0; k < 4; ++k) { const f32x4 q = v[r][k] * sc;
            const unsigned w = pack_i8x4((int)__builtin_rintf(q.x), (int)__builtin_rintf(q.y), (int)__builtin_rintf(q.z), (int)__builtin_rintf(q.w));
            *(GAS unsigned*)(dst + ((size_t)(2 * k + (lane >> 5)) * NEXP + e + r) * 128 + 4 * (lane & 31)) = w; }
        if (lane == 0) iscale[e + r] = isc; }
}
__device__ __forceinline__ void p0_prologue(Frame& F, const Ptrs& P) {
    LAS float* scr = (LAS float*)(F.lds + RING_OFF + F.wave * 16384);
    const int gw = F.vcu * NWAVES + F.wave, NGW = F.G * NWAVES;
    constexpr int I_IN = (D / 64) * (INW / 32), I_KV = (D / 64) * (KVW / 32), I_OUT = (D / 64) * (D / 32), I_PQ = (D / 64) * (PQW / 32);
    constexpr int NITEMS = I_IN + I_KV + I_OUT + I_PQ;
    for (int it = gw; it < NITEMS; it += NGW) {
        int r = it;
        if (r < I_IN) { p0_transpose_item(P.w_in, nullptr, D, INW, P.WIN, scr, r, F.lane); continue; } r -= I_IN;
        if (r < I_KV) { p0_transpose_item(P.w_mem_kv, nullptr, D, KVW, P.WKV, scr, r, F.lane); continue; } r -= I_KV;
        if (r < I_OUT) { p0_transpose_item(P.w_out, nullptr, D, D, P.WOUT, scr, r, F.lane); continue; } r -= I_OUT;
        p0_transpose_item(P.w_peer_q, P.ffn_g, D, PQW, P.WPQ, scr, r, F.lane);
    }
    for (int m = gw * 4; m < M; m += NGW * 4) rms_rows_to_bf16<4>(P.x + (size_t)m * D, P.attn_g, P.XN + (size_t)m * D, F.lane);
    for (int m = gw; m < MMEM; m += NGW) rms_rows_to_bf16<1>(P.mem + (size_t)m * D, P.mem_norm_g, P.MEMN + (size_t)m * D, F.lane);
    const size_t gtid = (size_t)gw * 64 + F.lane, nthr = (size_t)NGW * 64;
    cvt_f32_to_bf16_stream(P.keys1, P.KEYS, 8 * 128 * 128 / 8, gtid, nthr);
    cvt_f32_to_bf16_stream(P.keys2, P.KEYS + 8 * 128 * 128, 8 * 128 * 128 / 8, gtid, nthr);
}

__device__ __forceinline__ void conv_phase(Frame& F, const Ptrs& P) {
    LAS float* U = (LAS float*)(F.lds + 0);
    LAS float* Y = (LAS float*)(F.lds + 65536);
    const int tid = F.tid, c = tid & 255, half = tid >> 8;
    float w[31];
#pragma unroll
    for (int k = 0; k < 31; ++k) w[k] = P.conv_w[k * 256 + c];
    const float bias = P.conv_b[c];
    const f32x4 lg = ((const GAS f32x4*)P.conv_ln_g)[F.lane], lb = ((const GAS f32x4*)P.conv_ln_b)[F.lane];
    for (int it = F.vcu; it < BATCH * (SEQ / 32); it += F.G) {
        const int b = it / (SEQ / 32), t0 = (it % (SEQ / 32)) * 32;
        __syncthreads();
        for (int idx = tid; idx < 62 * 32; idx += 512) {
            const int r = idx >> 5, c8 = idx & 31, t = t0 - 30 + r;
            float u[8];
            if (t >= 0) { const bf16* src = P.PROJ + (size_t)(b * SEQ + t) * INW + c8 * 8;
                const v4u a = *(const GAS v4u*)(src + C_A), g = *(const GAS v4u*)(src + C_G);
                const unsigned aw[4] = {a.x, a.y, a.z, a.w}, gw_[4] = {g.x, g.y, g.z, g.w};
#pragma unroll
                for (int i = 0; i < 4; ++i) { const float a0 = bflo(aw[i]), a1 = bfhi(aw[i]), g0 = bflo(gw_[i]), g1 = bfhi(gw_[i]);
                    u[2 * i] = a0 * __builtin_amdgcn_rcpf(1.f + __expf(-g0)); u[2 * i + 1] = a1 * __builtin_amdgcn_rcpf(1.f + __expf(-g1)); }
            } else {
#pragma unroll
                for (int i = 0; i < 8; ++i) u[i] = 0.f;
            }
            LAS f32x4* dst = (LAS f32x4*)(U + r * 256 + c8 * 8);
            dst[0] = (f32x4){u[0], u[1], u[2], u[3]}; dst[1] = (f32x4){u[4], u[5], u[6], u[7]};
        }
        __syncthreads();
        {
            float win[46];
#pragma unroll
            for (int i = 0; i < 46; ++i) win[i] = U[(half * 16 + i) * 256 + c];
#pragma unroll
            for (int tt = 0; tt < 16; ++tt) { float y = bias;
#pragma unroll
                for (int k = 0; k < 31; ++k) y += w[k] * win[tt + k];
                Y[(half * 16 + tt) * 256 + c] = y; }
        }
        __syncthreads();
#pragma unroll
        for (int i = 0; i < 4; ++i) { const int tok = F.wave * 4 + i; const f32x4 y = *(const LAS f32x4*)(Y + tok * 256 + F.lane * 4);
            const float mu = wave_sum((y.x + y.y) + (y.z + y.w)) * (1.f / 256.f); const f32x4 d = y - mu;
            const float var = wave_sum((d.x * d.x + d.y * d.y) + (d.z * d.z + d.w * d.w)) * (1.f / 256.f);
            const float rinv = 1.f / sqrtf(var + EPS); const f32x4 yn = d * rinv * lg + lb;
            f32x4 s; s.x = yn.x * __builtin_amdgcn_rcpf(1.f + __expf(-yn.x)); s.y = yn.y * __builtin_amdgcn_rcpf(1.f + __expf(-yn.y)); s.z = yn.z * __builtin_amdgcn_rcpf(1.f + __expf(-yn.z)); s.w = yn.w * __builtin_amdgcn_rcpf(1.f + __expf(-yn.w));
            *(GAS unsigned long long*)(P.CAT + (size_t)(b * SEQ + t0 + tok) * D + F.lane * 4) = (unsigned long long)pk2(s.x, s.y) | ((unsigned long long)pk2(s.z, s.w) << 32); }
    }
}

typedef short bf16x8 __attribute__((ext_vector_type(8)));
typedef float f32x16 __attribute__((ext_vector_type(16)));
typedef short s16x4 __attribute__((ext_vector_type(4)));
constexpr int VSTR = 144;
constexpr int VL_BYTES = 32 * VSTR;
__device__ __forceinline__ unsigned cvtpk(float lo, float hi) { typedef float f2 __attribute__((ext_vector_type(2))); typedef __bf16 b2 __attribute__((ext_vector_type(2))); f2 v = {lo, hi}; b2 b = __builtin_convertvector(v, b2); return __builtin_bit_cast(unsigned, b); }
__device__ __forceinline__ s16x4 vtr(LAS unsigned char* p) { return __builtin_bit_cast(s16x4, __builtin_amdgcn_ds_read_tr16_b64_v4i16((LAS s16x4*)p)); }
__device__ __forceinline__ float swap_lo(float x, float& hi_out) { auto rr = __builtin_amdgcn_permlane32_swap(__float_as_uint(x), __float_as_uint(x), false, false); hi_out = __uint_as_float(rr[1]); return __uint_as_float(rr[0]); }
__device__ __forceinline__ void v_frags(LAS unsigned char* vl, int lane, bf16x8 (&vf)[2][2]) {
    const int il = lane & 15, q_ = il >> 2, p_ = il & 3, gg = lane >> 4, hi = lane >> 5;
    LAS unsigned char* base = vl + (4 * hi + q_) * VSTR + (16 * (gg & 1) + 4 * p_) * 2;
#pragma unroll
    for (int mt = 0; mt < 2; ++mt)
#pragma unroll
        for (int c = 0; c < 2; ++c) { const s16x4 lo = vtr(base + c * 16 * VSTR + mt * 64), hh = vtr(base + c * 16 * VSTR + 8 * VSTR + mt * 64);
            vf[mt][c] = (bf16x8){lo[0], lo[1], lo[2], lo[3], hh[0], hh[1], hh[2], hh[3]}; }
}
__device__ __forceinline__ void sb_weights(const f32x16& s, bool diag, int r32, int hi, float& R, bf16x8 (&pf)[2]) {
    typedef float f2 __attribute__((ext_vector_type(2)));
    f2 om2[2][4];
#pragma unroll
    for (int jj = 0; jj < 2; ++jj)
#pragma unroll
        for (int i = 0; i < 4; ++i) { const f2 z = (f2){s[4 * jj + i], s[4 * (jj + 2) + i]} * (0.125f * 1.4426950408889634f);
            f2 d; d.x = __builtin_amdgcn_exp2f(z.x); d.y = __builtin_amdgcn_exp2f(z.y); d = d + 1.0f;
            f2 o; o.x = __builtin_amdgcn_rcpf(d.x); o.y = __builtin_amdgcn_rcpf(d.y);
            if (diag) { const bool v0 = (i + 8 * jj + 4 * hi) < r32, v1 = (i + 8 * (jj + 2) + 4 * hi) < r32; o.x = v0 ? o.x : 1.f; o.y = v1 ? o.y : 1.f; }
            om2[jj][i] = o; }
    float G[4], Glo[4], Ghi[4];
#pragma unroll
    for (int jj = 0; jj < 2; ++jj) { const f2 g = (om2[jj][3] * om2[jj][2]) * (om2[jj][1] * om2[jj][0]); G[jj] = g.x; G[jj + 2] = g.y; }
#pragma unroll
    for (int j = 0; j < 4; ++j) Glo[j] = swap_lo(G[j], Ghi[j]);
    float run = R, st[4];
#pragma unroll
    for (int j = 3; j >= 0; --j) { const float s_hi = run, s_lo = run * Ghi[j]; st[j] = hi ? s_hi : s_lo; run = s_lo * Glo[j]; }
    R = run;
    float a[16];
#pragma unroll
    for (int jj = 0; jj < 2; ++jj) { f2 rb = {st[jj], st[jj + 2]};
#pragma unroll
        for (int i = 3; i >= 0; --i) { const f2 nx = rb * om2[jj][i]; const f2 d = rb - nx; a[4 * jj + i] = d.x; a[4 * (jj + 2) + i] = d.y; rb = nx; } }
#pragma unroll
    for (int c = 0; c < 2; ++c) pf[c] = __builtin_bit_cast(bf16x8, (v4u){cvtpk(a[8 * c], a[8 * c + 1]), cvtpk(a[8 * c + 2], a[8 * c + 3]), cvtpk(a[8 * c + 4], a[8 * c + 5]), cvtpk(a[8 * c + 6], a[8 * c + 7])});
}
__device__ __forceinline__ void sb_item_mfma(Frame& F, const Ptrs& P, int b, int G64) {
    const int lane = F.lane, h = F.wave, r32 = lane & 31, hi = lane >> 5;
    const int t0 = G64 * 64; const size_t rowbase = (size_t)b * SEQ;
    LAS unsigned char* vl = F.lds + F.wave * VL_BYTES;
    bf16x8 qA[4], qB[4];
    { const bf16* qp = P.PROJ + (rowbase + t0 + r32) * INW + C_Q + h * 64 + 8 * hi;
#pragma unroll
      for (int ks = 0; ks < 4; ++ks) { qA[ks] = *(const GAS bf16x8*)(qp + 16 * ks); qB[ks] = *(const GAS bf16x8*)(qp + (size_t)32 * INW + 16 * ks); } }
    f32x16 oA0, oA1, oB0, oB1;
#pragma unroll
    for (int r = 0; r < 16; ++r) { oA0[r] = 0.f; oA1[r] = 0.f; oB0[r] = 0.f; oB1[r] = 0.f; }
    float RA = 1.f, RB = 1.f;
    const bf16* kbase = P.KF + (rowbase >> 5) * 16384 + (size_t)h * 2048 + (hi * 32 + r32) * 8;
    const bf16* vbase = P.PROJ + (rowbase + (lane >> 3)) * INW + C_V + h * 64 + (lane & 7) * 8;
    bf16x8 kf[4]; v4u vp[4];
    const int top = t0 + 32;
#pragma unroll
    for (int ks = 0; ks < 4; ++ks) kf[ks] = *(const GAS bf16x8*)(kbase + (size_t)(top >> 5) * 16384 + 512 * ks);
#pragma unroll
    for (int k = 0; k < 4; ++k) vp[k] = *(const GAS v4u*)(vbase + (size_t)(top + 8 * k) * INW);
    {
        f32x16 sB;
#pragma unroll
        for (int r = 0; r < 16; ++r) sB[r] = 0.f;
#pragma unroll
        for (int ks = 0; ks < 4; ++ks) sB = __builtin_amdgcn_mfma_f32_32x32x16_bf16(kf[ks], qB[ks], sB, 0, 0, 0);
        asm volatile("" ::: "memory");
#pragma unroll
        for (int k = 0; k < 4; ++k) *(LAS v4u*)(vl + ((lane >> 3) + 8 * k) * VSTR + (lane & 7) * 16) = vp[k];
        asm volatile("" ::: "memory");
#pragma unroll
        for (int ks = 0; ks < 4; ++ks) kf[ks] = *(const GAS bf16x8*)(kbase + (size_t)(t0 >> 5) * 16384 + 512 * ks);
#pragma unroll
        for (int k = 0; k < 4; ++k) vp[k] = *(const GAS v4u*)(vbase + (size_t)(t0 + 8 * k) * INW);
        bf16x8 pB[2];
        sb_weights(sB, true, r32, hi, RB, pB);
        bf16x8 vf[2][2];
        v_frags(vl, lane, vf);
        oB0 = __builtin_amdgcn_mfma_f32_32x32x16_bf16(vf[0][0], pB[0], oB0, 0, 0, 0); oB1 = __builtin_amdgcn_mfma_f32_32x32x16_bf16(vf[1][0], pB[0], oB1, 0, 0, 0);
        oB0 = __builtin_amdgcn_mfma_f32_32x32x16_bf16(vf[0][1], pB[1], oB0, 0, 0, 0); oB1 = __builtin_amdgcn_mfma_f32_32x32x16_bf16(vf[1][1], pB[1], oB1, 0, 0, 0);
        asm volatile("" ::: "memory");
    }
    for (int s0 = t0; s0 >= 0; s0 -= 32) {
        f32x16 sA, sB;
#pragma unroll
        for (int r = 0; r < 16; ++r) { sA[r] = 0.f; sB[r] = 0.f; }
#pragma unroll
        for (int ks = 0; ks < 4; ++ks) sB = __builtin_amdgcn_mfma_f32_32x32x16_bf16(kf[ks], qB[ks], sB, 0, 0, 0);
#pragma unroll
        for (int ks = 0; ks < 4; ++ks) sA = __builtin_amdgcn_mfma_f32_32x32x16_bf16(kf[ks], qA[ks], sA, 0, 0, 0);
        asm volatile("" ::: "memory");
#pragma unroll
        for (int k = 0; k < 4; ++k) *(LAS v4u*)(vl + ((lane >> 3) + 8 * k) * VSTR + (lane & 7) * 16) = vp[k];
        asm volatile("" ::: "memory");
        { const int sn = s0 >= 32 ? s0 - 32 : 0;
#pragma unroll
          for (int ks = 0; ks < 4; ++ks) kf[ks] = *(const GAS bf16x8*)(kbase + (size_t)(sn >> 5) * 16384 + 512 * ks);
#pragma unroll
          for (int k = 0; k < 4; ++k) vp[k] = *(const GAS v4u*)(vbase + (size_t)(sn + 8 * k) * INW); }
        bf16x8 pB[2], pA[2];
        sb_weights(sB, false, r32, hi, RB, pB);
        bf16x8 vf[2][2];
        v_frags(vl, lane, vf);
        oB0 = __builtin_amdgcn_mfma_f32_32x32x16_bf16(vf[0][0], pB[0], oB0, 0, 0, 0); oB1 = __builtin_amdgcn_mfma_f32_32x32x16_bf16(vf[1][0], pB[0], oB1, 0, 0, 0);
        oB0 = __builtin_amdgcn_mfma_f32_32x32x16_bf16(vf[0][1], pB[1], oB0, 0, 0, 0); oB1 = __builtin_amdgcn_mfma_f32_32x32x16_bf16(vf[1][1], pB[1], oB1, 0, 0, 0);
        sb_weights(sA, s0 == t0, r32, hi, RA, pA);
        oA0 = __builtin_amdgcn_mfma_f32_32x32x16_bf16(vf[0][0], pA[0], oA0, 0, 0, 0); oA1 = __builtin_amdgcn_mfma_f32_32x32x16_bf16(vf[1][0], pA[0], oA1, 0, 0, 0);
        oA0 = __builtin_amdgcn_mfma_f32_32x32x16_bf16(vf[0][1], pA[1], oA0, 0, 0, 0); oA1 = __builtin_amdgcn_mfma_f32_32x32x16_bf16(vf[1][1], pA[1], oA1, 0, 0, 0);
        asm volatile("" ::: "memory");
        if (SB_EARLY_EXIT && __builtin_amdgcn_ballot_w64(fmaxf(RA, RB) > 0.0f) == 0ull) break;
    }
    float ssA = 0.f, ssB = 0.f;
#pragma unroll
    for (int r = 0; r < 16; ++r) { ssA += oA0[r] * oA0[r] + oA1[r] * oA1[r]; ssB += oB0[r] * oB0[r] + oB1[r] * oB1[r]; }
    { float sh; const float sl = swap_lo(ssA, sh); ssA = sl + sh; }
    { float sh; const float sl = swap_lo(ssB, sh); ssB = sl + sh; }
    LAS float* xs = (LAS float*)(F.lds + EXTRA_OFF);
    if (hi == 0) { xs[h * 64 + r32] = ssA; xs[h * 64 + 32 + r32] = ssB; }
    __syncthreads();
    float totA = 0.f, totB = 0.f;
#pragma unroll
    for (int w = 0; w < 8; ++w) { totA += xs[w * 64 + r32]; totB += xs[w * 64 + 32 + r32]; }
    const float rinvA = 1.f / sqrtf(totA * (1.f / 512.f) + EPS), rinvB = 1.f / sqrtf(totB * (1.f / 512.f) + EPS);
    bf16* dstA = P.CAT + (rowbase + t0 + r32) * D + 256 + h * 64 + 4 * hi; bf16* dstB = dstA + (size_t)32 * D; const float* gp = P.sb_out_g + h * 64 + 4 * hi;
#pragma unroll
    for (int mt = 0; mt < 2; ++mt)
#pragma unroll
        for (int j = 0; j < 4; ++j) { const f32x4 gv = *(const GAS f32x4*)(gp + 32 * mt + 8 * j);
            { const float a0 = (mt ? oA1[4 * j] : oA0[4 * j]) * rinvA * gv.x, a1 = (mt ? oA1[4 * j + 1] : oA0[4 * j + 1]) * rinvA * gv.y, a2 = (mt ? oA1[4 * j + 2] : oA0[4 * j + 2]) * rinvA * gv.z, a3 = (mt ? oA1[4 * j + 3] : oA0[4 * j + 3]) * rinvA * gv.w;
              *(GAS v2u*)(dstA + 32 * mt + 8 * j) = (v2u){cvtpk(a0, a1), cvtpk(a2, a3)}; }
            { const float a0 = (mt ? oB1[4 * j] : oB0[4 * j]) * rinvB * gv.x, a1 = (mt ? oB1[4 * j + 1] : oB0[4 * j + 1]) * rinvB * gv.y, a2 = (mt ? oB1[4 * j + 2] : oB0[4 * j + 2]) * rinvB * gv.z, a3 = (mt ? oB1[4 * j + 3] : oB0[4 * j + 3]) * rinvB * gv.w;
              *(GAS v2u*)(dstB + 32 * mt + 8 * j) = (v2u){cvtpk(a0, a1), cvtpk(a2, a3)}; } }
    __syncthreads();
}
__device__ __forceinline__ void mem_q_frags(const Ptrs& P, const bf16* qp, int hi, bf16x8 (&qf)[4], float& qsc) {
    float ssq = 0.f;
#pragma unroll
    for (int ks = 0; ks < 4; ++ks) { const v4u v = *(const GAS v4u*)(qp + 16 * ks); const unsigned w[4] = {v.x, v.y, v.z, v.w}; unsigned ow[4];
#pragma unroll
        for (int i = 0; i < 4; ++i) { const float a = bflo(w[i]), c = bfhi(w[i]); ssq += a * a + c * c; const int d = 16 * ks + 8 * hi + 2 * i;
            ow[i] = cvtpk(a * (P.q_norm_g[d] * P.k_norm_g[d]), c * (P.q_norm_g[d + 1] * P.k_norm_g[d + 1])); }
        qf[ks] = __builtin_bit_cast(bf16x8, (v4u){ow[0], ow[1], ow[2], ow[3]}); }
    float sh; const float sl = swap_lo(ssq, sh); qsc = 0.125f / sqrtf((sl + sh) * (1.f / 64.f) + EPS);
}
__device__ __forceinline__ void mem_softmax_tile(const f32x16& s, const LAS float* rk, int hi, float qsc, float& mx, float& lsum, f32x16& o0, f32x16& o1, bf16x8 (&pf)[2]) {
    float p[16]; float bm = -1.0e30f;
#pragma unroll
    for (int j = 0; j < 4; ++j) { const f32x4 rv = *(const LAS f32x4*)(rk + 8 * j + 4 * hi);
        p[4 * j] = s[4 * j] * qsc * rv.x; p[4 * j + 1] = s[4 * j + 1] * qsc * rv.y; p[4 * j + 2] = s[4 * j + 2] * qsc * rv.z; p[4 * j + 3] = s[4 * j + 3] * qsc * rv.w;
        bm = fmaxf(fmaxf(bm, fmaxf(p[4 * j], p[4 * j + 1])), fmaxf(p[4 * j + 2], p[4 * j + 3])); }
    { float bh; const float bl = swap_lo(bm, bh); bm = fmaxf(bl, bh); }
    const float mn = fmaxf(mx, bm), sc = __expf(mx - mn); mx = mn; lsum *= sc;
#pragma unroll
    for (int r = 0; r < 16; ++r) { o0[r] *= sc; o1[r] *= sc; p[r] = __expf(p[r] - mn); }
    lsum += ((p[0] + p[1]) + (p[2] + p[3])) + ((p[4] + p[5]) + (p[6] + p[7])) + (((p[8] + p[9]) + (p[10] + p[11])) + ((p[12] + p[13]) + (p[14] + p[15])));
#pragma unroll
    for (int c = 0; c < 2; ++c) pf[c] = __builtin_bit_cast(bf16x8, (v4u){cvtpk(p[8 * c], p[8 * c + 1]), cvtpk(p[8 * c + 2], p[8 * c + 3]), cvtpk(p[8 * c + 4], p[8 * c + 5]), cvtpk(p[8 * c + 6], p[8 * c + 7])});
}
__device__ __forceinline__ void mem_item_mfma(Frame& F, const Ptrs& P, int b, int qb) {
    const int lane = F.lane, h = F.wave & 3, half = F.wave >> 2, r32 = lane & 31, hi = lane >> 5;
    const size_t rowA = (size_t)b * SEQ + qb * 128 + half * 64 + r32, rowB = rowA + 32;
    LAS unsigned char* vl = F.lds + F.wave * VL_BYTES;
    LAS float* rk = (LAS float*)(F.lds + 8 * VL_BYTES + F.wave * 128);
    bf16x8 qA[4], qB[4]; float qscA, qscB;
    mem_q_frags(P, P.PROJ + rowA * INW + C_MQ + h * 64 + 8 * hi, hi, qA, qscA);
    mem_q_frags(P, P.PROJ + rowB * INW + C_MQ + h * 64 + 8 * hi, hi, qB, qscB);
    f32x16 oA0, oA1, oB0, oB1;
#pragma unroll
    for (int r = 0; r < 16; ++r) { oA0[r] = 0.f; oA1[r] = 0.f; oB0[r] = 0.f; oB1[r] = 0.f; }
    float mxA = -1.0e30f, lsA = 0.f, mxB = -1.0e30f, lsB = 0.f;
    const bf16* kbase = P.MKF + ((size_t)b * (MEML / 32)) * 8192 + (size_t)h * 2048 + (hi * 32 + r32) * 8;
    const bf16* vbase = P.MKV + ((size_t)b * MEML + (lane >> 3)) * KVW + 256 + h * 64 + (lane & 7) * 8;
    v4u kr[4], vp[4];
#pragma unroll
    for (int ks = 0; ks < 4; ++ks) kr[ks] = *(const GAS v4u*)(kbase + 512 * ks);
#pragma unroll
    for (int k = 0; k < 4; ++k) vp[k] = *(const GAS v4u*)(vbase + (size_t)(8 * k) * KVW);
    for (int s0 = 0; s0 < MEML; s0 += 32) {
        bf16x8 kf[4]; float kss; { float k0 = 0.f, k1 = 0.f, k2 = 0.f, k3 = 0.f;
#pragma unroll
        for (int ks = 0; ks < 4; ++ks) { const v4u v = kr[ks]; kf[ks] = __builtin_bit_cast(bf16x8, v);
            k0 = dot2(v.x, v.x, k0); k1 = dot2(v.y, v.y, k1); k2 = dot2(v.z, v.z, k2); k3 = dot2(v.w, v.w, k3); }
          kss = (k0 + k1) + (k2 + k3); }
        { float sh; const float sl = swap_lo(kss, sh); kss = 1.f / sqrtf((sl + sh) * (1.f / 64.f) + EPS); }
        asm volatile("" ::: "memory");
        if (hi == 0) rk[r32] = kss;
#pragma unroll
        for (int k = 0; k < 4; ++k) *(LAS v4u*)(vl + ((lane >> 3) + 8 * k) * VSTR + (lane & 7) * 16) = vp[k];
        asm volatile("" ::: "memory");
        bf16x8 vf[2][2];
        {
            f32x16 sA;
#pragma unroll
            for (int r = 0; r < 16; ++r) sA[r] = 0.f;
#pragma unroll
            for (int ks = 0; ks < 4; ++ks) sA = __builtin_amdgcn_mfma_f32_32x32x16_bf16(kf[ks], qA[ks], sA, 0, 0, 0);
            bf16x8 pA[2];
            mem_softmax_tile(sA, rk, hi, qscA, mxA, lsA, oA0, oA1, pA);
            v_frags(vl, lane, vf);
            oA0 = __builtin_amdgcn_mfma_f32_32x32x16_bf16(vf[0][0], pA[0], oA0, 0, 0, 0); oA1 = __builtin_amdgcn_mfma_f32_32x32x16_bf16(vf[1][0], pA[0], oA1, 0, 0, 0);
            oA0 = __builtin_amdgcn_mfma_f32_32x32x16_bf16(vf[0][1], pA[1], oA0, 0, 0, 0); oA1 = __builtin_amdgcn_mfma_f32_32x32x16_bf16(vf[1][1], pA[1], oA1, 0, 0, 0);
        }
        asm volatile("" ::: "memory"); __builtin_amdgcn_sched_barrier(0);
        {
            f32x16 sB;
#pragma unroll
            for (int r = 0; r < 16; ++r) sB[r] = 0.f;
#pragma unroll
            for (int ks = 0; ks < 4; ++ks) sB = __builtin_amdgcn_mfma_f32_32x32x16_bf16(kf[ks], qB[ks], sB, 0, 0, 0);
            if (s0 + 32 < MEML) {
#pragma unroll
                for (int ks = 0; ks < 4; ++ks) kr[ks] = *(const GAS v4u*)(kbase + (size_t)((s0 + 32) >> 5) * 8192 + 512 * ks);
#pragma unroll
                for (int k = 0; k < 4; ++k) vp[k] = *(const GAS v4u*)(vbase + (size_t)(s0 + 32 + 8 * k) * KVW);
            }
            bf16x8 pB[2];
            mem_softmax_tile(sB, rk, hi, qscB, mxB, lsB, oB0, oB1, pB);
            oB0 = __builtin_amdgcn_mfma_f32_32x32x16_bf16(vf[0][0], pB[0], oB0, 0, 0, 0); oB1 = __builtin_amdgcn_mfma_f32_32x32x16_bf16(vf[1][0], pB[0], oB1, 0, 0, 0);
            oB0 = __builtin_amdgcn_mfma_f32_32x32x16_bf16(vf[0][1], pB[1], oB0, 0, 0, 0); oB1 = __builtin_amdgcn_mfma_f32_32x32x16_bf16(vf[1][1], pB[1], oB1, 0, 0, 0);
        }
        asm volatile("" ::: "memory"); __builtin_amdgcn_sched_barrier(0);
    }
    { float lh; const float ll = swap_lo(lsA, lh); lsA = 1.f / (ll + lh); }
    { float lh; const float ll = swap_lo(lsB, lh); lsB = 1.f / (ll + lh); }
    float ssA = 0.f, ssB = 0.f;
#pragma unroll
    for (int r = 0; r < 16; ++r) { oA0[r] *= lsA; oA1[r] *= lsA; oB0[r] *= lsB; oB1[r] *= lsB; ssA += oA0[r] * oA0[r] + oA1[r] * oA1[r]; ssB += oB0[r] * oB0[r] + oB1[r] * oB1[r]; }
    { float sh; const float sl = swap_lo(ssA, sh); ssA = sl + sh; }
    { float sh; const float sl = swap_lo(ssB, sh); ssB = sl + sh; }
    LAS float* xs = (LAS float*)(F.lds + EXTRA_OFF);
    if (hi == 0) { xs[((half * 2 + 0) * 4 + h) * 32 + r32] = ssA; xs[((half * 2 + 1) * 4 + h) * 32 + r32] = ssB; }
    __syncthreads();
    float totA = 0.f, totB = 0.f;
#pragma unroll
    for (int w = 0; w < 4; ++w) { totA += xs[((half * 2 + 0) * 4 + w) * 32 + r32]; totB += xs[((half * 2 + 1) * 4 + w) * 32 + r32]; }
    const float rinvA = 1.f / sqrtf(totA * (1.f / 256.f) + EPS), rinvB = 1.f / sqrtf(totB * (1.f / 256.f) + EPS);
    bf16* dstA = P.CAT + rowA * D + 768 + h * 64 + 4 * hi; bf16* dstB = dstA + (size_t)32 * D; const float* gp = P.mem_out_g + h * 64 + 4 * hi;
#pragma unroll
    for (int mt = 0; mt < 2; ++mt)
#pragma unroll
        for (int j = 0; j < 4; ++j) { const f32x4 gv = *(const GAS f32x4*)(gp + 32 * mt + 8 * j);
            { const float a0 = (mt ? oA1[4 * j] : oA0[4 * j]) * rinvA * gv.x, a1 = (mt ? oA1[4 * j + 1] : oA0[4 * j + 1]) * rinvA * gv.y, a2 = (mt ? oA1[4 * j + 2] : oA0[4 * j + 2]) * rinvA * gv.z, a3 = (mt ? oA1[4 * j + 3] : oA0[4 * j + 3]) * rinvA * gv.w;
              *(GAS v2u*)(dstA + 32 * mt + 8 * j) = (v2u){cvtpk(a0, a1), cvtpk(a2, a3)}; }
            { const float a0 = (mt ? oB1[4 * j] : oB0[4 * j]) * rinvB * gv.x, a1 = (mt ? oB1[4 * j + 1] : oB0[4 * j + 1]) * rinvB * gv.y, a2 = (mt ? oB1[4 * j + 2] : oB0[4 * j + 2]) * rinvB * gv.z, a3 = (mt ? oB1[4 * j + 3] : oB0[4 * j + 3]) * rinvB * gv.w;
              *(GAS v2u*)(dstB + 32 * mt + 8 * j) = (v2u){cvtpk(a0, a1), cvtpk(a2, a3)}; } }
    __syncthreads();
}

#define CE(a, b) { const float hi_ = fmaxf(a, b), lo_ = fminf(a, b); a = hi_; b = lo_; }
#define SORT16(V) do { CE(V[0], V[1]); CE(V[2], V[3]); CE(V[0], V[2]); CE(V[1], V[3]); CE(V[1], V[2]); CE(V[4], V[5]); CE(V[6], V[7]); CE(V[4], V[6]); CE(V[5], V[7]); CE(V[5], V[6]); CE(V[0], V[4]); CE(V[2], V[6]); CE(V[2], V[4]); CE(V[1], V[5]); CE(V[3], V[7]); CE(V[3], V[5]); CE(V[1], V[2]); CE(V[3], V[4]); CE(V[5], V[6]); CE(V[8], V[9]); CE(V[10], V[11]); CE(V[8], V[10]); CE(V[9], V[11]); CE(V[9], V[10]); CE(V[12], V[13]); CE(V[14], V[15]); CE(V[12], V[14]); CE(V[13], V[15]); CE(V[13], V[14]); CE(V[8], V[12]); CE(V[10], V[14]); CE(V[10], V[12]); CE(V[9], V[13]); CE(V[11], V[15]); CE(V[11], V[13]); CE(V[9], V[10]); CE(V[11], V[12]); CE(V[13], V[14]); CE(V[0], V[8]); CE(V[4], V[12]); CE(V[4], V[8]); CE(V[2], V[10]); CE(V[6], V[14]); CE(V[6], V[10]); CE(V[2], V[4]); CE(V[6], V[8]); CE(V[10], V[12]); CE(V[1], V[9]); CE(V[5], V[13]); CE(V[5], V[9]); CE(V[3], V[11]); CE(V[7], V[15]); CE(V[7], V[11]); CE(V[3], V[5]); CE(V[7], V[9]); CE(V[11], V[13]); CE(V[1], V[2]); CE(V[3], V[4]); CE(V[5], V[6]); CE(V[7], V[8]); CE(V[9], V[10]); CE(V[11], V[12]); CE(V[13], V[14]); } while (0)
#define BITONIC16(V) do { CE(V[0], V[8]); CE(V[1], V[9]); CE(V[2], V[10]); CE(V[3], V[11]); CE(V[4], V[12]); CE(V[5], V[13]); CE(V[6], V[14]); CE(V[7], V[15]); CE(V[0], V[4]); CE(V[1], V[5]); CE(V[2], V[6]); CE(V[3], V[7]); CE(V[8], V[12]); CE(V[9], V[13]); CE(V[10], V[14]); CE(V[11], V[15]); CE(V[0], V[2]); CE(V[1], V[3]); CE(V[4], V[6]); CE(V[5], V[7]); CE(V[8], V[10]); CE(V[9], V[11]); CE(V[12], V[14]); CE(V[13], V[15]); CE(V[0], V[1]); CE(V[2], V[3]); CE(V[4], V[5]); CE(V[6], V[7]); CE(V[8], V[9]); CE(V[10], V[11]); CE(V[12], V[13]); CE(V[14], V[15]); } while (0)
#define MERGE16(A, B) do { _Pragma("unroll") for (int i_ = 0; i_ < 16; ++i_) A[i_] = fmaxf(A[i_], B[15 - i_]); BITONIC16(A); } while (0)
constexpr int KSTR = 272;
constexpr int P5_KEYS2 = 128 * KSTR, P5_TAB = 2 * 128 * KSTR;
__device__ __forceinline__ void peer_top16(const LAS unsigned char* keysL, const bf16* qptr, int r32, int hi, float (&T)[16]) {
    bf16x8 qf[8];
#pragma unroll
    for (int ks = 0; ks < 8; ++ks) qf[ks] = *(const GAS bf16x8*)(qptr + 512 * ks);
    f32x16 acc[4];
#pragma unroll
    for (int mt = 0; mt < 4; ++mt)
#pragma unroll
        for (int r = 0; r < 16; ++r) acc[mt][r] = 0.f;
#pragma unroll
    for (int ks = 0; ks < 8; ++ks)
#pragma unroll
        for (int mt = 0; mt < 4; ++mt) { const bf16x8 a = *(const LAS bf16x8*)(keysL + (32 * mt + r32) * KSTR + (16 * ks + 8 * hi) * 2); acc[mt] = __builtin_amdgcn_mfma_f32_32x32x16_bf16(a, qf[ks], acc[mt], 0, 0, 0); }
    float v[4][16]; const unsigned hi4 = (unsigned)hi << 2;
#pragma unroll
    for (int mt = 0; mt < 4; ++mt)
#pragma unroll
        for (int r = 0; r < 16; ++r) v[mt][r] = __uint_as_float((__float_as_uint(acc[mt][r]) & 0xFFFFFF80u) | ((unsigned)(32 * mt + (r & 3) + 8 * (r >> 2)) | hi4));
    SORT16(v[0]); SORT16(v[1]); SORT16(v[2]); SORT16(v[3]);
    MERGE16(v[0], v[1]); MERGE16(v[2], v[3]); MERGE16(v[0], v[2]);
    float plo[16], phi[16];
#pragma unroll
    for (int i = 0; i < 16; ++i) plo[i] = swap_lo(v[0][i], phi[i]);
#pragma unroll
    for (int i = 0; i < 16; ++i) T[i] = fmaxf(plo[i], phi[15 - i]);
    BITONIC16(T);
}
__device__ __forceinline__ float pack8(float s, unsigned code) { return __uint_as_float((__float_as_uint(s) & 0xFFFFFF00u) | code); }
__device__ __forceinline__ void peer_select_mfma(Frame& F, const Ptrs& P, int tb, int h, bool load_keys) {
    LAS unsigned char* lds = F.lds; const int tid = F.tid, lane = F.lane, r32 = lane & 31, hi = lane >> 5;
    if (load_keys) {
        __syncthreads();
#pragma unroll
        for (int i = 0; i < 8; ++i) { const int c = tid + 512 * i; const int which = c >> 11, rem = c & 2047, n = rem >> 4, ch = rem & 15;
            *(LAS v4u*)(lds + which * P5_KEYS2 + n * KSTR + ch * 16) = *(const GAS v4u*)(P.KEYS + (size_t)which * 131072 + (size_t)h * 16384 + n * 128 + ch * 8); }
        __syncthreads();
    }
    const int tok = tb * 256 + F.wave * 32 + r32;
    const bf16* qrow = P.Q + ((size_t)tb * 8 + h) * 65536 + (size_t)F.wave * 4096 + (hi * 32 + r32) * 8;
    float T1[16], T2[16];
    peer_top16(lds, qrow, r32, hi, T1);
    peer_top16(lds + P5_KEYS2, qrow + 32768, r32, hi, T2);
    LAS unsigned char* tabA = lds + P5_TAB + F.wave * 2048 + lane; LAS unsigned char* tabB = tabA + 1024;
#pragma unroll
    for (int i = 0; i < 16; ++i) { tabA[i * 64] = (unsigned char)(__float_as_uint(T1[i]) & 127u); tabB[i * 64] = (unsigned char)(__float_as_uint(T2[i]) & 127u); }
    float C0[16], X0[16], X1[16];
#pragma unroll
    for (int j = 0; j < 16; ++j) C0[j] = pack8(T1[0] + T2[j], (unsigned)j);
    {
        int n = 0;
#pragma unroll
        for (int i = 1; i < 14; ++i)
#pragma unroll
            for (int j = 0; j < 16; ++j) if ((i + 1) * (j + 1) <= 16) { const float c = pack8(T1[i] + T2[j], (unsigned)(i * 16 + j)); if (n < 16) X0[n] = c; else X1[n - 16] = c; ++n; }
    }
    SORT16(X0); SORT16(X1);
    MERGE16(X0, X1); MERGE16(C0, X0);
#pragma unroll
    for (int i = 14; i < 16; ++i) { float cv = pack8(T1[i] + T2[0], (unsigned)(i * 16));
#pragma unroll
        for (int p = 0; p < 16; ++p) { const float hi_ = fmaxf(C0[p], cv), lo_ = fminf(C0[p], cv); C0[p] = hi_; cv = lo_; } }
    float e[16], sum = 0.f;
#pragma unroll
    for (int p = 0; p < 16; ++p) { e[p] = __expf(C0[p] - C0[0]); sum += e[p]; }
    const float inv = 1.f / sum;
    if (hi == 0) {
        unsigned id[16];
#pragma unroll
        for (int p = 0; p < 16; ++p) { const unsigned code = __float_as_uint(C0[p]) & 255u; id[p] = (unsigned)tabA[(code >> 4) * 64] * 128u + (unsigned)tabB[(code & 15u) * 64]; }
        GAS v4u* di = (GAS v4u*)(P.SELH + ((size_t)tok * 8 + h) * 16);
#pragma unroll
        for (int j = 0; j < 2; ++j) di[j] = (v4u){id[8 * j] | (id[8 * j + 1] << 16), id[8 * j + 2] | (id[8 * j + 3] << 16), id[8 * j + 4] | (id[8 * j + 5] << 16), id[8 * j + 6] | (id[8 * j + 7] << 16)};
    } else {
        GAS f32x4* dg = (GAS f32x4*)(P.SELG + ((size_t)tok * 8 + h) * 16);
#pragma unroll
        for (int j = 0; j < 4; ++j) dg[j] = (f32x4){e[4 * j] * inv, e[4 * j + 1] * inv, e[4 * j + 2] * inv, e[4 * j + 3] * inv};
    }
}

typedef float f32x2 __attribute__((ext_vector_type(2)));
__device__ __forceinline__ float dpp_xor1(float x) { return __uint_as_float(__builtin_amdgcn_update_dpp(0u, __float_as_uint(x), 0xB1, 0xF, 0xF, true)); }
__device__ __forceinline__ float dpp_xor2(float x) { return __uint_as_float(__builtin_amdgcn_update_dpp(0u, __float_as_uint(x), 0x4E, 0xF, 0xF, true)); }
__device__ __forceinline__ float dpp_hmir(float x) { return __uint_as_float(__builtin_amdgcn_update_dpp(0u, __float_as_uint(x), 0x141, 0xF, 0xF, true)); }
__device__ __forceinline__ void asm_store_b64_nt(float* p, f32x2 v) { asm volatile("global_store_dwordx2 %0, %1, off nt" :: "v"(p), "v"(v) : "memory"); }
__device__ __forceinline__ void asm_store_b32_nt(unsigned* p, unsigned v) { asm volatile("global_store_dword %0, %1, off nt" :: "v"(p), "v"(v) : "memory"); }
__device__ __forceinline__ void asm_store_b64(float* p, f32x2 v) { asm volatile("global_store_dwordx2 %0, %1, off" :: "v"(p), "v"(v) : "memory"); }
__device__ __forceinline__ float fp8_dot16(const v4u r, const f32x2 (&hh)[8]) {
    const unsigned w[4] = {r.x, r.y, r.z, r.w}; f32x2 d = {0.f, 0.f};
#pragma unroll
    for (int i = 0; i < 4; ++i) { d += __builtin_amdgcn_cvt_pk_f32_fp8(w[i], false) * hh[2 * i]; d += __builtin_amdgcn_cvt_pk_f32_fp8(w[i], true) * hh[2 * i + 1]; }
    return d.x + d.y;
}
__device__ __forceinline__ int dppi(int x, const int ctrl_sel) { return ctrl_sel == 0 ? __builtin_amdgcn_update_dpp(0, x, 0xB1, 0xF, 0xF, true) : ctrl_sel == 1 ? __builtin_amdgcn_update_dpp(0, x, 0x4E, 0xF, 0xF, true) : __builtin_amdgcn_update_dpp(0, x, 0x141, 0xF, 0xF, true); }
__device__ __forceinline__ int i8_dot128(const v4u r, const unsigned (&hq)[4]) {
    int p = __builtin_amdgcn_sdot4((int)r.x, (int)hq[0], 0, false); p = __builtin_amdgcn_sdot4((int)r.y, (int)hq[1], p, false); p = __builtin_amdgcn_sdot4((int)r.z, (int)hq[2], p, false); p = __builtin_amdgcn_sdot4((int)r.w, (int)hq[3], p, false);
    p += dppi(p, 0); p += dppi(p, 1); p += dppi(p, 2);
    return p;
}
__device__ __forceinline__ float ssq_f32(const unsigned long long* p) { return (float)((double)__hip_atomic_load(p, RLX_AGENT) * 2.3283064365386963e-10); }
__device__ __forceinline__ void load_x1b16(const bf16* p, f32x4 (&xv)[4]) {
    const v4u a = ((const GAS v4u*)p)[0], b = ((const GAS v4u*)p)[1];
    xv[0] = (f32x4){bflo(a.x), bfhi(a.x), bflo(a.y), bfhi(a.y)}; xv[1] = (f32x4){bflo(a.z), bfhi(a.z), bflo(a.w), bfhi(a.w)};
    xv[2] = (f32x4){bflo(b.x), bfhi(b.x), bflo(b.y), bfhi(b.y)}; xv[3] = (f32x4){bflo(b.z), bfhi(b.z), bflo(b.w), bfhi(b.w)};
}
__device__ __forceinline__ void peer_h2q_rows(const Ptrs& P, int t0, int lane) {
    f32x4 xv[4][4], gv[4]; float sq[4];
#pragma unroll
    for (int r = 0; r < 4; ++r) { load_x1b16(P.XN + (size_t)(t0 + r) * D + 16 * lane, xv[r]); sq[r] = ssq_f32(P.SSQ2 + t0 + r); }
    const GAS f32x4* gr = (const GAS f32x4*)(P.ffn_g + 16 * lane);
#pragma unroll
    for (int i = 0; i < 4; ++i) gv[i] = gr[i];
#pragma unroll
    for (int r = 0; r < 4; ++r) {
        const float rs = 1.0f / sqrtf(sq[r] * (1.0f / 1024.0f) + EPS); f32x4 hv[4]; float am = 0.f;
#pragma unroll
        for (int i = 0; i < 4; ++i) { hv[i] = xv[r][i] * rs * gv[i]; am = fmaxf(fmaxf(am, fmaxf(fabsf(hv[i].x), fabsf(hv[i].y))), fmaxf(fabsf(hv[i].z), fabsf(hv[i].w))); }
        am = fmaxf(am, dpp_xor1(am)); am = fmaxf(am, dpp_xor2(am)); am = fmaxf(am, dpp_hmir(am));
        const float sc = am > 0.f ? 127.f / am : 1.f, hs = am > 0.f ? am * (1.f / 127.f) : 1.f;
        v4u q; unsigned hw[4];
#pragma unroll
        for (int i = 0; i < 4; ++i) { const f32x4 v = hv[i] * sc; hw[i] = pack_i8x4((int)__builtin_rintf(v.x), (int)__builtin_rintf(v.y), (int)__builtin_rintf(v.z), (int)__builtin_rintf(v.w)); }
        q = (v4u){hw[0], hw[1], hw[2], hw[3]};
        *(GAS v4u*)(P.H2Q + ((size_t)(lane >> 3) * M + (size_t)(t0 + r)) * 128 + 16 * (lane & 7)) = q;
        if ((lane & 7) == 0) P.HS[(size_t)(lane >> 3) * M + t0 + r] = hs;
    }
}
__device__ __forceinline__ void peer_dots_phase(Frame& F, const Ptrs& P) {
    const int nsl = F.G >> 3; if ((int)blockIdx.x >= nsl * 8) return;
    const int sx = blockIdx.x & 7, rank = blockIdx.x >> 3, lane = F.lane, k = lane >> 3, c = lane & 7;
    const int tstride = nsl * NWAVES;
    const unsigned char* tab = P.UT + (size_t)sx * NEXP * 128 + 16 * c;
    LAS float* tl = (LAS float*)(F.lds + F.wave * 512);
    int t = rank * NWAVES + F.wave;
    if (t >= M) return;
    const unsigned char* h2p = P.H2Q + (size_t)sx * M * 128 + 16 * c; const float* hsp = P.HS + (size_t)sx * M;
    int e0 = P.SELH[(size_t)t * 128 + lane], e1 = P.SELH[(size_t)t * 128 + 64 + lane];
    v4u hqv = *(const GAS v4u*)(h2p + (size_t)t * 128); float hsv = hsp[t];
    v4u ra[8], rb[8];
    asm volatile("" ::: "memory"); __builtin_amdgcn_sched_barrier(0);
#pragma unroll
    for (int i = 0; i < 8; ++i) { const int ej = __shfl(e0, 8 * i + k); ra[i] = *(const GAS v4u*)(tab + (size_t)ej * 128); }
    asm volatile("" ::: "memory"); __builtin_amdgcn_sched_barrier(0);
    for (; t < M; t += tstride) {
        const int tn = (t + tstride < M) ? t + tstride : t;
        const unsigned hq[4] = {hqv.x, hqv.y, hqv.z, hqv.w}; const float hs = hsv;
        __builtin_amdgcn_sched_barrier(0);
        const int ne0 = __builtin_nontemporal_load(P.SELH + (size_t)tn * 128 + lane), ne1 = __builtin_nontemporal_load(P.SELH + (size_t)tn * 128 + 64 + lane);
        hqv = __builtin_nontemporal_load((const v4u*)(h2p + (size_t)tn * 128)); hsv = __builtin_nontemporal_load(hsp + tn);
#pragma unroll
        for (int i = 0; i < 8; ++i) { const int ej = __shfl(e1, 8 * i + k); rb[i] = *(const GAS v4u*)(tab + (size_t)ej * 128); }
        asm volatile("" ::: "memory"); __builtin_amdgcn_sched_barrier(0);
        int res[16];
#pragma unroll
        for (int i = 0; i < 8; ++i) res[i] = i8_dot128(ra[i], hq);
        asm volatile("" ::: "memory"); __builtin_amdgcn_sched_barrier(0);
#pragma unroll
        for (int i = 0; i < 8; ++i) { const int ej = __shfl(ne0, 8 * i + k); ra[i] = *(const GAS v4u*)(tab + (size_t)ej * 128); }
        asm volatile("" ::: "memory"); __builtin_amdgcn_sched_barrier(0);
#pragma unroll
        for (int i = 0; i < 8; ++i) res[8 + i] = i8_dot128(rb[i], hq);
        __builtin_amdgcn_sched_barrier(0);
        if (c == 0) {
#pragma unroll
            for (int i = 0; i < 16; ++i) ((LAS int*)tl)[8 * i + k] = res[i];
        }
        const v2u pi = *(const LAS v2u*)(tl + 2 * lane);
        asm_store_b32_nt((unsigned*)P.PART + ((size_t)sx * M + t) * 64 + lane, cvtpk((float)(int)pi.x * hs, (float)(int)pi.y * hs));
        e0 = ne0; e1 = ne1;
    }
}
__device__ __forceinline__ void peer_act_phase(Frame& F, const Ptrs& P) {
    LAS float* scl = (LAS float*)(F.lds + RING_OFF);
    __syncthreads();
#pragma unroll
    for (int i = 0; i < 16; ++i) __builtin_amdgcn_global_load_lds((const unsigned*)((const unsigned char*)P.USC + (size_t)(F.wave + 8 * i) * 1024 + F.lane * 16), (LAS unsigned*)(F.lds + RING_OFF + (F.wave + 8 * i) * 1024), 16, 0, 0);
    asm volatile("s_waitcnt vmcnt(0)" ::: "memory");
    __syncthreads();
    const size_t n4 = (size_t)M * 128 / 4, nthr = (size_t)F.G * NWAVES * 64;
    for (size_t i = (size_t)blockIdx.x * (NWAVES * 64) + F.tid; i < n4; i += nthr) {
        f32x4 d = {0.f, 0.f, 0.f, 0.f};
#pragma unroll
        for (int sx = 0; sx < 8; ++sx) { const v2u pw = ((const GAS v2u*)((const unsigned*)P.PART + (size_t)sx * M * 64))[i]; d += (f32x4){bflo(pw.x), bfhi(pw.x), bflo(pw.y), bfhi(pw.y)}; }
        const v2u e = ((const GAS v2u*)P.SELH)[i]; const f32x4 g = ((const GAS f32x4*)P.SELG)[i];
        const unsigned ee[4] = {e.x & 0xffffu, e.x >> 16, e.y & 0xffffu, e.y >> 16}; const float dd[4] = {d.x, d.y, d.z, d.w}, gg[4] = {g.x, g.y, g.z, g.w}; float w[4];
#pragma unroll
        for (int q = 0; q < 4; ++q) { const float dot = dd[q] * scl[ee[q]]; w[q] = 0.5f * dot * (1.f + erff(dot * 0.70710678118654752f)) * gg[q] * scl[NEXP + ee[q]]; }
        ((GAS v2u*)P.WB)[i] = (v2u){cvtpk(w[0], w[1]), cvtpk(w[2], w[3])};
    }
    __syncthreads();
}
__device__ __forceinline__ void fp8_axpy16(const v4u r, const float w, f32x2 (&acc)[8]) {
    const unsigned ww[4] = {r.x, r.y, r.z, r.w};
#pragma unroll
    for (int i = 0; i < 4; ++i) { acc[2 * i] += __builtin_amdgcn_cvt_pk_f32_fp8(ww[i], false) * w; acc[2 * i + 1] += __builtin_amdgcn_cvt_pk_f32_fp8(ww[i], true) * w; }
}
__device__ __forceinline__ void peer_accum_phase(Frame& F, const Ptrs& P) {
    const int nsl = F.G >> 3; if ((int)blockIdx.x >= nsl * 8) return;
    const int sx = blockIdx.x & 7, rank = blockIdx.x >> 3, lane = F.lane, k = lane >> 3, c = lane & 7;
    const int tstride = nsl * NWAVES;
    const unsigned char* tab = P.VT + (size_t)sx * NEXP * 128 + 16 * c;
    const bool h5 = (lane & 32) != 0, h4 = (lane & 16) != 0, h3 = (lane & 8) != 0;
    const int chan = 128 * sx + 16 * c + 8 * (h5 ? 1 : 0) + 4 * (h4 ? 1 : 0) + 2 * (h3 ? 1 : 0);
    int t = rank * NWAVES + F.wave;
    if (t >= M) return;
    int e0 = P.SELH[(size_t)t * 128 + lane], e1 = P.SELH[(size_t)t * 128 + 64 + lane];
    float w0 = bflo(P.WB[(size_t)t * 128 + lane]), w1 = bflo(P.WB[(size_t)t * 128 + 64 + lane]);
    unsigned xres = *(const GAS unsigned*)(P.XN + (size_t)t * D + chan);
    v4u ra[8], rb[8];
    asm volatile("" ::: "memory"); __builtin_amdgcn_sched_barrier(0);
#pragma unroll
    for (int i = 0; i < 8; ++i) { const int ej = __shfl(e0, 8 * i + k); ra[i] = *(const GAS v4u*)(tab + (size_t)ej * 128); }
    asm volatile("" ::: "memory"); __builtin_amdgcn_sched_barrier(0);
    for (; t < M; t += tstride) {
        const int tn = (t + tstride < M) ? t + tstride : t;
        const int ne0 = __builtin_nontemporal_load(P.SELH + (size_t)tn * 128 + lane), ne1 = __builtin_nontemporal_load(P.SELH + (size_t)tn * 128 + 64 + lane);
        const float nw0 = bflo(__builtin_nontemporal_load(P.WB + (size_t)tn * 128 + lane)), nw1 = bflo(__builtin_nontemporal_load(P.WB + (size_t)tn * 128 + 64 + lane));
        const unsigned nx = __builtin_nontemporal_load((const unsigned*)(P.XN + (size_t)tn * D + chan));
#pragma unroll
        for (int i = 0; i < 8; ++i) { const int ej = __shfl(e1, 8 * i + k); rb[i] = *(const GAS v4u*)(tab + (size_t)ej * 128); }
        asm volatile("" ::: "memory"); __builtin_amdgcn_sched_barrier(0);
        f32x2 acc[8];
#pragma unroll
        for (int i = 0; i < 8; ++i) acc[i] = (f32x2){0.f, 0.f};
#pragma unroll
        for (int i = 0; i < 8; ++i) fp8_axpy16(ra[i], __shfl(w0, 8 * i + k), acc);
        asm volatile("" ::: "memory"); __builtin_amdgcn_sched_barrier(0);
#pragma unroll
        for (int i = 0; i < 8; ++i) { const int ej = __shfl(ne0, 8 * i + k); ra[i] = *(const GAS v4u*)(tab + (size_t)ej * 128); }
        asm volatile("" ::: "memory"); __builtin_amdgcn_sched_barrier(0);
#pragma unroll
        for (int i = 0; i < 8; ++i) fp8_axpy16(rb[i], __shfl(w1, 8 * i + k), acc);
        __builtin_amdgcn_sched_barrier(0);
        f32x2 b4[4], b2[2], b1;
#pragma unroll
        for (int i = 0; i < 4; ++i) { const f32x2 keep = h5 ? acc[4 + i] : acc[i], send = h5 ? acc[i] : acc[4 + i]; b4[i] = (f32x2){keep.x + __shfl_xor(send.x, 32), keep.y + __shfl_xor(send.y, 32)}; }
#pragma unroll
        for (int i = 0; i < 2; ++i) { const f32x2 keep = h4 ? b4[2 + i] : b4[i], send = h4 ? b4[i] : b4[2 + i]; b2[i] = (f32x2){keep.x + __shfl_xor(send.x, 16), keep.y + __shfl_xor(send.y, 16)}; }
        { const f32x2 keep = h3 ? b2[1] : b2[0], send = h3 ? b2[0] : b2[1]; b1 = (f32x2){keep.x + __shfl_xor(send.x, 8), keep.y + __shfl_xor(send.y, 8)}; }
        asm_store_b64_nt(P.out + (size_t)t * D + chan, (f32x2){bflo(xres), bfhi(xres)} + b1);
        e0 = ne0; e1 = ne1; w0 = nw0; w1 = nw1; xres = nx;
    }
}

struct Args { const float* in[21]; float* out; unsigned char* ws; int ph_lo, ph_hi, li, pad; };
__device__ __forceinline__ Ptrs make_ptrs(const Args& args) {
    unsigned char* ws = args.ws;
    Ptrs P;
    P.x = args.in[0]; P.mem = args.in[1]; P.attn_g = args.in[2]; P.w_in = args.in[3]; P.conv_w = args.in[4]; P.conv_b = args.in[5]; P.conv_ln_g = args.in[6]; P.conv_ln_b = args.in[7];
    P.sb_out_g = args.in[8]; P.mem_norm_g = args.in[9]; P.w_mem_kv = args.in[10]; P.q_norm_g = args.in[11]; P.k_norm_g = args.in[12]; P.mem_out_g = args.in[13]; P.w_out = args.in[14];
    P.ffn_g = args.in[15]; P.w_peer_q = args.in[16]; P.keys1 = args.in[17]; P.keys2 = args.in[18]; P.peer_u = args.in[19]; P.peer_v = args.in[20];
    P.out = args.out;
    P.WIN = (bf16*)(ws + WS_WIN); P.WKV = (bf16*)(ws + WS_WKV); P.WOUT = (bf16*)(ws + WS_WOUT); P.WPQ = (bf16*)(ws + WS_WPQ); P.KEYS = (bf16*)(ws + WS_KEYS);
    P.MEMN = (bf16*)(ws + WS_MEMN); P.MKV = (bf16*)(ws + WS_MKV); P.UT = ws + WS_UT; P.VT = ws + WS_VT; P.PART = (float*)(ws + WS_PROJ); P.USC = (float*)(ws + WS_SC); P.VSC = (float*)(ws + WS_SC) + NEXP; P.XN = (bf16*)(ws + WS_XN); P.CAT = (bf16*)(ws + WS_CAT);
    P.PROJ = (bf16*)(ws + WS_PROJ); P.Q = (bf16*)(ws + WS_Q); P.SELH = (unsigned short*)(ws + WS_SELI); P.WB = (unsigned short*)(ws + WS_CAT); P.SELG = (float*)(ws + WS_SELG); P.SSQ2 = (unsigned long long*)((unsigned*)(ws + WS_CTL) + CW_SSQ2); P.KF = (bf16*)(ws + WS_KF); P.MKF = (bf16*)(ws + WS_MKF); P.H2Q = ws + WS_KF; P.HS = (float*)(ws + WS_MKF);
    return P;
}
__global__ void __launch_bounds__(NWAVES * 64, 2) fwd_kernel(Args args) {
    extern __shared__ __attribute__((aligned(16))) unsigned char lds[];
    Frame F;
    F.lds = (LAS unsigned char*)lds;
    F.MISC = (volatile LAS unsigned*)(F.lds + MISC_OFF);
    F.tid = threadIdx.x; F.lane = F.tid & 63; F.wave = __builtin_amdgcn_readfirstlane(F.tid >> 6);
    F.G = gridDim.x; { const int bx = blockIdx.x; F.vcu = (F.G % 8 == 0) ? (bx % 8) * (F.G / 8) + bx / 8 : bx; }
    unsigned char* ws = args.ws;
    F.ctl = (gu32*)(ws + WS_CTL);
    for (int u = F.tid; u < (LDS_BYTES - LDSCTL_OFF) / 4; u += NWAVES * 64) ((LAS unsigned*)(F.lds + LDSCTL_OFF))[u] = 0u;
    __syncthreads();
    XcdBarrier bar; bar.bar = (unsigned*)(F.ctl + CW_BAR); bar.x = 0; bar.st = nullptr;
    if (N_LAUNCHES != PER_PHASE) bar = xcd_barrier_post((unsigned*)(F.ctl + CW_BAR), F.MISC + 8);
#define GRID_BAR() do { if (N_LAUNCHES != PER_PHASE) xcd_barrier(bar); } while (0)
    const int lo = args.ph_lo, hi = args.ph_hi;
#define IN(k) (lo <= (k) && (k) < hi)
#define BOTH(k) (IN(k) && IN((k) + 1))

    if (IN(0)) { const Ptrs P = make_ptrs(args); for (int rep = 0; rep < (PROBE_DBL == 0 ? 2 : 1); ++rep) p0_prologue(F, P); if (BOTH(0)) GRID_BAR(); }

    if (IN(1)) { const Ptrs P = make_ptrs(args);
        { pg8::Gemm g{P.XN, P.WIN, M, INW, D}; pg8::StaticOrder S; S.init(M, INW, F.G, (int)blockIdx.x);
          pg8::EpiBf16K E{P.PROJ, INW, P.KF, C_K / 256, C_K / 256 + 1, 8};
          for (int rep = 0; rep < (PROBE_DBL == 1 ? 2 : 1); ++rep)
          pg8::gemm_phase<pg8::EpiBf16K, pg8::StaticOrder, PG8_ALIGN, PG8_SP2>(F.lds + RING_OFF, g, S, E); }
        { pg8::Gemm g{P.MEMN, P.WKV, MMEM, KVW, D}; pg8::StaticOrder S; S.init(MMEM, KVW, F.G, (int)((blockIdx.x + (unsigned)(F.G / 2)) % (unsigned)F.G));
          pg8::EpiBf16K E{P.MKV, KVW, P.MKF, 0, 0, 4};
          pg8::gemm_phase<pg8::EpiBf16K, pg8::StaticOrder, PG8_ALIGN, PG8_SP2>(F.lds + RING_OFF, g, S, E); }
        if (BOTH(1)) GRID_BAR();
    }

    if (IN(2)) { const Ptrs P = make_ptrs(args);
        const int c = F.vcu;
        for (int rep = 0; rep < (PROBE_DBL == 2 ? 2 : 1); ++rep) {
        const int cls = (blockIdx.x >> 3) & 3;
#define P2_SB(F) do { for (int r2 = 0; r2 < (PROBE_DBL == 20 ? 2 : 1); ++r2) { \
            const bool deal = (F.G == 256); const int nit = deal ? 2 : (BATCH * (SEQ / 64) - c + F.G - 1) / F.G; \
            for (int i = 0; i < nit; ++i) { const int it = c + i * F.G, s = c & 31; const int b = deal ? (c >> 5) : (it >> 6), g = deal ? (i == 0 ? 63 - s : s) : (it & 63); sb_item_mfma(F, P, b, g); } } __syncthreads(); } while (0)
#define P2_MEM(F) do { for (int r2 = 0; r2 < (PROBE_DBL == 21 ? 2 : 1); ++r2) for (int it = c; it < BATCH * (SEQ / 128); it += F.G) mem_item_mfma(F, P, it >> 5, it & 31); __syncthreads(); } while (0)
#define P2_CONV(F) do { for (int r2 = 0; r2 < (PROBE_DBL == 22 ? 2 : 1); ++r2) conv_phase(F, P); __syncthreads(); } while (0)
#define P2_TAB(F) do { const int gw = F.vcu * NWAVES + F.wave, NGW = F.G * NWAVES; \
            for (int r = gw * 4; r < 2 * NEXP; r += NGW * 4) { if (r < NEXP) rows_to_i8<4>(P.peer_u, P.UT, P.USC, r, F.lane); else rows_to_fp8<4>(P.peer_v, P.VT, P.VSC, r - NEXP, F.lane); } __syncthreads(); } while (0)
        if (cls == 0)      { Frame Fa = F; asm volatile("" : "+v"(Fa.tid), "+v"(Fa.lane)); P2_SB(Fa); P2_MEM(Fa); P2_CONV(Fa); P2_TAB(Fa); }
        else if (cls == 1) { Frame Fb = F; asm volatile("" : "+v"(Fb.tid), "+v"(Fb.lane)); P2_TAB(Fb); P2_CONV(Fb); P2_MEM(Fb); P2_SB(Fb); }
        else if (cls == 2) { Frame Fc = F; asm volatile("" : "+v"(Fc.tid), "+v"(Fc.lane)); P2_CONV(Fc); P2_SB(Fc); P2_TAB(Fc); P2_MEM(Fc); }
        else               { Frame Fd = F; asm volatile("" : "+v"(Fd.tid), "+v"(Fd.lane)); P2_MEM(Fd); P2_TAB(Fd); P2_SB(Fd); P2_CONV(Fd); }
#undef P2_SB
#undef P2_MEM
#undef P2_CONV
#undef P2_TAB
        }
        if (BOTH(2)) GRID_BAR();
    }

    if (IN(3)) { const Ptrs P = make_ptrs(args);
        pg8::Gemm g{P.CAT, P.WOUT, M, D, D}; pg8::StaticOrder S; S.init(M, D, F.G, (int)blockIdx.x);
        pg8::EpiResid E{P.x, P.XN, P.SSQ2, D};
        pg8::gemm_phase<pg8::EpiResid, pg8::StaticOrder, PG8_ALIGN, PG8_SP2>(F.lds + RING_OFF, g, S, E);
        if (PROBE_DBL == 3) { pg8::EpiResid E2{P.x, P.XN, (unsigned long long*)P.SELG, D}; pg8::gemm_phase<pg8::EpiResid, pg8::StaticOrder, PG8_ALIGN, PG8_SP2>(F.lds + RING_OFF, g, S, E2); }
        if (BOTH(3)) GRID_BAR();
    }

    if (IN(4)) { const Ptrs P = make_ptrs(args);
        pg8::Gemm g{P.XN, P.WPQ, M, PQW, D}; pg8::StaticOrder S; S.init(M, PQW, F.G, (int)blockIdx.x);
        pg8::EpiBf16RowQ E{P.Q, PQW, P.SSQ2};
        for (int rep = 0; rep < (PROBE_DBL == 4 ? 2 : 1); ++rep)
        pg8::gemm_phase<pg8::EpiBf16RowQ, pg8::StaticOrder, PG8_ALIGN, PG8_SP2>(F.lds + RING_OFF, g, S, E);
        asm volatile("s_waitcnt vmcnt(0)" ::: "memory");
        __builtin_amdgcn_fence(__ATOMIC_ACQUIRE, "agent");
        asm volatile("s_waitcnt vmcnt(0)" ::: "memory");
        __syncthreads();
        for (int rep = 0; rep < (PROBE_DBL == 5 ? 2 : 1); ++rep) { pg8::Unit u; for (int i = 0; S.next(i, u); ++i) peer_select_mfma(F, P, u.pm, u.pn, true); }
        { const int gw = F.vcu * NWAVES + F.wave, NGW = F.G * NWAVES; for (int g4 = gw; g4 < M / 4; g4 += NGW) peer_h2q_rows(P, 4 * g4, F.lane); }
        __syncthreads();
        if (BOTH(4)) GRID_BAR();
    }
    if (IN(6)) { const Ptrs P = make_ptrs(args); for (int rep = 0; rep < (PROBE_DBL == 6 ? 2 : 1); ++rep) peer_dots_phase(F, P); if (BOTH(6)) GRID_BAR(); }
    if (IN(7)) { const Ptrs P = make_ptrs(args); for (int rep = 0; rep < (PROBE_DBL == 7 ? 2 : 1); ++rep) peer_act_phase(F, P); if (BOTH(7)) GRID_BAR(); }
    if (IN(8)) { const Ptrs P = make_ptrs(args); peer_accum_phase(F, P);
        if (PROBE_DBL == 8) { GRID_BAR(); for (size_t i = (size_t)blockIdx.x * 512 + F.tid; i < (size_t)M * 16; i += (size_t)F.G * 512) ((GAS v4u*)P.WB)[i] = (v4u){0u, 0u, 0u, 0u}; GRID_BAR(); peer_accum_phase(F, P); } }
#undef IN
#undef BOTH
}

extern "C" void kernel_launch(void* const* d_in, const int* in_sizes, int n_in, void* d_out, int out_size, void* d_ws, size_t ws_size, hipStream_t stream) {
    static int grid = 0;
    if (grid == 0) {
        if (n_in != 21 || in_sizes[0] != M * D || out_size != M * D || ws_size < WS_END) { fprintf(stderr, "kernel_launch: unexpected shapes/workspace (n_in %d, in0 %d, out %d, ws %zu); nothing launched\n", n_in, n_in > 0 ? in_sizes[0] : -1, out_size, ws_size); grid = -1; return; }
        int dev = 0, cus = 0, per_cu = 0;
        if (hipGetDevice(&dev) != hipSuccess || hipDeviceGetAttribute(&cus, hipDeviceAttributeMultiprocessorCount, dev) != hipSuccess) { grid = -1; return; }
        if (hipFuncSetAttribute((const void*)fwd_kernel, hipFuncAttributeMaxDynamicSharedMemorySize, LDS_BYTES) != hipSuccess) { fprintf(stderr, "kernel_launch: hipFuncSetAttribute failed\n"); grid = -1; return; }
        if (hipOccupancyMaxActiveBlocksPerMultiprocessor(&per_cu, (const void*)fwd_kernel, NWAVES * 64, LDS_BYTES) != hipSuccess || per_cu < 1) { fprintf(stderr, "kernel_launch: occupancy query says %d blocks per CU\n", per_cu); }
        (void)hipGetLastError();
        grid = cus;
    }
    if (grid < 0) return;
    if (hipMemsetAsync((char*)d_ws + WS_CTL, 0, CTL_ZERO_BYTES, stream) != hipSuccess) { fprintf(stderr, "kernel_launch: memset failed\n"); return; }
    Args a{};
    for (int i = 0; i < 21; ++i) a.in[i] = (const float*)d_in[i];
    a.out = (float*)d_out; a.ws = (unsigned char*)d_ws;
    for (int li = 0; li < N_LAUNCHES; ++li) {
        a.ph_lo = (N_LAUNCHES == PER_PHASE) ? li : 0; a.ph_hi = (N_LAUNCHES == PER_PHASE) ? li + 1 : PER_PHASE; a.li = li;
        { void* kargs[] = {(void*)&a}; (void)hipLaunchCooperativeKernel((const void*)fwd_kernel, dim3(grid), dim3(NWAVES * 64), kargs, LDS_BYTES, stream); }
        const hipError_t le = hipPeekAtLastError();
        if (le != hipSuccess) { fprintf(stderr, "kernel_launch: launch %d failed: %s\n", li, hipGetErrorName(le)); break; }
    }
}
```

```cpp
#include <hip/hip_runtime.h>
#include <cstdio>
#include <cstdint>
namespace pg8 {
#define PG8_LAS __attribute__((address_space(3)))
typedef unsigned short bf16_t;
typedef short bf16x8 __attribute__((ext_vector_type(8)));
typedef float f32x4 __attribute__((ext_vector_type(4)));
typedef unsigned u32x4 __attribute__((ext_vector_type(4)));
constexpr int BM = 256, BK = 64, HALF = 128, HTB = HALF * BK * 2  , STAGE_BYTES = 8 * HTB, NXCD = 8, WGM = 8;

__host__ __device__ __forceinline__ int lds_byte(int r, int c) { const int st = (r >> 4) * 2 + (c >> 5), rr = r & 15, cc = c & 31, ob = rr * 64 + cc * 2; return st * 1024 + (ob ^ (((ob >> 9) & 1) << 5)); }
__host__ __device__ __forceinline__ void stage_rc(int b, int& R, int& C) { const int st = b / 1024, sb = b % 1024, swz = sb ^ (((sb >> 9) & 1) << 5); R = (st >> 1) * 16 + swz / 64; C = (st & 1) * 32 + (swz % 64) / 2; }
__host__ __device__ __forceinline__ int perm32(int rho) { const int n = rho >> 4, i = rho & 15; return 8 * (i >> 2) + 4 * n + (i & 3); }

struct Unit { int pm, pn; };
struct Gemm { const bf16_t* A; const bf16_t* Bt; int M, N, K; };

struct StaticOrder {
    int nM, nN, nwg, G, c;
    __host__ __device__ void init(int M, int N, int G_, int c_) { nM = M / BM; nN = N / BM; nwg = nM * nN; G = G_; c = c_; }
    __host__ __device__ bool next(int i, Unit& u) const {
        const long L = (long)i * G + c; if (L >= nwg) return false;
        int wgid = (int)L; { const int q = nwg / NXCD, r = nwg % NXCD, xcd = wgid % NXCD, off = wgid / NXCD; wgid = (xcd < r ? xcd * (q + 1) : r * (q + 1) + (xcd - r) * q) + off; }
        const int nig = WGM * nN, gid = wgid / nig, fm = gid * WGM, gsz = (nM - fm) < WGM ? (nM - fm) : WGM;
        u.pm = fm + ((wgid % nig) % gsz); u.pn = (wgid % nig) / gsz; return true;
    }
    __device__ __forceinline__ void a_ready(const Unit&) const {}
    __device__ __forceinline__ void done(const Unit&) const {}
};

__device__ __forceinline__ unsigned cvt_pk_bf16(float lo, float hi) { unsigned r; asm volatile("v_cvt_pk_bf16_f32 %0, %1, %2" : "=v"(r) : "v"(lo), "v"(hi)); return r; }
typedef unsigned u32x2 __attribute__((ext_vector_type(2)));

struct EpiBf16 {
    static constexpr bool PERM = true, AFTER_DRAIN = false;
    bf16_t* O; int ldc;
    __device__ __forceinline__ void operator()(const f32x4 (&acc)[2][2][4][2], const Unit& u, int wr, int wc, int fr, int fq) const {
        const int row0 = u.pm * BM + wr * 64 + fr; const int col0 = u.pn * BM + wc * 32 + 8 * fq;
#pragma unroll
        for (int ai = 0; ai < 2; ++ai)
#pragma unroll
            for (int m = 0; m < 4; ++m) { bf16_t* rowp = O + (size_t)(row0 + ai * HALF + m * 16) * ldc + col0;
#pragma unroll
                for (int bj = 0; bj < 2; ++bj) { const f32x4 v0 = acc[ai][bj][m][0], v1 = acc[ai][bj][m][1];
                    u32x4 w; w.x = cvt_pk_bf16(v0[0], v0[1]); w.y = cvt_pk_bf16(v0[2], v0[3]); w.z = cvt_pk_bf16(v1[0], v1[1]); w.w = cvt_pk_bf16(v1[2], v1[3]);
                    *(u32x4*)(rowp + bj * HALF) = w; } }
    }
};
struct EpiBf16Row {
    static constexpr bool PERM = true, AFTER_DRAIN = false;
    bf16_t* O; int ldc; const unsigned long long* ssq;
    __device__ __forceinline__ void operator()(const f32x4 (&acc)[2][2][4][2], const Unit& u, int wr, int wc, int fr, int fq) const {
        const int row0 = u.pm * BM + wr * 64 + fr; const int col0 = u.pn * BM + wc * 32 + 8 * fq;
#pragma unroll
        for (int ai = 0; ai < 2; ++ai)
#pragma unroll
            for (int m = 0; m < 4; ++m) { const int row = row0 + ai * HALF + m * 16; bf16_t* rowp = O + (size_t)row * ldc + col0;
                const float rs = 1.0f / sqrtf((float)((double)__hip_atomic_load(ssq + row, __ATOMIC_RELAXED, __HIP_MEMORY_SCOPE_AGENT) * 2.3283064365386963e-10) * (1.0f / 1024.0f) + 1e-6f);
#pragma unroll
                for (int bj = 0; bj < 2; ++bj) { const f32x4 v0 = acc[ai][bj][m][0] * rs, v1 = acc[ai][bj][m][1] * rs;
                    u32x4 w; w.x = cvt_pk_bf16(v0[0], v0[1]); w.y = cvt_pk_bf16(v0[2], v0[3]); w.z = cvt_pk_bf16(v1[0], v1[1]); w.w = cvt_pk_bf16(v1[2], v1[3]);
                    *(u32x4*)(rowp + bj * HALF) = w; } }
    }
};
struct EpiBf16RowQ {
    static constexpr bool PERM = true, AFTER_DRAIN = false;
    bf16_t* O; int ldc; const unsigned long long* ssq;
    __device__ __forceinline__ void operator()(const f32x4 (&acc)[2][2][4][2], const Unit& u, int wr, int wc, int fr, int fq) const {
        const int row0 = u.pm * BM + wr * 64 + fr;
        u32x4* blk = (u32x4*)O + ((size_t)u.pm * (ldc / BM) + u.pn) * 8192;
        unsigned long long sq[2][4];
#pragma unroll
        for (int ai = 0; ai < 2; ++ai)
#pragma unroll
            for (int m = 0; m < 4; ++m) sq[ai][m] = __builtin_nontemporal_load(ssq + row0 + ai * HALF + m * 16);
#pragma unroll
        for (int ai = 0; ai < 2; ++ai)
#pragma unroll
            for (int m = 0; m < 4; ++m) {
                const float rs = 1.0f / sqrtf((float)((double)sq[ai][m] * 2.3283064365386963e-10) * (1.0f / 1024.0f) + 1e-6f);
#pragma unroll
                for (int bj = 0; bj < 2; ++bj) { const f32x4 v0 = acc[ai][bj][m][0] * rs, v1 = acc[ai][bj][m][1] * rs;
                    u32x4 w; w.x = cvt_pk_bf16(v0[0], v0[1]); w.y = cvt_pk_bf16(v0[2], v0[3]); w.z = cvt_pk_bf16(v1[0], v1[1]); w.w = cvt_pk_bf16(v1[2], v1[3]);
                    blk[((((bj * 8 + (ai * 4 + wr * 2 + (m >> 1))) * 8 + (2 * wc + (fq >> 1))) * 2 + (fq & 1)) * 32) + ((m & 1) * 16 + fr)] = w; } }
    }
};
struct EpiBf16K {
    static constexpr bool PERM = true, AFTER_DRAIN = false;
    bf16_t* O; int ldc; bf16_t* KF; int pn_lo, pn_hi, NH;
    __device__ __forceinline__ void operator()(const f32x4 (&acc)[2][2][4][2], const Unit& u, int wr, int wc, int fr, int fq) const {
        const int row0 = u.pm * BM + wr * 64 + fr; const int col0 = u.pn * BM + wc * 32 + 8 * fq;
        const bool isk = u.pn >= pn_lo && u.pn <= pn_hi;
#pragma unroll
        for (int ai = 0; ai < 2; ++ai)
#pragma unroll
            for (int m = 0; m < 4; ++m) { bf16_t* rowp = O + (size_t)(row0 + ai * HALF + m * 16) * ldc + col0;
#pragma unroll
                for (int bj = 0; bj < 2; ++bj) { const f32x4 v0 = acc[ai][bj][m][0], v1 = acc[ai][bj][m][1];
                    u32x4 w; w.x = cvt_pk_bf16(v0[0], v0[1]); w.y = cvt_pk_bf16(v0[2], v0[3]); w.z = cvt_pk_bf16(v1[0], v1[1]); w.w = cvt_pk_bf16(v1[2], v1[3]);
                    if (isk) { const size_t kt = (size_t)u.pm * 8 + ai * 4 + wr * 2 + (m >> 1); const int h = (u.pn - pn_lo) * 4 + 2 * bj + (wc >> 1), ks = 2 * (wc & 1) + (fq >> 1);
                        ((u32x4*)KF)[(((kt * NH + h) * 4 + ks) * 2 + (fq & 1)) * 32 + ((m & 1) * 16 + fr)] = w; }
                    else *(u32x4*)(rowp + bj * HALF) = w; } }
    }
};
struct EpiResid {
    static constexpr bool PERM = true, AFTER_DRAIN = false;
    const float* x; bf16_t* xb; unsigned long long* ssq; int ldc;
    __device__ __forceinline__ void operator()(const f32x4 (&acc)[2][2][4][2], const Unit& u, int wr, int wc, int fr, int fq) const {
        const int col0 = u.pn * BM + wc * 32 + 8 * fq;
#pragma unroll
        for (int ai = 0; ai < 2; ++ai)
#pragma unroll
            for (int m = 0; m < 4; ++m) { const int row = u.pm * BM + ai * HALF + wr * 64 + m * 16 + fr; const size_t off = (size_t)row * ldc + col0; float s = 0.f;
#pragma unroll
                for (int bj = 0; bj < 2; ++bj) { const f32x4 x0 = *(const f32x4*)(x + off + bj * HALF), x1 = *(const f32x4*)(x + off + bj * HALF + 4);
                    const f32x4 o0 = x0 + acc[ai][bj][m][0], o1 = x1 + acc[ai][bj][m][1];
                    s += ((o0[0] * o0[0] + o0[1] * o0[1]) + (o0[2] * o0[2] + o0[3] * o0[3])) + ((o1[0] * o1[0] + o1[1] * o1[1]) + (o1[2] * o1[2] + o1[3] * o1[3]));
                    u32x4 w; w.x = cvt_pk_bf16(o0[0], o0[1]); w.y = cvt_pk_bf16(o0[2], o0[3]); w.z = cvt_pk_bf16(o1[0], o1[1]); w.w = cvt_pk_bf16(o1[2], o1[3]);
                    *(u32x4*)(xb + off + bj * HALF) = w; }
                s += __shfl_xor(s, 16); s += __shfl_xor(s, 32);
                if (fq == 0) atomicAdd(ssq + row, (unsigned long long)((double)s * 4294967296.0)); }
    }
};

template <class Epi, class Sched, bool ALIGN_EPI = false, bool SP2 = false>
__device__ __forceinline__ void gemm_phase(PG8_LAS unsigned char* lds, const Gemm g, const Sched& S, const Epi& E) {
    const int tid = threadIdx.x, wid = __builtin_amdgcn_readfirstlane(tid >> 6), lane = tid & 63, wr = wid >> 2, wc = wid & 3, fr = lane & 15, fq = lane >> 4;
    const int K = g.K, nt = K / BK;
    unsigned voffA[2], voffB[2];
#pragma unroll
    for (int i = 0; i < 2; ++i) { int R, C; stage_rc(tid * 16 + i * 8192, R, C); const int Rb = Epi::PERM ? ((R & ~31) + perm32(R & 31)) : R;
        voffA[i] = (unsigned)(R * K + C) * 2u; voffB[i] = (unsigned)(Rb * K + C) * 2u; }
    const size_t kstep = (size_t)(BK * 2);
    const size_t hstep = (size_t)HALF * K * 2;
    const size_t tstep = 2 * hstep;
    const unsigned ldsw = (unsigned)wid * 1024u;
    const int aoff = lds_byte(wr * 64 + fr, fq * 8), boff = lds_byte(wc * 32 + fr, fq * 8);
#define PG8_SA(b, h) (((b) * 2 + (h)) * HTB)
#define PG8_SB(b, h) ((4 + (b) * 2 + (h)) * HTB)
#define PG8_STAGE(bufoff, gbase, voff) do { _Pragma("unroll") for (int _i = 0; _i < 2; ++_i) \
        __builtin_amdgcn_global_load_lds((const unsigned*)((const char*)(gbase) + (voff)[_i]), (PG8_LAS unsigned*)(lds + (bufoff) + ldsw + _i * 8192), 16, 0, 0); } while (0)
#define PG8_LDA(dst, b, h) do { _Pragma("unroll") for (int m = 0; m < 4; ++m) _Pragma("unroll") for (int k = 0; k < 2; ++k) dst[m][k] = *(const PG8_LAS bf16x8*)(lds + PG8_SA(b, h) + aoff + m * 2048 + k * 1024); } while (0)
#define PG8_LDB(dst, b, h) do { _Pragma("unroll") for (int n = 0; n < 2; ++n) _Pragma("unroll") for (int k = 0; k < 2; ++k) dst[n][k] = *(const PG8_LAS bf16x8*)(lds + PG8_SB(b, h) + boff + n * 2048 + k * 1024); } while (0)
#define PG8_MMA(ai, bj, At, Bt) do { __builtin_amdgcn_s_setprio(1); _Pragma("unroll") for (int m = 0; m < 4; ++m) _Pragma("unroll") for (int n = 0; n < 2; ++n) _Pragma("unroll") for (int k = 0; k < 2; ++k) \
        acc[ai][bj][m][n] = __builtin_amdgcn_mfma_f32_16x16x32_bf16(Bt[n][k], At[m][k], acc[ai][bj][m][n], 0, 0, 0); __builtin_amdgcn_s_setprio(0); } while (0)
#define PG8_WAIT_V(n) asm volatile("s_waitcnt vmcnt(" #n ")" ::: "memory")
#define PG8_WAIT_L(n) asm volatile("s_waitcnt lgkmcnt(" #n ")" ::: "memory")
#define PG8_BAR __builtin_amdgcn_s_barrier()
#define PG8_SCHED __builtin_amdgcn_sched_barrier(0)
    Unit cur, nxt; int ui = 0;
    if (!S.next(0, cur)) return;
    f32x4 acc[2][2][4][2];
#pragma unroll
    for (int a = 0; a < 2; ++a)
#pragma unroll
        for (int b = 0; b < 2; ++b)
#pragma unroll
            for (int m = 0; m < 4; ++m)
#pragma unroll
                for (int n = 0; n < 2; ++n) acc[a][b][m][n] = (f32x4){0.f, 0.f, 0.f, 0.f};
    bf16x8 At[4][2], B0[2][2], B1[2][2];
    const char* cA = (const char*)g.A + (size_t)cur.pm * tstep; const char* cB = (const char*)g.Bt + (size_t)cur.pn * tstep;
    S.a_ready(cur);
    if constexpr (SP2) {
        PG8_STAGE(PG8_SB(0, 0), cB, voffB); PG8_STAGE(PG8_SB(0, 1), cB + hstep, voffB); PG8_STAGE(PG8_SA(0, 0), cA, voffA); PG8_STAGE(PG8_SA(0, 1), cA + hstep, voffA);
        if (wr == 1) PG8_BAR;
        PG8_WAIT_V(2); PG8_BAR;
        PG8_STAGE(PG8_SB(1, 0), cB + kstep, voffB); PG8_STAGE(PG8_SA(1, 0), cA + kstep, voffA); PG8_STAGE(PG8_SB(1, 1), cB + hstep + kstep, voffB);
        PG8_WAIT_V(6); PG8_BAR;
    } else {
        PG8_STAGE(PG8_SB(0, 0), cB, voffB); PG8_STAGE(PG8_SA(0, 0), cA, voffA); PG8_STAGE(PG8_SB(0, 1), cB + hstep, voffB); PG8_STAGE(PG8_SA(0, 1), cA + hstep, voffA);
        if (wr == 1) PG8_BAR;
        PG8_WAIT_V(4); PG8_BAR;
        PG8_STAGE(PG8_SB(1, 0), cB + kstep, voffB); PG8_STAGE(PG8_SA(1, 0), cA + kstep, voffA); PG8_STAGE(PG8_SB(1, 1), cB + hstep + kstep, voffB);
        PG8_WAIT_V(6); PG8_BAR;
    }
    for (;;) {
        const bool has_next = S.next(ui + 1, nxt);
        const char* nA = has_next ? (const char*)g.A + (size_t)nxt.pm * tstep : cA; const char* nB = has_next ? (const char*)g.Bt + (size_t)nxt.pn * tstep : cB;
        for (int t = 0; t < nt; t += 2) {
            const bool last = (t == nt - 2);
            const char* a1 = cA + (size_t)(t + 1) * kstep;
            const char* a2 = last ? nA : cA + (size_t)(t + 2) * kstep; const char* b2 = last ? nB : cB + (size_t)(t + 2) * kstep;
            const char* a3 = a2 + kstep; const char* b3 = b2 + kstep;
            if (last && has_next) S.a_ready(nxt);
            if constexpr (SP2) {
            PG8_LDB(B0, 0, 0); PG8_LDB(B1, 0, 1); PG8_SCHED; PG8_LDA(At, 0, 0); PG8_STAGE(PG8_SA(1, 1), a1 + hstep, voffA);
            PG8_WAIT_V(8); PG8_WAIT_L(0); PG8_BAR; PG8_MMA(0, 0, At, B0); PG8_MMA(0, 1, At, B1); PG8_BAR; PG8_SCHED;
            PG8_LDA(At, 0, 1); PG8_STAGE(PG8_SB(0, 0), b2, voffB); PG8_STAGE(PG8_SB(0, 1), b2 + hstep, voffB); PG8_STAGE(PG8_SA(0, 0), a2, voffA);
            PG8_WAIT_V(8); PG8_WAIT_L(0); PG8_BAR; PG8_MMA(1, 0, At, B0); PG8_MMA(1, 1, At, B1); PG8_BAR; PG8_SCHED;
            PG8_LDB(B0, 1, 0); PG8_LDB(B1, 1, 1); PG8_SCHED; PG8_LDA(At, 1, 0); PG8_STAGE(PG8_SA(0, 1), a2 + hstep, voffA);
            PG8_WAIT_V(8); PG8_WAIT_L(0); PG8_BAR; PG8_MMA(0, 0, At, B0); PG8_MMA(0, 1, At, B1); PG8_BAR; PG8_SCHED;
            PG8_LDA(At, 1, 1); PG8_STAGE(PG8_SB(1, 0), b3, voffB); PG8_STAGE(PG8_SB(1, 1), b3 + hstep, voffB); PG8_STAGE(PG8_SA(1, 0), a3, voffA);
            PG8_WAIT_V(8); PG8_WAIT_L(0); PG8_BAR; PG8_MMA(1, 0, At, B0); PG8_MMA(1, 1, At, B1); PG8_BAR; PG8_SCHED;
            } else {
            PG8_LDB(B0, 0, 0); PG8_SCHED; PG8_LDA(At, 0, 0); PG8_STAGE(PG8_SA(1, 1), a1 + hstep, voffA);
            PG8_WAIT_L(8); PG8_BAR; PG8_WAIT_L(0); PG8_MMA(0, 0, At, B0); PG8_BAR; PG8_SCHED;
            PG8_LDB(B1, 0, 1); PG8_STAGE(PG8_SB(0, 0), b2, voffB);
            PG8_BAR; PG8_WAIT_L(0); PG8_MMA(0, 1, At, B1); PG8_BAR;
            PG8_LDA(At, 0, 1); PG8_STAGE(PG8_SA(0, 0), a2, voffA);
            PG8_BAR; PG8_WAIT_L(0); PG8_MMA(1, 0, At, B0); PG8_BAR; PG8_SCHED;
            PG8_STAGE(PG8_SB(0, 1), b2 + hstep, voffB);
            PG8_WAIT_V(6); PG8_BAR; PG8_MMA(1, 1, At, B1); PG8_BAR;
            PG8_LDB(B0, 1, 0); PG8_SCHED; PG8_LDA(At, 1, 0); PG8_STAGE(PG8_SA(0, 1), a2 + hstep, voffA);
            PG8_WAIT_L(8); PG8_BAR; PG8_WAIT_L(0); PG8_MMA(0, 0, At, B0); PG8_BAR; PG8_SCHED;
            PG8_LDB(B1, 1, 1); PG8_STAGE(PG8_SB(1, 0), b3, voffB);
            PG8_BAR; PG8_WAIT_L(0); PG8_MMA(0, 1, At, B1); PG8_BAR;
            PG8_LDA(At, 1, 1); PG8_STAGE(PG8_SA(1, 0), a3, voffA);
            PG8_BAR; PG8_WAIT_L(0); PG8_MMA(1, 0, At, B0); PG8_BAR; PG8_SCHED;
            PG8_STAGE(PG8_SB(1, 1), b3 + hstep, voffB);
            PG8_WAIT_V(6); PG8_BAR; PG8_MMA(1, 1, At, B1); PG8_BAR;
            }
        }
        if constexpr (ALIGN_EPI) { if (wr == 0) PG8_BAR; }
        if constexpr (!Epi::AFTER_DRAIN) { E(acc, cur, wr, wc, fr, fq); S.done(cur); }
        if (!has_next) break;
#pragma unroll
        for (int a = 0; a < 2; ++a)
#pragma unroll
            for (int b = 0; b < 2; ++b)
#pragma unroll
                for (int m = 0; m < 4; ++m)
#pragma unroll
                    for (int n = 0; n < 2; ++n) acc[a][b][m][n] = (f32x4){0.f, 0.f, 0.f, 0.f};
        cur = nxt; cA = nA; cB = nB; ++ui;
        if constexpr (ALIGN_EPI) { if (wr == 1) PG8_BAR; }
    }
    PG8_WAIT_V(0);
    if constexpr (!ALIGN_EPI) { if (wr == 0) PG8_BAR; }
    PG8_BAR;
    if constexpr (Epi::AFTER_DRAIN) { E.fused(acc, cur, wr, wc, fr, fq, lds, wid, lane); S.done(cur); }
#undef PG8_SA
#undef PG8_SB
#undef PG8_STAGE
#undef PG8_LDA
#undef PG8_LDB
#undef PG8_MMA
#undef PG8_WAIT_V
#undef PG8_WAIT_L
#undef PG8_BAR
#undef PG8_SCHED
}
}

#ifndef PG8_SP2
#define PG8_SP2 true
#endif
#ifndef PG8_ALIGN
#define PG8_ALIGN true
#endif
#ifndef MK_N_LAUNCHES
#define MK_N_LAUNCHES 1
#endif
#ifndef SB_EARLY_EXIT
#define SB_EARLY_EXIT 1
#endif
#ifndef PROBE_DBL
#define PROBE_DBL -1
#endif
constexpr int NWAVES = 8;
constexpr int PER_PHASE = 9;
constexpr int N_LAUNCHES = MK_N_LAUNCHES;

constexpr int BATCH = 8, SEQ = 4096, D = 1024, M = BATCH * SEQ;
constexpr int MEML = 256, MMEM = BATCH * MEML;
constexpr int INW = 2304, KVW = 512, PQW = 2048;
constexpr int C_A = 0, C_G = 256, C_Q = 512, C_K = 1024, C_V = 1536, C_MQ = 2048;
constexpr int NEXP = 16384;
constexpr float EPS = 1e-6f;

constexpr size_t MiB = 1u << 20;
constexpr size_t WS_CTL = 0, CTL_ZERO_BYTES = 1 * MiB;
constexpr size_t WS_WIN = 2 * MiB, WS_WKV = 7 * MiB, WS_WOUT = 8 * MiB, WS_WPQ = 10 * MiB, WS_KEYS = 14 * MiB;
constexpr size_t WS_MEMN = 15 * MiB, WS_MKV = 19 * MiB;
constexpr size_t WS_SC = 22 * MiB;
constexpr size_t WS_UT = 24 * MiB, WS_VT = 56 * MiB;
constexpr size_t WS_XN = 88 * MiB;
constexpr size_t WS_CAT = 152 * MiB;
constexpr size_t WS_SELI = 216 * MiB, WS_SELG = 232 * MiB;
constexpr size_t WS_PROJ = 256 * MiB;
constexpr size_t WS_Q = 256 * MiB;
constexpr size_t WS_KF = 400 * MiB;
constexpr size_t WS_MKF = 432 * MiB;
constexpr size_t WS_END = 434 * MiB;
constexpr int CW_BAR = 4096;
constexpr int CW_SSQ2 = 65536;
static_assert((CW_SSQ2 + 2 * M) * 4 <= (int)CTL_ZERO_BYTES, "ctl");

constexpr int RING_OFF = 0, RING_BYTES = 131072;
constexpr int LDSCTL_OFF = RING_BYTES, MISC_OFF = LDSCTL_OFF + 320;
constexpr int EXTRA_OFF = RING_BYTES + 1024;
constexpr int LDS_BYTES = 147456;

#define GAS __attribute__((address_space(1)))
#define LAS __attribute__((address_space(3)))
typedef unsigned short bf16;
typedef unsigned v4u __attribute__((ext_vector_type(4)));
typedef unsigned v2u __attribute__((ext_vector_type(2)));
typedef float f32x4 __attribute__((ext_vector_type(4)));
typedef GAS unsigned gu32;
typedef __bf16 bf16x2_t __attribute__((ext_vector_type(2)));
#define RLX_AGENT __ATOMIC_RELAXED, __HIP_MEMORY_SCOPE_AGENT
#define LDS_WAIT() asm volatile("s_waitcnt lgkmcnt(0)" ::: "memory")
__device__ __forceinline__ unsigned f2bf(float f) { unsigned u = __builtin_bit_cast(unsigned, f); return (u + 0x7fffu + ((u >> 16) & 1u)) >> 16; }
__device__ __forceinline__ unsigned pk2(float lo, float hi) { return f2bf(lo) | (f2bf(hi) << 16); }
__device__ __forceinline__ float bflo(unsigned w) { return __uint_as_float(w << 16); }
__device__ __forceinline__ float bfhi(unsigned w) { return __uint_as_float(w & 0xffff0000u); }
__device__ __forceinline__ float dot2(unsigned a, unsigned b, float c) { return __builtin_amdgcn_fdot2_f32_bf16(__builtin_bit_cast(bf16x2_t, a), __builtin_bit_cast(bf16x2_t, b), c, false); }
__device__ __forceinline__ float wave_sum(float v) {
#pragma unroll
    for (int o = 1; o < 64; o <<= 1) v += __shfl_xor(v, o);
    return v;
}
#define XB_TMO      128
#define XB_XCNT(j)  (256  + 64 * (j))
#define XB_XSUB(j)  (1280 + 64 * (j))
#define XB_XGEN(j)  (2304 + 64 * (j))
#define XB_TOP      3328
#define XB_TOPGEN   3392
#define XCD_BAR_WORDS 3456
#define XB_SPIN_CAP (1u << 18)

__device__ __forceinline__ unsigned xb_ld(unsigned* p)              { return __hip_atomic_load(p, __ATOMIC_RELAXED, __HIP_MEMORY_SCOPE_AGENT); }
__device__ __forceinline__ unsigned xb_add(unsigned* p, unsigned v) { return __hip_atomic_fetch_add(p, v, __ATOMIC_RELAXED, __HIP_MEMORY_SCOPE_AGENT); }
__device__ __forceinline__ unsigned xb_xcc_id() { return (unsigned)__builtin_amdgcn_s_getreg((3 << 11) | 20) & 0xFu; }
#define XB_SPIN(cond, bar) do { unsigned _sp = 0; while (cond) { __builtin_amdgcn_s_sleep(1); \
    if ((++_sp & 255u) == 0u) { if (xb_ld(&(bar)[XB_TMO])) break; if (_sp > XB_SPIN_CAP) { atomicAdd(&(bar)[XB_TMO], 1u); break; } } } } while (0)

struct XcdBarrier {
    unsigned* bar; unsigned x;
    volatile LAS unsigned* st;
};

__device__ __forceinline__ XcdBarrier xcd_barrier_post(unsigned* bar, volatile LAS unsigned* st) {
    XcdBarrier b; b.bar = bar; b.x = xb_xcc_id(); b.st = st;
    if (threadIdx.x == 0) (void)xb_add(&bar[XB_XCNT(b.x)], 1u);
    return b;
}
__device__ __forceinline__ void xcd_barrier_complete(unsigned* bar, unsigned x, unsigned& nloc, unsigned& nx) {
    const unsigned G = gridDim.x * gridDim.y * gridDim.z;
    unsigned sum, cnt, mine, sp = 0u;
    for (;;) {
        sum = 0u; cnt = 0u; mine = 0u;
#pragma unroll
        for (unsigned j = 0; j < 16; ++j) { const unsigned c = xb_ld(&bar[XB_XCNT(j)]); sum += c; cnt += (c > 0u) ? 1u : 0u; mine = (j == x) ? c : mine; }
        if (sum == G) break;
        __builtin_amdgcn_s_sleep(1);
        if ((++sp & 255u) == 0u) { if (xb_ld(&bar[XB_TMO])) break; if (sp > XB_SPIN_CAP) { atomicAdd(&bar[XB_TMO], 1u); break; } }
    }
    nloc = mine > 0u ? mine : 1u; nx = cnt > 0u ? cnt : 1u;
}

__device__ __forceinline__ void xcd_barrier(const XcdBarrier& b) {
    asm volatile("s_waitcnt vmcnt(0)" ::: "memory");
    __syncthreads();
    if (threadIdx.x == 0) {
        unsigned* bar = b.bar;
        __builtin_amdgcn_s_waitcnt(0);
        unsigned nloc = b.st[0], nx = b.st[1];
        if (nloc == 0u) { xcd_barrier_complete(bar, b.x, nloc, nx); b.st[0] = nloc; b.st[1] = nx; }
        const unsigned old = xb_add(&bar[XB_XSUB(b.x)], 1u);
        const unsigned gen = old / nloc;
        if (old + 1u == (gen + 1u) * nloc) {
            __builtin_amdgcn_fence(__ATOMIC_RELEASE, "agent");
            asm volatile("s_waitcnt vmcnt(0)" ::: "memory");
            const unsigned og = xb_add(&bar[XB_TOP], 1u);
            const unsigned tg = og / nx;
            if (og + 1u == (tg + 1u) * nx) xb_add(&bar[XB_TOPGEN], 1u);
            else XB_SPIN(xb_ld(&bar[XB_TOPGEN]) == tg, bar);
            __builtin_amdgcn_fence(__ATOMIC_ACQUIRE, "agent");
            xb_add(&bar[XB_XGEN(b.x)], 1u);
            asm volatile("s_waitcnt vmcnt(0)" ::: "memory");
        } else {
            XB_SPIN(xb_ld(&bar[XB_XGEN(b.x)]) == gen, bar);
            __builtin_amdgcn_fence(__ATOMIC_ACQUIRE, "agent");
            asm volatile("s_waitcnt vmcnt(0)" ::: "memory");
        }
    }
    __syncthreads();
}

struct Frame {
    LAS unsigned char* lds;
    volatile LAS unsigned* MISC;
    gu32* ctl;
    int tid, lane, wave;
    int vcu, G;
};
struct Ptrs {
    const float *x, *mem, *attn_g, *w_in, *conv_w, *conv_b, *conv_ln_g, *conv_ln_b, *sb_out_g, *mem_norm_g, *w_mem_kv, *q_norm_g, *k_norm_g, *mem_out_g,
                *w_out, *ffn_g, *w_peer_q, *keys1, *keys2, *peer_u, *peer_v;
    float* out;
    bf16 *WIN, *WKV, *WOUT, *WPQ, *KEYS, *MEMN, *MKV, *XN, *CAT, *PROJ, *Q;
    unsigned char *UT, *VT; float *USC, *VSC, *PART;
    unsigned short* SELH; float* SELG; unsigned long long* SSQ2; unsigned short* WB; bf16 *KF, *MKF; unsigned char* H2Q; float* HS;
};

__device__ __forceinline__ void p0_transpose_item(const float* W, const float* gk, int K, int N, bf16* WT, LAS float* scr, int item, int lane) {
    const int nblk = N / 32, kb = item / nblk, nb = item % nblk, k0 = 64 * kb, n0 = 32 * nb;
    float wv[32];
#pragma unroll
    for (int i = 0; i < 32; ++i) { const int kk = 2 * i + (lane >> 5); wv[i] = W[(size_t)(k0 + kk) * N + n0 + (lane & 31)]; }
#pragma unroll
    for (int i = 0; i < 32; ++i) { const int kk = 2 * i + (lane >> 5); float w = wv[i]; if (gk) w *= gk[k0 + kk]; scr[kk * 33 + (lane & 31)] = w; }
    LDS_WAIT(); asm volatile("" ::: "memory");
    const int c = lane & 7;
#pragma unroll
    for (int j = 0; j < 4; ++j) { const int n = (lane >> 3) + 8 * j; const LAS float* s = scr + (8 * c) * 33 + n;
        v4u o; o.x = pk2(s[0 * 33], s[1 * 33]); o.y = pk2(s[2 * 33], s[3 * 33]); o.z = pk2(s[4 * 33], s[5 * 33]); o.w = pk2(s[6 * 33], s[7 * 33]);
        *(GAS v4u*)(WT + (size_t)(n0 + n) * K + k0 + 8 * c) = o; }
    LDS_WAIT(); asm volatile("" ::: "memory");
}
template <int NR> __device__ __forceinline__ void rms_rows_to_bf16(const float* xrow, const float* g, bf16* orow, int lane) {
    const GAS f32x4* gr = (const GAS f32x4*)g + lane;
    f32x4 v[NR][4]; float s[NR];
#pragma unroll
    for (int r = 0; r < NR; ++r) { const GAS f32x4* xr = (const GAS f32x4*)(xrow + (size_t)r * D) + lane;
#pragma unroll
        for (int j = 0; j < 4; ++j) v[r][j] = __builtin_nontemporal_load(xr + 64 * j); }
    f32x4 gg[4];
#pragma unroll
    for (int j = 0; j < 4; ++j) gg[j] = gr[64 * j];
#pragma unroll
    for (int r = 0; r < NR; ++r) { s[r] = 0.f;
#pragma unroll
        for (int j = 0; j < 4; ++j) s[r] += (v[r][j].x * v[r][j].x + v[r][j].y * v[r][j].y) + (v[r][j].z * v[r][j].z + v[r][j].w * v[r][j].w); }
#pragma unroll
    for (int o = 1; o < 64; o <<= 1)
#pragma unroll
        for (int r = 0; r < NR; ++r) s[r] += __shfl_xor(s[r], o);
#pragma unroll
    for (int r = 0; r < NR; ++r) { const float rinv = 1.f / sqrtf(s[r] * (1.f / 1024.f) + EPS);
        GAS unsigned long long* o8 = (GAS unsigned long long*)(orow + (size_t)r * D) + lane;
#pragma unroll
        for (int j = 0; j < 4; ++j) { const f32x4 o = v[r][j] * rinv * gg[j];
            o8[64 * j] = (unsigned long long)pk2(o.x, o.y) | ((unsigned long long)pk2(o.z, o.w) << 32); } }
}
__device__ __forceinline__ void cvt_f32_to_bf16_stream(const float* src, bf16* dst, size_t n8, size_t gtid, size_t nthr) {
    for (size_t i = gtid; i < n8; i += nthr) { const f32x4 a = ((const GAS f32x4*)src)[2 * i], b = ((const GAS f32x4*)src)[2 * i + 1];
        v4u o; o.x = pk2(a.x, a.y); o.y = pk2(a.z, a.w); o.z = pk2(b.x, b.y); o.w = pk2(b.z, b.w); ((GAS v4u*)dst)[i] = o; }
}
__device__ __forceinline__ unsigned pack_i8x4(int a, int b, int c, int d) { return (unsigned)(a & 255) | ((unsigned)(b & 255) << 8) | ((unsigned)(c & 255) << 16) | ((unsigned)(d & 255) << 24); }
template <int NR> __device__ __forceinline__ void rows_to_fp8(const float* src, unsigned char* dst, float* iscale, int e, int lane) {
    f32x4 v[NR][4]; float am[NR];
#pragma unroll
    for (int r = 0; r < NR; ++r) { const GAS f32x4* p = (const GAS f32x4*)(src + (size_t)(e + r) * D) + lane;
#pragma unroll
        for (int k = 0; k < 4; ++k) v[r][k] = __builtin_nontemporal_load(p + 64 * k); }
#pragma unroll
    for (int r = 0; r < NR; ++r) { am[r] = 0.f;
#pragma unroll
        for (int k = 0; k < 4; ++k) am[r] = fmaxf(fmaxf(am[r], fmaxf(fabsf(v[r][k].x), fabsf(v[r][k].y))), fmaxf(fabsf(v[r][k].z), fabsf(v[r][k].w))); }
#pragma unroll
    for (int o = 1; o < 64; o <<= 1)
#pragma unroll
        for (int r = 0; r < NR; ++r) am[r] = fmaxf(am[r], __shfl_xor(am[r], o));
#pragma unroll
    for (int r = 0; r < NR; ++r) { const float sc = am[r] > 0.f ? 256.f / am[r] : 1.f, isc = am[r] > 0.f ? am[r] * (1.f / 256.f) : 1.f;
#pragma unroll
        for (int k = 0; k < 4; ++k) { int w = 0; w = __builtin_amdgcn_cvt_pk_fp8_f32(v[r][k].x * sc, v[r][k].y * sc, w, false); w = __builtin_amdgcn_cvt_pk_fp8_f32(v[r][k].z * sc, v[r][k].w * sc, w, true);
            *(GAS unsigned*)(dst + ((size_t)(2 * k + (lane >> 5)) * NEXP + e + r) * 128 + 4 * (lane & 31)) = (unsigned)w; }
        if (lane == 0) iscale[e + r] = isc; }
}
template <int NR> __device__ __forceinline__ void rows_to_i8(const float* src, unsigned char* dst, float* iscale, int e, int lane) {
    f32x4 v[NR][4]; float am[NR];
#pragma unroll
    for (int r = 0; r < NR; ++r) { const GAS f32x4* p = (const GAS f32x4*)(src + (size_t)(e + r) * D) + lane;
#pragma unroll
        for (int k = 0; k < 4; ++k) v[r][k] = __builtin_nontemporal_load(p + 64 * k); }
#pragma unroll
    for (int r = 0; r < NR; ++r) { am[r] = 0.f;
#pragma unroll
        for (int k = 0; k < 4; ++k) am[r] = fmaxf(fmaxf(am[r], fmaxf(fabsf(v[r][k].x), fabsf(v[r][k].y))), fmaxf(fabsf(v[r][k].z), fabsf(v[r][k].w))); }
#pragma unroll
    for (int o = 1; o < 64; o <<= 1)
#pragma unroll
        for (int r = 0; r < NR; ++r) am[r] = fmaxf(am[r], __shfl_xor(am[r], o));
#pragma unroll
    for (int r = 0; r < NR; ++r) { const float sc = am[r] > 0.f ? 127.f / am[r] : 1.f, isc = am[r] > 0.f ? am[r] * (1.f / 127.f) : 1.f;
#pragma unroll
        for (int k = 0; k < 4; ++k) { const f32x4 q = v[r][k] * sc;
            const unsigned w = pack_i8x4((int)__builtin_rintf(q.x), (int)__builtin_rintf(q.y), (int)__builtin_rintf(q.z), (int)__builtin_rintf(q.w));
            *(GAS unsigned*)(dst + ((size_t)(2 * k + (lane >> 5)) * NEXP + e + r) * 128 + 4 * (lane & 31)) = w; }
        if (lane == 0) iscale[e + r] = isc; }
}
__device__ __forceinline__ void p0_prologue(Frame& F, const Ptrs& P) {
    LAS float* scr = (LAS float*)(F.lds + RING_OFF + F.wave * 16384);
    const int gw = F.vcu * NWAVES + F.wave, NGW = F.G * NWAVES;
    constexpr int I_IN = (D / 64) * (INW / 32), I_KV = (D / 64) * (KVW / 32), I_OUT = (D / 64) * (D / 32), I_PQ = (D / 64) * (PQW / 32);
    constexpr int NITEMS = I_IN + I_KV + I_OUT + I_PQ;
    for (int it = gw; it < NITEMS; it += NGW) {
        int r = it;
        if (r < I_IN) { p0_transpose_item(P.w_in, nullptr, D, INW, P.WIN, scr, r, F.lane); continue; } r -= I_IN;
        if (r < I_KV) { p0_transpose_item(P.w_mem_kv, nullptr, D, KVW, P.WKV, scr, r, F.lane); continue; } r -= I_KV;
        if (r < I_OUT) { p0_transpose_item(P.w_out, nullptr, D, D, P.WOUT, scr, r, F.lane); continue; } r -= I_OUT;
        p0_transpose_item(P.w_peer_q, P.ffn_g, D, PQW, P.WPQ, scr, r, F.lane);
    }
    for (int m = gw * 4; m < M; m += NGW * 4) rms_rows_to_bf16<4>(P.x + (size_t)m * D, P.attn_g, P.XN + (size_t)m * D, F.lane);
    for (int m = gw; m < MMEM; m += NGW) rms_rows_to_bf16<1>(P.mem + (size_t)m * D, P.mem_norm_g, P.MEMN + (size_t)m * D, F.lane);
    const size_t gtid = (size_t)gw * 64 + F.lane, nthr = (size_t)NGW * 64;
    cvt_f32_to_bf16_stream(P.keys1, P.KEYS, 8 * 128 * 128 / 8, gtid, nthr);
    cvt_f32_to_bf16_stream(P.keys2, P.KEYS + 8 * 128 * 128, 8 * 128 * 128 / 8, gtid, nthr);
}

__device__ __forceinline__ void conv_phase(Frame& F, const Ptrs& P) {
    LAS float* U = (LAS float*)(F.lds + 0);
    LAS float* Y = (LAS float*)(F.lds + 65536);
    const int tid = F.tid, c = tid & 255, half = tid >> 8;
    float w[31];
#pragma unroll
    for (int k = 0; k < 31; ++k) w[k] = P.conv_w[k * 256 + c];
    const float bias = P.conv_b[c];
    const f32x4 lg = ((const GAS f32x4*)P.conv_ln_g)[F.lane], lb = ((const GAS f32x4*)P.conv_ln_b)[F.lane];
    for (int it = F.vcu; it < BATCH * (SEQ / 32); it += F.G) {
        const int b = it / (SEQ / 32), t0 = (it % (SEQ / 32)) * 32;
        __syncthreads();
        for (int idx = tid; idx < 62 * 32; idx += 512) {
            const int r = idx >> 5, c8 = idx & 31, t = t0 - 30 + r;
            float u[8];
            if (t >= 0) { const bf16* src = P.PROJ + (size_t)(b * SEQ + t) * INW + c8 * 8;
                const v4u a = *(const GAS v4u*)(src + C_A), g = *(const GAS v4u*)(src + C_G);
                const unsigned aw[4] = {a.x, a.y, a.z, a.w}, gw_[4] = {g.x, g.y, g.z, g.w};
#pragma unroll
                for (int i = 0; i < 4; ++i) { const float a0 = bflo(aw[i]), a1 = bfhi(aw[i]), g0 = bflo(gw_[i]), g1 = bfhi(gw_[i]);
                    u[2 * i] = a0 * __builtin_amdgcn_rcpf(1.f + __expf(-g0)); u[2 * i + 1] = a1 * __builtin_amdgcn_rcpf(1.f + __expf(-g1)); }
            } else {
#pragma unroll
                for (int i = 0; i < 8; ++i) u[i] = 0.f;
            }
            LAS f32x4* dst = (LAS f32x4*)(U + r * 256 + c8 * 8);
            dst[0] = (f32x4){u[0], u[1], u[2], u[3]}; dst[1] = (f32x4){u[4], u[5], u[6], u[7]};
        }
        __syncthreads();
        {
            float win[46];
#pragma unroll
            for (int i = 0; i < 46; ++i) win[i] = U[(half * 16 + i) * 256 + c];
#pragma unroll
            for (int tt = 0; tt < 16; ++tt) { float y = bias;
#pragma unroll
                for (int k = 0; k < 31; ++k) y += w[k] * win[tt + k];
                Y[(half * 16 + tt) * 256 + c] = y; }
        }
        __syncthreads();
#pragma unroll
        for (int i = 0; i < 4; ++i) { const int tok = F.wave * 4 + i; const f32x4 y = *(const LAS f32x4*)(Y + tok * 256 + F.lane * 4);
            const float mu = wave_sum((y.x + y.y) + (y.z + y.w)) * (1.f / 256.f); const f32x4 d = y - mu;
            const float var = wave_sum((d.x * d.x + d.y * d.y) + (d.z * d.z + d.w * d.w)) * (1.f / 256.f);
            const float rinv = 1.f / sqrtf(var + EPS); const f32x4 yn = d * rinv * lg + lb;
            f32x4 s; s.x = yn.x * __builtin_amdgcn_rcpf(1.f + __expf(-yn.x)); s.y = yn.y * __builtin_amdgcn_rcpf(1.f + __expf(-yn.y)); s.z = yn.z * __builtin_amdgcn_rcpf(1.f + __expf(-yn.z)); s.w = yn.w * __builtin_amdgcn_rcpf(1.f + __expf(-yn.w));
            *(GAS unsigned long long*)(P.CAT + (size_t)(b * SEQ + t0 + tok) * D + F.lane * 4) = (unsigned long long)pk2(s.x, s.y) | ((unsigned long long)pk2(s.z, s.w) << 32); }
    }
}

typedef short bf16x8 __attribute__((ext_vector_type(8)));
typedef float f32x16 __attribute__((ext_vector_type(16)));
typedef short s16x4 __attribute__((ext_vector_type(4)));
constexpr int VSTR = 144;
constexpr int VL_BYTES = 32 * VSTR;
__device__ __forceinline__ unsigned cvtpk(float lo, float hi) { typedef float f2 __attribute__((ext_vector_type(2))); typedef __bf16 b2 __attribute__((ext_vector_type(2))); f2 v = {lo, hi}; b2 b = __builtin_convertvector(v, b2); return __builtin_bit_cast(unsigned, b); }
__device__ __forceinline__ s16x4 vtr(LAS unsigned char* p) { return __builtin_bit_cast(s16x4, __builtin_amdgcn_ds_read_tr16_b64_v4i16((LAS s16x4*)p)); }
__device__ __forceinline__ float swap_lo(float x, float& hi_out) { auto rr = __builtin_amdgcn_permlane32_swap(__float_as_uint(x), __float_as_uint(x), false, false); hi_out = __uint_as_float(rr[1]); return __uint_as_float(rr[0]); }
__device__ __forceinline__ void v_frags(LAS unsigned char* vl, int lane, bf16x8 (&vf)[2][2]) {
    const int il = lane & 15, q_ = il >> 2, p_ = il & 3, gg = lane >> 4, hi = lane >> 5;
    LAS unsigned char* base = vl + (4 * hi + q_) * VSTR + (16 * (gg & 1) + 4 * p_) * 2;
#pragma unroll
    for (int mt = 0; mt < 2; ++mt)
#pragma unroll
        for (int c = 0; c < 2; ++c) { const s16x4 lo = vtr(base + c * 16 * VSTR + mt * 64), hh = vtr(base + c * 16 * VSTR + 8 * VSTR + mt * 64);
            vf[mt][c] = (bf16x8){lo[0], lo[1], lo[2], lo[3], hh[0], hh[1], hh[2], hh[3]}; }
}
__device__ __forceinline__ void sb_weights(const f32x16& s, bool diag, int r32, int hi, float& R, bf16x8 (&pf)[2]) {
    typedef float f2 __attribute__((ext_vector_type(2)));
    f2 om2[2][4];
#pragma unroll
    for (int jj = 0; jj < 2; ++jj)
#pragma unroll
        for (int i = 0; i < 4; ++i) { const f2 z = (f2){s[4 * jj + i], s[4 * (jj + 2) + i]} * (0.125f * 1.4426950408889634f);
            f2 d; d.x = __builtin_amdgcn_exp2f(z.x); d.y = __builtin_amdgcn_exp2f(z.y); d = d + 1.0f;
            f2 o; o.x = __builtin_amdgcn_rcpf(d.x); o.y = __builtin_amdgcn_rcpf(d.y);
            if (diag) { const bool v0 = (i + 8 * jj + 4 * hi) < r32, v1 = (i + 8 * (jj + 2) + 4 * hi) < r32; o.x = v0 ? o.x : 1.f; o.y = v1 ? o.y : 1.f; }
            om2[jj][i] = o; }
    float G[4], Glo[4], Ghi[4];
#pragma unroll
    for (int jj = 0; jj < 2; ++jj) { const f2 g = (om2[jj][3] * om2[jj][2]) * (om2[jj][1] * om2[jj][0]); G[jj] = g.x; G[jj + 2] = g.y; }
#pragma unroll
    for (int j = 0; j < 4; ++j) Glo[j] = swap_lo(G[j], Ghi[j]);
    float run = R, st[4];
#pragma unroll
    for (int j = 3; j >= 0; --j) { const float s_hi = run, s_lo = run * Ghi[j]; st[j] = hi ? s_hi : s_lo; run = s_lo * Glo[j]; }
    R = run;
    float a[16];
#pragma unroll
    for (int jj = 0; jj < 2; ++jj) { f2 rb = {st[jj], st[jj + 2]};
#pragma unroll
        for (int i = 3; i >= 0; --i) { const f2 nx = rb * om2[jj][i]; const f2 d = rb - nx; a[4 * jj + i] = d.x; a[4 * (jj + 2) + i] = d.y; rb = nx; } }
#pragma unroll
    for (int c = 0; c < 2; ++c) pf[c] = __builtin_bit_cast(bf16x8, (v4u){cvtpk(a[8 * c], a[8 * c + 1]), cvtpk(a[8 * c + 2], a[8 * c + 3]), cvtpk(a[8 * c + 4], a[8 * c + 5]), cvtpk(a[8 * c + 6], a[8 * c + 7])});
}
__device__ __forceinline__ void sb_item_mfma(Frame& F, const Ptrs& P, int b, int G64) {
    const int lane = F.lane, h = F.wave, r32 = lane & 31, hi = lane >> 5;
    const int t0 = G64 * 64; const size_t rowbase = (size_t)b * SEQ;
    LAS unsigned char* vl = F.lds + F.wave * VL_BYTES;
    bf16x8 qA[4], qB[4];
    { const bf16* qp = P.PROJ + (rowbase + t0 + r32) * INW + C_Q + h * 64 + 8 * hi;
#pragma unroll
      for (int ks = 0; ks < 4; ++ks) { qA[ks] = *(const GAS bf16x8*)(qp + 16 * ks); qB[ks] = *(const GAS bf16x8*)(qp + (size_t)32 * INW + 16 * ks); } }
    f32x16 oA0, oA1, oB0, oB1;
#pragma unroll
    for (int r = 0; r < 16; ++r) { oA0[r] = 0.f; oA1[r] = 0.f; oB0[r] = 0.f; oB1[r] = 0.f; }
    float RA = 1.f, RB = 1.f;
    const bf16* kbase = P.KF + (rowbase >> 5) * 16384 + (size_t)h * 2048 + (hi * 32 + r32) * 8;
    const bf16* vbase = P.PROJ + (rowbase + (lane >> 3)) * INW + C_V + h * 64 + (lane & 7) * 8;
    bf16x8 kf[4]; v4u vp[4];
    const int top = t0 + 32;
#pragma unroll
    for (int ks = 0; ks < 4; ++ks) kf[ks] = *(const GAS bf16x8*)(kbase + (size_t)(top >> 5) * 16384 + 512 * ks);
#pragma unroll
    for (int k = 0; k < 4; ++k) vp[k] = *(const GAS v4u*)(vbase + (size_t)(top + 8 * k) * INW);
    {
        f32x16 sB;
#pragma unroll
        for (int r = 0; r < 16; ++r) sB[r] = 0.f;
#pragma unroll
        for (int ks = 0; ks < 4; ++ks) sB = __builtin_amdgcn_mfma_f32_32x32x16_bf16(kf[ks], qB[ks], sB, 0, 0, 0);
        asm volatile("" ::: "memory");
#pragma unroll
        for (int k = 0; k < 4; ++k) *(LAS v4u*)(vl + ((lane >> 3) + 8 * k) * VSTR + (lane & 7) * 16) = vp[k];
        asm volatile("" ::: "memory");
#pragma unroll
        for (int ks = 0; ks < 4; ++ks) kf[ks] = *(const GAS bf16x8*)(kbase + (size_t)(t0 >> 5) * 16384 + 512 * ks);
#pragma unroll
        for (int k = 0; k < 4; ++k) vp[k] = *(const GAS v4u*)(vbase + (size_t)(t0 + 8 * k) * INW);
        bf16x8 pB[2];
        sb_weights(sB, true, r32, hi, RB, pB);
        bf16x8 vf[2][2];
        v_frags(vl, lane, vf);
        oB0 = __builtin_amdgcn_mfma_f32_32x32x16_bf16(vf[0][0], pB[0], oB0, 0, 0, 0); oB1 = __builtin_amdgcn_mfma_f32_32x32x16_bf16(vf[1][0], pB[0], oB1, 0, 0, 0);
        oB0 = __builtin_amdgcn_mfma_f32_32x32x16_bf16(vf[0][1], pB[1], oB0, 0, 0, 0); oB1 = __builtin_amdgcn_mfma_f32_32x32x16_bf16(vf[1][1], pB[1], oB1, 0, 0, 0);
        asm volatile("" ::: "memory");
    }
    for (int s0 = t0; s0 >= 0; s0 -= 32) {
        f32x16 sA, sB;
#pragma unroll
        for (int r = 0; r < 16; ++r) { sA[r] = 0.f; sB[r] = 0.f; }
#pragma unroll
        for (int ks = 0; ks < 4; ++ks) sB = __builtin_amdgcn_mfma_f32_32x32x16_bf16(kf[ks], qB[ks], sB, 0, 0, 0);
#pragma unroll
        for (int ks = 0; ks < 4; ++ks) sA = __builtin_amdgcn_mfma_f32_32x32x16_bf16(kf[ks], qA[ks], sA, 0, 0, 0);
        asm volatile("" ::: "memory");
#pragma unroll
        for (int k = 0; k < 4; ++k) *(LAS v4u*)(vl + ((lane >> 3) + 8 * k) * VSTR + (lane & 7) * 16) = vp[k];
        asm volatile("" ::: "memory");
        { const int sn = s0 >= 32 ? s0 - 32 : 0;
#pragma unroll
          for (int ks = 0; ks < 4; ++ks) kf[ks] = *(const GAS bf16x8*)(kbase + (size_t)(sn >> 5) * 16384 + 512 * ks);
#pragma unroll
          for (int k = 0; k < 4; ++k) vp[k] = *(const GAS v4u*)(vbase + (size_t)(sn + 8 * k) * INW); }
        bf16x8 pB[2], pA[2];
        sb_weights(sB, false, r32, hi, RB, pB);
        bf16x8 vf[2][2];
        v_frags(vl, lane, vf);
        oB0 = __builtin_amdgcn_mfma_f32_32x32x16_bf16(vf[0][0], pB[0], oB0, 0, 0, 0); oB1 = __builtin_amdgcn_mfma_f32_32x32x16_bf16(vf[1][0], pB[0], oB1, 0, 0, 0);
        oB0 = __builtin_amdgcn_mfma_f32_32x32x16_bf16(vf[0][1], pB[1], oB0, 0, 0, 0); oB1 = __builtin_amdgcn_mfma_f32_32x32x16_bf16(vf[1][1], pB[1], oB1, 0, 0, 0);
        sb_weights(sA, s0 == t0, r32, hi, RA, pA);
        oA0 = __builtin_amdgcn_mfma_f32_32x32x16_bf16(vf[0][0], pA[0], oA0, 0, 0, 0); oA1 = __builtin_amdgcn_mfma_f32_32x32x16_bf16(vf[1][0], pA[0], oA1, 0, 0, 0);
        oA0 = __builtin_amdgcn_mfma_f32_32x32x16_bf16(vf[0][1], pA[1], oA0, 0, 0, 0); oA1 = __builtin_amdgcn_mfma_f32_32x32x16_bf16(vf[1][1], pA[1], oA1, 0, 0, 0);
        asm volatile("" ::: "memory");
        if (SB_EARLY_EXIT && __builtin_amdgcn_ballot_w64(fmaxf(RA, RB) > 0.0f) == 0ull) break;
    }
    float ssA = 0.f, ssB = 0.f;
#pragma unroll
    for (int r = 0; r < 16; ++r) { ssA += oA0[r] * oA0[r] + oA1[r] * oA1[r]; ssB += oB0[r] * oB0[r] + oB1[r] * oB1[r]; }
    { float sh; const float sl = swap_lo(ssA, sh); ssA = sl + sh; }
    { float sh; const float sl = swap_lo(ssB, sh); ssB = sl + sh; }
    LAS float* xs = (LAS float*)(F.lds + EXTRA_OFF);
    if (hi == 0) { xs[h * 64 + r32] = ssA; xs[h * 64 + 32 + r32] = ssB; }
    __syncthreads();
    float totA = 0.f, totB = 0.f;
#pragma unroll
    for (int w = 0; w < 8; ++w) { totA += xs[w * 64 + r32]; totB += xs[w * 64 + 32 + r32]; }
    const float rinvA = 1.f / sqrtf(totA * (1.f / 512.f) + EPS), rinvB = 1.f / sqrtf(totB * (1.f / 512.f) + EPS);
    bf16* dstA = P.CAT + (rowbase + t0 + r32) * D + 256 + h * 64 + 4 * hi; bf16* dstB = dstA + (size_t)32 * D; const float* gp = P.sb_out_g + h * 64 + 4 * hi;
#pragma unroll
    for (int mt = 0; mt < 2; ++mt)
#pragma unroll
        for (int j = 0; j < 4; ++j) { const f32x4 gv = *(const GAS f32x4*)(gp + 32 * mt + 8 * j);
            { const float a0 = (mt ? oA1[4 * j] : oA0[4 * j]) * rinvA * gv.x, a1 = (mt ? oA1[4 * j + 1] : oA0[4 * j + 1]) * rinvA * gv.y, a2 = (mt ? oA1[4 * j + 2] : oA0[4 * j + 2]) * rinvA * gv.z, a3 = (mt ? oA1[4 * j + 3] : oA0[4 * j + 3]) * rinvA * gv.w;
              *(GAS v2u*)(dstA + 32 * mt + 8 * j) = (v2u){cvtpk(a0, a1), cvtpk(a2, a3)}; }
            { const float a0 = (mt ? oB1[4 * j] : oB0[4 * j]) * rinvB * gv.x, a1 = (mt ? oB1[4 * j + 1] : oB0[4 * j + 1]) * rinvB * gv.y, a2 = (mt ? oB1[4 * j + 2] : oB0[4 * j + 2]) * rinvB * gv.z, a3 = (mt ? oB1[4 * j + 3] : oB0[4 * j + 3]) * rinvB * gv.w;
              *(GAS v2u*)(dstB + 32 * mt + 8 * j) = (v2u){cvtpk(a0, a1), cvtpk(a2, a3)}; } }
    __syncthreads();
}
__device__ __forceinline__ void mem_q_frags(const Ptrs& P, const bf16* qp, int hi, bf16x8 (&qf)[4], float& qsc) {
    float ssq = 0.f;
#pragma unroll
    for (int ks = 0; ks < 4; ++ks) { const v4u v = *(const GAS v4u*)(qp + 16 * ks); const unsigned w[4] = {v.x, v.y, v.z, v.w}; unsigned ow[4];
#pragma unroll
        for (int i = 0; i < 4; ++i) { const float a = bflo(w[i]), c = bfhi(w[i]); ssq += a * a + c * c; const int d = 16 * ks + 8 * hi + 2 * i;
            ow[i] = cvtpk(a * (P.q_norm_g[d] * P.k_norm_g[d]), c * (P.q_norm_g[d + 1] * P.k_norm_g[d + 1])); }
        qf[ks] = __builtin_bit_cast(bf16x8, (v4u){ow[0], ow[1], ow[2], ow[3]}); }
    float sh; const float sl = swap_lo(ssq, sh); qsc = 0.125f / sqrtf((sl + sh) * (1.f / 64.f) + EPS);
}
__device__ __forceinline__ void mem_softmax_tile(const f32x16& s, const LAS float* rk, int hi, float qsc, float& mx, float& lsum, f32x16& o0, f32x16& o1, bf16x8 (&pf)[2]) {
    float p[16]; float bm = -1.0e30f;
#pragma unroll
    for (int j = 0; j < 4; ++j) { const f32x4 rv = *(const LAS f32x4*)(rk + 8 * j + 4 * hi);
        p[4 * j] = s[4 * j] * qsc * rv.x; p[4 * j + 1] = s[4 * j + 1] * qsc * rv.y; p[4 * j + 2] = s[4 * j + 2] * qsc * rv.z; p[4 * j + 3] = s[4 * j + 3] * qsc * rv.w;
        bm = fmaxf(fmaxf(bm, fmaxf(p[4 * j], p[4 * j + 1])), fmaxf(p[4 * j + 2], p[4 * j + 3])); }
    { float bh; const float bl = swap_lo(bm, bh); bm = fmaxf(bl, bh); }
    const float mn = fmaxf(mx, bm), sc = __expf(mx - mn); mx = mn; lsum *= sc;
#pragma unroll
    for (int r = 0; r < 16; ++r) { o0[r] *= sc; o1[r] *= sc; p[r] = __expf(p[r] - mn); }
    lsum += ((p[0] + p[1]) + (p[2] + p[3])) + ((p[4] + p[5]) + (p[6] + p[7])) + (((p[8] + p[9]) + (p[10] + p[11])) + ((p[12] + p[13]) + (p[14] + p[15])));
#pragma unroll
    for (int c = 0; c < 2; ++c) pf[c] = __builtin_bit_cast(bf16x8, (v4u){cvtpk(p[8 * c], p[8 * c + 1]), cvtpk(p[8 * c + 2], p[8 * c + 3]), cvtpk(p[8 * c + 4], p[8 * c + 5]), cvtpk(p[8 * c + 6], p[8 * c + 7])});
}
__device__ __forceinline__ void mem_item_mfma(Frame& F, const Ptrs& P, int b, int qb) {
    const int lane = F.lane, h = F.wave & 3, half = F.wave >> 2, r32 = lane & 31, hi = lane >> 5;
    const size_t rowA = (size_t)b * SEQ + qb * 128 + half * 64 + r32, rowB = rowA + 32;
    LAS unsigned char* vl = F.lds + F.wave * VL_BYTES;
    LAS float* rk = (LAS float*)(F.lds + 8 * VL_BYTES + F.wave * 128);
    bf16x8 qA[4], qB[4]; float qscA, qscB;
    mem_q_frags(P, P.PROJ + rowA * INW + C_MQ + h * 64 + 8 * hi, hi, qA, qscA);
    mem_q_frags(P, P.PROJ + rowB * INW + C_MQ + h * 64 + 8 * hi, hi, qB, qscB);
    f32x16 oA0, oA1, oB0, oB1;
#pragma unroll
    for (int r = 0; r < 16; ++r) { oA0[r] = 0.f; oA1[r] = 0.f; oB0[r] = 0.f; oB1[r] = 0.f; }
    float mxA = -1.0e30f, lsA = 0.f, mxB = -1.0e30f, lsB = 0.f;
    const bf16* kbase = P.MKF + ((size_t)b * (MEML / 32)) * 8192 + (size_t)h * 2048 + (hi * 32 + r32) * 8;
    const bf16* vbase = P.MKV + ((size_t)b * MEML + (lane >> 3)) * KVW + 256 + h * 64 + (lane & 7) * 8;
    v4u kr[4], vp[4];
#pragma unroll
    for (int ks = 0; ks < 4; ++ks) kr[ks] = *(const GAS v4u*)(kbase + 512 * ks);
#pragma unroll
    for (int k = 0; k < 4; ++k) vp[k] = *(const GAS v4u*)(vbase + (size_t)(8 * k) * KVW);
    for (int s0 = 0; s0 < MEML; s0 += 32) {
        bf16x8 kf[4]; float kss; { float k0 = 0.f, k1 = 0.f, k2 = 0.f, k3 = 0.f;
#pragma unroll
        for (int ks = 0; ks < 4; ++ks) { const v4u v = kr[ks]; kf[ks] = __builtin_bit_cast(bf16x8, v);
            k0 = dot2(v.x, v.x, k0); k1 = dot2(v.y, v.y, k1); k2 = dot2(v.z, v.z, k2); k3 = dot2(v.w, v.w, k3); }
          kss = (k0 + k1) + (k2 + k3); }
        { float sh; const float sl = swap_lo(kss, sh); kss = 1.f / sqrtf((sl + sh) * (1.f / 64.f) + EPS); }
        asm volatile("" ::: "memory");
        if (hi == 0) rk[r32] = kss;
#pragma unroll
        for (int k = 0; k < 4; ++k) *(LAS v4u*)(vl + ((lane >> 3) + 8 * k) * VSTR + (lane & 7) * 16) = vp[k];
        asm volatile("" ::: "memory");
        bf16x8 vf[2][2];
        {
            f32x16 sA;
#pragma unroll
            for (int r = 0; r < 16; ++r) sA[r] = 0.f;
#pragma unroll
            for (int ks = 0; ks < 4; ++ks) sA = __builtin_amdgcn_mfma_f32_32x32x16_bf16(kf[ks], qA[ks], sA, 0, 0, 0);
            bf16x8 pA[2];
            mem_softmax_tile(sA, rk, hi, qscA, mxA, lsA, oA0, oA1, pA);
            v_frags(vl, lane, vf);
            oA0 = __builtin_amdgcn_mfma_f32_32x32x16_bf16(vf[0][0], pA[0], oA0, 0, 0, 0); oA1 = __builtin_amdgcn_mfma_f32_32x32x16_bf16(vf[1][0], pA[0], oA1, 0, 0, 0);
            oA0 = __builtin_amdgcn_mfma_f32_32x32x16_bf16(vf[0][1], pA[1], oA0, 0, 0, 0); oA1 = __builtin_amdgcn_mfma_f32_32x32x16_bf16(vf[1][1], pA[1], oA1, 0, 0, 0);
        }
        asm volatile("" ::: "memory"); __builtin_amdgcn_sched_barrier(0);
        {
            f32x16 sB;
#pragma unroll
            for (int r = 0; r < 16; ++r) sB[r] = 0.f;
#pragma unroll
            for (int ks = 0; ks < 4; ++ks) sB = __builtin_amdgcn_mfma_f32_32x32x16_bf16(kf[ks], qB[ks], sB, 0, 0, 0);
            if (s0 + 32 < MEML) {
#pragma unroll
                for (int ks = 0; ks < 4; ++ks) kr[ks] = *(const GAS v4u*)(kbase + (size_t)((s0 + 32) >> 5) * 8192 + 512 * ks);
#pragma unroll
                for (int k = 0; k < 4; ++k) vp[k] = *(const GAS v4u*)(vbase + (size_t)(s0 + 32 + 8 * k) * KVW);
            }
            bf16x8 pB[2];
            mem_softmax_tile(sB, rk, hi, qscB, mxB, lsB, oB0, oB1, pB);
            oB0 = __builtin_amdgcn_mfma_f32_32x32x16_bf16(vf[0][0], pB[0], oB0, 0, 0, 0); oB1 = __builtin_amdgcn_mfma_f32_32x32x16_bf16(vf[1][0], pB[0], oB1, 0, 0, 0);
            oB0 = __builtin_amdgcn_mfma_f32_32x32x16_bf16(vf[0][1], pB[1], oB0, 0, 0, 0); oB1 = __builtin_amdgcn_mfma_f32_32x32x16_bf16(vf[1][1], pB[1], oB1, 0, 0, 0);
        }
        asm volatile("" ::: "memory"); __builtin_amdgcn_sched_barrier(0);
    }
    { float lh; const float ll = swap_lo(lsA, lh); lsA = 1.f / (ll + lh); }
    { float lh; const float ll = swap_lo(lsB, lh); lsB = 1.f / (ll + lh); }
    float ssA = 0.f, ssB = 0.f;
#pragma unroll
    for (int r = 0; r < 16; ++r) { oA0[r] *= lsA; oA1[r] *= lsA; oB0[r] *= lsB; oB1[r] *= lsB; ssA += oA0[r] * oA0[r] + oA1[r] * oA1[r]; ssB += oB0[r] * oB0[r] + oB1[r] * oB1[r]; }
    { float sh; const float sl = swap_lo(ssA, sh); ssA = sl + sh; }
    { float sh; const float sl = swap_lo(ssB, sh); ssB = sl + sh; }
    LAS float* xs = (LAS float*)(F.lds + EXTRA_OFF);
    if (hi == 0) { xs[((half * 2 + 0) * 4 + h) * 32 + r32] = ssA; xs[((half * 2 + 1) * 4 + h) * 32 + r32] = ssB; }
    __syncthreads();
    float totA = 0.f, totB = 0.f;
#pragma unroll
    for (int w = 0; w < 4; ++w) { totA += xs[((half * 2 + 0) * 4 + w) * 32 + r32]; totB += xs[((half * 2 + 1) * 4 + w) * 32 + r32]; }
    const float rinvA = 1.f / sqrtf(totA * (1.f / 256.f) + EPS), rinvB = 1.f / sqrtf(totB * (1.f / 256.f) + EPS);
    bf16* dstA = P.CAT + rowA * D + 768 + h * 64 + 4 * hi; bf16* dstB = dstA + (size_t)32 * D; const float* gp = P.mem_out_g + h * 64 + 4 * hi;
#pragma unroll
    for (int mt = 0; mt < 2; ++mt)
#pragma unroll
        for (int j = 0; j < 4; ++j) { const f32x4 gv = *(const GAS f32x4*)(gp + 32 * mt + 8 * j);
            { const float a0 = (mt ? oA1[4 * j] : oA0[4 * j]) * rinvA * gv.x, a1 = (mt ? oA1[4 * j + 1] : oA0[4 * j + 1]) * rinvA * gv.y, a2 = (mt ? oA1[4 * j + 2] : oA0[4 * j + 2]) * rinvA * gv.z, a3 = (mt ? oA1[4 * j + 3] : oA0[4 * j + 3]) * rinvA * gv.w;
              *(GAS v2u*)(dstA + 32 * mt + 8 * j) = (v2u){cvtpk(a0, a1), cvtpk(a2, a3)}; }
            { const float a0 = (mt ? oB1[4 * j] : oB0[4 * j]) * rinvB * gv.x, a1 = (mt ? oB1[4 * j + 1] : oB0[4 * j + 1]) * rinvB * gv.y, a2 = (mt ? oB1[4 * j + 2] : oB0[4 * j + 2]) * rinvB * gv.z, a3 = (mt ? oB1[4 * j + 3] : oB0[4 * j + 3]) * rinvB * gv.w;
              *(GAS v2u*)(dstB + 32 * mt + 8 * j) = (v2u){cvtpk(a0, a1), cvtpk(a2, a3)}; } }
    __syncthreads();
}

#define CE(a, b) { const float hi_ = fmaxf(a, b), lo_ = fminf(a, b); a = hi_; b = lo_; }
#define SORT16(V) do { CE(V[0], V[1]); CE(V[2], V[3]); CE(V[0], V[2]); CE(V[1], V[3]); CE(V[1], V[2]); CE(V[4], V[5]); CE(V[6], V[7]); CE(V[4], V[6]); CE(V[5], V[7]); CE(V[5], V[6]); CE(V[0], V[4]); CE(V[2], V[6]); CE(V[2], V[4]); CE(V[1], V[5]); CE(V[3], V[7]); CE(V[3], V[5]); CE(V[1], V[2]); CE(V[3], V[4]); CE(V[5], V[6]); CE(V[8], V[9]); CE(V[10], V[11]); CE(V[8], V[10]); CE(V[9], V[11]); CE(V[9], V[10]); CE(V[12], V[13]); CE(V[14], V[15]); CE(V[12], V[14]); CE(V[13], V[15]); CE(V[13], V[14]); CE(V[8], V[12]); CE(V[10], V[14]); CE(V[10], V[12]); CE(V[9], V[13]); CE(V[11], V[15]); CE(V[11], V[13]); CE(V[9], V[10]); CE(V[11], V[12]); CE(V[13], V[14]); CE(V[0], V[8]); CE(V[4], V[12]); CE(V[4], V[8]); CE(V[2], V[10]); CE(V[6], V[14]); CE(V[6], V[10]); CE(V[2], V[4]); CE(V[6], V[8]); CE(V[10], V[12]); CE(V[1], V[9]); CE(V[5], V[13]); CE(V[5], V[9]); CE(V[3], V[11]); CE(V[7], V[15]); CE(V[7], V[11]); CE(V[3], V[5]); CE(V[7], V[9]); CE(V[11], V[13]); CE(V[1], V[2]); CE(V[3], V[4]); CE(V[5], V[6]); CE(V[7], V[8]); CE(V[9], V[10]); CE(V[11], V[12]); CE(V[13], V[14]); } while (0)
#define BITONIC16(V) do { CE(V[0], V[8]); CE(V[1], V[9]); CE(V[2], V[10]); CE(V[3], V[11]); CE(V[4], V[12]); CE(V[5], V[13]); CE(V[6], V[14]); CE(V[7], V[15]); CE(V[0], V[4]); CE(V[1], V[5]); CE(V[2], V[6]); CE(V[3], V[7]); CE(V[8], V[12]); CE(V[9], V[13]); CE(V[10], V[14]); CE(V[11], V[15]); CE(V[0], V[2]); CE(V[1], V[3]); CE(V[4], V[6]); CE(V[5], V[7]); CE(V[8], V[10]); CE(V[9], V[11]); CE(V[12], V[14]); CE(V[13], V[15]); CE(V[0], V[1]); CE(V[2], V[3]); CE(V[4], V[5]); CE(V[6], V[7]); CE(V[8], V[9]); CE(V[10], V[11]); CE(V[12], V[13]); CE(V[14], V[15]); } while (0)
#define MERGE16(A, B) do { _Pragma("unroll") for (int i_ = 0; i_ < 16; ++i_) A[i_] = fmaxf(A[i_], B[15 - i_]); BITONIC16(A); } while (0)
constexpr int KSTR = 272;
constexpr int P5_KEYS2 = 128 * KSTR, P5_TAB = 2 * 128 * KSTR;
__device__ __forceinline__ void peer_top16(const LAS unsigned char* keysL, const bf16* qptr, int r32, int hi, float (&T)[16]) {
    bf16x8 qf[8];
#pragma unroll
    for (int ks = 0; ks < 8; ++ks) qf[ks] = *(const GAS bf16x8*)(qptr + 512 * ks);
    f32x16 acc[4];
#pragma unroll
    for (int mt = 0; mt < 4; ++mt)
#pragma unroll
        for (int r = 0; r < 16; ++r) acc[mt][r] = 0.f;
#pragma unroll
    for (int ks = 0; ks < 8; ++ks)
#pragma unroll
        for (int mt = 0; mt < 4; ++mt) { const bf16x8 a = *(const LAS bf16x8*)(keysL + (32 * mt + r32) * KSTR + (16 * ks + 8 * hi) * 2); acc[mt] = __builtin_amdgcn_mfma_f32_32x32x16_bf16(a, qf[ks], acc[mt], 0, 0, 0); }
    float v[4][16]; const unsigned hi4 = (unsigned)hi << 2;
#pragma unroll
    for (int mt = 0; mt < 4; ++mt)
#pragma unroll
        for (int r = 0; r < 16; ++r) v[mt][r] = __uint_as_float((__float_as_uint(acc[mt][r]) & 0xFFFFFF80u) | ((unsigned)(32 * mt + (r & 3) + 8 * (r >> 2)) | hi4));
    SORT16(v[0]); SORT16(v[1]); SORT16(v[2]); SORT16(v[3]);
    MERGE16(v[0], v[1]); MERGE16(v[2], v[3]); MERGE16(v[0], v[2]);
    float plo[16], phi[16];
#pragma unroll
    for (int i = 0; i < 16; ++i) plo[i] = swap_lo(v[0][i], phi[i]);
#pragma unroll
    for (int i = 0; i < 16; ++i) T[i] = fmaxf(plo[i], phi[15 - i]);
    BITONIC16(T);
}
__device__ __forceinline__ float pack8(float s, unsigned code) { return __uint_as_float((__float_as_uint(s) & 0xFFFFFF00u) | code); }
__device__ __forceinline__ void peer_select_mfma(Frame& F, const Ptrs& P, int tb, int h, bool load_keys) {
    LAS unsigned char* lds = F.lds; const int tid = F.tid, lane = F.lane, r32 = lane & 31, hi = lane >> 5;
    if (load_keys) {
        __syncthreads();
#pragma unroll
        for (int i = 0; i < 8; ++i) { const int c = tid + 512 * i; const int which = c >> 11, rem = c & 2047, n = rem >> 4, ch = rem & 15;
            *(LAS v4u*)(lds + which * P5_KEYS2 + n * KSTR + ch * 16) = *(const GAS v4u*)(P.KEYS + (size_t)which * 131072 + (size_t)h * 16384 + n * 128 + ch * 8); }
        __syncthreads();
    }
    const int tok = tb * 256 + F.wave * 32 + r32;
    const bf16* qrow = P.Q + ((size_t)tb * 8 + h) * 65536 + (size_t)F.wave * 4096 + (hi * 32 + r32) * 8;
    float T1[16], T2[16];
    peer_top16(lds, qrow, r32, hi, T1);
    peer_top16(lds + P5_KEYS2, qrow + 32768, r32, hi, T2);
    LAS unsigned char* tabA = lds + P5_TAB + F.wave * 2048 + lane; LAS unsigned char* tabB = tabA + 1024;
#pragma unroll
    for (int i = 0; i < 16; ++i) { tabA[i * 64] = (unsigned char)(__float_as_uint(T1[i]) & 127u); tabB[i * 64] = (unsigned char)(__float_as_uint(T2[i]) & 127u); }
    float C0[16], X0[16], X1[16];
#pragma unroll
    for (int j = 0; j < 16; ++j) C0[j] = pack8(T1[0] + T2[j], (unsigned)j);
    {
        int n = 0;
#pragma unroll
        for (int i = 1; i < 14; ++i)
#pragma unroll
            for (int j = 0; j < 16; ++j) if ((i + 1) * (j + 1) <= 16) { const float c = pack8(T1[i] + T2[j], (unsigned)(i * 16 + j)); if (n < 16) X0[n] = c; else X1[n - 16] = c; ++n; }
    }
    SORT16(X0); SORT16(X1);
    MERGE16(X0, X1); MERGE16(C0, X0);
#pragma unroll
    for (int i = 14; i < 16; ++i) { float cv = pack8(T1[i] + T2[0], (unsigned)(i * 16));
#pragma unroll
        for (int p = 0; p < 16; ++p) { const float hi_ = fmaxf(C0[p], cv), lo_ = fminf(C0[p], cv); C0[p] = hi_; cv = lo_; } }
    float e[16], sum = 0.f;
#pragma unroll
    for (int p = 0; p < 16; ++p) { e[p] = __expf(C0[p] - C0[0]); sum += e[p]; }
    const float inv = 1.f / sum;
    if (hi == 0) {
        unsigned id[16];
#pragma unroll
        for (int p = 0; p < 16; ++p) { const unsigned code = __float_as_uint(C0[p]) & 255u; id[p] = (unsigned)tabA[(code >> 4) * 64] * 128u + (unsigned)tabB[(code & 15u) * 64]; }
        GAS v4u* di = (GAS v4u*)(P.SELH + ((size_t)tok * 8 + h) * 16);
#pragma unroll
        for (int j = 0; j < 2; ++j) di[j] = (v4u){id[8 * j] | (id[8 * j + 1] << 16), id[8 * j + 2] | (id[8 * j + 3] << 16), id[8 * j + 4] | (id[8 * j + 5] << 16), id[8 * j + 6] | (id[8 * j + 7] << 16)};
    } else {
        GAS f32x4* dg = (GAS f32x4*)(P.SELG + ((size_t)tok * 8 + h) * 16);
#pragma unroll
        for (int j = 0; j < 4; ++j) dg[j] = (f32x4){e[4 * j] * inv, e[4 * j + 1] * inv, e[4 * j + 2] * inv, e[4 * j + 3] * inv};
    }
}

typedef float f32x2 __attribute__((ext_vector_type(2)));
__device__ __forceinline__ float dpp_xor1(float x) { return __uint_as_float(__builtin_amdgcn_update_dpp(0u, __float_as_uint(x), 0xB1, 0xF, 0xF, true)); }
__device__ __forceinline__ float dpp_xor2(float x) { return __uint_as_float(__builtin_amdgcn_update_dpp(0u, __float_as_uint(x), 0x4E, 0xF, 0xF, true)); }
__device__ __forceinline__ float dpp_hmir(float x) { return __uint_as_float(__builtin_amdgcn_update_dpp(0u, __float_as_uint(x), 0x141, 0xF, 0xF, true)); }
__device__ __forceinline__ void asm_store_b64_nt(float* p, f32x2 v) { asm volatile("global_store_dwordx2 %0, %1, off nt" :: "v"(p), "v"(v) : "memory"); }
__device__ __forceinline__ void asm_store_b32_nt(unsigned* p, unsigned v) { asm volatile("global_store_dword %0, %1, off nt" :: "v"(p), "v"(v) : "memory"); }
__device__ __forceinline__ void asm_store_b64(float* p, f32x2 v) { asm volatile("global_store_dwordx2 %0, %1, off" :: "v"(p), "v"(v) : "memory"); }
__device__ __forceinline__ float fp8_dot16(const v4u r, const f32x2 (&hh)[8]) {
    const unsigned w[4] = {r.x, r.y, r.z, r.w}; f32x2 d = {0.f, 0.f};
#pragma unroll
    for (int i = 0; i < 4; ++i) { d += __builtin_amdgcn_cvt_pk_f32_fp8(w[i], false) * hh[2 * i]; d += __builtin_amdgcn_cvt_pk_f32_fp8(w[i], true) * hh[2 * i + 1]; }
    return d.x + d.y;
}
__device__ __forceinline__ int dppi(int x, const int ctrl_sel) { return ctrl_sel == 0 ? __builtin_amdgcn_update_dpp(0, x, 0xB1, 0xF, 0xF, true) : ctrl_sel == 1 ? __builtin_amdgcn_update_dpp(0, x, 0x4E, 0xF, 0xF, true) : __builtin_amdgcn_update_dpp(0, x, 0x141, 0xF, 0xF, true); }
__device__ __forceinline__ float i8_dot128(const v4u r, const unsigned (&hq)[4]) {
    int p = __builtin_amdgcn_sdot4((int)r.x, (int)hq[0], 0, false); p = __builtin_amdgcn_sdot4((int)r.y, (int)hq[1], p, false); p = __builtin_amdgcn_sdot4((int)r.z, (int)hq[2], p, false); p = __builtin_amdgcn_sdot4((int)r.w, (int)hq[3], p, false);
    p += dppi(p, 0); p += dppi(p, 1); p += dppi(p, 2);
    return (float)p;
}
__device__ __forceinline__ float ssq_f32(const unsigned long long* p) { return (float)((double)__hip_atomic_load(p, RLX_AGENT) * 2.3283064365386963e-10); }
__device__ __forceinline__ void load_x1b16(const bf16* p, f32x4 (&xv)[4]) {
    const v4u a = ((const GAS v4u*)p)[0], b = ((const GAS v4u*)p)[1];
    xv[0] = (f32x4){bflo(a.x), bfhi(a.x), bflo(a.y), bfhi(a.y)}; xv[1] = (f32x4){bflo(a.z), bfhi(a.z), bflo(a.w), bfhi(a.w)};
    xv[2] = (f32x4){bflo(b.x), bfhi(b.x), bflo(b.y), bfhi(b.y)}; xv[3] = (f32x4){bflo(b.z), bfhi(b.z), bflo(b.w), bfhi(b.w)};
}
__device__ __forceinline__ void peer_h2q_rows(const Ptrs& P, int t0, int lane) {
    f32x4 xv[4][4], gv[4]; float sq[4];
#pragma unroll
    for (int r = 0; r < 4; ++r) { load_x1b16(P.XN + (size_t)(t0 + r) * D + 16 * lane, xv[r]); sq[r] = ssq_f32(P.SSQ2 + t0 + r); }
    const GAS f32x4* gr = (const GAS f32x4*)(P.ffn_g + 16 * lane);
#pragma unroll
    for (int i = 0; i < 4; ++i) gv[i] = gr[i];
#pragma unroll
    for (int r = 0; r < 4; ++r) {
        const float rs = 1.0f / sqrtf(sq[r] * (1.0f / 1024.0f) + EPS); f32x4 hv[4]; float am = 0.f;
#pragma unroll
        for (int i = 0; i < 4; ++i) { hv[i] = xv[r][i] * rs * gv[i]; am = fmaxf(fmaxf(am, fmaxf(fabsf(hv[i].x), fabsf(hv[i].y))), fmaxf(fabsf(hv[i].z), fabsf(hv[i].w))); }
        am = fmaxf(am, dpp_xor1(am)); am = fmaxf(am, dpp_xor2(am)); am = fmaxf(am, dpp_hmir(am));
        const float sc = am > 0.f ? 127.f / am : 1.f, hs = am > 0.f ? am * (1.f / 127.f) : 1.f;
        v4u q; unsigned hw[4];
#pragma unroll
        for (int i = 0; i < 4; ++i) { const f32x4 v = hv[i] * sc; hw[i] = pack_i8x4((int)__builtin_rintf(v.x), (int)__builtin_rintf(v.y), (int)__builtin_rintf(v.z), (int)__builtin_rintf(v.w)); }
        q = (v4u){hw[0], hw[1], hw[2], hw[3]};
        *(GAS v4u*)(P.H2Q + ((size_t)(lane >> 3) * M + (size_t)(t0 + r)) * 128 + 16 * (lane & 7)) = q;
        if ((lane & 7) == 0) P.HS[(size_t)(lane >> 3) * M + t0 + r] = hs;
    }
}
__device__ __forceinline__ void peer_dots_phase(Frame& F, const Ptrs& P) {
    const int nsl = F.G >> 3; if ((int)blockIdx.x >= nsl * 8) return;
    const int sx = blockIdx.x & 7, rank = blockIdx.x >> 3, lane = F.lane, k = lane >> 3, c = lane & 7;
    const int tstride = nsl * NWAVES;
    const unsigned char* tab = P.UT + (size_t)sx * NEXP * 128 + 16 * c;
    LAS float* tl = (LAS float*)(F.lds + F.wave * 512);
    int t = rank * NWAVES + F.wave;
    if (t >= M) return;
    const unsigned char* h2p = P.H2Q + (size_t)sx * M * 128 + 16 * c; const float* hsp = P.HS + (size_t)sx * M;
    int e0 = P.SELH[(size_t)t * 128 + lane], e1 = P.SELH[(size_t)t * 128 + 64 + lane];
    v4u hqv = *(const GAS v4u*)(h2p + (size_t)t * 128); float hsv = hsp[t];
    v4u ra[8], rb[8];
    asm volatile("" ::: "memory"); __builtin_amdgcn_sched_barrier(0);
#pragma unroll
    for (int i = 0; i < 8; ++i) { const int ej = __shfl(e0, 8 * i + k); ra[i] = *(const GAS v4u*)(tab + (size_t)ej * 128); }
    asm volatile("" ::: "memory"); __builtin_amdgcn_sched_barrier(0);
    for (; t < M; t += tstride) {
        const int tn = (t + tstride < M) ? t + tstride : t;
        const unsigned hq[4] = {hqv.x, hqv.y, hqv.z, hqv.w}; const float hs = hsv;
        __builtin_amdgcn_sched_barrier(0);
        const int ne0 = __builtin_nontemporal_load(P.SELH + (size_t)tn * 128 + lane), ne1 = __builtin_nontemporal_load(P.SELH + (size_t)tn * 128 + 64 + lane);
        hqv = __builtin_nontemporal_load((const v4u*)(h2p + (size_t)tn * 128)); hsv = __builtin_nontemporal_load(hsp + tn);
#pragma unroll
        for (int i = 0; i < 8; ++i) { const int ej = __shfl(e1, 8 * i + k); rb[i] = *(const GAS v4u*)(tab + (size_t)ej * 128); }
        asm volatile("" ::: "memory"); __builtin_amdgcn_sched_barrier(0);
        float res[16];
#pragma unroll
        for (int i = 0; i < 8; ++i) res[i] = i8_dot128(ra[i], hq) * hs;
        asm volatile("" ::: "memory"); __builtin_amdgcn_sched_barrier(0);
#pragma unroll
        for (int i = 0; i < 8; ++i) { const int ej = __shfl(ne0, 8 * i + k); ra[i] = *(const GAS v4u*)(tab + (size_t)ej * 128); }
        asm volatile("" ::: "memory"); __builtin_amdgcn_sched_barrier(0);
#pragma unroll
        for (int i = 0; i < 8; ++i) res[8 + i] = i8_dot128(rb[i], hq) * hs;
        __builtin_amdgcn_sched_barrier(0);
        if (c == 0) {
#pragma unroll
            for (int i = 0; i < 16; ++i) tl[8 * i + k] = res[i];
        }
        const f32x2 pv = *(const LAS f32x2*)(tl + 2 * lane);
        asm_store_b32_nt((unsigned*)P.PART + ((size_t)sx * M + t) * 64 + lane, cvtpk(pv.x, pv.y));
        e0 = ne0; e1 = ne1;
    }
}
__device__ __forceinline__ void peer_act_phase(Frame& F, const Ptrs& P) {
    LAS float* scl = (LAS float*)(F.lds + RING_OFF);
    __syncthreads();
#pragma unroll
    for (int i = 0; i < 16; ++i) __builtin_amdgcn_global_load_lds((const unsigned*)((const unsigned char*)P.USC + (size_t)(F.wave + 8 * i) * 1024 + F.lane * 16), (LAS unsigned*)(F.lds + RING_OFF + (F.wave + 8 * i) * 1024), 16, 0, 0);
    asm volatile("s_waitcnt vmcnt(0)" ::: "memory");
    __syncthreads();
    const size_t n4 = (size_t)M * 128 / 4, nthr = (size_t)F.G * NWAVES * 64;
    for (size_t i = (size_t)blockIdx.x * (NWAVES * 64) + F.tid; i < n4; i += nthr) {
        f32x4 d = {0.f, 0.f, 0.f, 0.f};
#pragma unroll
        for (int sx = 0; sx < 8; ++sx) { const v2u pw = ((const GAS v2u*)((const unsigned*)P.PART + (size_t)sx * M * 64))[i]; d += (f32x4){bflo(pw.x), bfhi(pw.x), bflo(pw.y), bfhi(pw.y)}; }
        const v2u e = ((const GAS v2u*)P.SELH)[i]; const f32x4 g = ((const GAS f32x4*)P.SELG)[i];
        const unsigned ee[4] = {e.x & 0xffffu, e.x >> 16, e.y & 0xffffu, e.y >> 16}; const float dd[4] = {d.x, d.y, d.z, d.w}, gg[4] = {g.x, g.y, g.z, g.w}; float w[4];
#pragma unroll
        for (int q = 0; q < 4; ++q) { const float dot = dd[q] * scl[ee[q]]; w[q] = 0.5f * dot * (1.f + erff(dot * 0.70710678118654752f)) * gg[q] * scl[NEXP + ee[q]]; }
        ((GAS v2u*)P.WB)[i] = (v2u){cvtpk(w[0], w[1]), cvtpk(w[2], w[3])};
    }
    __syncthreads();
}
__device__ __forceinline__ void fp8_axpy16(const v4u r, const float w, f32x2 (&acc)[8]) {
    const unsigned ww[4] = {r.x, r.y, r.z, r.w};
#pragma unroll
    for (int i = 0; i < 4; ++i) { acc[2 * i] += __builtin_amdgcn_cvt_pk_f32_fp8(ww[i], false) * w; acc[2 * i + 1] += __builtin_amdgcn_cvt_pk_f32_fp8(ww[i], true) * w; }
}
__device__ __forceinline__ void peer_accum_phase(Frame& F, const Ptrs& P) {
    const int nsl = F.G >> 3; if ((int)blockIdx.x >= nsl * 8) return;
    const int sx = blockIdx.x & 7, rank = blockIdx.x >> 3, lane = F.lane, k = lane >> 3, c = lane & 7;
    const int tstride = nsl * NWAVES;
    const unsigned char* tab = P.VT + (size_t)sx * NEXP * 128 + 16 * c;
    const bool h5 = (lane & 32) != 0, h4 = (lane & 16) != 0, h3 = (lane & 8) != 0;
    const int chan = 128 * sx + 16 * c + 8 * (h5 ? 1 : 0) + 4 * (h4 ? 1 : 0) + 2 * (h3 ? 1 : 0);
    int t = rank * NWAVES + F.wave;
    if (t >= M) return;
    int e0 = P.SELH[(size_t)t * 128 + lane], e1 = P.SELH[(size_t)t * 128 + 64 + lane];
    float w0 = bflo(P.WB[(size_t)t * 128 + lane]), w1 = bflo(P.WB[(size_t)t * 128 + 64 + lane]);
    unsigned xres = *(const GAS unsigned*)(P.XN + (size_t)t * D + chan);
    v4u ra[8], rb[8];
    asm volatile("" ::: "memory"); __builtin_amdgcn_sched_barrier(0);
#pragma unroll
    for (int i = 0; i < 8; ++i) { const int ej = __shfl(e0, 8 * i + k); ra[i] = *(const GAS v4u*)(tab + (size_t)ej * 128); }
    asm volatile("" ::: "memory"); __builtin_amdgcn_sched_barrier(0);
    for (; t < M; t += tstride) {
        const int tn = (t + tstride < M) ? t + tstride : t;
        float wsa[8], wsb[8];
#pragma unroll
        for (int i = 0; i < 8; ++i) { wsa[i] = __shfl(w0, 8 * i + k); wsb[i] = __shfl(w1, 8 * i + k); }
        asm volatile("" ::: "memory"); __builtin_amdgcn_sched_barrier(0);
        const int ne0 = __builtin_nontemporal_load(P.SELH + (size_t)tn * 128 + lane), ne1 = __builtin_nontemporal_load(P.SELH + (size_t)tn * 128 + 64 + lane);
        const float nw0 = bflo(__builtin_nontemporal_load(P.WB + (size_t)tn * 128 + lane)), nw1 = bflo(__builtin_nontemporal_load(P.WB + (size_t)tn * 128 + 64 + lane));
        const unsigned nx = __builtin_nontemporal_load((const unsigned*)(P.XN + (size_t)tn * D + chan));
#pragma unroll
        for (int i = 0; i < 8; ++i) { const int ej = __shfl(e1, 8 * i + k); rb[i] = *(const GAS v4u*)(tab + (size_t)ej * 128); }
        asm volatile("" ::: "memory"); __builtin_amdgcn_sched_barrier(0);
        f32x2 acc[8];
#pragma unroll
        for (int i = 0; i < 8; ++i) acc[i] = (f32x2){0.f, 0.f};
#pragma unroll
        for (int i = 0; i < 8; ++i) fp8_axpy16(ra[i], wsa[i], acc);
        asm volatile("" ::: "memory"); __builtin_amdgcn_sched_barrier(0);
#pragma unroll
        for (int i = 0; i < 8; ++i) { const int ej = __shfl(ne0, 8 * i + k); ra[i] = *(const GAS v4u*)(tab + (size_t)ej * 128); }
        asm volatile("" ::: "memory"); __builtin_amdgcn_sched_barrier(0);
#pragma unroll
        for (int i = 0; i < 8; ++i) fp8_axpy16(rb[i], wsb[i], acc);
        __builtin_amdgcn_sched_barrier(0);
        f32x2 b4[4], b2[2], b1;
#pragma unroll
        for (int i = 0; i < 4; ++i) { const f32x2 keep = h5 ? acc[4 + i] : acc[i], send = h5 ? acc[i] : acc[4 + i]; b4[i] = (f32x2){keep.x + __shfl_xor(send.x, 32), keep.y + __shfl_xor(send.y, 32)}; }
#pragma unroll
        for (int i = 0; i < 2; ++i) { const f32x2 keep = h4 ? b4[2 + i] : b4[i], send = h4 ? b4[i] : b4[2 + i]; b2[i] = (f32x2){keep.x + __shfl_xor(send.x, 16), keep.y + __shfl_xor(send.y, 16)}; }
        { const f32x2 keep = h3 ? b2[1] : b2[0], send = h3 ? b2[0] : b2[1]; b1 = (f32x2){keep.x + __shfl_xor(send.x, 8), keep.y + __shfl_xor(send.y, 8)}; }
        asm_store_b64_nt(P.out + (size_t)t * D + chan, (f32x2){bflo(xres), bfhi(xres)} + b1);
        e0 = ne0; e1 = ne1; w0 = nw0; w1 = nw1; xres = nx;
    }
}

struct Args { const float* in[21]; float* out; unsigned char* ws; int ph_lo, ph_hi, li, pad; };
__device__ __forceinline__ Ptrs make_ptrs(const Args& args) {
    unsigned char* ws = args.ws;
    Ptrs P;
    P.x = args.in[0]; P.mem = args.in[1]; P.attn_g = args.in[2]; P.w_in = args.in[3]; P.conv_w = args.in[4]; P.conv_b = args.in[5]; P.conv_ln_g = args.in[6]; P.conv_ln_b = args.in[7];
    P.sb_out_g = args.in[8]; P.mem_norm_g = args.in[9]; P.w_mem_kv = args.in[10]; P.q_norm_g = args.in[11]; P.k_norm_g = args.in[12]; P.mem_out_g = args.in[13]; P.w_out = args.in[14];
    P.ffn_g = args.in[15]; P.w_peer_q = args.in[16]; P.keys1 = args.in[17]; P.keys2 = args.in[18]; P.peer_u = args.in[19]; P.peer_v = args.in[20];
    P.out = args.out;
    P.WIN = (bf16*)(ws + WS_WIN); P.WKV = (bf16*)(ws + WS_WKV); P.WOUT = (bf16*)(ws + WS_WOUT); P.WPQ = (bf16*)(ws + WS_WPQ); P.KEYS = (bf16*)(ws + WS_KEYS);
    P.MEMN = (bf16*)(ws + WS_MEMN); P.MKV = (bf16*)(ws + WS_MKV); P.UT = ws + WS_UT; P.VT = ws + WS_VT; P.PART = (float*)(ws + WS_PROJ); P.USC = (float*)(ws + WS_SC); P.VSC = (float*)(ws + WS_SC) + NEXP; P.XN = (bf16*)(ws + WS_XN); P.CAT = (bf16*)(ws + WS_CAT);
    P.PROJ = (bf16*)(ws + WS_PROJ); P.Q = (bf16*)(ws + WS_Q); P.SELH = (unsigned short*)(ws + WS_SELI); P.WB = (unsigned short*)(ws + WS_CAT); P.SELG = (float*)(ws + WS_SELG); P.SSQ2 = (unsigned long long*)((unsigned*)(ws + WS_CTL) + CW_SSQ2); P.KF = (bf16*)(ws + WS_KF); P.MKF = (bf16*)(ws + WS_MKF); P.H2Q = ws + WS_KF; P.HS = (float*)(ws + WS_MKF);
    return P;
}
__global__ void __launch_bounds__(NWAVES * 64, 2) fwd_kernel(Args args) {
    extern __shared__ __attribute__((aligned(16))) unsigned char lds[];
    Frame F;
    F.lds = (LAS unsigned char*)lds;
    F.MISC = (volatile LAS unsigned*)(F.lds + MISC_OFF);
    F.tid = threadIdx.x; F.lane = F.tid & 63; F.wave = __builtin_amdgcn_readfirstlane(F.tid >> 6);
    F.G = gridDim.x; { const int bx = blockIdx.x; F.vcu = (F.G % 8 == 0) ? (bx % 8) * (F.G / 8) + bx / 8 : bx; }
    unsigned char* ws = args.ws;
    F.ctl = (gu32*)(ws + WS_CTL);
    for (int u = F.tid; u < (LDS_BYTES - LDSCTL_OFF) / 4; u += NWAVES * 64) ((LAS unsigned*)(F.lds + LDSCTL_OFF))[u] = 0u;
    __syncthreads();
    XcdBarrier bar; bar.bar = (unsigned*)(F.ctl + CW_BAR); bar.x = 0; bar.st = nullptr;
    if (N_LAUNCHES != PER_PHASE) bar = xcd_barrier_post((unsigned*)(F.ctl + CW_BAR), F.MISC + 8);
#define GRID_BAR() do { if (N_LAUNCHES != PER_PHASE) xcd_barrier(bar); } while (0)
    const int lo = args.ph_lo, hi = args.ph_hi;
#define IN(k) (lo <= (k) && (k) < hi)
#define BOTH(k) (IN(k) && IN((k) + 1))

    if (IN(0)) { const Ptrs P = make_ptrs(args); for (int rep = 0; rep < (PROBE_DBL == 0 ? 2 : 1); ++rep) p0_prologue(F, P); if (BOTH(0)) GRID_BAR(); }

    if (IN(1)) { const Ptrs P = make_ptrs(args);
        { pg8::Gemm g{P.XN, P.WIN, M, INW, D}; pg8::StaticOrder S; S.init(M, INW, F.G, (int)blockIdx.x);
          pg8::EpiBf16K E{P.PROJ, INW, P.KF, C_K / 256, C_K / 256 + 1, 8};
          for (int rep = 0; rep < (PROBE_DBL == 1 ? 2 : 1); ++rep)
          pg8::gemm_phase<pg8::EpiBf16K, pg8::StaticOrder, PG8_ALIGN, PG8_SP2>(F.lds + RING_OFF, g, S, E); }
        { pg8::Gemm g{P.MEMN, P.WKV, MMEM, KVW, D}; pg8::StaticOrder S; S.init(MMEM, KVW, F.G, (int)((blockIdx.x + (unsigned)(F.G / 2)) % (unsigned)F.G));
          pg8::EpiBf16K E{P.MKV, KVW, P.MKF, 0, 0, 4};
          pg8::gemm_phase<pg8::EpiBf16K, pg8::StaticOrder, PG8_ALIGN, PG8_SP2>(F.lds + RING_OFF, g, S, E); }
        if (BOTH(1)) GRID_BAR();
    }

    if (IN(2)) { const Ptrs P = make_ptrs(args);
        const int c = F.vcu;
        for (int rep = 0; rep < (PROBE_DBL == 2 ? 2 : 1); ++rep) {
        const int cls = (blockIdx.x >> 3) & 3;
#define P2_SB(F) do { for (int r2 = 0; r2 < (PROBE_DBL == 20 ? 2 : 1); ++r2) { \
            const bool deal = (F.G == 256); const int nit = deal ? 2 : (BATCH * (SEQ / 64) - c + F.G - 1) / F.G; \
            for (int i = 0; i < nit; ++i) { const int it = c + i * F.G, s = c & 31; const int b = deal ? (c >> 5) : (it >> 6), g = deal ? (i == 0 ? 63 - s : s) : (it & 63); sb_item_mfma(F, P, b, g); } } __syncthreads(); } while (0)
#define P2_MEM(F) do { for (int r2 = 0; r2 < (PROBE_DBL == 21 ? 2 : 1); ++r2) for (int it = c; it < BATCH * (SEQ / 128); it += F.G) mem_item_mfma(F, P, it >> 5, it & 31); __syncthreads(); } while (0)
#define P2_CONV(F) do { for (int r2 = 0; r2 < (PROBE_DBL == 22 ? 2 : 1); ++r2) conv_phase(F, P); __syncthreads(); } while (0)
#define P2_TAB(F) do { const int gw = F.vcu * NWAVES + F.wave, NGW = F.G * NWAVES; \
            for (int r = gw * 4; r < 2 * NEXP; r += NGW * 4) { if (r < NEXP) rows_to_i8<4>(P.peer_u, P.UT, P.USC, r, F.lane); else rows_to_fp8<4>(P.peer_v, P.VT, P.VSC, r - NEXP, F.lane); } __syncthreads(); } while (0)
        if (cls == 0)      { Frame Fa = F; asm volatile("" : "+v"(Fa.tid), "+v"(Fa.lane)); P2_SB(Fa); P2_MEM(Fa); P2_CONV(Fa); P2_TAB(Fa); }
        else if (cls == 1) { Frame Fb = F; asm volatile("" : "+v"(Fb.tid), "+v"(Fb.lane)); P2_TAB(Fb); P2_CONV(Fb); P2_MEM(Fb); P2_SB(Fb); }
        else if (cls == 2) { Frame Fc = F; asm volatile("" : "+v"(Fc.tid), "+v"(Fc.lane)); P2_CONV(Fc); P2_SB(Fc); P2_TAB(Fc); P2_MEM(Fc); }
        else               { Frame Fd = F; asm volatile("" : "+v"(Fd.tid), "+v"(Fd.lane)); P2_MEM(Fd); P2_TAB(Fd); P2_SB(Fd); P2_CONV(Fd); }
#undef P2_SB
#undef P2_MEM
#undef P2_CONV
#undef P2_TAB
        }
        if (BOTH(2)) GRID_BAR();
    }

    if (IN(3)) { const Ptrs P = make_ptrs(args);
        pg8::Gemm g{P.CAT, P.WOUT, M, D, D}; pg8::StaticOrder S; S.init(M, D, F.G, (int)blockIdx.x);
        pg8::EpiResid E{P.x, P.XN, P.SSQ2, D};
        pg8::gemm_phase<pg8::EpiResid, pg8::StaticOrder, PG8_ALIGN, PG8_SP2>(F.lds + RING_OFF, g, S, E);
        if (PROBE_DBL == 3) { pg8::EpiResid E2{P.x, P.XN, (unsigned long long*)P.SELG, D}; pg8::gemm_phase<pg8::EpiResid, pg8::StaticOrder, PG8_ALIGN, PG8_SP2>(F.lds + RING_OFF, g, S, E2); }
        if (BOTH(3)) GRID_BAR();
    }

    if (IN(4)) { const Ptrs P = make_ptrs(args);
        pg8::Gemm g{P.XN, P.WPQ, M, PQW, D}; pg8::StaticOrder S; S.init(M, PQW, F.G, (int)blockIdx.x);
        pg8::EpiBf16RowQ E{P.Q, PQW, P.SSQ2};
        for (int rep = 0; rep < (PROBE_DBL == 4 ? 2 : 1); ++rep)
        pg8::gemm_phase<pg8::EpiBf16RowQ, pg8::StaticOrder, PG8_ALIGN, PG8_SP2>(F.lds + RING_OFF, g, S, E);
        asm volatile("s_waitcnt vmcnt(0)" ::: "memory");
        __builtin_amdgcn_fence(__ATOMIC_ACQUIRE, "agent");
        asm volatile("s_waitcnt vmcnt(0)" ::: "memory");
        __syncthreads();
        for (int rep = 0; rep < (PROBE_DBL == 5 ? 2 : 1); ++rep) { pg8::Unit u; for (int i = 0; S.next(i, u); ++i) peer_select_mfma(F, P, u.pm, u.pn, true); }
        { const int gw = F.vcu * NWAVES + F.wave, NGW = F.G * NWAVES; for (int g4 = gw; g4 < M / 4; g4 += NGW) peer_h2q_rows(P, 4 * g4, F.lane); }
        __syncthreads();
        if (BOTH(4)) GRID_BAR();
    }
    if (IN(6)) { const Ptrs P = make_ptrs(args); for (int rep = 0; rep < (PROBE_DBL == 6 ? 2 : 1); ++rep) peer_dots_phase(F, P); if (BOTH(6)) GRID_BAR(); }
    if (IN(7)) { const Ptrs P = make_ptrs(args); for (int rep = 0; rep < (PROBE_DBL == 7 ? 2 : 1); ++rep) peer_act_phase(F, P); if (BOTH(7)) GRID_BAR(); }
    if (IN(8)) { const Ptrs P = make_ptrs(args); for (int rep = 0; rep < (PROBE_DBL == 8 ? 2 : 1); ++rep) peer_accum_phase(F, P); }
#undef IN
#undef BOTH
}

extern "C" void kernel_launch(void* const* d_in, const int* in_sizes, int n_in, void* d_out, int out_size, void* d_ws, size_t ws_size, hipStream_t stream) {
    static int grid = 0;
    if (grid == 0) {
        if (n_in != 21 || in_sizes[0] != M * D || out_size != M * D || ws_size < WS_END) { fprintf(stderr, "kernel_launch: unexpected shapes/workspace (n_in %d, in0 %d, out %d, ws %zu); nothing launched\n", n_in, n_in > 0 ? in_sizes[0] : -1, out_size, ws_size); grid = -1; return; }
        int dev = 0, cus = 0, per_cu = 0;
        if (hipGetDevice(&dev) != hipSuccess || hipDeviceGetAttribute(&cus, hipDeviceAttributeMultiprocessorCount, dev) != hipSuccess) { grid = -1; return; }
        if (hipFuncSetAttribute((const void*)fwd_kernel, hipFuncAttributeMaxDynamicSharedMemorySize, LDS_BYTES) != hipSuccess) { fprintf(stderr, "kernel_launch: hipFuncSetAttribute failed\n"); grid = -1; return; }
        if (hipOccupancyMaxActiveBlocksPerMultiprocessor(&per_cu, (const void*)fwd_kernel, NWAVES * 64, LDS_BYTES) != hipSuccess || per_cu < 1) { fprintf(stderr, "kernel_launch: occupancy query says %d blocks per CU\n", per_cu); }
        (void)hipGetLastError();
        grid = cus;
    }
    if (grid < 0) return;
    if (hipMemsetAsync((char*)d_ws + WS_CTL, 0, CTL_ZERO_BYTES, stream) != hipSuccess) { fprintf(stderr, "kernel_launch: memset failed\n"); return; }
    Args a{};
    for (int i = 0; i < 21; ++i) a.in[i] = (const float*)d_in[i];
    a.out = (float*)d_out; a.ws = (unsigned char*)d_ws;
    for (int li = 0; li < N_LAUNCHES; ++li) {
        a.ph_lo = (N_LAUNCHES == PER_PHASE) ? li : 0; a.ph_hi = (N_LAUNCHES == PER_PHASE) ? li + 1 : PER_PHASE; a.li = li;
        { void* kargs[] = {(void*)&a}; (void)hipLaunchCooperativeKernel((const void*)fwd_kernel, dim3(grid), dim3(NWAVES * 64), kargs, LDS_BYTES, stream); }
        const hipError_t le = hipPeekAtLastError();
        if (le != hipSuccess) { fprintf(stderr, "kernel_launch: launch %d failed: %s\n", li, hipGetErrorName(le)); break; }
    }
}
```

```cpp
#include <hip/hip_runtime.h>
#include <cstdio>
#include <cstdint>
namespace pg8 {
#define PG8_LAS __attribute__((address_space(3)))
typedef unsigned short bf16_t;
typedef short bf16x8 __attribute__((ext_vector_type(8)));
typedef float f32x4 __attribute__((ext_vector_type(4)));
typedef unsigned u32x4 __attribute__((ext_vector_type(4)));
constexpr int BM = 256, BK = 64, HALF = 128, HTB = HALF * BK * 2  , STAGE_BYTES = 8 * HTB, NXCD = 8, WGM = 8;

__host__ __device__ __forceinline__ int lds_byte(int r, int c) { const int st = (r >> 4) * 2 + (c >> 5), rr = r & 15, cc = c & 31, ob = rr * 64 + cc * 2; return st * 1024 + (ob ^ (((ob >> 9) & 1) << 5)); }
__host__ __device__ __forceinline__ void stage_rc(int b, int& R, int& C) { const int st = b / 1024, sb = b % 1024, swz = sb ^ (((sb >> 9) & 1) << 5); R = (st >> 1) * 16 + swz / 64; C = (st & 1) * 32 + (swz % 64) / 2; }
__host__ __device__ __forceinline__ int perm32(int rho) { const int n = rho >> 4, i = rho & 15; return 8 * (i >> 2) + 4 * n + (i & 3); }

struct Unit { int pm, pn; };
struct Gemm { const bf16_t* A; const bf16_t* Bt; int M, N, K; };

struct StaticOrder {
    int nM, nN, nwg, G, c;
    __host__ __device__ void init(int M, int N, int G_, int c_) { nM = M / BM; nN = N / BM; nwg = nM * nN; G = G_; c = c_; }
    __host__ __device__ bool next(int i, Unit& u) const {
        const long L = (long)i * G + c; if (L >= nwg) return false;
        int wgid = (int)L; { const int q = nwg / NXCD, r = nwg % NXCD, xcd = wgid % NXCD, off = wgid / NXCD; wgid = (xcd < r ? xcd * (q + 1) : r * (q + 1) + (xcd - r) * q) + off; }
        const int nig = WGM * nN, gid = wgid / nig, fm = gid * WGM, gsz = (nM - fm) < WGM ? (nM - fm) : WGM;
        u.pm = fm + ((wgid % nig) % gsz); u.pn = (wgid % nig) / gsz; return true;
    }
    __device__ __forceinline__ void a_ready(const Unit&) const {}
    __device__ __forceinline__ void done(const Unit&) const {}
};

__device__ __forceinline__ unsigned cvt_pk_bf16(float lo, float hi) { unsigned r; asm volatile("v_cvt_pk_bf16_f32 %0, %1, %2" : "=v"(r) : "v"(lo), "v"(hi)); return r; }
typedef unsigned u32x2 __attribute__((ext_vector_type(2)));

struct EpiBf16 {
    static constexpr bool PERM = true, AFTER_DRAIN = false;
    bf16_t* O; int ldc;
    __device__ __forceinline__ void operator()(const f32x4 (&acc)[2][2][4][2], const Unit& u, int wr, int wc, int fr, int fq) const {
        const int row0 = u.pm * BM + wr * 64 + fr; const int col0 = u.pn * BM + wc * 32 + 8 * fq;
#pragma unroll
        for (int ai = 0; ai < 2; ++ai)
#pragma unroll
            for (int m = 0; m < 4; ++m) { bf16_t* rowp = O + (size_t)(row0 + ai * HALF + m * 16) * ldc + col0;
#pragma unroll
                for (int bj = 0; bj < 2; ++bj) { const f32x4 v0 = acc[ai][bj][m][0], v1 = acc[ai][bj][m][1];
                    u32x4 w; w.x = cvt_pk_bf16(v0[0], v0[1]); w.y = cvt_pk_bf16(v0[2], v0[3]); w.z = cvt_pk_bf16(v1[0], v1[1]); w.w = cvt_pk_bf16(v1[2], v1[3]);
                    *(u32x4*)(rowp + bj * HALF) = w; } }
    }
};
struct EpiBf16Row {
    static constexpr bool PERM = true, AFTER_DRAIN = false;
    bf16_t* O; int ldc; const unsigned long long* ssq;
    __device__ __forceinline__ void operator()(const f32x4 (&acc)[2][2][4][2], const Unit& u, int wr, int wc, int fr, int fq) const {
        const int row0 = u.pm * BM + wr * 64 + fr; const int col0 = u.pn * BM + wc * 32 + 8 * fq;
#pragma unroll
        for (int ai = 0; ai < 2; ++ai)
#pragma unroll
            for (int m = 0; m < 4; ++m) { const int row = row0 + ai * HALF + m * 16; bf16_t* rowp = O + (size_t)row * ldc + col0;
                const float rs = 1.0f / sqrtf((float)((double)__hip_atomic_load(ssq + row, __ATOMIC_RELAXED, __HIP_MEMORY_SCOPE_AGENT) * 2.3283064365386963e-10) * (1.0f / 1024.0f) + 1e-6f);
#pragma unroll
                for (int bj = 0; bj < 2; ++bj) { const f32x4 v0 = acc[ai][bj][m][0] * rs, v1 = acc[ai][bj][m][1] * rs;
                    u32x4 w; w.x = cvt_pk_bf16(v0[0], v0[1]); w.y = cvt_pk_bf16(v0[2], v0[3]); w.z = cvt_pk_bf16(v1[0], v1[1]); w.w = cvt_pk_bf16(v1[2], v1[3]);
                    *(u32x4*)(rowp + bj * HALF) = w; } }
    }
};
struct EpiBf16RowQ {
    static constexpr bool PERM = true, AFTER_DRAIN = false;
    bf16_t* O; int ldc; const unsigned long long* ssq;
    __device__ __forceinline__ void operator()(const f32x4 (&acc)[2][2][4][2], const Unit& u, int wr, int wc, int fr, int fq) const {
        const int row0 = u.pm * BM + wr * 64 + fr;
        u32x4* blk = (u32x4*)O + ((size_t)u.pm * (ldc / BM) + u.pn) * 8192;
        unsigned long long sq[2][4];
#pragma unroll
        for (int ai = 0; ai < 2; ++ai)
#pragma unroll
            for (int m = 0; m < 4; ++m) sq[ai][m] = __builtin_nontemporal_load(ssq + row0 + ai * HALF + m * 16);
#pragma unroll
        for (int ai = 0; ai < 2; ++ai)
#pragma unroll
            for (int m = 0; m < 4; ++m) {
                const float rs = 1.0f / sqrtf((float)((double)sq[ai][m] * 2.3283064365386963e-10) * (1.0f / 1024.0f) + 1e-6f);
#pragma unroll
                for (int bj = 0; bj < 2; ++bj) { const f32x4 v0 = acc[ai][bj][m][0] * rs, v1 = acc[ai][bj][m][1] * rs;
                    u32x4 w; w.x = cvt_pk_bf16(v0[0], v0[1]); w.y = cvt_pk_bf16(v0[2], v0[3]); w.z = cvt_pk_bf16(v1[0], v1[1]); w.w = cvt_pk_bf16(v1[2], v1[3]);
                    blk[((((bj * 8 + (ai * 4 + wr * 2 + (m >> 1))) * 8 + (2 * wc + (fq >> 1))) * 2 + (fq & 1)) * 32) + ((m & 1) * 16 + fr)] = w; } }
    }
};
struct EpiBf16K {
    static constexpr bool PERM = true, AFTER_DRAIN = false;
    bf16_t* O; int ldc; bf16_t* KF; int pn_lo, pn_hi, NH; int qs_lo, qs_hi; float qscale;
    __device__ __forceinline__ void operator()(const f32x4 (&acc)[2][2][4][2], const Unit& u, int wr, int wc, int fr, int fq) const {
        const int row0 = u.pm * BM + wr * 64 + fr; const int col0 = u.pn * BM + wc * 32 + 8 * fq;
        const bool isk = u.pn >= pn_lo && u.pn <= pn_hi; const float qs = (u.pn >= qs_lo && u.pn <= qs_hi) ? qscale : 1.0f;
#pragma unroll
        for (int ai = 0; ai < 2; ++ai)
#pragma unroll
            for (int m = 0; m < 4; ++m) { bf16_t* rowp = O + (size_t)(row0 + ai * HALF + m * 16) * ldc + col0;
#pragma unroll
                for (int bj = 0; bj < 2; ++bj) { const f32x4 v0 = acc[ai][bj][m][0] * qs, v1 = acc[ai][bj][m][1] * qs;
                    u32x4 w; w.x = cvt_pk_bf16(v0[0], v0[1]); w.y = cvt_pk_bf16(v0[2], v0[3]); w.z = cvt_pk_bf16(v1[0], v1[1]); w.w = cvt_pk_bf16(v1[2], v1[3]);
                    if (isk) { const size_t kt = (size_t)u.pm * 8 + ai * 4 + wr * 2 + (m >> 1); const int h = (u.pn - pn_lo) * 4 + 2 * bj + (wc >> 1), ks = 2 * (wc & 1) + (fq >> 1);
                        ((u32x4*)KF)[(((kt * NH + h) * 4 + ks) * 2 + (fq & 1)) * 32 + ((m & 1) * 16 + fr)] = w; }
                    else *(u32x4*)(rowp + bj * HALF) = w; } }
    }
};
struct EpiResid {
    static constexpr bool PERM = true, AFTER_DRAIN = false;
    const float* x; bf16_t* xb; unsigned long long* ssq; int ldc;
    __device__ __forceinline__ void operator()(const f32x4 (&acc)[2][2][4][2], const Unit& u, int wr, int wc, int fr, int fq) const {
        const int col0 = u.pn * BM + wc * 32 + 8 * fq;
#pragma unroll
        for (int ai = 0; ai < 2; ++ai)
#pragma unroll
            for (int m = 0; m < 4; ++m) { const int row = u.pm * BM + ai * HALF + wr * 64 + m * 16 + fr; const size_t off = (size_t)row * ldc + col0; float s = 0.f;
#pragma unroll
                for (int bj = 0; bj < 2; ++bj) { const f32x4 x0 = *(const f32x4*)(x + off + bj * HALF), x1 = *(const f32x4*)(x + off + bj * HALF + 4);
                    const f32x4 o0 = x0 + acc[ai][bj][m][0], o1 = x1 + acc[ai][bj][m][1];
                    s += ((o0[0] * o0[0] + o0[1] * o0[1]) + (o0[2] * o0[2] + o0[3] * o0[3])) + ((o1[0] * o1[0] + o1[1] * o1[1]) + (o1[2] * o1[2] + o1[3] * o1[3]));
                    u32x4 w; w.x = cvt_pk_bf16(o0[0], o0[1]); w.y = cvt_pk_bf16(o0[2], o0[3]); w.z = cvt_pk_bf16(o1[0], o1[1]); w.w = cvt_pk_bf16(o1[2], o1[3]);
                    *(u32x4*)(xb + off + bj * HALF) = w; }
                s += __shfl_xor(s, 16); s += __shfl_xor(s, 32);
                if (fq == 0) atomicAdd(ssq + row, (unsigned long long)((double)s * 4294967296.0)); }
    }
};

template <class Epi, class Sched, bool ALIGN_EPI = false, bool SP2 = false>
__device__ __forceinline__ void gemm_phase(PG8_LAS unsigned char* lds, const Gemm g, const Sched& S, const Epi& E) {
    const int tid = threadIdx.x, wid = __builtin_amdgcn_readfirstlane(tid >> 6), lane = tid & 63, wr = wid >> 2, wc = wid & 3, fr = lane & 15, fq = lane >> 4;
    const int K = g.K, nt = K / BK;
    unsigned voffA[2], voffB[2];
#pragma unroll
    for (int i = 0; i < 2; ++i) { int R, C; stage_rc(tid * 16 + i * 8192, R, C); const int Rb = Epi::PERM ? ((R & ~31) + perm32(R & 31)) : R;
        voffA[i] = (unsigned)(R * K + C) * 2u; voffB[i] = (unsigned)(Rb * K + C) * 2u; }
    const size_t kstep = (size_t)(BK * 2);
    const size_t hstep = (size_t)HALF * K * 2;
    const size_t tstep = 2 * hstep;
    const unsigned ldsw = (unsigned)wid * 1024u;
    const int aoff = lds_byte(wr * 64 + fr, fq * 8), boff = lds_byte(wc * 32 + fr, fq * 8);
#define PG8_SA(b, h) (((b) * 2 + (h)) * HTB)
#define PG8_SB(b, h) ((4 + (b) * 2 + (h)) * HTB)
#define PG8_STAGE(bufoff, gbase, voff) do { _Pragma("unroll") for (int _i = 0; _i < 2; ++_i) \
        __builtin_amdgcn_global_load_lds((const unsigned*)((const char*)(gbase) + (voff)[_i]), (PG8_LAS unsigned*)(lds + (bufoff) + ldsw + _i * 8192), 16, 0, 0); } while (0)
#define PG8_LDA(dst, b, h) do { _Pragma("unroll") for (int m = 0; m < 4; ++m) _Pragma("unroll") for (int k = 0; k < 2; ++k) dst[m][k] = *(const PG8_LAS bf16x8*)(lds + PG8_SA(b, h) + aoff + m * 2048 + k * 1024); } while (0)
#define PG8_LDB(dst, b, h) do { _Pragma("unroll") for (int n = 0; n < 2; ++n) _Pragma("unroll") for (int k = 0; k < 2; ++k) dst[n][k] = *(const PG8_LAS bf16x8*)(lds + PG8_SB(b, h) + boff + n * 2048 + k * 1024); } while (0)
#define PG8_MMA(ai, bj, At, Bt) do { __builtin_amdgcn_s_setprio(1); _Pragma("unroll") for (int m = 0; m < 4; ++m) _Pragma("unroll") for (int n = 0; n < 2; ++n) _Pragma("unroll") for (int k = 0; k < 2; ++k) \
        acc[ai][bj][m][n] = __builtin_amdgcn_mfma_f32_16x16x32_bf16(Bt[n][k], At[m][k], acc[ai][bj][m][n], 0, 0, 0); __builtin_amdgcn_s_setprio(0); } while (0)
#define PG8_WAIT_V(n) asm volatile("s_waitcnt vmcnt(" #n ")" ::: "memory")
#define PG8_WAIT_L(n) asm volatile("s_waitcnt lgkmcnt(" #n ")" ::: "memory")
#define PG8_BAR __builtin_amdgcn_s_barrier()
#define PG8_SCHED __builtin_amdgcn_sched_barrier(0)
    Unit cur, nxt; int ui = 0;
    if (!S.next(0, cur)) return;
    f32x4 acc[2][2][4][2];
#pragma unroll
    for (int a = 0; a < 2; ++a)
#pragma unroll
        for (int b = 0; b < 2; ++b)
#pragma unroll
            for (int m = 0; m < 4; ++m)
#pragma unroll
                for (int n = 0; n < 2; ++n) acc[a][b][m][n] = (f32x4){0.f, 0.f, 0.f, 0.f};
    bf16x8 At[4][2], B0[2][2], B1[2][2];
    const char* cA = (const char*)g.A + (size_t)cur.pm * tstep; const char* cB = (const char*)g.Bt + (size_t)cur.pn * tstep;
    S.a_ready(cur);
    if constexpr (SP2) {
        PG8_STAGE(PG8_SB(0, 0), cB, voffB); PG8_STAGE(PG8_SB(0, 1), cB + hstep, voffB); PG8_STAGE(PG8_SA(0, 0), cA, voffA); PG8_STAGE(PG8_SA(0, 1), cA + hstep, voffA);
        if (wr == 1) PG8_BAR;
        PG8_WAIT_V(2); PG8_BAR;
        PG8_STAGE(PG8_SB(1, 0), cB + kstep, voffB); PG8_STAGE(PG8_SA(1, 0), cA + kstep, voffA); PG8_STAGE(PG8_SB(1, 1), cB + hstep + kstep, voffB);
        PG8_WAIT_V(6); PG8_BAR;
    } else {
        PG8_STAGE(PG8_SB(0, 0), cB, voffB); PG8_STAGE(PG8_SA(0, 0), cA, voffA); PG8_STAGE(PG8_SB(0, 1), cB + hstep, voffB); PG8_STAGE(PG8_SA(0, 1), cA + hstep, voffA);
        if (wr == 1) PG8_BAR;
        PG8_WAIT_V(4); PG8_BAR;
        PG8_STAGE(PG8_SB(1, 0), cB + kstep, voffB); PG8_STAGE(PG8_SA(1, 0), cA + kstep, voffA); PG8_STAGE(PG8_SB(1, 1), cB + hstep + kstep, voffB);
        PG8_WAIT_V(6); PG8_BAR;
    }
    for (;;) {
        const bool has_next = S.next(ui + 1, nxt);
        const char* nA = has_next ? (const char*)g.A + (size_t)nxt.pm * tstep : cA; const char* nB = has_next ? (const char*)g.Bt + (size_t)nxt.pn * tstep : cB;
        for (int t = 0; t < nt; t += 2) {
            const bool last = (t == nt - 2);
            const char* a1 = cA + (size_t)(t + 1) * kstep;
            const char* a2 = last ? nA : cA + (size_t)(t + 2) * kstep; const char* b2 = last ? nB : cB + (size_t)(t + 2) * kstep;
            const char* a3 = a2 + kstep; const char* b3 = b2 + kstep;
            if (last && has_next) S.a_ready(nxt);
            if constexpr (SP2) {
            PG8_LDB(B0, 0, 0); PG8_LDB(B1, 0, 1); PG8_SCHED; PG8_LDA(At, 0, 0); PG8_STAGE(PG8_SA(1, 1), a1 + hstep, voffA);
            PG8_WAIT_V(8); PG8_WAIT_L(0); PG8_BAR; PG8_MMA(0, 0, At, B0); PG8_MMA(0, 1, At, B1); PG8_BAR; PG8_SCHED;
            PG8_LDA(At, 0, 1); PG8_STAGE(PG8_SB(0, 0), b2, voffB); PG8_STAGE(PG8_SB(0, 1), b2 + hstep, voffB); PG8_STAGE(PG8_SA(0, 0), a2, voffA);
            PG8_WAIT_V(8); PG8_WAIT_L(0); PG8_BAR; PG8_MMA(1, 0, At, B0); PG8_MMA(1, 1, At, B1); PG8_BAR; PG8_SCHED;
            PG8_LDB(B0, 1, 0); PG8_LDB(B1, 1, 1); PG8_SCHED; PG8_LDA(At, 1, 0); PG8_STAGE(PG8_SA(0, 1), a2 + hstep, voffA);
            PG8_WAIT_V(8); PG8_WAIT_L(0); PG8_BAR; PG8_MMA(0, 0, At, B0); PG8_MMA(0, 1, At, B1); PG8_BAR; PG8_SCHED;
            PG8_LDA(At, 1, 1); PG8_STAGE(PG8_SB(1, 0), b3, voffB); PG8_STAGE(PG8_SB(1, 1), b3 + hstep, voffB); PG8_STAGE(PG8_SA(1, 0), a3, voffA);
            PG8_WAIT_V(8); PG8_WAIT_L(0); PG8_BAR; PG8_MMA(1, 0, At, B0); PG8_MMA(1, 1, At, B1); PG8_BAR; PG8_SCHED;
            } else {
            PG8_LDB(B0, 0, 0); PG8_SCHED; PG8_LDA(At, 0, 0); PG8_STAGE(PG8_SA(1, 1), a1 + hstep, voffA);
            PG8_WAIT_L(8); PG8_BAR; PG8_WAIT_L(0); PG8_MMA(0, 0, At, B0); PG8_BAR; PG8_SCHED;
            PG8_LDB(B1, 0, 1); PG8_STAGE(PG8_SB(0, 0), b2, voffB);
            PG8_BAR; PG8_WAIT_L(0); PG8_MMA(0, 1, At, B1); PG8_BAR;
            PG8_LDA(At, 0, 1); PG8_STAGE(PG8_SA(0, 0), a2, voffA);
            PG8_BAR; PG8_WAIT_L(0); PG8_MMA(1, 0, At, B0); PG8_BAR; PG8_SCHED;
            PG8_STAGE(PG8_SB(0, 1), b2 + hstep, voffB);
            PG8_WAIT_V(6); PG8_BAR; PG8_MMA(1, 1, At, B1); PG8_BAR;
            PG8_LDB(B0, 1, 0); PG8_SCHED; PG8_LDA(At, 1, 0); PG8_STAGE(PG8_SA(0, 1), a2 + hstep, voffA);
            PG8_WAIT_L(8); PG8_BAR; PG8_WAIT_L(0); PG8_MMA(0, 0, At, B0); PG8_BAR; PG8_SCHED;
            PG8_LDB(B1, 1, 1); PG8_STAGE(PG8_SB(1, 0), b3, voffB);
            PG8_BAR; PG8_WAIT_L(0); PG8_MMA(0, 1, At, B1); PG8_BAR;
            PG8_LDA(At, 1, 1); PG8_STAGE(PG8_SA(1, 0), a3, voffA);
            PG8_BAR; PG8_WAIT_L(0); PG8_MMA(1, 0, At, B0); PG8_BAR; PG8_SCHED;
            PG8_STAGE(PG8_SB(1, 1), b3 + hstep, voffB);
            PG8_WAIT_V(6); PG8_BAR; PG8_MMA(1, 1, At, B1); PG8_BAR;
            }
        }
        if constexpr (ALIGN_EPI) { if (wr == 0) PG8_BAR; }
        if constexpr (!Epi::AFTER_DRAIN) { E(acc, cur, wr, wc, fr, fq); S.done(cur); }
        if (!has_next) break;
#pragma unroll
        for (int a = 0; a < 2; ++a)
#pragma unroll
            for (int b = 0; b < 2; ++b)
#pragma unroll
                for (int m = 0; m < 4; ++m)
#pragma unroll
                    for (int n = 0; n < 2; ++n) acc[a][b][m][n] = (f32x4){0.f, 0.f, 0.f, 0.f};
        cur = nxt; cA = nA; cB = nB; ++ui;
        if constexpr (ALIGN_EPI) { if (wr == 1) PG8_BAR; }
    }
    PG8_WAIT_V(0);
    if constexpr (!ALIGN_EPI) { if (wr == 0) PG8_BAR; }
    PG8_BAR;
    if constexpr (Epi::AFTER_DRAIN) { E.fused(acc, cur, wr, wc, fr, fq, lds, wid, lane); S.done(cur); }
#undef PG8_SA
#undef PG8_SB
#undef PG8_STAGE
#undef PG8_LDA
#undef PG8_LDB
#undef PG8_MMA
#undef PG8_WAIT_V
#undef PG8_WAIT_L
#undef PG8_BAR
#undef PG8_SCHED
}
}

#ifndef PG8_SP2
#define PG8_SP2 true
#endif
#ifndef PG8_ALIGN
#define PG8_ALIGN true
#endif
#ifndef MK_N_LAUNCHES
#define MK_N_LAUNCHES 1
#endif
#ifndef SB_EARLY_EXIT
#define SB_EARLY_EXIT 1
#endif
#ifndef LATE_TRANSPOSES
#define LATE_TRANSPOSES 1
#endif
#ifndef P1_VROWS
#define P1_VROWS 0
#endif
#ifndef PROBE_DBL
#define PROBE_DBL -1
#endif
constexpr int NWAVES = 8;
constexpr int PER_PHASE = 9;
constexpr int N_LAUNCHES = MK_N_LAUNCHES;

constexpr int BATCH = 8, SEQ = 4096, D = 1024, M = BATCH * SEQ;
constexpr int MEML = 256, MMEM = BATCH * MEML;
constexpr int INW = 2304, KVW = 512, PQW = 2048;
constexpr int C_A = 0, C_G = 256, C_Q = 512, C_K = 1024, C_V = 1536, C_MQ = 2048;
constexpr int NEXP = 16384;
constexpr float EPS = 1e-6f;

constexpr size_t MiB = 1u << 20;
constexpr size_t WS_CTL = 0, CTL_ZERO_BYTES = 1 * MiB;
constexpr size_t WS_WIN = 2 * MiB, WS_WKV = 7 * MiB, WS_WOUT = 8 * MiB, WS_WPQ = 10 * MiB, WS_KEYS = 14 * MiB;
constexpr size_t WS_MEMN = 15 * MiB, WS_MKV = 19 * MiB;
constexpr size_t WS_SC = 22 * MiB;
constexpr size_t WS_UT = 24 * MiB, WS_VT = 56 * MiB;
constexpr size_t WS_XN = 88 * MiB;
constexpr size_t WS_CAT = 152 * MiB;
constexpr size_t WS_SELI = 216 * MiB, WS_SELG = 232 * MiB;
constexpr size_t WS_PROJ = 256 * MiB;
constexpr size_t WS_Q = 256 * MiB;
constexpr size_t WS_KF = 400 * MiB;
constexpr size_t WS_MKF = 432 * MiB;
constexpr size_t WS_END = 434 * MiB;
constexpr int CW_BAR = 4096;
constexpr int CW_SSQ2 = 65536;
static_assert((CW_SSQ2 + 2 * M) * 4 <= (int)CTL_ZERO_BYTES, "ctl");

constexpr int RING_OFF = 0, RING_BYTES = 131072;
constexpr int LDSCTL_OFF = RING_BYTES, MISC_OFF = LDSCTL_OFF + 320;
constexpr int EXTRA_OFF = RING_BYTES + 1024;
constexpr int LDS_BYTES = 147456;

#define GAS __attribute__((address_space(1)))
#define LAS __attribute__((address_space(3)))
typedef unsigned short bf16;
typedef unsigned v4u __attribute__((ext_vector_type(4)));
typedef unsigned v2u __attribute__((ext_vector_type(2)));
typedef float f32x4 __attribute__((ext_vector_type(4)));
typedef GAS unsigned gu32;
typedef __bf16 bf16x2_t __attribute__((ext_vector_type(2)));
#define RLX_AGENT __ATOMIC_RELAXED, __HIP_MEMORY_SCOPE_AGENT
#define LDS_WAIT() asm volatile("s_waitcnt lgkmcnt(0)" ::: "memory")
__device__ __forceinline__ unsigned f2bf(float f) { unsigned u = __builtin_bit_cast(unsigned, f); return (u + 0x7fffu + ((u >> 16) & 1u)) >> 16; }
__device__ __forceinline__ unsigned pk2(float lo, float hi) { return f2bf(lo) | (f2bf(hi) << 16); }
__device__ __forceinline__ float bflo(unsigned w) { return __uint_as_float(w << 16); }
__device__ __forceinline__ float bfhi(unsigned w) { return __uint_as_float(w & 0xffff0000u); }
__device__ __forceinline__ float dot2(unsigned a, unsigned b, float c) { return __builtin_amdgcn_fdot2_f32_bf16(__builtin_bit_cast(bf16x2_t, a), __builtin_bit_cast(bf16x2_t, b), c, false); }
__device__ __forceinline__ float wave_sum(float v) {
#define WS_DPP(x, ctrl, rmask, bc) __uint_as_float(__builtin_amdgcn_update_dpp(0u, __float_as_uint(x), ctrl, rmask, 0xF, bc))
    v += WS_DPP(v, 0xB1, 0xF, true);
    v += WS_DPP(v, 0x4E, 0xF, true);
    v += WS_DPP(v, 0x141, 0xF, true);
    v += WS_DPP(v, 0x140, 0xF, true);
    v += WS_DPP(v, 0x142, 0xA, false);
    v += WS_DPP(v, 0x143, 0xC, false);
#undef WS_DPP
    return __uint_as_float(__builtin_amdgcn_readlane(__float_as_uint(v), 63));
}
#define XB_TMO      128
#define XB_XCNT(j)  (256  + 64 * (j))
#define XB_XSUB(j)  (1280 + 64 * (j))
#define XB_XGEN(j)  (2304 + 64 * (j))
#define XB_TOP      3328
#define XB_TOPGEN   3392
#define XCD_BAR_WORDS 3456
#define XB_SPIN_CAP (1u << 18)

__device__ __forceinline__ unsigned xb_ld(unsigned* p)              { return __hip_atomic_load(p, __ATOMIC_RELAXED, __HIP_MEMORY_SCOPE_AGENT); }
__device__ __forceinline__ unsigned xb_add(unsigned* p, unsigned v) { return __hip_atomic_fetch_add(p, v, __ATOMIC_RELAXED, __HIP_MEMORY_SCOPE_AGENT); }
__device__ __forceinline__ unsigned xb_xcc_id() { return (unsigned)__builtin_amdgcn_s_getreg((3 << 11) | 20) & 0xFu; }
#define XB_SPIN(cond, bar) do { unsigned _sp = 0; while (cond) { __builtin_amdgcn_s_sleep(1); \
    if ((++_sp & 255u) == 0u) { if (xb_ld(&(bar)[XB_TMO])) break; if (_sp > XB_SPIN_CAP) { atomicAdd(&(bar)[XB_TMO], 1u); break; } } } } while (0)

struct XcdBarrier {
    unsigned* bar; unsigned x;
    volatile LAS unsigned* st;
};

__device__ __forceinline__ XcdBarrier xcd_barrier_post(unsigned* bar, volatile LAS unsigned* st) {
    XcdBarrier b; b.bar = bar; b.x = xb_xcc_id(); b.st = st;
    if (threadIdx.x == 0) (void)xb_add(&bar[XB_XCNT(b.x)], 1u);
    return b;
}
__device__ __forceinline__ void xcd_barrier_complete(unsigned* bar, unsigned x, unsigned& nloc, unsigned& nx) {
    const unsigned G = gridDim.x * gridDim.y * gridDim.z;
    unsigned sum, cnt, mine, sp = 0u;
    for (;;) {
        sum = 0u; cnt = 0u; mine = 0u;
#pragma unroll
        for (unsigned j = 0; j < 16; ++j) { const unsigned c = xb_ld(&bar[XB_XCNT(j)]); sum += c; cnt += (c > 0u) ? 1u : 0u; mine = (j == x) ? c : mine; }
        if (sum == G) break;
        __builtin_amdgcn_s_sleep(1);
        if ((++sp & 255u) == 0u) { if (xb_ld(&bar[XB_TMO])) break; if (sp > XB_SPIN_CAP) { atomicAdd(&bar[XB_TMO], 1u); break; } }
    }
    nloc = mine > 0u ? mine : 1u; nx = cnt > 0u ? cnt : 1u;
}

__device__ __forceinline__ void xcd_barrier(const XcdBarrier& b) {
    asm volatile("s_waitcnt vmcnt(0)" ::: "memory");
    __syncthreads();
    if (threadIdx.x == 0) {
        unsigned* bar = b.bar;
        __builtin_amdgcn_s_waitcnt(0);
        unsigned nloc = b.st[0], nx = b.st[1];
        if (nloc == 0u) { xcd_barrier_complete(bar, b.x, nloc, nx); b.st[0] = nloc; b.st[1] = nx; }
        const unsigned old = xb_add(&bar[XB_XSUB(b.x)], 1u);
        const unsigned gen = old / nloc;
        if (old + 1u == (gen + 1u) * nloc) {
            __builtin_amdgcn_fence(__ATOMIC_RELEASE, "agent");
            asm volatile("s_waitcnt vmcnt(0)" ::: "memory");
            const unsigned og = xb_add(&bar[XB_TOP], 1u);
            const unsigned tg = og / nx;
            if (og + 1u == (tg + 1u) * nx) xb_add(&bar[XB_TOPGEN], 1u);
            else XB_SPIN(xb_ld(&bar[XB_TOPGEN]) == tg, bar);
            __builtin_amdgcn_fence(__ATOMIC_ACQUIRE, "agent");
            xb_add(&bar[XB_XGEN(b.x)], 1u);
            asm volatile("s_waitcnt vmcnt(0)" ::: "memory");
        } else {
            XB_SPIN(xb_ld(&bar[XB_XGEN(b.x)]) == gen, bar);
            __builtin_amdgcn_fence(__ATOMIC_ACQUIRE, "agent");
            asm volatile("s_waitcnt vmcnt(0)" ::: "memory");
        }
    }
    __syncthreads();
}

struct Frame {
    LAS unsigned char* lds;
    volatile LAS unsigned* MISC;
    gu32* ctl;
    int tid, lane, wave;
    int vcu, G;
};
struct Ptrs {
    const float *x, *mem, *attn_g, *w_in, *conv_w, *conv_b, *conv_ln_g, *conv_ln_b, *sb_out_g, *mem_norm_g, *w_mem_kv, *q_norm_g, *k_norm_g, *mem_out_g,
                *w_out, *ffn_g, *w_peer_q, *keys1, *keys2, *peer_u, *peer_v;
    float* out;
    bf16 *WIN, *WKV, *WOUT, *WPQ, *KEYS, *MEMN, *MKV, *XN, *CAT, *PROJ, *Q;
    unsigned char *UT, *VT; float *USC, *VSC, *PART;
    unsigned short* SELH; float* SELG; unsigned long long* SSQ2; unsigned short* WB; bf16 *KF, *MKF; unsigned char* H2Q; float* HS;
};

__device__ __forceinline__ void p0_transpose_item(const float* W, const float* gk, int K, int N, bf16* WT, LAS float* scr, int item, int lane) {
    const int nblk = N / 32, kb = item / nblk, nb = item % nblk, k0 = 64 * kb, n0 = 32 * nb;
    float wv[32];
#pragma unroll
    for (int i = 0; i < 32; ++i) { const int kk = 2 * i + (lane >> 5); wv[i] = W[(size_t)(k0 + kk) * N + n0 + (lane & 31)]; }
    if (gk) {
        float gl[32];
#pragma unroll
        for (int i = 0; i < 32; ++i) gl[i] = gk[k0 + 2 * i + (lane >> 5)];
#pragma unroll
        for (int i = 0; i < 32; ++i) wv[i] *= gl[i];
    }
#pragma unroll
    for (int i = 0; i < 32; ++i) { const int kk = 2 * i + (lane >> 5); scr[kk * 33 + (lane & 31)] = wv[i]; }
    LDS_WAIT(); asm volatile("" ::: "memory");
    const int c = lane & 7;
#pragma unroll
    for (int j = 0; j < 4; ++j) { const int n = (lane >> 3) + 8 * j; const LAS float* s = scr + (8 * c) * 33 + n;
        v4u o; o.x = pk2(s[0 * 33], s[1 * 33]); o.y = pk2(s[2 * 33], s[3 * 33]); o.z = pk2(s[4 * 33], s[5 * 33]); o.w = pk2(s[6 * 33], s[7 * 33]);
        *(GAS v4u*)(WT + (size_t)(n0 + n) * K + k0 + 8 * c) = o; }
    LDS_WAIT(); asm volatile("" ::: "memory");
}
template <int NR> __device__ __forceinline__ void rms_rows_to_bf16(const float* xrow, const float* g, bf16* orow, int lane) {
    const GAS f32x4* gr = (const GAS f32x4*)g + lane;
    f32x4 v[NR][4]; float s[NR];
#pragma unroll
    for (int r = 0; r < NR; ++r) { const GAS f32x4* xr = (const GAS f32x4*)(xrow + (size_t)r * D) + lane;
#pragma unroll
        for (int j = 0; j < 4; ++j) v[r][j] = __builtin_nontemporal_load(xr + 64 * j); }
    f32x4 gg[4];
#pragma unroll
    for (int j = 0; j < 4; ++j) gg[j] = gr[64 * j];
#pragma unroll
    for (int r = 0; r < NR; ++r) { s[r] = 0.f;
#pragma unroll
        for (int j = 0; j < 4; ++j) s[r] += (v[r][j].x * v[r][j].x + v[r][j].y * v[r][j].y) + (v[r][j].z * v[r][j].z + v[r][j].w * v[r][j].w); }
#pragma unroll
    for (int o = 1; o < 64; o <<= 1)
#pragma unroll
        for (int r = 0; r < NR; ++r) s[r] += __shfl_xor(s[r], o);
#pragma unroll
    for (int r = 0; r < NR; ++r) { const float rinv = 1.f / sqrtf(s[r] * (1.f / 1024.f) + EPS);
        GAS unsigned long long* o8 = (GAS unsigned long long*)(orow + (size_t)r * D) + lane;
#pragma unroll
        for (int j = 0; j < 4; ++j) { const f32x4 o = v[r][j] * rinv * gg[j];
            o8[64 * j] = (unsigned long long)pk2(o.x, o.y) | ((unsigned long long)pk2(o.z, o.w) << 32); } }
}
__device__ __forceinline__ void cvt_f32_to_bf16_stream(const float* src, bf16* dst, size_t n8, size_t gtid, size_t nthr) {
    for (size_t i = gtid; i < n8; i += nthr) { const f32x4 a = ((const GAS f32x4*)src)[2 * i], b = ((const GAS f32x4*)src)[2 * i + 1];
        v4u o; o.x = pk2(a.x, a.y); o.y = pk2(a.z, a.w); o.z = pk2(b.x, b.y); o.w = pk2(b.z, b.w); ((GAS v4u*)dst)[i] = o; }
}
__device__ __forceinline__ unsigned pack_i8x4(int a, int b, int c, int d) { return (unsigned)(a & 255) | ((unsigned)(b & 255) << 8) | ((unsigned)(c & 255) << 16) | ((unsigned)(d & 255) << 24); }
template <int NR> __device__ __forceinline__ void rows_to_fp8(const float* src, unsigned char* dst, float* iscale, int e, int lane) {
    f32x4 v[NR][4]; float am[NR];
#pragma unroll
    for (int r = 0; r < NR; ++r) { const GAS f32x4* p = (const GAS f32x4*)(src + (size_t)(e + r) * D) + lane;
#pragma unroll
        for (int k = 0; k < 4; ++k) v[r][k] = __builtin_nontemporal_load(p + 64 * k); }
#pragma unroll
    for (int r = 0; r < NR; ++r) { am[r] = 0.f;
#pragma unroll
        for (int k = 0; k < 4; ++k) am[r] = fmaxf(fmaxf(am[r], fmaxf(fabsf(v[r][k].x), fabsf(v[r][k].y))), fmaxf(fabsf(v[r][k].z), fabsf(v[r][k].w))); }
#pragma unroll
    for (int o = 1; o < 64; o <<= 1)
#pragma unroll
        for (int r = 0; r < NR; ++r) am[r] = fmaxf(am[r], __shfl_xor(am[r], o));
#pragma unroll
    for (int r = 0; r < NR; ++r) { const float sc = am[r] > 0.f ? 256.f / am[r] : 1.f, isc = am[r] > 0.f ? am[r] * (1.f / 256.f) : 1.f;
#pragma unroll
        for (int k = 0; k < 4; ++k) { int w = 0; w = __builtin_amdgcn_cvt_pk_fp8_f32(v[r][k].x * sc, v[r][k].y * sc, w, false); w = __builtin_amdgcn_cvt_pk_fp8_f32(v[r][k].z * sc, v[r][k].w * sc, w, true);
            *(GAS unsigned*)(dst + ((size_t)(2 * k + (lane >> 5)) * NEXP + e + r) * 128 + 4 * (lane & 31)) = (unsigned)w; }
        if (lane == 0) iscale[e + r] = isc; }
}
template <int NR> __device__ __forceinline__ void rows_to_i8(const float* src, unsigned char* dst, float* iscale, int e, int lane) {
    f32x4 v[NR][4]; float am[NR];
#pragma unroll
    for (int r = 0; r < NR; ++r) { const GAS f32x4* p = (const GAS f32x4*)(src + (size_t)(e + r) * D) + lane;
#pragma unroll
        for (int k = 0; k < 4; ++k) v[r][k] = __builtin_nontemporal_load(p + 64 * k); }
#pragma unroll
    for (int r = 0; r < NR; ++r) { am[r] = 0.f;
#pragma unroll
        for (int k = 0; k < 4; ++k) am[r] = fmaxf(fmaxf(am[r], fmaxf(fabsf(v[r][k].x), fabsf(v[r][k].y))), fmaxf(fabsf(v[r][k].z), fabsf(v[r][k].w))); }
#pragma unroll
    for (int o = 1; o < 64; o <<= 1)
#pragma unroll
        for (int r = 0; r < NR; ++r) am[r] = fmaxf(am[r], __shfl_xor(am[r], o));
#pragma unroll
    for (int r = 0; r < NR; ++r) { const float sc = am[r] > 0.f ? 127.f / am[r] : 1.f, isc = am[r] > 0.f ? am[r] * (1.f / 127.f) : 1.f;
#pragma unroll
        for (int k = 0; k < 4; ++k) { const f32x4 q = v[r][k] * sc;
            const unsigned w = pack_i8x4((int)__builtin_rintf(q.x), (int)__builtin_rintf(q.y), (int)__builtin_rintf(q.z), (int)__builtin_rintf(q.w));
            *(GAS unsigned*)(dst + ((size_t)(2 * k + (lane >> 5)) * NEXP + e + r) * 128 + 4 * (lane & 31)) = w; }
        if (lane == 0) iscale[e + r] = isc; }
}
__device__ __forceinline__ void p0_prologue(Frame& F, const Ptrs& P) {
    LAS float* scr = (LAS float*)(F.lds + RING_OFF + F.wave * 16384);
    const int gw = F.vcu * NWAVES + F.wave, NGW = F.G * NWAVES;
    constexpr int I_IN = (D / 64) * (INW / 32), I_KV = (D / 64) * (KVW / 32), I_OUT = (D / 64) * (D / 32), I_PQ = (D / 64) * (PQW / 32);
    constexpr int NITEMS = I_IN + I_KV + I_OUT + I_PQ;
    for (int it = gw; it < (LATE_TRANSPOSES ? I_IN + I_KV : NITEMS); it += NGW) {
        int r = it;
        if (r < I_IN) { p0_transpose_item(P.w_in, nullptr, D, INW, P.WIN, scr, r, F.lane); continue; } r -= I_IN;
        if (r < I_KV) { p0_transpose_item(P.w_mem_kv, nullptr, D, KVW, P.WKV, scr, r, F.lane); continue; } r -= I_KV;
        if (r < I_OUT) { p0_transpose_item(P.w_out, nullptr, D, D, P.WOUT, scr, r, F.lane); continue; } r -= I_OUT;
        p0_transpose_item(P.w_peer_q, P.ffn_g, D, PQW, P.WPQ, scr, r, F.lane);
    }
    for (int m = gw * 4; m < M; m += NGW * 4) rms_rows_to_bf16<4>(P.x + (size_t)m * D, P.attn_g, P.XN + (size_t)m * D, F.lane);
    for (int m = gw; m < MMEM; m += NGW) rms_rows_to_bf16<1>(P.mem + (size_t)m * D, P.mem_norm_g, P.MEMN + (size_t)m * D, F.lane);
    const size_t gtid = (size_t)gw * 64 + F.lane, nthr = (size_t)NGW * 64;
    cvt_f32_to_bf16_stream(P.keys1, P.KEYS, 8 * 128 * 128 / 8, gtid, nthr);
    cvt_f32_to_bf16_stream(P.keys2, P.KEYS + 8 * 128 * 128, 8 * 128 * 128 / 8, gtid, nthr);
}
__device__ __forceinline__ void p0_late_transposes(Frame& F, const Ptrs& P, int gw, int NGW) {
    LAS float* scr = (LAS float*)(F.lds + RING_OFF + F.wave * 16384);
    constexpr int I_OUT = (D / 64) * (D / 32), I_PQ = (D / 64) * (PQW / 32);
    for (int it = gw; it < I_OUT + I_PQ; it += NGW) {
        if (it < I_OUT) p0_transpose_item(P.w_out, nullptr, D, D, P.WOUT, scr, it, F.lane);
        else p0_transpose_item(P.w_peer_q, P.ffn_g, D, PQW, P.WPQ, scr, it - I_OUT, F.lane);
    }
}

__device__ __forceinline__ void conv_phase(Frame& F, const Ptrs& P) {
    LAS float* U = (LAS float*)(F.lds + 0);
    LAS float* Y = (LAS float*)(F.lds + 0);
    const int tid = F.tid, c = tid & 255, half = tid >> 8;
    float w[31];
#pragma unroll
    for (int k = 0; k < 31; ++k) w[k] = P.conv_w[k * 256 + c];
    const float bias = P.conv_b[c];
    const f32x4 lg = ((const GAS f32x4*)P.conv_ln_g)[F.lane], lb = ((const GAS f32x4*)P.conv_ln_b)[F.lane];
    for (int it = F.vcu; it < BATCH * (SEQ / 64); it += F.G) {
        const int b = it / (SEQ / 64), t0 = (it % (SEQ / 64)) * 64;
        v4u av[6], gv[6];
#pragma unroll
        for (int j = 0; j < 6; ++j) { const int idx = tid + 512 * j; const int r = idx >> 5, c8 = idx & 31, t = t0 - 30 + r;
            av[j] = (v4u){0u, 0u, 0u, 0u}; gv[j] = (v4u){0u, 0u, 0u, 0u};
            if (idx < 94 * 32 && t >= 0) { const bf16* src = P.PROJ + (size_t)(b * SEQ + t) * INW + c8 * 8; av[j] = *(const GAS v4u*)(src + C_A); gv[j] = *(const GAS v4u*)(src + C_G); } }
        __syncthreads();
#pragma unroll
        for (int j = 0; j < 6; ++j) { const int idx = tid + 512 * j; const int r = idx >> 5, c8 = idx & 31;
            if (idx < 94 * 32) {
                const unsigned aw[4] = {av[j].x, av[j].y, av[j].z, av[j].w}, gw_[4] = {gv[j].x, gv[j].y, gv[j].z, gv[j].w};
                float u[8];
#pragma unroll
                for (int i = 0; i < 4; ++i) { const float a0 = bflo(aw[i]), a1 = bfhi(aw[i]), g0 = bflo(gw_[i]), g1 = bfhi(gw_[i]);
                    u[2 * i] = a0 * __builtin_amdgcn_rcpf(1.f + __expf(-g0)); u[2 * i + 1] = a1 * __builtin_amdgcn_rcpf(1.f + __expf(-g1)); }
                LAS f32x4* dst = (LAS f32x4*)(U + r * 256 + c8 * 8);
                dst[0] = (f32x4){u[0], u[1], u[2], u[3]}; dst[1] = (f32x4){u[4], u[5], u[6], u[7]}; } }
        __syncthreads();
        {
            float win[62];
#pragma unroll
            for (int i = 0; i < 62; ++i) win[i] = U[(half * 32 + i) * 256 + c];
            __syncthreads();
#pragma unroll
            for (int tt = 0; tt < 32; ++tt) { float y = bias;
#pragma unroll
                for (int k = 0; k < 31; ++k) y += w[k] * win[tt + k];
                Y[(half * 32 + tt) * 256 + c] = y; }
        }
        __syncthreads();
#pragma unroll
        for (int i = 0; i < 8; ++i) { const int tok = F.wave * 8 + i; const f32x4 y = *(const LAS f32x4*)(Y + tok * 256 + F.lane * 4);
            const float mu = wave_sum((y.x + y.y) + (y.z + y.w)) * (1.f / 256.f); const f32x4 d = y - mu;
            const float var = wave_sum((d.x * d.x + d.y * d.y) + (d.z * d.z + d.w * d.w)) * (1.f / 256.f);
            const float rinv = 1.f / sqrtf(var + EPS); const f32x4 yn = d * rinv * lg + lb;
            f32x4 s; s.x = yn.x * __builtin_amdgcn_rcpf(1.f + __expf(-yn.x)); s.y = yn.y * __builtin_amdgcn_rcpf(1.f + __expf(-yn.y)); s.z = yn.z * __builtin_amdgcn_rcpf(1.f + __expf(-yn.z)); s.w = yn.w * __builtin_amdgcn_rcpf(1.f + __expf(-yn.w));
            *(GAS unsigned long long*)(P.CAT + (size_t)(b * SEQ + t0 + tok) * D + F.lane * 4) = (unsigned long long)pk2(s.x, s.y) | ((unsigned long long)pk2(s.z, s.w) << 32); }
    }
}

typedef short bf16x8 __attribute__((ext_vector_type(8)));
typedef float f32x16 __attribute__((ext_vector_type(16)));
typedef short s16x4 __attribute__((ext_vector_type(4)));
constexpr int VSTR = 144;
constexpr int VL_BYTES = 32 * VSTR;
__device__ __forceinline__ unsigned cvtpk(float lo, float hi) { typedef float f2 __attribute__((ext_vector_type(2))); typedef __bf16 b2 __attribute__((ext_vector_type(2))); f2 v = {lo, hi}; b2 b = __builtin_convertvector(v, b2); return __builtin_bit_cast(unsigned, b); }
__device__ __forceinline__ s16x4 vtr(LAS unsigned char* p) { return __builtin_bit_cast(s16x4, __builtin_amdgcn_ds_read_tr16_b64_v4i16((LAS s16x4*)p)); }
__device__ __forceinline__ float swap_lo(float x, float& hi_out) { auto rr = __builtin_amdgcn_permlane32_swap(__float_as_uint(x), __float_as_uint(x), false, false); hi_out = __uint_as_float(rr[1]); return __uint_as_float(rr[0]); }
__device__ __forceinline__ void v_frags(LAS unsigned char* vl, int lane, bf16x8 (&vf)[2][2]) {
    const int il = lane & 15, q_ = il >> 2, p_ = il & 3, gg = lane >> 4, hi = lane >> 5;
    LAS unsigned char* base = vl + (4 * hi + q_) * VSTR + (16 * (gg & 1) + 4 * p_) * 2;
#pragma unroll
    for (int mt = 0; mt < 2; ++mt)
#pragma unroll
        for (int c = 0; c < 2; ++c) { const s16x4 lo = vtr(base + c * 16 * VSTR + mt * 64), hh = vtr(base + c * 16 * VSTR + 8 * VSTR + mt * 64);
            vf[mt][c] = (bf16x8){lo[0], lo[1], lo[2], lo[3], hh[0], hh[1], hh[2], hh[3]}; }
}
__device__ __forceinline__ void sb_weights(const f32x16& s, bool diag, int r32, int hi, float& R, bf16x8 (&pf)[2]) {
    typedef float f2 __attribute__((ext_vector_type(2)));
    f2 om2[2][4];
#pragma unroll
    for (int jj = 0; jj < 2; ++jj)
#pragma unroll
        for (int i = 0; i < 4; ++i) { const f2 z = (f2){s[4 * jj + i], s[4 * (jj + 2) + i]};
            f2 d; d.x = __builtin_amdgcn_exp2f(z.x); d.y = __builtin_amdgcn_exp2f(z.y); d = d + 1.0f;
            f2 o; o.x = __builtin_amdgcn_rcpf(d.x); o.y = __builtin_amdgcn_rcpf(d.y);
            if (diag) { const bool v0 = (i + 8 * jj + 4 * hi) < r32, v1 = (i + 8 * (jj + 2) + 4 * hi) < r32; o.x = v0 ? o.x : 1.f; o.y = v1 ? o.y : 1.f; }
            om2[jj][i] = o; }
    float G[4], Glo[4], Ghi[4];
#pragma unroll
    for (int jj = 0; jj < 2; ++jj) { const f2 g = (om2[jj][3] * om2[jj][2]) * (om2[jj][1] * om2[jj][0]); G[jj] = g.x; G[jj + 2] = g.y; }
#pragma unroll
    for (int j = 0; j < 4; ++j) Glo[j] = swap_lo(G[j], Ghi[j]);
    float run = R, st[4];
#pragma unroll
    for (int j = 3; j >= 0; --j) { const float s_hi = run, s_lo = run * Ghi[j]; st[j] = hi ? s_hi : s_lo; run = s_lo * Glo[j]; }
    R = run;
    float a[16];
#pragma unroll
    for (int jj = 0; jj < 2; ++jj) { f2 rb = {st[jj], st[jj + 2]};
#pragma unroll
        for (int i = 3; i >= 0; --i) { const f2 nx = rb * om2[jj][i]; const f2 d = rb - nx; a[4 * jj + i] = d.x; a[4 * (jj + 2) + i] = d.y; rb = nx; } }
#pragma unroll
    for (int c = 0; c < 2; ++c) pf[c] = __builtin_bit_cast(bf16x8, (v4u){cvtpk(a[8 * c], a[8 * c + 1]), cvtpk(a[8 * c + 2], a[8 * c + 3]), cvtpk(a[8 * c + 4], a[8 * c + 5]), cvtpk(a[8 * c + 6], a[8 * c + 7])});
}
__device__ __forceinline__ void sb_item_mfma(Frame& F, const Ptrs& P, int b, int G64) {
    const int lane = F.lane, h = F.wave, r32 = lane & 31, hi = lane >> 5;
    const int t0 = G64 * 64; const size_t rowbase = (size_t)b * SEQ;
    LAS unsigned char* vl = F.lds + F.wave * VL_BYTES;
    bf16x8 qA[4], qB[4];
    { const bf16* qp = P.PROJ + (rowbase + t0 + r32) * INW + C_Q + h * 64 + 8 * hi;
#pragma unroll
      for (int ks = 0; ks < 4; ++ks) { qA[ks] = *(const GAS bf16x8*)(qp + 16 * ks); qB[ks] = *(const GAS bf16x8*)(qp + (size_t)32 * INW + 16 * ks); } }
    f32x16 oA0, oA1, oB0, oB1;
#pragma unroll
    for (int r = 0; r < 16; ++r) { oA0[r] = 0.f; oA1[r] = 0.f; oB0[r] = 0.f; oB1[r] = 0.f; }
    float RA = 1.f, RB = 1.f;
    const bf16* kbase = P.KF + (rowbase >> 5) * 16384 + (size_t)h * 2048 + (hi * 32 + r32) * 8;
    const bf16* vbase = P.PROJ + (rowbase + (lane >> 3)) * INW + C_V + h * 64 + (lane & 7) * 8;
    bf16x8 kf[4]; v4u vp[4];
    const int top = t0 + 32;
#pragma unroll
    for (int ks = 0; ks < 4; ++ks) kf[ks] = *(const GAS bf16x8*)(kbase + (size_t)(top >> 5) * 16384 + 512 * ks);
#pragma unroll
    for (int k = 0; k < 4; ++k) vp[k] = *(const GAS v4u*)(vbase + (size_t)(top + 8 * k) * INW);
    {
        f32x16 sB;
#pragma unroll
        for (int r = 0; r < 16; ++r) sB[r] = 0.f;
#pragma unroll
        for (int ks = 0; ks < 4; ++ks) sB = __builtin_amdgcn_mfma_f32_32x32x16_bf16(kf[ks], qB[ks], sB, 0, 0, 0);
        asm volatile("" ::: "memory");
#pragma unroll
        for (int k = 0; k < 4; ++k) *(LAS v4u*)(vl + ((lane >> 3) + 8 * k) * VSTR + (lane & 7) * 16) = vp[k];
        asm volatile("" ::: "memory");
#pragma unroll
        for (int ks = 0; ks < 4; ++ks) kf[ks] = *(const GAS bf16x8*)(kbase + (size_t)(t0 >> 5) * 16384 + 512 * ks);
#pragma unroll
        for (int k = 0; k < 4; ++k) vp[k] = *(const GAS v4u*)(vbase + (size_t)(t0 + 8 * k) * INW);
        bf16x8 pB[2];
        sb_weights(sB, true, r32, hi, RB, pB);
        bf16x8 vf[2][2];
        v_frags(vl, lane, vf);
        oB0 = __builtin_amdgcn_mfma_f32_32x32x16_bf16(vf[0][0], pB[0], oB0, 0, 0, 0); oB1 = __builtin_amdgcn_mfma_f32_32x32x16_bf16(vf[1][0], pB[0], oB1, 0, 0, 0);
        oB0 = __builtin_amdgcn_mfma_f32_32x32x16_bf16(vf[0][1], pB[1], oB0, 0, 0, 0); oB1 = __builtin_amdgcn_mfma_f32_32x32x16_bf16(vf[1][1], pB[1], oB1, 0, 0, 0);
        asm volatile("" ::: "memory");
    }
    for (int s0 = t0; s0 >= 0; s0 -= 32) {
        const bool aliveA = !SB_EARLY_EXIT || __builtin_amdgcn_ballot_w64(RA > 0.0f) != 0ull, aliveB = !SB_EARLY_EXIT || __builtin_amdgcn_ballot_w64(RB > 0.0f) != 0ull;
        f32x16 sA, sB;
#pragma unroll
        for (int r = 0; r < 16; ++r) { sA[r] = 0.f; sB[r] = 0.f; }
        if (aliveB) {
#pragma unroll
        for (int ks = 0; ks < 4; ++ks) sB = __builtin_amdgcn_mfma_f32_32x32x16_bf16(kf[ks], qB[ks], sB, 0, 0, 0); }
        if (aliveA) {
#pragma unroll
        for (int ks = 0; ks < 4; ++ks) sA = __builtin_amdgcn_mfma_f32_32x32x16_bf16(kf[ks], qA[ks], sA, 0, 0, 0); }
        asm volatile("" ::: "memory");
#pragma unroll
        for (int k = 0; k < 4; ++k) *(LAS v4u*)(vl + ((lane >> 3) + 8 * k) * VSTR + (lane & 7) * 16) = vp[k];
        asm volatile("" ::: "memory");
        { const int sn = s0 >= 32 ? s0 - 32 : 0;
#pragma unroll
          for (int ks = 0; ks < 4; ++ks) kf[ks] = *(const GAS bf16x8*)(kbase + (size_t)(sn >> 5) * 16384 + 512 * ks);
#pragma unroll
          for (int k = 0; k < 4; ++k) vp[k] = *(const GAS v4u*)(vbase + (size_t)(sn + 8 * k) * INW); }
        bf16x8 pB[2], pA[2];
        bf16x8 vf[2][2];
        if (aliveB) {
        sb_weights(sB, false, r32, hi, RB, pB);
        v_frags(vl, lane, vf);
        oB0 = __builtin_amdgcn_mfma_f32_32x32x16_bf16(vf[0][0], pB[0], oB0, 0, 0, 0); oB1 = __builtin_amdgcn_mfma_f32_32x32x16_bf16(vf[1][0], pB[0], oB1, 0, 0, 0);
        oB0 = __builtin_amdgcn_mfma_f32_32x32x16_bf16(vf[0][1], pB[1], oB0, 0, 0, 0); oB1 = __builtin_amdgcn_mfma_f32_32x32x16_bf16(vf[1][1], pB[1], oB1, 0, 0, 0);
        } else v_frags(vl, lane, vf);
        if (aliveA) {
        sb_weights(sA, s0 == t0, r32, hi, RA, pA);
        oA0 = __builtin_amdgcn_mfma_f32_32x32x16_bf16(vf[0][0], pA[0], oA0, 0, 0, 0); oA1 = __builtin_amdgcn_mfma_f32_32x32x16_bf16(vf[1][0], pA[0], oA1, 0, 0, 0);
        oA0 = __builtin_amdgcn_mfma_f32_32x32x16_bf16(vf[0][1], pA[1], oA0, 0, 0, 0); oA1 = __builtin_amdgcn_mfma_f32_32x32x16_bf16(vf[1][1], pA[1], oA1, 0, 0, 0);
        }
        asm volatile("" ::: "memory");
        if (SB_EARLY_EXIT && __builtin_amdgcn_ballot_w64(fmaxf(RA, RB) > 0.0f) == 0ull) break;
    }
    float ssA = 0.f, ssB = 0.f;
#pragma unroll
    for (int r = 0; r < 16; ++r) { ssA += oA0[r] * oA0[r] + oA1[r] * oA1[r]; ssB += oB0[r] * oB0[r] + oB1[r] * oB1[r]; }
    { float sh; const float sl = swap_lo(ssA, sh); ssA = sl + sh; }
    { float sh; const float sl = swap_lo(ssB, sh); ssB = sl + sh; }
    LAS float* xs = (LAS float*)(F.lds + EXTRA_OFF);
    if (hi == 0) { xs[h * 64 + r32] = ssA; xs[h * 64 + 32 + r32] = ssB; }
    f32x4 gvv[2][4];
    { const float* gp0 = P.sb_out_g + h * 64 + 4 * hi;
#pragma unroll
      for (int mt = 0; mt < 2; ++mt)
#pragma unroll
          for (int j = 0; j < 4; ++j) gvv[mt][j] = *(const GAS f32x4*)(gp0 + 32 * mt + 8 * j); }
    __syncthreads();
    float totA = 0.f, totB = 0.f;
#pragma unroll
    for (int w = 0; w < 8; ++w) { totA += xs[w * 64 + r32]; totB += xs[w * 64 + 32 + r32]; }
    const float rinvA = 1.f / sqrtf(totA * (1.f / 512.f) + EPS), rinvB = 1.f / sqrtf(totB * (1.f / 512.f) + EPS);
    bf16* dstA = P.CAT + (rowbase + t0 + r32) * D + 256 + h * 64 + 4 * hi; bf16* dstB = dstA + (size_t)32 * D;
#pragma unroll
    for (int mt = 0; mt < 2; ++mt)
#pragma unroll
        for (int j = 0; j < 4; ++j) { const f32x4 gv = gvv[mt][j];
            { const float a0 = (mt ? oA1[4 * j] : oA0[4 * j]) * rinvA * gv.x, a1 = (mt ? oA1[4 * j + 1] : oA0[4 * j + 1]) * rinvA * gv.y, a2 = (mt ? oA1[4 * j + 2] : oA0[4 * j + 2]) * rinvA * gv.z, a3 = (mt ? oA1[4 * j + 3] : oA0[4 * j + 3]) * rinvA * gv.w;
              *(GAS v2u*)(dstA + 32 * mt + 8 * j) = (v2u){cvtpk(a0, a1), cvtpk(a2, a3)}; }
            { const float a0 = (mt ? oB1[4 * j] : oB0[4 * j]) * rinvB * gv.x, a1 = (mt ? oB1[4 * j + 1] : oB0[4 * j + 1]) * rinvB * gv.y, a2 = (mt ? oB1[4 * j + 2] : oB0[4 * j + 2]) * rinvB * gv.z, a3 = (mt ? oB1[4 * j + 3] : oB0[4 * j + 3]) * rinvB * gv.w;
              *(GAS v2u*)(dstB + 32 * mt + 8 * j) = (v2u){cvtpk(a0, a1), cvtpk(a2, a3)}; } }
    __syncthreads();
}
__device__ __forceinline__ void mem_q_frags(const Ptrs& P, const bf16* qp, int hi, bf16x8 (&qf)[4], float& qsc) {
    float ssq = 0.f;
#pragma unroll
    for (int ks = 0; ks < 4; ++ks) { const v4u v = *(const GAS v4u*)(qp + 16 * ks); const unsigned w[4] = {v.x, v.y, v.z, v.w}; unsigned ow[4];
#pragma unroll
        for (int i = 0; i < 4; ++i) { const float a = bflo(w[i]), c = bfhi(w[i]); ssq += a * a + c * c; const int d = 16 * ks + 8 * hi + 2 * i;
            ow[i] = cvtpk(a * (P.q_norm_g[d] * P.k_norm_g[d]), c * (P.q_norm_g[d + 1] * P.k_norm_g[d + 1])); }
        qf[ks] = __builtin_bit_cast(bf16x8, (v4u){ow[0], ow[1], ow[2], ow[3]}); }
    float sh; const float sl = swap_lo(ssq, sh); qsc = 0.125f / sqrtf((sl + sh) * (1.f / 64.f) + EPS);
}
template <bool FIXED> __device__ __forceinline__ void mem_softmax_tile(const f32x16& s, const LAS float* rk, int hi, float qsc, float mfix, float& mx, float& lsum, f32x16& o0, f32x16& o1, bf16x8 (&pf)[2]) {
    float p[16];
    if (FIXED) {
#pragma unroll
        for (int j = 0; j < 4; ++j) { const f32x4 rv = *(const LAS f32x4*)(rk + 8 * j + 4 * hi);
            const float ql = qsc * 1.4426950408889634f, ml = mfix * 1.4426950408889634f;
            p[4 * j] = __builtin_amdgcn_exp2f(__builtin_fmaf(s[4 * j] * rv.x, ql, -ml)); p[4 * j + 1] = __builtin_amdgcn_exp2f(__builtin_fmaf(s[4 * j + 1] * rv.y, ql, -ml));
            p[4 * j + 2] = __builtin_amdgcn_exp2f(__builtin_fmaf(s[4 * j + 2] * rv.z, ql, -ml)); p[4 * j + 3] = __builtin_amdgcn_exp2f(__builtin_fmaf(s[4 * j + 3] * rv.w, ql, -ml)); }
    } else {
        float bm = -1.0e30f;
#pragma unroll
        for (int j = 0; j < 4; ++j) { const f32x4 rv = *(const LAS f32x4*)(rk + 8 * j + 4 * hi);
            p[4 * j] = s[4 * j] * qsc * rv.x; p[4 * j + 1] = s[4 * j + 1] * qsc * rv.y; p[4 * j + 2] = s[4 * j + 2] * qsc * rv.z; p[4 * j + 3] = s[4 * j + 3] * qsc * rv.w;
            bm = fmaxf(fmaxf(bm, fmaxf(p[4 * j], p[4 * j + 1])), fmaxf(p[4 * j + 2], p[4 * j + 3])); }
        { float bh; const float bl = swap_lo(bm, bh); bm = fmaxf(bl, bh); }
        const float mn = fmaxf(mx, bm), sc = __expf(mx - mn); mx = mn; lsum *= sc;
#pragma unroll
        for (int r = 0; r < 16; ++r) { o0[r] *= sc; o1[r] *= sc; p[r] = __expf(p[r] - mn); }
    }
    lsum += ((p[0] + p[1]) + (p[2] + p[3])) + ((p[4] + p[5]) + (p[6] + p[7])) + (((p[8] + p[9]) + (p[10] + p[11])) + ((p[12] + p[13]) + (p[14] + p[15])));
#pragma unroll
    for (int c = 0; c < 2; ++c) pf[c] = __builtin_bit_cast(bf16x8, (v4u){cvtpk(p[8 * c], p[8 * c + 1]), cvtpk(p[8 * c + 2], p[8 * c + 3]), cvtpk(p[8 * c + 4], p[8 * c + 5]), cvtpk(p[8 * c + 6], p[8 * c + 7])});
}
template <bool FIXED> __device__ __forceinline__ void mem_item_body(Frame& F, const Ptrs& P, int b, int qb, float mfix) {
    const int lane = F.lane, h = F.wave & 3, half = F.wave >> 2, r32 = lane & 31, hi = lane >> 5;
    const size_t rowA = (size_t)b * SEQ + qb * 128 + half * 64 + r32, rowB = rowA + 32;
    LAS unsigned char* vl = F.lds + F.wave * VL_BYTES;
    LAS float* rk = (LAS float*)(F.lds + 8 * VL_BYTES + F.wave * 128);
    bf16x8 qA[4], qB[4]; float qscA, qscB;
    mem_q_frags(P, P.PROJ + rowA * INW + C_MQ + h * 64 + 8 * hi, hi, qA, qscA);
    mem_q_frags(P, P.PROJ + rowB * INW + C_MQ + h * 64 + 8 * hi, hi, qB, qscB);
    f32x16 oA0, oA1, oB0, oB1;
#pragma unroll
    for (int r = 0; r < 16; ++r) { oA0[r] = 0.f; oA1[r] = 0.f; oB0[r] = 0.f; oB1[r] = 0.f; }
    float mxA = -1.0e30f, lsA = 0.f, mxB = -1.0e30f, lsB = 0.f;
    const bf16* kbase = P.MKF + ((size_t)b * (MEML / 32)) * 8192 + (size_t)h * 2048 + (hi * 32 + r32) * 8;
    const bf16* vbase = P.MKV + ((size_t)b * MEML + (lane >> 3)) * KVW + 256 + h * 64 + (lane & 7) * 8;
    v4u kr[4], vp[4];
#pragma unroll
    for (int ks = 0; ks < 4; ++ks) kr[ks] = *(const GAS v4u*)(kbase + 512 * ks);
#pragma unroll
    for (int k = 0; k < 4; ++k) vp[k] = *(const GAS v4u*)(vbase + (size_t)(8 * k) * KVW);
    for (int s0 = 0; s0 < MEML; s0 += 32) {
        bf16x8 kf[4]; float kss; { float k0 = 0.f, k1 = 0.f, k2 = 0.f, k3 = 0.f;
#pragma unroll
        for (int ks = 0; ks < 4; ++ks) { const v4u v = kr[ks]; kf[ks] = __builtin_bit_cast(bf16x8, v);
            k0 = dot2(v.x, v.x, k0); k1 = dot2(v.y, v.y, k1); k2 = dot2(v.z, v.z, k2); k3 = dot2(v.w, v.w, k3); }
          kss = (k0 + k1) + (k2 + k3); }
        { float sh; const float sl = swap_lo(kss, sh); kss = 1.f / sqrtf((sl + sh) * (1.f / 64.f) + EPS); }
        asm volatile("" ::: "memory");
        if (hi == 0) rk[r32] = kss;
#pragma unroll
        for (int k = 0; k < 4; ++k) *(LAS v4u*)(vl + ((lane >> 3) + 8 * k) * VSTR + (lane & 7) * 16) = vp[k];
        asm volatile("" ::: "memory");
        bf16x8 vf[2][2];
        {
            f32x16 sA;
#pragma unroll
            for (int r = 0; r < 16; ++r) sA[r] = 0.f;
#pragma unroll
            for (int ks = 0; ks < 4; ++ks) sA = __builtin_amdgcn_mfma_f32_32x32x16_bf16(kf[ks], qA[ks], sA, 0, 0, 0);
            bf16x8 pA[2];
            mem_softmax_tile<FIXED>(sA, rk, hi, qscA, mfix, mxA, lsA, oA0, oA1, pA);
            v_frags(vl, lane, vf);
            oA0 = __builtin_amdgcn_mfma_f32_32x32x16_bf16(vf[0][0], pA[0], oA0, 0, 0, 0); oA1 = __builtin_amdgcn_mfma_f32_32x32x16_bf16(vf[1][0], pA[0], oA1, 0, 0, 0);
            oA0 = __builtin_amdgcn_mfma_f32_32x32x16_bf16(vf[0][1], pA[1], oA0, 0, 0, 0); oA1 = __builtin_amdgcn_mfma_f32_32x32x16_bf16(vf[1][1], pA[1], oA1, 0, 0, 0);
        }
        asm volatile("" ::: "memory"); __builtin_amdgcn_sched_barrier(0);
        {
            f32x16 sB;
#pragma unroll
            for (int r = 0; r < 16; ++r) sB[r] = 0.f;
#pragma unroll
            for (int ks = 0; ks < 4; ++ks) sB = __builtin_amdgcn_mfma_f32_32x32x16_bf16(kf[ks], qB[ks], sB, 0, 0, 0);
            if (s0 + 32 < MEML) {
#pragma unroll
                for (int ks = 0; ks < 4; ++ks) kr[ks] = *(const GAS v4u*)(kbase + (size_t)((s0 + 32) >> 5) * 8192 + 512 * ks);
#pragma unroll
                for (int k = 0; k < 4; ++k) vp[k] = *(const GAS v4u*)(vbase + (size_t)(s0 + 32 + 8 * k) * KVW);
            }
            bf16x8 pB[2];
            mem_softmax_tile<FIXED>(sB, rk, hi, qscB, mfix, mxB, lsB, oB0, oB1, pB);
            oB0 = __builtin_amdgcn_mfma_f32_32x32x16_bf16(vf[0][0], pB[0], oB0, 0, 0, 0); oB1 = __builtin_amdgcn_mfma_f32_32x32x16_bf16(vf[1][0], pB[0], oB1, 0, 0, 0);
            oB0 = __builtin_amdgcn_mfma_f32_32x32x16_bf16(vf[0][1], pB[1], oB0, 0, 0, 0); oB1 = __builtin_amdgcn_mfma_f32_32x32x16_bf16(vf[1][1], pB[1], oB1, 0, 0, 0);
        }
        asm volatile("" ::: "memory"); __builtin_amdgcn_sched_barrier(0);
    }
    { float lh; const float ll = swap_lo(lsA, lh); lsA = 1.f / (ll + lh); }
    { float lh; const float ll = swap_lo(lsB, lh); lsB = 1.f / (ll + lh); }
    float ssA = 0.f, ssB = 0.f;
#pragma unroll
    for (int r = 0; r < 16; ++r) { oA0[r] *= lsA; oA1[r] *= lsA; oB0[r] *= lsB; oB1[r] *= lsB; ssA += oA0[r] * oA0[r] + oA1[r] * oA1[r]; ssB += oB0[r] * oB0[r] + oB1[r] * oB1[r]; }
    { float sh; const float sl = swap_lo(ssA, sh); ssA = sl + sh; }
    { float sh; const float sl = swap_lo(ssB, sh); ssB = sl + sh; }
    LAS float* xs = (LAS float*)(F.lds + EXTRA_OFF);
    if (hi == 0) { xs[((half * 2 + 0) * 4 + h) * 32 + r32] = ssA; xs[((half * 2 + 1) * 4 + h) * 32 + r32] = ssB; }
    f32x4 gvv[2][4];
    { const float* gp0 = P.mem_out_g + h * 64 + 4 * hi;
#pragma unroll
      for (int mt = 0; mt < 2; ++mt)
#pragma unroll
          for (int j = 0; j < 4; ++j) gvv[mt][j] = *(const GAS f32x4*)(gp0 + 32 * mt + 8 * j); }
    __syncthreads();
    float totA = 0.f, totB = 0.f;
#pragma unroll
    for (int w = 0; w < 4; ++w) { totA += xs[((half * 2 + 0) * 4 + w) * 32 + r32]; totB += xs[((half * 2 + 1) * 4 + w) * 32 + r32]; }
    const float rinvA = 1.f / sqrtf(totA * (1.f / 256.f) + EPS), rinvB = 1.f / sqrtf(totB * (1.f / 256.f) + EPS);
    bf16* dstA = P.CAT + rowA * D + 768 + h * 64 + 4 * hi; bf16* dstB = dstA + (size_t)32 * D;
#pragma unroll
    for (int mt = 0; mt < 2; ++mt)
#pragma unroll
        for (int j = 0; j < 4; ++j) { const f32x4 gv = gvv[mt][j];
            { const float a0 = (mt ? oA1[4 * j] : oA0[4 * j]) * rinvA * gv.x, a1 = (mt ? oA1[4 * j + 1] : oA0[4 * j + 1]) * rinvA * gv.y, a2 = (mt ? oA1[4 * j + 2] : oA0[4 * j + 2]) * rinvA * gv.z, a3 = (mt ? oA1[4 * j + 3] : oA0[4 * j + 3]) * rinvA * gv.w;
              *(GAS v2u*)(dstA + 32 * mt + 8 * j) = (v2u){cvtpk(a0, a1), cvtpk(a2, a3)}; }
            { const float a0 = (mt ? oB1[4 * j] : oB0[4 * j]) * rinvB * gv.x, a1 = (mt ? oB1[4 * j + 1] : oB0[4 * j + 1]) * rinvB * gv.y, a2 = (mt ? oB1[4 * j + 2] : oB0[4 * j + 2]) * rinvB * gv.z, a3 = (mt ? oB1[4 * j + 3] : oB0[4 * j + 3]) * rinvB * gv.w;
              *(GAS v2u*)(dstB + 32 * mt + 8 * j) = (v2u){cvtpk(a0, a1), cvtpk(a2, a3)}; } }
    __syncthreads();
}

__device__ __forceinline__ void mem_item_mfma(Frame& F, const Ptrs& P, int b, int qb) {
    float mfix = fabsf(P.q_norm_g[F.lane] * P.k_norm_g[F.lane]);
#pragma unroll
    for (int o = 1; o < 64; o <<= 1) mfix = fmaxf(mfix, __shfl_xor(mfix, o));
    mfix = 8.0f * mfix * 1.001f;
    if (__builtin_amdgcn_readfirstlane(__float_as_uint(mfix)) <= __float_as_uint(32.0f)) { Frame Fa = F; asm volatile("" : "+v"(Fa.tid), "+v"(Fa.lane)); mem_item_body<true>(Fa, P, b, qb, mfix); }
    else { Frame Fb = F; asm volatile("" : "+v"(Fb.tid), "+v"(Fb.lane)); mem_item_body<false>(Fb, P, b, qb, mfix); }
}

#define CE(a, b) { const float hi_ = fmaxf(a, b), lo_ = fminf(a, b); a = hi_; b = lo_; }
#define SORT16(V) do { CE(V[0], V[1]); CE(V[2], V[3]); CE(V[0], V[2]); CE(V[1], V[3]); CE(V[1], V[2]); CE(V[4], V[5]); CE(V[6], V[7]); CE(V[4], V[6]); CE(V[5], V[7]); CE(V[5], V[6]); CE(V[0], V[4]); CE(V[2], V[6]); CE(V[2], V[4]); CE(V[1], V[5]); CE(V[3], V[7]); CE(V[3], V[5]); CE(V[1], V[2]); CE(V[3], V[4]); CE(V[5], V[6]); CE(V[8], V[9]); CE(V[10], V[11]); CE(V[8], V[10]); CE(V[9], V[11]); CE(V[9], V[10]); CE(V[12], V[13]); CE(V[14], V[15]); CE(V[12], V[14]); CE(V[13], V[15]); CE(V[13], V[14]); CE(V[8], V[12]); CE(V[10], V[14]); CE(V[10], V[12]); CE(V[9], V[13]); CE(V[11], V[15]); CE(V[11], V[13]); CE(V[9], V[10]); CE(V[11], V[12]); CE(V[13], V[14]); CE(V[0], V[8]); CE(V[4], V[12]); CE(V[4], V[8]); CE(V[2], V[10]); CE(V[6], V[14]); CE(V[6], V[10]); CE(V[2], V[4]); CE(V[6], V[8]); CE(V[10], V[12]); CE(V[1], V[9]); CE(V[5], V[13]); CE(V[5], V[9]); CE(V[3], V[11]); CE(V[7], V[15]); CE(V[7], V[11]); CE(V[3], V[5]); CE(V[7], V[9]); CE(V[11], V[13]); CE(V[1], V[2]); CE(V[3], V[4]); CE(V[5], V[6]); CE(V[7], V[8]); CE(V[9], V[10]); CE(V[11], V[12]); CE(V[13], V[14]); } while (0)
#define BITONIC16(V) do { CE(V[0], V[8]); CE(V[1], V[9]); CE(V[2], V[10]); CE(V[3], V[11]); CE(V[4], V[12]); CE(V[5], V[13]); CE(V[6], V[14]); CE(V[7], V[15]); CE(V[0], V[4]); CE(V[1], V[5]); CE(V[2], V[6]); CE(V[3], V[7]); CE(V[8], V[12]); CE(V[9], V[13]); CE(V[10], V[14]); CE(V[11], V[15]); CE(V[0], V[2]); CE(V[1], V[3]); CE(V[4], V[6]); CE(V[5], V[7]); CE(V[8], V[10]); CE(V[9], V[11]); CE(V[12], V[14]); CE(V[13], V[15]); CE(V[0], V[1]); CE(V[2], V[3]); CE(V[4], V[5]); CE(V[6], V[7]); CE(V[8], V[9]); CE(V[10], V[11]); CE(V[12], V[13]); CE(V[14], V[15]); } while (0)
#define MERGE16(A, B) do { _Pragma("unroll") for (int i_ = 0; i_ < 16; ++i_) A[i_] = fmaxf(A[i_], B[15 - i_]); BITONIC16(A); } while (0)
constexpr int KSTR = 272;
constexpr int P5_KEYS2 = 128 * KSTR, P5_TAB = 2 * 128 * KSTR;
__device__ __forceinline__ void peer_top16(const LAS unsigned char* keysL, const bf16* qptr, int r32, int hi, float (&T)[16]) {
    bf16x8 qf[8];
#pragma unroll
    for (int ks = 0; ks < 8; ++ks) qf[ks] = *(const GAS bf16x8*)(qptr + 512 * ks);
    f32x16 acc[4];
#pragma unroll
    for (int mt = 0; mt < 4; ++mt)
#pragma unroll
        for (int r = 0; r < 16; ++r) acc[mt][r] = 0.f;
#pragma unroll
    for (int ks = 0; ks < 8; ++ks)
#pragma unroll
        for (int mt = 0; mt < 4; ++mt) { const bf16x8 a = *(const LAS bf16x8*)(keysL + (32 * mt + r32) * KSTR + (16 * ks + 8 * hi) * 2); acc[mt] = __builtin_amdgcn_mfma_f32_32x32x16_bf16(a, qf[ks], acc[mt], 0, 0, 0); }
    float v[4][16]; const unsigned hi4 = (unsigned)hi << 2;
#pragma unroll
    for (int mt = 0; mt < 4; ++mt)
#pragma unroll
        for (int r = 0; r < 16; ++r) v[mt][r] = __uint_as_float((__float_as_uint(acc[mt][r]) & 0xFFFFFF80u) | ((unsigned)(32 * mt + (r & 3) + 8 * (r >> 2)) | hi4));
    SORT16(v[0]); SORT16(v[1]); SORT16(v[2]); SORT16(v[3]);
    MERGE16(v[0], v[1]); MERGE16(v[2], v[3]); MERGE16(v[0], v[2]);
    float plo[16], phi[16];
#pragma unroll
    for (int i = 0; i < 16; ++i) plo[i] = swap_lo(v[0][i], phi[i]);
#pragma unroll
    for (int i = 0; i < 16; ++i) T[i] = fmaxf(plo[i], phi[15 - i]);
    BITONIC16(T);
}
__device__ __forceinline__ float pack8(float s, unsigned code) { return __uint_as_float((__float_as_uint(s) & 0xFFFFFF00u) | code); }
__device__ __forceinline__ void peer_select_mfma(Frame& F, const Ptrs& P, int tb, int h, bool load_keys) {
    LAS unsigned char* lds = F.lds; const int tid = F.tid, lane = F.lane, r32 = lane & 31, hi = lane >> 5;
    if (load_keys) {
        __syncthreads();
#pragma unroll
        for (int i = 0; i < 8; ++i) { const int c = tid + 512 * i; const int which = c >> 11, rem = c & 2047, n = rem >> 4, ch = rem & 15;
            *(LAS v4u*)(lds + which * P5_KEYS2 + n * KSTR + ch * 16) = *(const GAS v4u*)(P.KEYS + (size_t)which * 131072 + (size_t)h * 16384 + n * 128 + ch * 8); }
        __syncthreads();
    }
    const int tok = tb * 256 + F.wave * 32 + r32;
    const bf16* qrow = P.Q + ((size_t)tb * 8 + h) * 65536 + (size_t)F.wave * 4096 + (hi * 32 + r32) * 8;
    float T1[16], T2[16];
    peer_top16(lds, qrow, r32, hi, T1);
    peer_top16(lds + P5_KEYS2, qrow + 32768, r32, hi, T2);
    LAS unsigned char* tabA = lds + P5_TAB + F.wave * 2048 + lane; LAS unsigned char* tabB = tabA + 1024;
#pragma unroll
    for (int i = 0; i < 16; ++i) { tabA[i * 64] = (unsigned char)(__float_as_uint(T1[i]) & 127u); tabB[i * 64] = (unsigned char)(__float_as_uint(T2[i]) & 127u); }
    float C0[16], X0[16], X1[16];
#pragma unroll
    for (int j = 0; j < 16; ++j) C0[j] = pack8(T1[0] + T2[j], (unsigned)j);
    {
        int n = 0;
#pragma unroll
        for (int i = 1; i < 14; ++i)
#pragma unroll
            for (int j = 0; j < 16; ++j) if ((i + 1) * (j + 1) <= 16) { const float c = pack8(T1[i] + T2[j], (unsigned)(i * 16 + j)); if (n < 16) X0[n] = c; else X1[n - 16] = c; ++n; }
    }
    SORT16(X0); SORT16(X1);
    MERGE16(X0, X1);
#pragma unroll
    for (int i_ = 0; i_ < 16; ++i_) C0[i_] = fmaxf(C0[i_], X0[15 - i_]);
    CE(C0[0], C0[8]); CE(C0[1], C0[9]); CE(C0[2], C0[10]); CE(C0[3], C0[11]); CE(C0[4], C0[12]); CE(C0[5], C0[13]); CE(C0[6], C0[14]); CE(C0[7], C0[15]);
    CE(C0[8], C0[12]); CE(C0[9], C0[13]); CE(C0[10], C0[14]); CE(C0[11], C0[15]);
    CE(C0[12], C0[14]); CE(C0[13], C0[15]); CE(C0[14], C0[15]);
    { const float cv = pack8(T1[14] + T2[0], 224u); const float l14 = fminf(C0[14], cv); C0[14] = fmaxf(C0[14], cv); C0[15] = fmaxf(C0[15], l14); }
    { const float cv = pack8(T1[15] + T2[0], 240u); C0[15] = fmaxf(C0[15], cv); }
    float e[16], sum = 0.f;
#pragma unroll
    for (int p = 0; p < 16; ++p) { e[p] = __expf(C0[p] - C0[0]); sum += e[p]; }
    const float inv = 1.f / sum;
    if (hi == 0) {
        unsigned id[16];
#pragma unroll
        for (int p = 0; p < 16; ++p) { const unsigned code = __float_as_uint(C0[p]) & 255u; id[p] = (unsigned)tabA[(code >> 4) * 64] * 128u + (unsigned)tabB[(code & 15u) * 64]; }
        GAS v4u* di = (GAS v4u*)(P.SELH + ((size_t)tok * 8 + h) * 16);
#pragma unroll
        for (int j = 0; j < 2; ++j) di[j] = (v4u){id[8 * j] | (id[8 * j + 1] << 16), id[8 * j + 2] | (id[8 * j + 3] << 16), id[8 * j + 4] | (id[8 * j + 5] << 16), id[8 * j + 6] | (id[8 * j + 7] << 16)};
    } else {
        GAS f32x4* dg = (GAS f32x4*)(P.SELG + ((size_t)tok * 8 + h) * 16);
#pragma unroll
        for (int j = 0; j < 4; ++j) dg[j] = (f32x4){e[4 * j] * inv, e[4 * j + 1] * inv, e[4 * j + 2] * inv, e[4 * j + 3] * inv};
    }
}

typedef float f32x2 __attribute__((ext_vector_type(2)));
__device__ __forceinline__ float dpp_xor1(float x) { return __uint_as_float(__builtin_amdgcn_update_dpp(0u, __float_as_uint(x), 0xB1, 0xF, 0xF, true)); }
__device__ __forceinline__ float dpp_xor2(float x) { return __uint_as_float(__builtin_amdgcn_update_dpp(0u, __float_as_uint(x), 0x4E, 0xF, 0xF, true)); }
__device__ __forceinline__ float dpp_hmir(float x) { return __uint_as_float(__builtin_amdgcn_update_dpp(0u, __float_as_uint(x), 0x141, 0xF, 0xF, true)); }
__device__ __forceinline__ void asm_store_b64_nt(float* p, f32x2 v) { asm volatile("global_store_dwordx2 %0, %1, off nt" :: "v"(p), "v"(v) : "memory"); }
__device__ __forceinline__ void asm_store_b32_nt(unsigned* p, unsigned v) { asm volatile("global_store_dword %0, %1, off nt" :: "v"(p), "v"(v) : "memory"); }
__device__ __forceinline__ void asm_store_b32(unsigned* p, unsigned v) { asm volatile("global_store_dword %0, %1, off" :: "v"(p), "v"(v) : "memory"); }
__device__ __forceinline__ void asm_store_b64(float* p, f32x2 v) { asm volatile("global_store_dwordx2 %0, %1, off" :: "v"(p), "v"(v) : "memory"); }
__device__ __forceinline__ float fp8_dot16(const v4u r, const f32x2 (&hh)[8]) {
    const unsigned w[4] = {r.x, r.y, r.z, r.w}; f32x2 d = {0.f, 0.f};
#pragma unroll
    for (int i = 0; i < 4; ++i) { d += __builtin_amdgcn_cvt_pk_f32_fp8(w[i], false) * hh[2 * i]; d += __builtin_amdgcn_cvt_pk_f32_fp8(w[i], true) * hh[2 * i + 1]; }
    return d.x + d.y;
}
__device__ __forceinline__ int dppi(int x, const int ctrl_sel) { return ctrl_sel == 0 ? __builtin_amdgcn_update_dpp(0, x, 0xB1, 0xF, 0xF, true) : ctrl_sel == 1 ? __builtin_amdgcn_update_dpp(0, x, 0x4E, 0xF, 0xF, true) : __builtin_amdgcn_update_dpp(0, x, 0x141, 0xF, 0xF, true); }
__device__ __forceinline__ int i8_dot128(const v4u r, const unsigned (&hq)[4]) {
    int p = __builtin_amdgcn_sdot4((int)r.x, (int)hq[0], 0, false); p = __builtin_amdgcn_sdot4((int)r.y, (int)hq[1], p, false); p = __builtin_amdgcn_sdot4((int)r.z, (int)hq[2], p, false); p = __builtin_amdgcn_sdot4((int)r.w, (int)hq[3], p, false);
    p += dppi(p, 0); p += dppi(p, 1); p += dppi(p, 2);
    return p;
}
__device__ __forceinline__ float ssq_f32(const unsigned long long* p) { return (float)((double)__hip_atomic_load(p, RLX_AGENT) * 2.3283064365386963e-10); }
__device__ __forceinline__ void load_x1b16(const bf16* p, f32x4 (&xv)[4]) {
    const v4u a = ((const GAS v4u*)p)[0], b = ((const GAS v4u*)p)[1];
    xv[0] = (f32x4){bflo(a.x), bfhi(a.x), bflo(a.y), bfhi(a.y)}; xv[1] = (f32x4){bflo(a.z), bfhi(a.z), bflo(a.w), bfhi(a.w)};
    xv[2] = (f32x4){bflo(b.x), bfhi(b.x), bflo(b.y), bfhi(b.y)}; xv[3] = (f32x4){bflo(b.z), bfhi(b.z), bflo(b.w), bfhi(b.w)};
}
__device__ __forceinline__ void peer_h2q_rows(const Ptrs& P, int t0, int lane) {
    f32x4 xv[4][4], gv[4]; float sq[4];
#pragma unroll
    for (int r = 0; r < 4; ++r) { load_x1b16(P.XN + (size_t)(t0 + r) * D + 16 * lane, xv[r]); sq[r] = ssq_f32(P.SSQ2 + t0 + r); }
    const GAS f32x4* gr = (const GAS f32x4*)(P.ffn_g + 16 * lane);
#pragma unroll
    for (int i = 0; i < 4; ++i) gv[i] = gr[i];
#pragma unroll
    for (int r = 0; r < 4; ++r) {
        const float rs = 1.0f / sqrtf(sq[r] * (1.0f / 1024.0f) + EPS); f32x4 hv[4]; float am = 0.f;
#pragma unroll
        for (int i = 0; i < 4; ++i) { hv[i] = xv[r][i] * rs * gv[i]; am = fmaxf(fmaxf(am, fmaxf(fabsf(hv[i].x), fabsf(hv[i].y))), fmaxf(fabsf(hv[i].z), fabsf(hv[i].w))); }
        am = fmaxf(am, dpp_xor1(am)); am = fmaxf(am, dpp_xor2(am)); am = fmaxf(am, dpp_hmir(am));
        const float sc = am > 0.f ? 127.f / am : 1.f, hs = am > 0.f ? am * (1.f / 127.f) : 1.f;
        v4u q; unsigned hw[4];
#pragma unroll
        for (int i = 0; i < 4; ++i) { const f32x4 v = hv[i] * sc; hw[i] = pack_i8x4((int)__builtin_rintf(v.x), (int)__builtin_rintf(v.y), (int)__builtin_rintf(v.z), (int)__builtin_rintf(v.w)); }
        q = (v4u){hw[0], hw[1], hw[2], hw[3]};
        *(GAS v4u*)(P.H2Q + ((size_t)(lane >> 3) * M + (size_t)(t0 + r)) * 128 + 16 * (lane & 7)) = q;
        if ((lane & 7) == 0) P.HS[(size_t)(lane >> 3) * M + t0 + r] = hs;
    }
}
__device__ __forceinline__ void peer_dots_phase(Frame& F, const Ptrs& P) {
    const int nsl = F.G >> 3; if ((int)blockIdx.x >= nsl * 8) return;
    const int sx = blockIdx.x & 7, rank = blockIdx.x >> 3, lane = F.lane, k = lane >> 3, c = lane & 7;
    const int tstride = nsl * NWAVES;
    const unsigned char* tab = P.UT + (size_t)sx * NEXP * 128; const unsigned coff = 16u * (unsigned)c;
    LAS float* tl = (LAS float*)(F.lds + F.wave * 512);
    int t = rank * NWAVES + F.wave;
    if (t >= M) return;
    const unsigned char* h2p = P.H2Q + (size_t)sx * M * 128 + 16 * c; const float* hsp = P.HS + (size_t)sx * M;
    int e0 = P.SELH[(size_t)t * 128 + lane], e1 = P.SELH[(size_t)t * 128 + 64 + lane];
    v4u hqv = *(const GAS v4u*)(h2p + (size_t)t * 128); float hsv = hsp[t];
    v4u ra[8], rb[8];
    asm volatile("" ::: "memory"); __builtin_amdgcn_sched_barrier(0);
#pragma unroll
    for (int i = 0; i < 8; ++i) { const int ej = __shfl(e0, 8 * i + k); ra[i] = *(const GAS v4u*)(tab + (((unsigned)ej << 7) + coff)); }
    asm volatile("" ::: "memory"); __builtin_amdgcn_sched_barrier(0);
    for (; t < M; t += tstride) {
        const int tn = (t + tstride < M) ? t + tstride : t;
        const unsigned hq[4] = {hqv.x, hqv.y, hqv.z, hqv.w}; const float hs = hsv;
        __builtin_amdgcn_sched_barrier(0);
        const int ne0 = __builtin_nontemporal_load(P.SELH + (size_t)tn * 128 + lane), ne1 = __builtin_nontemporal_load(P.SELH + (size_t)tn * 128 + 64 + lane);
        hqv = __builtin_nontemporal_load((const v4u*)(h2p + (size_t)tn * 128)); hsv = __builtin_nontemporal_load(hsp + tn);
#pragma unroll
        for (int i = 0; i < 8; ++i) { const int ej = __shfl(e1, 8 * i + k); rb[i] = *(const GAS v4u*)(tab + (((unsigned)ej << 7) + coff)); }
        asm volatile("" ::: "memory"); __builtin_amdgcn_sched_barrier(0);
        int res[16];
#pragma unroll
        for (int i = 0; i < 8; ++i) res[i] = i8_dot128(ra[i], hq);
        asm volatile("" ::: "memory"); __builtin_amdgcn_sched_barrier(0);
#pragma unroll
        for (int i = 0; i < 8; ++i) { const int ej = __shfl(ne0, 8 * i + k); ra[i] = *(const GAS v4u*)(tab + (((unsigned)ej << 7) + coff)); }
        asm volatile("" ::: "memory"); __builtin_amdgcn_sched_barrier(0);
#pragma unroll
        for (int i = 0; i < 8; ++i) res[8 + i] = i8_dot128(rb[i], hq);
        __builtin_amdgcn_sched_barrier(0);
        if (c == 0) {
#pragma unroll
            for (int i = 0; i < 16; ++i) ((LAS int*)tl)[8 * i + k] = res[i];
        }
        const v2u pi = *(const LAS v2u*)(tl + 2 * lane);
        asm_store_b32((unsigned*)P.PART + ((size_t)sx * M + t) * 64 + lane, cvtpk((float)(int)pi.x * hs, (float)(int)pi.y * hs));
        e0 = ne0; e1 = ne1;
    }
}
__device__ __forceinline__ void peer_act_phase(Frame& F, const Ptrs& P) {
    LAS float* scl = (LAS float*)(F.lds + RING_OFF);
    __syncthreads();
#pragma unroll
    for (int i = 0; i < 16; ++i) __builtin_amdgcn_global_load_lds((const unsigned*)((const unsigned char*)P.USC + (size_t)(F.wave + 8 * i) * 1024 + F.lane * 16), (LAS unsigned*)(F.lds + RING_OFF + (F.wave + 8 * i) * 1024), 16, 0, 0);
    asm volatile("s_waitcnt vmcnt(0)" ::: "memory");
    __syncthreads();
    const size_t n4 = (size_t)M * 128 / 4, nthr = (size_t)F.G * NWAVES * 64;
    for (size_t i = (size_t)blockIdx.x * (NWAVES * 64) + F.tid; i < n4; i += nthr) {
        f32x4 d = {0.f, 0.f, 0.f, 0.f};
#pragma unroll
        for (int sx = 0; sx < 8; ++sx) { const v2u pw = ((const GAS v2u*)((const unsigned*)P.PART + (size_t)sx * M * 64))[i]; d += (f32x4){bflo(pw.x), bfhi(pw.x), bflo(pw.y), bfhi(pw.y)}; }
        const v2u e = ((const GAS v2u*)P.SELH)[i]; const f32x4 g = ((const GAS f32x4*)P.SELG)[i];
        const unsigned ee[4] = {e.x & 0xffffu, e.x >> 16, e.y & 0xffffu, e.y >> 16}; const float dd[4] = {d.x, d.y, d.z, d.w}, gg[4] = {g.x, g.y, g.z, g.w}; float w[4];
#pragma unroll
        for (int q = 0; q < 4; ++q) { const float dot = dd[q] * scl[ee[q]]; w[q] = 0.5f * dot * (1.f + erff(dot * 0.70710678118654752f)) * gg[q] * scl[NEXP + ee[q]]; }
        ((GAS v2u*)P.WB)[i] = (v2u){cvtpk(w[0], w[1]), cvtpk(w[2], w[3])};
    }
    __syncthreads();
}
__device__ __forceinline__ void fp8_axpy16(const v4u r, const float w, f32x2 (&acc)[8]) {
    const unsigned ww[4] = {r.x, r.y, r.z, r.w};
#pragma unroll
    for (int i = 0; i < 4; ++i) { acc[2 * i] += __builtin_amdgcn_cvt_pk_f32_fp8(ww[i], false) * w; acc[2 * i + 1] += __builtin_amdgcn_cvt_pk_f32_fp8(ww[i], true) * w; }
}
__device__ __forceinline__ void fp8_mul16(const v4u r, const float w, f32x2 (&acc)[8]) {
    const unsigned ww[4] = {r.x, r.y, r.z, r.w};
#pragma unroll
    for (int i = 0; i < 4; ++i) { acc[2 * i] = __builtin_amdgcn_cvt_pk_f32_fp8(ww[i], false) * w; acc[2 * i + 1] = __builtin_amdgcn_cvt_pk_f32_fp8(ww[i], true) * w; }
}
__device__ __forceinline__ void peer_accum_phase(Frame& F, const Ptrs& P) {
    const int nsl = F.G >> 3; if ((int)blockIdx.x >= nsl * 8) return;
    const int sx = blockIdx.x & 7, rank = blockIdx.x >> 3, lane = F.lane, k = lane >> 3, c = lane & 7;
    const int tstride = nsl * NWAVES;
    const unsigned char* tab = P.VT + (size_t)sx * NEXP * 128; const unsigned coff = 16u * (unsigned)c;
    const bool h5 = (lane & 32) != 0, h4 = (lane & 16) != 0, h3 = (lane & 8) != 0;
    const int chan = 128 * sx + 16 * c + 8 * (h5 ? 1 : 0) + 4 * (h3 ? 1 : 0) + 2 * (h4 ? 1 : 0);
    int t = rank * NWAVES + F.wave;
    if (t >= M) return;
    int e0 = P.SELH[(size_t)t * 128 + lane], e1 = P.SELH[(size_t)t * 128 + 64 + lane];
    float w0 = bflo(P.WB[(size_t)t * 128 + lane]), w1 = bflo(P.WB[(size_t)t * 128 + 64 + lane]);
    unsigned xres = *(const GAS unsigned*)(P.XN + (size_t)t * D + chan);
    v4u ra[8], rb[8];
    asm volatile("" ::: "memory"); __builtin_amdgcn_sched_barrier(0);
#pragma unroll
    for (int i = 0; i < 8; ++i) { const int ej = __shfl(e0, 8 * i + k); ra[i] = *(const GAS v4u*)(tab + (((unsigned)ej << 7) + coff)); }
    asm volatile("" ::: "memory"); __builtin_amdgcn_sched_barrier(0);
    for (; t < M; t += tstride) {
        const int tn = (t + tstride < M) ? t + tstride : t;
        float wsa[8], wsb[8];
#pragma unroll
        for (int i = 0; i < 8; ++i) { wsa[i] = __shfl(w0, 8 * i + k); wsb[i] = __shfl(w1, 8 * i + k); }
        asm volatile("" ::: "memory"); __builtin_amdgcn_sched_barrier(0);
        const int ne0 = __builtin_nontemporal_load(P.SELH + (size_t)tn * 128 + lane), ne1 = __builtin_nontemporal_load(P.SELH + (size_t)tn * 128 + 64 + lane);
        const float nw0 = bflo(__builtin_nontemporal_load(P.WB + (size_t)tn * 128 + lane)), nw1 = bflo(__builtin_nontemporal_load(P.WB + (size_t)tn * 128 + 64 + lane));
        const unsigned nx = __builtin_nontemporal_load((const unsigned*)(P.XN + (size_t)tn * D + chan));
#pragma unroll
        for (int i = 0; i < 8; ++i) { const int ej = __shfl(e1, 8 * i + k); rb[i] = *(const GAS v4u*)(tab + (((unsigned)ej << 7) + coff)); }
        asm volatile("" ::: "memory"); __builtin_amdgcn_sched_barrier(0);
        f32x2 acc[8];
        fp8_mul16(ra[0], wsa[0], acc);
#pragma unroll
        for (int i = 1; i < 8; ++i) fp8_axpy16(ra[i], wsa[i], acc);
        asm volatile("" ::: "memory"); __builtin_amdgcn_sched_barrier(0);
#pragma unroll
        for (int i = 0; i < 8; ++i) { const int ej = __shfl(ne0, 8 * i + k); ra[i] = *(const GAS v4u*)(tab + (((unsigned)ej << 7) + coff)); }
        asm volatile("" ::: "memory"); __builtin_amdgcn_sched_barrier(0);
#pragma unroll
        for (int i = 0; i < 8; ++i) fp8_axpy16(rb[i], wsb[i], acc);
        __builtin_amdgcn_sched_barrier(0);
        f32x2 b4[4], b2[2], b1;
#pragma unroll
        for (int i = 0; i < 4; ++i) {
            auto sx_ = __builtin_amdgcn_permlane32_swap(__float_as_uint(acc[i].x), __float_as_uint(acc[4 + i].x), false, false); auto sy_ = __builtin_amdgcn_permlane32_swap(__float_as_uint(acc[i].y), __float_as_uint(acc[4 + i].y), false, false);
            b4[i] = (f32x2){__uint_as_float(sx_[0]) + __uint_as_float(sx_[1]), __uint_as_float(sy_[0]) + __uint_as_float(sy_[1])}; }
#pragma unroll
        for (int i = 0; i < 2; ++i) { const f32x2 keep = h3 ? b4[2 + i] : b4[i], send = h3 ? b4[i] : b4[2 + i];
            b2[i] = (f32x2){keep.x + __uint_as_float(__builtin_amdgcn_update_dpp(0u, __float_as_uint(send.x), 0x128, 0xF, 0xF, true)), keep.y + __uint_as_float(__builtin_amdgcn_update_dpp(0u, __float_as_uint(send.y), 0x128, 0xF, 0xF, true))}; }
        { const f32x2 keep = h4 ? b2[1] : b2[0], send = h4 ? b2[0] : b2[1]; b1 = (f32x2){keep.x + __shfl_xor(send.x, 16), keep.y + __shfl_xor(send.y, 16)}; }
        asm_store_b64_nt(P.out + (size_t)t * D + chan, (f32x2){bflo(xres), bfhi(xres)} + b1);
        e0 = ne0; e1 = ne1; w0 = nw0; w1 = nw1; xres = nx;
    }
}

struct Args { const float* in[21]; float* out; unsigned char* ws; int ph_lo, ph_hi, li, pad; };
__device__ __forceinline__ Ptrs make_ptrs(const Args& args) {
    unsigned char* ws = args.ws;
    Ptrs P;
    P.x = args.in[0]; P.mem = args.in[1]; P.attn_g = args.in[2]; P.w_in = args.in[3]; P.conv_w = args.in[4]; P.conv_b = args.in[5]; P.conv_ln_g = args.in[6]; P.conv_ln_b = args.in[7];
    P.sb_out_g = args.in[8]; P.mem_norm_g = args.in[9]; P.w_mem_kv = args.in[10]; P.q_norm_g = args.in[11]; P.k_norm_g = args.in[12]; P.mem_out_g = args.in[13]; P.w_out = args.in[14];
    P.ffn_g = args.in[15]; P.w_peer_q = args.in[16]; P.keys1 = args.in[17]; P.keys2 = args.in[18]; P.peer_u = args.in[19]; P.peer_v = args.in[20];
    P.out = args.out;
    P.WIN = (bf16*)(ws + WS_WIN); P.WKV = (bf16*)(ws + WS_WKV); P.WOUT = (bf16*)(ws + WS_WOUT); P.WPQ = (bf16*)(ws + WS_WPQ); P.KEYS = (bf16*)(ws + WS_KEYS);
    P.MEMN = (bf16*)(ws + WS_MEMN); P.MKV = (bf16*)(ws + WS_MKV); P.UT = ws + WS_UT; P.VT = ws + WS_VT; P.PART = (float*)(ws + WS_PROJ); P.USC = (float*)(ws + WS_SC); P.VSC = (float*)(ws + WS_SC) + NEXP; P.XN = (bf16*)(ws + WS_XN); P.CAT = (bf16*)(ws + WS_CAT);
    P.PROJ = (bf16*)(ws + WS_PROJ); P.Q = (bf16*)(ws + WS_Q); P.SELH = (unsigned short*)(ws + WS_SELI); P.WB = (unsigned short*)(ws + WS_CAT); P.SELG = (float*)(ws + WS_SELG); P.SSQ2 = (unsigned long long*)((unsigned*)(ws + WS_CTL) + CW_SSQ2); P.KF = (bf16*)(ws + WS_KF); P.MKF = (bf16*)(ws + WS_MKF); P.H2Q = ws + WS_KF; P.HS = (float*)(ws + WS_MKF);
    return P;
}
__global__ void __launch_bounds__(NWAVES * 64, 2) fwd_kernel(Args args) {
    extern __shared__ __attribute__((aligned(16))) unsigned char lds[];
    Frame F;
    F.lds = (LAS unsigned char*)lds;
    F.MISC = (volatile LAS unsigned*)(F.lds + MISC_OFF);
    F.tid = threadIdx.x; F.lane = F.tid & 63; F.wave = __builtin_amdgcn_readfirstlane(F.tid >> 6);
    F.G = gridDim.x; { const int bx = blockIdx.x; F.vcu = (F.G % 8 == 0) ? (bx % 8) * (F.G / 8) + bx / 8 : bx; }
    unsigned char* ws = args.ws;
    F.ctl = (gu32*)(ws + WS_CTL);
    for (int u = F.tid; u < (LDS_BYTES - LDSCTL_OFF) / 4; u += NWAVES * 64) ((LAS unsigned*)(F.lds + LDSCTL_OFF))[u] = 0u;
    __syncthreads();
    XcdBarrier bar; bar.bar = (unsigned*)(F.ctl + CW_BAR); bar.x = 0; bar.st = nullptr;
    if (N_LAUNCHES != PER_PHASE) bar = xcd_barrier_post((unsigned*)(F.ctl + CW_BAR), F.MISC + 8);
#define GRID_BAR() do { if (N_LAUNCHES != PER_PHASE) xcd_barrier(bar); } while (0)
    const int lo = args.ph_lo, hi = args.ph_hi;
#define IN(k) (lo <= (k) && (k) < hi)
#define BOTH(k) (IN(k) && IN((k) + 1))

    if (IN(0)) { const Ptrs P = make_ptrs(args); for (int rep = 0; rep < (PROBE_DBL == 0 ? 2 : 1); ++rep) p0_prologue(F, P); if (BOTH(0)) GRID_BAR(); }

    if (IN(1)) { const Ptrs P = make_ptrs(args);
        { pg8::Gemm g{P.XN, P.WIN, M, INW, D}; pg8::StaticOrder S; S.init(M, INW, F.G, (int)blockIdx.x);
          pg8::EpiBf16K E{P.PROJ, INW, P.KF, C_K / 256, C_K / 256 + 1, 8, C_Q / 256, C_Q / 256 + 1, 0.125f * 1.4426950408889634f};
          for (int rep = 0; rep < (PROBE_DBL == 1 ? 2 : 1); ++rep)
          pg8::gemm_phase<pg8::EpiBf16K, pg8::StaticOrder, PG8_ALIGN, PG8_SP2>(F.lds + RING_OFF, g, S, E); }
        { pg8::Gemm g{P.MEMN, P.WKV, MMEM, KVW, D}; pg8::StaticOrder S; S.init(MMEM, KVW, F.G, (int)((blockIdx.x + (unsigned)(F.G / 2)) % (unsigned)F.G));
          pg8::EpiBf16K E{P.MKV, KVW, P.MKF, 0, 0, 4, 1, 0, 1.0f};
          pg8::gemm_phase<pg8::EpiBf16K, pg8::StaticOrder, PG8_ALIGN, PG8_SP2>(F.lds + RING_OFF, g, S, E); }
        { const int first = (F.G == 256) ? 144 : 0; const int wg = (int)blockIdx.x;
          if (wg >= first) { const int gw = (wg - first) * NWAVES + F.wave, NGW = (F.G - first) * NWAVES;
              if (LATE_TRANSPOSES) { __syncthreads(); p0_late_transposes(F, P, gw, NGW); }
              for (int r = gw * 4; r < NEXP + P1_VROWS; r += NGW * 4) { if (r < NEXP) rows_to_i8<4>(P.peer_u, P.UT, P.USC, r, F.lane); else rows_to_fp8<4>(P.peer_v, P.VT, P.VSC, r - NEXP, F.lane); } } }
        if (BOTH(1)) GRID_BAR();
    }

    if (IN(2)) { const Ptrs P = make_ptrs(args);
        const int c = F.vcu;
        for (int rep = 0; rep < (PROBE_DBL == 2 ? 2 : 1); ++rep) {
        const int cls = (blockIdx.x >> 3) & 3;
#define P2_SB(F) do { for (int r2 = 0; r2 < (PROBE_DBL == 20 ? 2 : 1); ++r2) { \
            const bool deal = (F.G == 256); const int nit = deal ? 2 : (BATCH * (SEQ / 64) - c + F.G - 1) / F.G; \
            for (int i = 0; i < nit; ++i) { const int it = c + i * F.G, s = c & 31; const int b = deal ? (c >> 5) : (it >> 6), g = deal ? (i == 0 ? 63 - s : s) : (it & 63); sb_item_mfma(F, P, b, g); } } __syncthreads(); } while (0)
#define P2_MEM(F) do { for (int r2 = 0; r2 < (PROBE_DBL == 21 ? 2 : 1); ++r2) for (int it = c; it < BATCH * (SEQ / 128); it += F.G) mem_item_mfma(F, P, it >> 5, it & 31); __syncthreads(); } while (0)
#define P2_CONV(F) do { for (int r2 = 0; r2 < (PROBE_DBL == 22 ? 2 : 1); ++r2) conv_phase(F, P); __syncthreads(); } while (0)
#define P2_TAB(F) do { const int gw = F.vcu * NWAVES + F.wave, NGW = F.G * NWAVES; \
            for (int r = ((F.G == 256) ? P1_VROWS : 0) + gw * 4; r < NEXP; r += NGW * 4) rows_to_fp8<4>(P.peer_v, P.VT, P.VSC, r, F.lane); __syncthreads(); } while (0)
        if (cls == 0)      { Frame Fa = F; asm volatile("" : "+v"(Fa.tid), "+v"(Fa.lane)); P2_SB(Fa); P2_MEM(Fa); P2_CONV(Fa); P2_TAB(Fa); }
        else if (cls == 1) { Frame Fb = F; asm volatile("" : "+v"(Fb.tid), "+v"(Fb.lane)); P2_TAB(Fb); P2_CONV(Fb); P2_MEM(Fb); P2_SB(Fb); }
        else if (cls == 2) { Frame Fc = F; asm volatile("" : "+v"(Fc.tid), "+v"(Fc.lane)); P2_CONV(Fc); P2_SB(Fc); P2_TAB(Fc); P2_MEM(Fc); }
        else               { Frame Fd = F; asm volatile("" : "+v"(Fd.tid), "+v"(Fd.lane)); P2_MEM(Fd); P2_TAB(Fd); P2_SB(Fd); P2_CONV(Fd); }
#undef P2_SB
#undef P2_MEM
#undef P2_CONV
#undef P2_TAB
        }
        if (BOTH(2)) GRID_BAR();
    }

    if (IN(3)) { const Ptrs P = make_ptrs(args);
        pg8::Gemm g{P.CAT, P.WOUT, M, D, D}; pg8::StaticOrder S; S.init(M, D, F.G, (int)blockIdx.x);
        pg8::EpiResid E{P.x, P.XN, P.SSQ2, D};
        pg8::gemm_phase<pg8::EpiResid, pg8::StaticOrder, PG8_ALIGN, PG8_SP2>(F.lds + RING_OFF, g, S, E);
        if (PROBE_DBL == 3) { pg8::EpiResid E2{P.x, P.XN, (unsigned long long*)P.SELG, D}; pg8::gemm_phase<pg8::EpiResid, pg8::StaticOrder, PG8_ALIGN, PG8_SP2>(F.lds + RING_OFF, g, S, E2); }
        if (BOTH(3)) GRID_BAR();
    }

    if (IN(4)) { const Ptrs P = make_ptrs(args);
        pg8::Gemm g{P.XN, P.WPQ, M, PQW, D}; pg8::StaticOrder S; S.init(M, PQW, F.G, (int)blockIdx.x);
        pg8::EpiBf16RowQ E{P.Q, PQW, P.SSQ2};
        for (int rep = 0; rep < (PROBE_DBL == 4 ? 2 : 1); ++rep)
        pg8::gemm_phase<pg8::EpiBf16RowQ, pg8::StaticOrder, PG8_ALIGN, PG8_SP2>(F.lds + RING_OFF, g, S, E);
        asm volatile("s_waitcnt vmcnt(0)" ::: "memory");
        __builtin_amdgcn_fence(__ATOMIC_ACQUIRE, "agent");
        asm volatile("s_waitcnt vmcnt(0)" ::: "memory");
        __syncthreads();
        for (int rep = 0; rep < (PROBE_DBL == 5 ? 2 : 1); ++rep) { pg8::Unit u; int prev = -1;
            for (int j = 0; j < 2; ++j) for (int i = j; S.next(i, u); i += 2) { peer_select_mfma(F, P, u.pm, u.pn, u.pn != prev); prev = u.pn; } }
        { const int gw = F.vcu * NWAVES + F.wave, NGW = F.G * NWAVES; for (int g4 = gw; g4 < M / 4; g4 += NGW) peer_h2q_rows(P, 4 * g4, F.lane); }
        __syncthreads();
        if (BOTH(4)) GRID_BAR();
    }
    if (IN(6)) { const Ptrs P = make_ptrs(args); for (int rep = 0; rep < (PROBE_DBL == 6 ? 2 : 1); ++rep) peer_dots_phase(F, P); if (BOTH(6)) GRID_BAR(); }
    if (IN(7)) { const Ptrs P = make_ptrs(args); for (int rep = 0; rep < (PROBE_DBL == 7 ? 2 : 1); ++rep) peer_act_phase(F, P); if (BOTH(7)) GRID_BAR(); }
    if (IN(8)) { const Ptrs P = make_ptrs(args); for (int rep = 0; rep < (PROBE_DBL == 8 ? 2 : 1); ++rep) peer_accum_phase(F, P); }
#undef IN
#undef BOTH
}

extern "C" void kernel_launch(void* const* d_in, const int* in_sizes, int n_in, void* d_out, int out_size, void* d_ws, size_t ws_size, hipStream_t stream) {
    static int grid = 0;
    if (grid == 0) {
        if (n_in != 21 || in_sizes[0] != M * D || out_size != M * D || ws_size < WS_END) { fprintf(stderr, "kernel_launch: unexpected shapes/workspace (n_in %d, in0 %d, out %d, ws %zu); nothing launched\n", n_in, n_in > 0 ? in_sizes[0] : -1, out_size, ws_size); grid = -1; return; }
        int dev = 0, cus = 0, per_cu = 0;
        if (hipGetDevice(&dev) != hipSuccess || hipDeviceGetAttribute(&cus, hipDeviceAttributeMultiprocessorCount, dev) != hipSuccess) { grid = -1; return; }
        if (hipFuncSetAttribute((const void*)fwd_kernel, hipFuncAttributeMaxDynamicSharedMemorySize, LDS_BYTES) != hipSuccess) { fprintf(stderr, "kernel_launch: hipFuncSetAttribute failed\n"); grid = -1; return; }
        if (hipOccupancyMaxActiveBlocksPerMultiprocessor(&per_cu, (const void*)fwd_kernel, NWAVES * 64, LDS_BYTES) != hipSuccess || per_cu < 1) { fprintf(stderr, "kernel_launch: occupancy query says %d blocks per CU\n", per_cu); }
        (void)hipGetLastError();
        grid = cus;
    }
    if (grid < 0) return;
    if (hipMemsetAsync((char*)d_ws + WS_CTL, 0, CTL_ZERO_BYTES, stream) != hipSuccess) { fprintf(stderr, "kernel_launch: memset failed\n"); return; }
    Args a{};
    for (int i = 0; i < 21; ++i) a.in[i] = (const float*)d_in[i];
    a.out = (float*)d_out; a.ws = (unsigned char*)d_ws;
    for (int li = 0; li < N_LAUNCHES; ++li) {
        a.ph_lo = (N_LAUNCHES == PER_PHASE) ? li : 0; a.ph_hi = (N_LAUNCHES == PER_PHASE) ? li + 1 : PER_PHASE; a.li = li;
        { void* kargs[] = {(void*)&a}; (void)hipLaunchCooperativeKernel((const void*)fwd_kernel, dim3(grid), dim3(NWAVES * 64), kargs, LDS_BYTES, stream); }
        const hipError_t le = hipPeekAtLastError();
        if (le != hipSuccess) { fprintf(stderr, "kernel_launch: launch %d failed: %s\n", li, hipGetErrorName(le)); break; }
    }
}
```
